# Optimizing an MI355X kernel written in HIP

```python
import math
import jax
import jax.numpy as jnp
from jax import lax
import numpy as np

D_MODEL = 1024
BATCH = 8
SEQ = 2048
DEPTH = 2

CTX_LEN = 256
GRID_W = 64
EPS = 1e-6
F32 = jnp.float32

N_AB = (DEPTH + 1) // 2
N_C = DEPTH // 2

A_HEADS = 4
A_DK = 128
A_DV = 128
A_WIDTH = A_HEADS * A_DV
CHUNK = 64
CONV_W = 4

B_WIDTH = 512
B_BLOCKS = 8
B_BLK = B_WIDTH // B_BLOCKS
RG_C = 8.0

AB_PROJ = 4 * A_WIDTH + 4 * A_HEADS + 2 * B_WIDTH
MIX_WIDTH = A_WIDTH + B_WIDTH

C_HEADS = 8
C_KV_HEADS = 2
C_HD = 128
C_QBLOCK = 128
ROPE_THETA = 10000.0
C_QKV = (C_HEADS + 2 * C_KV_HEADS) * C_HD

N_GROUPS = 4
EXP_PER_GROUP = 8
N_EXPERTS = N_GROUPS * EXP_PER_GROUP
D_EXPERT = 512
TOP_K = 2

kernel_name = "hybrid_deltanet_rglru_gqa_hmoe_dit"


def rms_norm(x, w):
    xf = x.astype(F32)
    y = xf * lax.rsqrt(jnp.mean(xf * xf, axis=-1, keepdims=True) + EPS)
    return (y * w.astype(F32)).astype(x.dtype)


def l2norm(x):
    return x * lax.rsqrt(jnp.sum(x * x, axis=-1, keepdims=True) + EPS)


def ada_mod(cond, w, b):
    m = jax.nn.silu(cond) @ w + b
    return [t[:, None, :] for t in jnp.split(m, 6, axis=-1)]


def modulate(x, gain, shift, scale):
    return rms_norm(x, gain) * (1 + scale) + shift


def dw_conv(x, w):
    ch = x.shape[-1]
    pad = (CONV_W // 2, CONV_W - 1 - CONV_W // 2)
    return lax.conv_general_dilated(x, w[:, None, :].astype(x.dtype), window_strides=(1,), padding=[pad],
                                    dimension_numbers=('NWC', 'WIO', 'NWC'), feature_group_count=ch)


def gated_delta_chunked(q, k, v, g, beta, s0):
    bsz, t, nh, _ = q.shape
    dv = v.shape[-1]
    n = t // CHUNK

    def to_chunks(a):
        return jnp.moveaxis(a.reshape(bsz, n, CHUNK, nh, *a.shape[3:]), 3, 1)

    q, k, v, g, beta = [to_chunks(a) for a in (q, k, v, g, beta)]
    gc = jnp.cumsum(g, axis=-1)
    idx = jnp.arange(CHUNK)
    lower = idx[:, None] >= idx[None, :]
    strict = idx[:, None] > idx[None, :]
    diff = gc[..., :, None] - gc[..., None, :]
    decay = jnp.where(lower, jnp.exp(jnp.where(lower, diff, 0.0)), 0.0)
    kb = k * beta[..., None]
    lmat = jnp.where(strict, jnp.einsum('bhnid,bhnjd->bhnij', kb, k) * decay, 0.0)
    eye = jnp.eye(CHUNK, dtype=F32)
    rhs = jnp.concatenate([v * beta[..., None], kb * jnp.exp(gc)[..., None]], axis=-1)
    sol = lax.linalg.triangular_solve(lmat + eye, rhs, left_side=True, lower=True, unit_diagonal=True)
    u, w = sol[..., :dv], sol[..., dv:]
    attn = jnp.einsum('bhnid,bhnjd->bhnij', q, k) * decay
    q_dec = q * jnp.exp(gc)[..., None]
    g_last = gc[..., -1]
    k_dec = k * jnp.exp(g_last[..., None] - gc)[..., None]

    def step(s, xs):
        u_i, w_i, q_i, k_i, a_i, gl_i = xs
        v_new = u_i - jnp.einsum('bhcd,bhde->bhce', w_i, s)
        o_i = jnp.einsum('bhcd,bhde->bhce', q_i, s) + jnp.einsum('bhij,bhje->bhie', a_i, v_new)
        s = s * jnp.exp(gl_i)[..., None, None] + jnp.einsum('bhcd,bhce->bhde', k_i, v_new)
        return s, o_i

    xs = [jnp.moveaxis(a, 2, 0) for a in (u, w, q_dec, k_dec, attn, g_last)]
    s_fin, o = lax.scan(step, s0, xs)
    o = jnp.transpose(o, (1, 0, 3, 2, 4)).reshape(bsz, t, nh, dv)
    return o, s_fin


def linear_scan(a, b, h0):
    def comb(left, right):
        al, bl = left
        ar, br = right
        return al * ar, ar * bl + br
    acum, bcum = lax.associative_scan(comb, (a, b), axis=1)
    h = acum * h0[:, None, :] + bcum
    return h, h[:, -1]


def bidirectional(run, ctx_f, lat_f, ctx_b, lat_b, s0):
    rev = lambda xs: [jnp.flip(a, axis=1) for a in xs]
    oc_f, sc_f = run(*ctx_f, s0)
    ol_f, _ = run(*lat_f, sc_f)
    oc_b, sc_b = run(*rev(ctx_b), s0)
    ol_b, _ = run(*rev(lat_b), sc_b)
    return oc_f + jnp.flip(oc_b, axis=1), ol_f + jnp.flip(ol_b, axis=1)


def ab_mixer(h_ctx, h_lat, w_in, conv_qkv, a_log, dt_bias, onorm, conv_x,
             rg_wr, rg_br, rg_wi, rg_bi, rg_lam, w_out):
    o1 = 3 * A_WIDTH
    o2 = 4 * A_WIDTH
    o3 = o2 + 4 * A_HEADS
    o4 = o3 + B_WIDTH

    def prep(h):
        bsz, t, _ = h.shape
        z = h @ w_in
        qkv = jax.nn.silu(dw_conv(z[..., :o1], conv_qkv)).astype(F32)
        q, k, v = [a.reshape(bsz, t, A_HEADS, A_DK) for a in jnp.split(qkv, 3, axis=-1)]
        q = l2norm(q) * A_DK ** -0.5
        k = l2norm(k)
        gates = z[..., o2:o3].astype(F32).reshape(bsz, t, 2, 2, A_HEADS)
        decay = -jnp.exp(a_log.astype(F32)) * jax.nn.softplus(gates[:, :, :, 0] + dt_bias)
        beta = jax.nn.sigmoid(gates[:, :, :, 1])
        xc = dw_conv(z[..., o3:o4], conv_x).astype(F32)
        xcb = xc.reshape(bsz, t, B_BLOCKS, B_BLK)
        r = jax.nn.sigmoid(jnp.einsum('btgk,dgkj->btdgj', xcb, rg_wr) + rg_br).reshape(bsz, t, 2, B_WIDTH)
        i = jax.nn.sigmoid(jnp.einsum('btgk,dgkj->btdgj', xcb, rg_wi) + rg_bi).reshape(bsz, t, 2, B_WIDTH)
        log_a = -RG_C * r * jax.nn.softplus(-rg_lam.astype(F32))
        a = jnp.exp(log_a)
        b = jnp.sqrt(-jnp.expm1(2.0 * log_a)) * i * xc[:, :, None, :]
        delta_dirs = [(q, k, v, decay[:, :, d], beta[:, :, d]) for d in (0, 1)]
        lru_dirs = [(a[:, :, d], b[:, :, d]) for d in (0, 1)]
        return delta_dirs, lru_dirs, z[..., o1:o2], z[..., o4:]

    dc, lc, gout_c, y_c = prep(h_ctx)
    dl, ll, gout_l, y_l = prep(h_lat)
    bsz = h_lat.shape[0]
    s0_delta = jnp.zeros((bsz, A_HEADS, A_DK, A_DV), F32)
    s0_lru = jnp.zeros((bsz, B_WIDTH), F32)
    oa_c, oa_l = bidirectional(gated_delta_chunked, dc[0], dl[0], dc[1], dl[1], s0_delta)
    ob_c, ob_l = bidirectional(linear_scan, lc[0], ll[0], lc[1], ll[1], s0_lru)

    def merge(oa, ob, gout, y):
        b_, t = oa.shape[:2]
        ya = rms_norm(oa, onorm).reshape(b_, t, A_WIDTH) * jax.nn.silu(gout.astype(F32))
        yb = ob * jax.nn.gelu(y.astype(F32))
        return jnp.concatenate([ya, yb], axis=-1).astype(h_lat.dtype) @ w_out

    return merge(oa_c, ob_c, gout_c, y_c), merge(oa_l, ob_l, gout_l, y_l)


def axial_rope(t):
    rows = t // GRID_W
    row = jnp.repeat(jnp.arange(rows, dtype=F32), GRID_W)
    col = jnp.tile(jnp.arange(GRID_W, dtype=F32), rows)
    n_freq = C_HD // 4
    inv = ROPE_THETA ** (-jnp.arange(n_freq, dtype=F32) / n_freq)
    ang = jnp.concatenate([row[:, None] * inv, col[:, None] * inv], axis=-1)
    return jnp.cos(ang), jnp.sin(ang)


def apply_rope(x, cos, sin):
    xf = x.astype(F32).reshape(*x.shape[:-1], C_HD // 2, 2)
    x1, x2 = xf[..., 0], xf[..., 1]
    c = cos[None, :, None, :]
    s = sin[None, :, None, :]
    out = jnp.stack([x1 * c - x2 * s, x1 * s + x2 * c], axis=-1).reshape(x.shape)
    return out.astype(x.dtype)


def blocked_attention(q, k, v):
    bsz, tq = q.shape[:2]
    nblk = tq // C_QBLOCK
    grp = C_HEADS // C_KV_HEADS
    qb = (q * C_HD ** -0.5).reshape(bsz, nblk, C_QBLOCK, C_KV_HEADS, grp, C_HD)
    qb = jnp.moveaxis(qb, 1, 0)

    def one_block(qi):
        s = jnp.einsum('bqhgd,bkhd->bhgqk', qi, k, preferred_element_type=F32)
        p = jax.nn.softmax(s, axis=-1).astype(v.dtype)
        return jnp.einsum('bhgqk,bkhd->bqhgd', p, v)

    o = lax.map(one_block, qb)
    return jnp.moveaxis(o, 0, 1).reshape(bsz, tq, C_HEADS * C_HD)


def attn_mixer(h_ctx, h_lat, w_qkv, q_norm, k_norm, w_out, need_ctx):
    nq = C_HEADS * C_HD
    nk = C_KV_HEADS * C_HD
    heads = lambda z, n: z.reshape(*z.shape[:2], n, C_HD)
    t = h_lat.shape[1]
    zl = h_lat @ w_qkv
    cos, sin = axial_rope(t)
    ql = apply_rope(rms_norm(heads(zl[..., :nq], C_HEADS), q_norm), cos, sin)
    kl = apply_rope(rms_norm(heads(zl[..., nq:nq + nk], C_KV_HEADS), k_norm), cos, sin)
    vl = heads(zl[..., nq + nk:], C_KV_HEADS)
    zc = h_ctx @ w_qkv[:, nq:]
    kc = rms_norm(heads(zc[..., :nk], C_KV_HEADS), k_norm)
    vc = heads(zc[..., nk:], C_KV_HEADS)
    k_all = jnp.concatenate([kl, kc], axis=1)
    v_all = jnp.concatenate([vl, vc], axis=1)
    y_lat = blocked_attention(ql, k_all, v_all) @ w_out
    y_ctx = None
    if need_ctx:
        qc = rms_norm(heads(h_ctx @ w_qkv[:, :nq], C_HEADS), q_norm)
        y_ctx = blocked_attention(qc, kc, vc) @ w_out
    return y_ctx, y_lat


def hier_moe(h, w_grp, b_grp, w_exp, b_exp, w_gate, w_up, w_down):
    bsz, t, d = h.shape
    x = h.reshape(bsz * t, d)
    g_logit = (x @ w_grp).astype(F32) + b_grp
    _, g_idx = lax.top_k(g_logit, 1)
    g_w = jnp.take_along_axis(jax.nn.softmax(g_logit, axis=-1), g_idx, axis=-1)
    e_logit = ((x @ w_exp).astype(F32) + b_exp).reshape(-1, N_GROUPS, EXP_PER_GROUP)
    e_in = jnp.take_along_axis(e_logit, g_idx[:, :, None], axis=1)[:, 0]
    e_val, e_idx = lax.top_k(e_in, TOP_K)
    w_sel = jax.nn.softmax(e_val, axis=-1) * g_w
    expert = g_idx * EXP_PER_GROUP + e_idx
    gates = jnp.sum(jax.nn.one_hot(expert, N_EXPERTS, dtype=F32) * w_sel[..., None], axis=1)
    hg = jnp.einsum('nd,edf->nef', x, w_gate).astype(F32)
    hu = jnp.einsum('nd,edf->nef', x, w_up).astype(F32)
    act = (jax.nn.silu(hg) * hu * gates[..., None]).astype(x.dtype)
    y = jnp.einsum('nef,efd->nd', act, w_down)
    return y.reshape(bsz, t, d).astype(h.dtype)


def setup_inputs(seed: int = 0) -> dict:
    key = jax.random.key(seed)
    k = jax.random.split(key, 32)
    nrm = lambda i, shape, scale: jax.random.normal(k[i], shape, F32) * scale
    gain = lambda i, shape: 1.0 + 0.05 * jax.random.normal(k[i], shape, F32)
    a_log = jnp.log(jax.random.uniform(k[10], (N_AB, 2, A_HEADS), F32, 1.0, 16.0))
    dt = jnp.exp(jax.random.uniform(k[11], (N_AB, 2, A_HEADS), F32, math.log(1e-3), math.log(0.1)))
    dt_bias = dt + jnp.log(-jnp.expm1(-dt))
    a_base = jax.random.uniform(k[18], (N_AB, 2, B_WIDTH), F32, 0.9, 0.999) ** (1.0 / RG_C)
    rg_lam = jnp.log(a_base) - jnp.log1p(-a_base)
    return {
        'x': nrm(0, (BATCH, SEQ, D_MODEL), 1.0),
        'c': nrm(1, (BATCH, D_MODEL), 1.0),
        'ctx': nrm(2, (BATCH, CTX_LEN, D_MODEL), 1.0),
        'c_ctx': nrm(3, (D_MODEL,), 1.0),
        'ada_w': nrm(4, (DEPTH, D_MODEL, 6 * D_MODEL), D_MODEL ** -0.5),
        'ada_b': nrm(5, (DEPTH, 6 * D_MODEL), 0.02),
        'norm1': gain(6, (DEPTH, D_MODEL)),
        'norm2': gain(7, (DEPTH, D_MODEL)),
        'final_norm': gain(8, (D_MODEL,)),
        'ab_w_in': nrm(9, (N_AB, D_MODEL, AB_PROJ), D_MODEL ** -0.5),
        'ab_conv_qkv': nrm(12, (N_AB, CONV_W, 3 * A_WIDTH), CONV_W ** -0.5),
        'ab_a_log': a_log,
        'ab_dt_bias': dt_bias,
        'ab_onorm': gain(13, (N_AB, A_DV)),
        'ab_conv_x': nrm(14, (N_AB, CONV_W, B_WIDTH), CONV_W ** -0.5),
        'ab_rg_wr': nrm(15, (N_AB, 2, B_BLOCKS, B_BLK, B_BLK), B_BLK ** -0.5),
        'ab_rg_br': nrm(16, (N_AB, 2, B_BLOCKS, B_BLK), 0.1),
        'ab_rg_wi': nrm(17, (N_AB, 2, B_BLOCKS, B_BLK, B_BLK), B_BLK ** -0.5),
        'ab_rg_bi': nrm(19, (N_AB, 2, B_BLOCKS, B_BLK), 0.1),
        'ab_rg_lam': rg_lam,
        'ab_w_out': nrm(20, (N_AB, MIX_WIDTH, D_MODEL), MIX_WIDTH ** -0.5),
        'at_w_qkv': nrm(21, (N_C, D_MODEL, C_QKV), D_MODEL ** -0.5),
        'at_q_norm': gain(22, (N_C, C_HD)),
        'at_k_norm': gain(23, (N_C, C_HD)),
        'at_w_out': nrm(24, (N_C, C_HEADS * C_HD, D_MODEL), (C_HEADS * C_HD) ** -0.5),
        'moe_w_grp': nrm(25, (DEPTH, D_MODEL, N_GROUPS), D_MODEL ** -0.5),
        'moe_b_grp': nrm(26, (DEPTH, N_GROUPS), 0.01),
        'moe_w_exp': nrm(27, (DEPTH, D_MODEL, N_EXPERTS), D_MODEL ** -0.5),
        'moe_b_exp': nrm(28, (DEPTH, N_EXPERTS), 0.01),
        'moe_w_gate': nrm(29, (DEPTH, N_EXPERTS, D_MODEL, D_EXPERT), D_MODEL ** -0.5),
        'moe_w_up': nrm(30, (DEPTH, N_EXPERTS, D_MODEL, D_EXPERT), D_MODEL ** -0.5),
        'moe_w_down': nrm(31, (DEPTH, N_EXPERTS, D_EXPERT, D_MODEL), D_EXPERT ** -0.5),
    }


def reference(x, c, ctx, c_ctx, ada_w, ada_b, norm1, norm2, final_norm,
              ab_w_in, ab_conv_qkv, ab_a_log, ab_dt_bias, ab_onorm, ab_conv_x,
              ab_rg_wr, ab_rg_br, ab_rg_wi, ab_rg_bi, ab_rg_lam, ab_w_out,
              at_w_qkv, at_q_norm, at_k_norm, at_w_out,
              moe_w_grp, moe_b_grp, moe_w_exp, moe_b_exp, moe_w_gate, moe_w_up, moe_w_down):
    for l in range(DEPTH):
        last = l == DEPTH - 1
        j = l // 2
        sh1, sc1, g1, sh2, sc2, g2 = ada_mod(c, ada_w[l], ada_b[l])
        csh1, csc1, cg1, csh2, csc2, cg2 = ada_mod(c_ctx[None], ada_w[l], ada_b[l])
        h_lat = modulate(x, norm1[l], sh1, sc1)
        h_ctx = modulate(ctx, norm1[l], csh1, csc1)
        if l % 2 == 0:
            y_ctx, y_lat = ab_mixer(h_ctx, h_lat, ab_w_in[j], ab_conv_qkv[j], ab_a_log[j], ab_dt_bias[j],
                                    ab_onorm[j], ab_conv_x[j], ab_rg_wr[j], ab_rg_br[j], ab_rg_wi[j],
                                    ab_rg_bi[j], ab_rg_lam[j], ab_w_out[j])
        else:
            y_ctx, y_lat = attn_mixer(h_ctx, h_lat, at_w_qkv[j], at_q_norm[j], at_k_norm[j], at_w_out[j],
                                      not last)
        x = x + g1 * y_lat
        if not last:
            ctx = ctx + cg1 * y_ctx
        moe_p = (moe_w_grp[l], moe_b_grp[l], moe_w_exp[l], moe_b_exp[l], moe_w_gate[l], moe_w_up[l], moe_w_down[l])
        x = x + g2 * hier_moe(modulate(x, norm2[l], sh2, sc2), *moe_p)
        if not last:
            ctx = ctx + cg2 * hier_moe(modulate(ctx, norm2[l], csh2, csc2), *moe_p)
    return rms_norm(x, final_norm)
```

```cpp
#include <hip/hip_runtime.h>
#include <stdint.h>

#ifndef ONE_LAUNCH
#define ONE_LAUNCH 0
#endif

typedef unsigned short bf16_t;
typedef __attribute__((ext_vector_type(8))) short bf16x8;
typedef __attribute__((ext_vector_type(4))) float f32x4;

#define D_MODEL 1024
#define BATCH 8
#define SEQ 2048
#define CTXL 256
#define NL (BATCH * SEQ)
#define NC (BATCH * CTXL)
#define NT (NL + NC)
#define AB_PROJ 3088
#define TSEQ (SEQ + CTXL)
#define EPSF 1e-6f
#define NTHR 512

enum { I_X = 0, I_C, I_CTX, I_CCTX, I_ADAW, I_ADAB, I_NORM1, I_NORM2, I_FNORM, I_ABWIN, I_CONVQKV, I_ALOG, I_DTB,
       I_ONORM, I_CONVX, I_RGWR, I_RGBR, I_RGWI, I_RGBI, I_RGLAM, I_ABWOUT, I_ATWQKV, I_QNORM, I_KNORM, I_ATWOUT,
       I_WGRP, I_BGRP, I_WEXP, I_BEXP, I_WGATE, I_WUP, I_WDOWN };

#define AL256(x) (((size_t)(x) + 255) & ~(size_t)255)
#define OFF_ZERO 0
#define ZERO_BYTES 65536
#define OFF_CNT 16384
#define OFF_MOD (OFF_ZERO + ZERO_BYTES)
#define OFF_X AL256(OFF_MOD + 2 * 9 * 6144 * 4)
#define OFF_H AL256(OFF_X + (size_t)NT * 1024 * 4)
#define OFF_Z AL256(OFF_H + (size_t)NT * 1024 * 2)
#define OFF_QKVC AL256(OFF_Z + (size_t)NT * AB_PROJ * 2)
#define OFF_G AL256(OFF_QKVC + (size_t)NT * 1536 * 2)
#define OFF_BETA AL256(OFF_G + (size_t)2 * NT * 4 * 4)
#define OFF_LA AL256(OFF_BETA + (size_t)2 * NT * 4 * 4)
#define OFF_LB AL256(OFF_LA + (size_t)2 * NT * 512 * 4)
#define OFF_OA AL256(OFF_LB + (size_t)2 * NT * 512 * 4)
#define OFF_WSEL AL256(OFF_OA + (size_t)2 * NT * 512 * 2)
#define OFF_LIST AL256(OFF_WSEL + (size_t)2 * NT * 4)
#define OFF_END AL256(OFF_LIST + (size_t)32 * NT * 4)
#define OFF_ACT OFF_QKVC
#define OFF_YE OFF_LA
#define OFF_ZQ OFF_Z
#define OFF_ZC (OFF_Z + (size_t)NL * 1536 * 2)
#define OFF_QA OFF_LB
#define OFF_KA (OFF_QA + (size_t)NL * 1024 * 2)
#define OFF_VT (OFF_KA + (size_t)8 * 2 * TSEQ * 128 * 2)
#define OFF_O OFF_H

struct Params {
    const float* in[32];
    float* out;
    char* ws;
};

__device__ __forceinline__ bf16_t f2bf(float f) {
    unsigned u = __float_as_uint(f);
    u += 0x7fffu + ((u >> 16) & 1u);
    return (bf16_t)(u >> 16);
}
__device__ __forceinline__ float bf2f(bf16_t h) { return __uint_as_float(((unsigned)h) << 16); }
__device__ __forceinline__ unsigned pack2(float a, float b) { return (unsigned)f2bf(a) | ((unsigned)f2bf(b) << 16); }
__device__ __forceinline__ float sigmoidf_(float x) { return 1.f / (1.f + __expf(-x)); }
__device__ __forceinline__ float siluf_(float x) { return x / (1.f + __expf(-x)); }
__device__ __forceinline__ float softplusf_(float x) { return x > 20.f ? x : log1pf(__expf(x)); }
__device__ __forceinline__ float geluf_(float x) {
    const float u = 0.7978845608028654f * (x + 0.044715f * x * x * x);
    return 0.5f * x * (1.f + tanhf(u));
}
__device__ __forceinline__ float wave_sum(float v) {
#pragma unroll
    for (int o = 32; o >= 1; o >>= 1) v += __shfl_xor(v, o, 64);
    return v;
}
__device__ __forceinline__ int scan_row(int s, int dir, int b) {
    if (s < CTXL) { const int t = dir ? (CTXL - 1 - s) : s; return NL + b * CTXL + t; }
    const int u = s - CTXL; const int t = dir ? (SEQ - 1 - u) : u; return b * SEQ + t;
}

#define XB_TMO      128
#define XB_XCNT(j)  (256  + 64 * (j))
#define XB_XSUB(j)  (1280 + 64 * (j))
#define XB_XGEN(j)  (2304 + 64 * (j))
#define XB_TOP      3328
#define XB_TOPGEN   3392
#define XCD_BAR_WORDS 3456
#define XB_SPIN_CAP (1u << 22)
#define LAS __attribute__((address_space(3)))

__device__ __forceinline__ unsigned xb_ld(unsigned* p)              { return __hip_atomic_load(p, __ATOMIC_RELAXED, __HIP_MEMORY_SCOPE_AGENT); }
__device__ __forceinline__ unsigned xb_add(unsigned* p, unsigned v) { return __hip_atomic_fetch_add(p, v, __ATOMIC_RELAXED, __HIP_MEMORY_SCOPE_AGENT); }
__device__ __forceinline__ unsigned xb_xcc_id() { return (unsigned)__builtin_amdgcn_s_getreg((3 << 11) | 20) & 0xFu; }
#define XB_SPIN(cond, bar) do { unsigned _sp = 0; while (cond) { __builtin_amdgcn_s_sleep(1); \
    if ((++_sp & 255u) == 0u) { if (xb_ld(&(bar)[XB_TMO])) break; if (_sp > XB_SPIN_CAP) { atomicAdd(&(bar)[XB_TMO], 1u); break; } } } } while (0)

struct XcdBarrier {
    unsigned* bar; unsigned x;
    volatile LAS unsigned* st;
};
__device__ __forceinline__ XcdBarrier xcd_barrier_post(unsigned* bar, volatile LAS unsigned* st) {
    XcdBarrier b; b.bar = bar; b.x = xb_xcc_id(); b.st = st;
    if (threadIdx.x == 0) (void)xb_add(&bar[XB_XCNT(b.x)], 1u);
    return b;
}
__device__ __forceinline__ void xcd_barrier_complete(unsigned* bar, unsigned x, unsigned& nloc, unsigned& nx) {
    const unsigned G = gridDim.x * gridDim.y * gridDim.z;
    unsigned sum, cnt, mine, sp = 0u;
    for (;;) {
        sum = 0u; cnt = 0u; mine = 0u;
#pragma unroll
        for (unsigned j = 0; j < 16; ++j) { const unsigned c = xb_ld(&bar[XB_XCNT(j)]); sum += c; cnt += (c > 0u) ? 1u : 0u; mine = (j == x) ? c : mine; }
        if (sum == G) break;
        __builtin_amdgcn_s_sleep(1);
        if ((++sp & 255u) == 0u) { if (xb_ld(&bar[XB_TMO])) break; if (sp > XB_SPIN_CAP) { atomicAdd(&bar[XB_TMO], 1u); break; } }
    }
    nloc = mine > 0u ? mine : 1u; nx = cnt > 0u ? cnt : 1u;
}
__device__ __forceinline__ void xcd_barrier(const XcdBarrier& b) {
    asm volatile("s_waitcnt vmcnt(0)" ::: "memory");
    __syncthreads();
    if (threadIdx.x == 0) {
        unsigned* bar = b.bar;
        __builtin_amdgcn_s_waitcnt(0);
        unsigned nloc = b.st[0], nx = b.st[1];
        if (nloc == 0u) { xcd_barrier_complete(bar, b.x, nloc, nx); b.st[0] = nloc; b.st[1] = nx; }
        const unsigned old = xb_add(&bar[XB_XSUB(b.x)], 1u);
        const unsigned gen = old / nloc;
        if (old + 1u == (gen + 1u) * nloc) {
            __builtin_amdgcn_fence(__ATOMIC_RELEASE, "agent");
            asm volatile("s_waitcnt vmcnt(0)" ::: "memory");
            const unsigned og = xb_add(&bar[XB_TOP], 1u);
            const unsigned tg = og / nx;
            if (og + 1u == (tg + 1u) * nx) xb_add(&bar[XB_TOPGEN], 1u);
            else XB_SPIN(xb_ld(&bar[XB_TOPGEN]) == tg, bar);
            __builtin_amdgcn_fence(__ATOMIC_ACQUIRE, "agent");
            xb_add(&bar[XB_XGEN(b.x)], 1u);
            asm volatile("s_waitcnt vmcnt(0)" ::: "memory");
        } else {
            XB_SPIN(xb_ld(&bar[XB_XGEN(b.x)]) == gen, bar);
            __builtin_amdgcn_fence(__ATOMIC_ACQUIRE, "agent");
            asm volatile("s_waitcnt vmcnt(0)" ::: "memory");
        }
    }
    __syncthreads();
}

template <int NB, class RowPtr, class Epi>
__device__ __forceinline__ void gemm_tile(RowPtr rowptr, const float* __restrict__ B0, const float* __restrict__ B1,
                                          int ldb, int K, int n0, int N, Epi epi, char* smem) {
    constexpr int LDS_LD = 72;
    bf16_t* As = (bf16_t*)smem;
    bf16_t* Bs0 = As + 128 * LDS_LD;
    bf16_t* Bs1 = Bs0 + 128 * LDS_LD;
    const int tid = threadIdx.x, lane = tid & 63, wave = tid >> 6;
    const int wm = wave >> 1, wn = wave & 1;
    const int l15 = lane & 15, lq = lane >> 4;

    const bf16_t* arow0 = rowptr(tid >> 3);
    const bf16_t* arow1 = rowptr((tid >> 3) + 64);
    const int akc = (tid & 7) * 8;
    const int bn = tid & 127, bkg = tid >> 7;
    const bool bok = (n0 + bn) < N;
    const float* b0p = B0 + (size_t)(bkg * 8) * ldb + n0 + bn;
    const float* b1p = (NB == 2) ? (B1 + (size_t)(bkg * 8) * ldb + n0 + bn) : nullptr;

    f32x4 acc0[2][4], acc1[2][4];
#pragma unroll
    for (int i = 0; i < 2; ++i)
#pragma unroll
        for (int j = 0; j < 4; ++j) { acc0[i][j] = (f32x4){0.f, 0.f, 0.f, 0.f}; acc1[i][j] = (f32x4){0.f, 0.f, 0.f, 0.f}; }

    uint4 ra0, ra1;
    float rb0[16], rb1[16];
    const int nk = K >> 6;
    auto load_regs = [&](int kt) {
        const int k0 = kt * 64;
        ra0 = arow0 ? *(const uint4*)(arow0 + k0 + akc) : make_uint4(0, 0, 0, 0);
        ra1 = arow1 ? *(const uint4*)(arow1 + k0 + akc) : make_uint4(0, 0, 0, 0);
#pragma unroll
        for (int r = 0; r < 2; ++r)
#pragma unroll
            for (int j = 0; j < 8; ++j) {
                const size_t o = (size_t)(k0 + r * 32 + j) * ldb;
                rb0[r * 8 + j] = bok ? b0p[o] : 0.f;
                if (NB == 2) rb1[r * 8 + j] = bok ? b1p[o] : 0.f;
            }
    };
    load_regs(0);
    for (int kt = 0; kt < nk; ++kt) {
        __syncthreads();
        *(uint4*)(As + (tid >> 3) * LDS_LD + akc) = ra0;
        *(uint4*)(As + ((tid >> 3) + 64) * LDS_LD + akc) = ra1;
#pragma unroll
        for (int r = 0; r < 2; ++r) {
            uint4 w;
            w.x = pack2(rb0[r * 8 + 0], rb0[r * 8 + 1]); w.y = pack2(rb0[r * 8 + 2], rb0[r * 8 + 3]);
            w.z = pack2(rb0[r * 8 + 4], rb0[r * 8 + 5]); w.w = pack2(rb0[r * 8 + 6], rb0[r * 8 + 7]);
            *(uint4*)(Bs0 + bn * LDS_LD + bkg * 8 + r * 32) = w;
            if (NB == 2) {
                w.x = pack2(rb1[r * 8 + 0], rb1[r * 8 + 1]); w.y = pack2(rb1[r * 8 + 2], rb1[r * 8 + 3]);
                w.z = pack2(rb1[r * 8 + 4], rb1[r * 8 + 5]); w.w = pack2(rb1[r * 8 + 6], rb1[r * 8 + 7]);
                *(uint4*)(Bs1 + bn * LDS_LD + bkg * 8 + r * 32) = w;
            }
        }
        __syncthreads();
        if (kt + 1 < nk) load_regs(kt + 1);
#pragma unroll
        for (int kk = 0; kk < 2; ++kk) {
            bf16x8 af[2];
#pragma unroll
            for (int mi = 0; mi < 2; ++mi)
                af[mi] = *(const bf16x8*)(As + (wm * 32 + mi * 16 + l15) * LDS_LD + kk * 32 + lq * 8);
#pragma unroll
            for (int ni = 0; ni < 4; ++ni) {
                const bf16x8 bf0 = *(const bf16x8*)(Bs0 + (wn * 64 + ni * 16 + l15) * LDS_LD + kk * 32 + lq * 8);
#pragma unroll
                for (int mi = 0; mi < 2; ++mi) acc0[mi][ni] = __builtin_amdgcn_mfma_f32_16x16x32_bf16(af[mi], bf0, acc0[mi][ni], 0, 0, 0);
                if (NB == 2) {
                    const bf16x8 bf1 = *(const bf16x8*)(Bs1 + (wn * 64 + ni * 16 + l15) * LDS_LD + kk * 32 + lq * 8);
#pragma unroll
                    for (int mi = 0; mi < 2; ++mi) acc1[mi][ni] = __builtin_amdgcn_mfma_f32_16x16x32_bf16(af[mi], bf1, acc1[mi][ni], 0, 0, 0);
                }
            }
        }
    }
#pragma unroll
    for (int mi = 0; mi < 2; ++mi)
#pragma unroll
        for (int ni = 0; ni < 4; ++ni) {
            const int n = n0 + wn * 64 + ni * 16 + l15;
            if (n < N) {
#pragma unroll
                for (int j = 0; j < 4; ++j) epi(wm * 32 + mi * 16 + lq * 4 + j, n, acc0[mi][ni][j], acc1[mi][ni][j]);
            }
        }
}

__device__ void ph_ada(const Params& p, char* smem) {
    const int tid = threadIdx.x;
    float* scond = (float*)smem;
    float* red = scond + 9 * 1024;
    float* MOD = (float*)(p.ws + OFF_MOD);
    for (int i = tid; i < 9 * 1024; i += NTHR) {
        const int r = i >> 10, k = i & 1023;
        const float v = r < 8 ? p.in[I_C][r * 1024 + k] : p.in[I_CCTX][k];
        scond[i] = siluf_(v);
    }
    __syncthreads();
    for (int item = blockIdx.x; item < 192; item += gridDim.x) {
        const int l = item / 96, cg = item % 96;
        const int kq = tid >> 6, cl = tid & 63, col = cg * 64 + cl;
        const float* W = p.in[I_ADAW] + (size_t)l * 1024 * 6144;
        float acc[9];
#pragma unroll
        for (int r = 0; r < 9; ++r) acc[r] = 0.f;
        for (int k = kq * 128; k < kq * 128 + 128; ++k) {
            const float w = W[(size_t)k * 6144 + col];
#pragma unroll
            for (int r = 0; r < 9; ++r) acc[r] += scond[r * 1024 + k] * w;
        }
#pragma unroll
        for (int r = 0; r < 9; ++r) red[(kq * 9 + r) * 64 + cl] = acc[r];
        __syncthreads();
        for (int i = tid; i < 9 * 64; i += NTHR) {
            const int r = i >> 6, cc = i & 63;
            float s = 0.f;
#pragma unroll
            for (int q = 0; q < 8; ++q) s += red[(q * 9 + r) * 64 + cc];
            MOD[(size_t)(l * 9 + r) * 6144 + cg * 64 + cc] = s + p.in[I_ADAB][l * 6144 + cg * 64 + cc];
        }
        __syncthreads();
    }
}

template <int MODE>
__device__ void ph_rows(const Params& p, char* smem) {
    const int tid = threadIdx.x, lane = tid & 63, wave = tid >> 6;
    constexpr int L = (MODE >= 2) ? 1 : 0;
    constexpr int NROWS = (MODE >= 3) ? NL : NT;
    constexpr bool ROUTER = (MODE == 1 || MODE == 3);
    float* X = (float*)(p.ws + OFF_X);
    bf16_t* H = (bf16_t*)(p.ws + OFF_H);
    const bf16_t* YE = (const bf16_t*)(p.ws + OFF_YE);
    const float* MOD = (const float*)(p.ws + OFF_MOD);
    float* hs = (float*)smem + wave * 1024;
    float* lg = (float*)smem + 8 * 1024 + wave * 64;
    unsigned* cnt = (unsigned*)(p.ws + OFF_CNT) + L * 32;
    int* LIST = (int*)(p.ws + OFF_LIST);
    float* WSEL = (float*)(p.ws + OFF_WSEL);

    for (int row = blockIdx.x * 8 + wave; row < NROWS; row += gridDim.x * 8) {
        const int mr = row < NL ? (row >> 11) : 8;
        float v[16];
        if (MODE == 0) {
            const float* src = row < NL ? p.in[I_X] + (size_t)row * 1024 : p.in[I_CTX] + (size_t)(row - NL) * 1024;
#pragma unroll
            for (int i = 0; i < 4; ++i) {
                const float4 t = *(const float4*)(src + i * 256 + lane * 4);
                v[i * 4 + 0] = t.x; v[i * 4 + 1] = t.y; v[i * 4 + 2] = t.z; v[i * 4 + 3] = t.w;
            }
        } else {
#pragma unroll
            for (int i = 0; i < 4; ++i) {
                const float4 t = *(const float4*)(X + (size_t)row * 1024 + i * 256 + lane * 4);
                v[i * 4 + 0] = t.x; v[i * 4 + 1] = t.y; v[i * 4 + 2] = t.z; v[i * 4 + 3] = t.w;
            }
        }
        if (MODE == 2 || MODE == 4) {
            constexpr int LP = (MODE == 2) ? 0 : 1;
            const float* g2 = MOD + (size_t)(LP * 9 + mr) * 6144 + 5 * 1024;
#pragma unroll
            for (int i = 0; i < 4; ++i) {
                const int c = i * 256 + lane * 4;
                const uint2 a = *(const uint2*)(YE + (size_t)(2 * row) * 1024 + c);
                const uint2 b = *(const uint2*)(YE + (size_t)(2 * row + 1) * 1024 + c);
                const float4 g = *(const float4*)(g2 + c);
                v[i * 4 + 0] += g.x * (bf2f((bf16_t)(a.x & 0xffff)) + bf2f((bf16_t)(b.x & 0xffff)));
                v[i * 4 + 1] += g.y * (bf2f((bf16_t)(a.x >> 16)) + bf2f((bf16_t)(b.x >> 16)));
                v[i * 4 + 2] += g.z * (bf2f((bf16_t)(a.y & 0xffff)) + bf2f((bf16_t)(b.y & 0xffff)));
                v[i * 4 + 3] += g.w * (bf2f((bf16_t)(a.y >> 16)) + bf2f((bf16_t)(b.y >> 16)));
            }
        }
        if (MODE == 0 || MODE == 2) {
#pragma unroll
            for (int i = 0; i < 4; ++i)
                *(float4*)(X + (size_t)row * 1024 + i * 256 + lane * 4) = make_float4(v[i * 4], v[i * 4 + 1], v[i * 4 + 2], v[i * 4 + 3]);
        }
        float ss = 0.f;
#pragma unroll
        for (int i = 0; i < 16; ++i) ss += v[i] * v[i];
        ss = wave_sum(ss);
        const float rinv = rsqrtf(ss * (1.f / 1024.f) + EPSF);
        if (MODE == 4) {
#pragma unroll
            for (int i = 0; i < 4; ++i) {
                const int c = i * 256 + lane * 4;
                const float4 w = *(const float4*)(p.in[I_FNORM] + c);
                *(float4*)(p.out + (size_t)row * 1024 + c) =
                    make_float4(v[i * 4] * rinv * w.x, v[i * 4 + 1] * rinv * w.y, v[i * 4 + 2] * rinv * w.z, v[i * 4 + 3] * rinv * w.w);
            }
        } else {
            constexpr int SH = (MODE == 0 || MODE == 2) ? 0 : 3;
            const float* gain = p.in[(MODE == 0 || MODE == 2) ? I_NORM1 : I_NORM2] + L * 1024;
            const float* sh = MOD + (size_t)(L * 9 + mr) * 6144 + SH * 1024;
            const float* sc = sh + 1024;
#pragma unroll
            for (int i = 0; i < 4; ++i) {
                const int c = i * 256 + lane * 4;
                const float4 w = *(const float4*)(gain + c);
                const float4 s1 = *(const float4*)(sc + c);
                const float4 s0 = *(const float4*)(sh + c);
                float h0 = v[i * 4 + 0] * rinv * w.x * (1.f + s1.x) + s0.x;
                float h1 = v[i * 4 + 1] * rinv * w.y * (1.f + s1.y) + s0.y;
                float h2 = v[i * 4 + 2] * rinv * w.z * (1.f + s1.z) + s0.z;
                float h3 = v[i * 4 + 3] * rinv * w.w * (1.f + s1.w) + s0.w;
                uint2 o; o.x = pack2(h0, h1); o.y = pack2(h2, h3);
                *(uint2*)(H + (size_t)row * 1024 + c) = o;
                if (ROUTER) *(float4*)(hs + c) = make_float4(h0, h1, h2, h3);
            }
            if (ROUTER) {
                __builtin_amdgcn_wave_barrier();
                if (lane < 36) {
                    const float* W; int ld; float bias;
                    if (lane < 4) { W = p.in[I_WGRP] + (size_t)L * 1024 * 4 + lane; ld = 4; bias = p.in[I_BGRP][L * 4 + lane]; }
                    else { W = p.in[I_WEXP] + (size_t)L * 1024 * 32 + (lane - 4); ld = 32; bias = p.in[I_BEXP][L * 32 + lane - 4]; }
                    float a0 = 0.f, a1 = 0.f, a2 = 0.f, a3 = 0.f;
                    for (int k = 0; k < 1024; k += 4) {
                        a0 += hs[k] * W[(size_t)k * ld];
                        a1 += hs[k + 1] * W[(size_t)(k + 1) * ld];
                        a2 += hs[k + 2] * W[(size_t)(k + 2) * ld];
                        a3 += hs[k + 3] * W[(size_t)(k + 3) * ld];
                    }
                    lg[lane] = (a0 + a1) + (a2 + a3) + bias;
                }
                __builtin_amdgcn_wave_barrier();
                if (lane == 0) {
                    int gi = 0; float gm = lg[0];
#pragma unroll
                    for (int j = 1; j < 4; ++j) if (lg[j] > gm) { gm = lg[j]; gi = j; }
                    float gs = 0.f;
#pragma unroll
                    for (int j = 0; j < 4; ++j) gs += __expf(lg[j] - gm);
                    const float gw = 1.f / gs;
                    const float* el = lg + 4 + gi * 8;
                    int e0 = 0; float v0 = el[0];
#pragma unroll
                    for (int j = 1; j < 8; ++j) if (el[j] > v0) { v0 = el[j]; e0 = j; }
                    int e1 = -1; float v1 = -3.0e38f;
#pragma unroll
                    for (int j = 0; j < 8; ++j) if (j != e0 && el[j] > v1) { v1 = el[j]; e1 = j; }
                    const float t = __expf(v1 - v0);
                    const float w0 = gw / (1.f + t), w1 = gw * t / (1.f + t);
                    const int x0 = gi * 8 + e0, x1 = gi * 8 + e1;
                    const unsigned s0 = __hip_atomic_fetch_add(&cnt[x0], 1u, __ATOMIC_RELAXED, __HIP_MEMORY_SCOPE_AGENT);
                    const unsigned s1 = __hip_atomic_fetch_add(&cnt[x1], 1u, __ATOMIC_RELAXED, __HIP_MEMORY_SCOPE_AGENT);
                    LIST[(size_t)x0 * NT + s0] = 2 * row;
                    LIST[(size_t)x1 * NT + s1] = 2 * row + 1;
                    WSEL[2 * row] = w0;
                    WSEL[2 * row + 1] = w1;
                }
                __builtin_amdgcn_wave_barrier();
            }
        }
    }
}

__device__ void ph_gemm_in(const Params& p, char* smem) {
    const bf16_t* H = (const bf16_t*)(p.ws + OFF_H);
    bf16_t* Z = (bf16_t*)(p.ws + OFF_Z);
    constexpr int NTN = (AB_PROJ + 127) / 128;
    for (int w = blockIdx.x; w < (NT / 128) * NTN; w += gridDim.x) {
        const int mt = w / NTN, nt = w % NTN;
        const int m0 = mt * 128;
        gemm_tile<1>([&](int m) { return H + (size_t)(m0 + m) * 1024; }, p.in[I_ABWIN], nullptr, AB_PROJ, 1024, nt * 128, AB_PROJ,
                     [&](int m, int n, float v0, float) { Z[(size_t)(m0 + m) * AB_PROJ + n] = f2bf(v0); }, smem);
    }
}
template <int L>
__device__ void ph_gemm_out(const Params& p, char* smem) {
    const bf16_t* A = (const bf16_t*)(p.ws + OFF_H);
    float* X = (float*)(p.ws + OFF_X);
    const float* MOD = (const float*)(p.ws + OFF_MOD);
    const float* W = p.in[L == 0 ? I_ABWOUT : I_ATWOUT];
    constexpr int NROWS = (L == 0) ? NT : NL;
    for (int w = blockIdx.x; w < (NROWS / 128) * 8; w += gridDim.x) {
        const int mt = w >> 3, nt = w & 7;
        const int m0 = mt * 128;
        const int mr = m0 < NL ? (m0 >> 11) : 8;
        const float* g1 = MOD + (size_t)(L * 9 + mr) * 6144 + 2 * 1024;
        gemm_tile<1>([&](int m) { return A + (size_t)(m0 + m) * 1024; }, W, nullptr, 1024, 1024, nt * 128, 1024,
                     [&](int m, int n, float v0, float) { X[(size_t)(m0 + m) * 1024 + n] += g1[n] * v0; }, smem);
    }
}
__device__ void ph_gemm_qkv(const Params& p, char* smem) {
    const bf16_t* H = (const bf16_t*)(p.ws + OFF_H);
    bf16_t* ZQ = (bf16_t*)(p.ws + OFF_ZQ);
    bf16_t* ZC = (bf16_t*)(p.ws + OFF_ZC);
    const int n_lat = (NL / 128) * 12, n_ctx = (NC / 128) * 4;
    for (int w = blockIdx.x; w < n_lat + n_ctx; w += gridDim.x) {
        if (w < n_lat) {
            const int mt = w / 12, nt = w % 12, m0 = mt * 128;
            gemm_tile<1>([&](int m) { return H + (size_t)(m0 + m) * 1024; }, p.in[I_ATWQKV], nullptr, 1536, 1024, nt * 128, 1536,
                         [&](int m, int n, float v0, float) { ZQ[(size_t)(m0 + m) * 1536 + n] = f2bf(v0); }, smem);
        } else {
            const int w2 = w - n_lat;
            const int mt = w2 >> 2, nt = w2 & 3, m0 = mt * 128;
            gemm_tile<1>([&](int m) { return H + (size_t)(NL + m0 + m) * 1024; }, p.in[I_ATWQKV] + 1024, nullptr, 1536, 1024, nt * 128, 512,
                         [&](int m, int n, float v0, float) { ZC[(size_t)(m0 + m) * 512 + n] = f2bf(v0); }, smem);
        }
    }
}

__device__ __forceinline__ int moe_prefix(const Params& p, int L, int* pre  ) {
    unsigned* cnt = (unsigned*)(p.ws + OFF_CNT) + L * 32;
    __syncthreads();
    if (threadIdx.x == 0) {
        int s = 0;
        for (int e = 0; e < 32; ++e) { pre[e] = s; s += ((int)xb_ld(&cnt[e]) + 127) >> 7; }
        pre[32] = s;
    }
    __syncthreads();
    return pre[32];
}
template <int L>
__device__ void ph_moe_up(const Params& p, char* smem) {
    int* pre = (int*)(smem + 60 * 1024);
    const int total = moe_prefix(p, L, pre);
    const unsigned* cnt = (const unsigned*)(p.ws + OFF_CNT) + L * 32;
    const bf16_t* H = (const bf16_t*)(p.ws + OFF_H);
    bf16_t* ACT = (bf16_t*)(p.ws + OFF_ACT);
    const int* LIST = (const int*)(p.ws + OFF_LIST);
    const float* WSEL = (const float*)(p.ws + OFF_WSEL);
    for (int w = blockIdx.x; w < total * 4; w += gridDim.x) {
        const int mt = w >> 2, nt = w & 3;
        int e = 0;
        for (int j = 1; j < 32; ++j) if (pre[j] <= mt) e = j;
        const int m0 = (mt - pre[e]) * 128;
        const int mv = (int)cnt[e] - m0;
        const int* lst = LIST + (size_t)e * NT + m0;
        const float* Wg = p.in[I_WGATE] + ((size_t)L * 32 + e) * 1024 * 512;
        const float* Wu = p.in[I_WUP] + ((size_t)L * 32 + e) * 1024 * 512;
        gemm_tile<2>([&](int m) -> const bf16_t* { return m < mv ? H + (size_t)(lst[m] >> 1) * 1024 : nullptr; }, Wg, Wu, 512, 1024,
                     nt * 128, 512,
                     [&](int m, int n, float v0, float v1) {
                         if (m < mv) { const int r = lst[m]; ACT[(size_t)r * 512 + n] = f2bf(siluf_(v0) * v1 * WSEL[r]); }
                     }, smem);
    }
}
template <int L>
__device__ void ph_moe_down(const Params& p, char* smem) {
    int* pre = (int*)(smem + 60 * 1024);
    const int total = moe_prefix(p, L, pre);
    const unsigned* cnt = (const unsigned*)(p.ws + OFF_CNT) + L * 32;
    const bf16_t* ACT = (const bf16_t*)(p.ws + OFF_ACT);
    bf16_t* YE = (bf16_t*)(p.ws + OFF_YE);
    const int* LIST = (const int*)(p.ws + OFF_LIST);
    for (int w = blockIdx.x; w < total * 8; w += gridDim.x) {
        const int mt = w >> 3, nt = w & 7;
        int e = 0;
        for (int j = 1; j < 32; ++j) if (pre[j] <= mt) e = j;
        const int m0 = (mt - pre[e]) * 128;
        const int mv = (int)cnt[e] - m0;
        const int* lst = LIST + (size_t)e * NT + m0;
        const float* Wd = p.in[I_WDOWN] + ((size_t)L * 32 + e) * 512 * 1024;
        gemm_tile<1>([&](int m) -> const bf16_t* { return m < mv ? ACT + (size_t)lst[m] * 512 : nullptr; }, Wd, nullptr, 1024, 512,
                     nt * 128, 1024,
                     [&](int m, int n, float v0, float) {
                         if (m < mv) YE[(size_t)lst[m] * 1024 + n] = f2bf(v0);
                     }, smem);
    }
}

__device__ void ph_prep(const Params& p, char* smem) {
    const int tid = threadIdx.x, lane = tid & 63, wave = tid >> 6;
    const bf16_t* Z = (const bf16_t*)(p.ws + OFF_Z);
    bf16_t* QKVC = (bf16_t*)(p.ws + OFF_QKVC);
    float* G = (float*)(p.ws + OFF_G);
    float* BETA = (float*)(p.ws + OFF_BETA);
    float* LA = (float*)(p.ws + OFF_LA);
    float* LB = (float*)(p.ws + OFF_LB);
    float* xcs = (float*)smem;
    const float* cw = p.in[I_CONVQKV];
    const float* cx = p.in[I_CONVX];
    for (int item = blockIdx.x; item < NT / 8; item += gridDim.x) {
        const int row0 = item * 8;
        int sbeg, send;
        if (row0 < NL) { sbeg = (row0 >> 11) << 11; send = sbeg + SEQ; }
        else { sbeg = NL + (((row0 - NL) >> 8) << 8); send = sbeg + CTXL; }
        for (int u = wave; u < 96; u += 8) {
            const int tk = u / 12, grp = u % 12;
            const int row = row0 + tk;
            const int c = grp * 128 + lane * 2;
            float a0 = 0.f, a1 = 0.f;
#pragma unroll
            for (int j = 0; j < 4; ++j) {
                const int r = row + j - 2;
                if (r >= sbeg && r < send) {
                    const unsigned z2 = *(const unsigned*)(Z + (size_t)r * AB_PROJ + c);
                    a0 += bf2f((bf16_t)(z2 & 0xffff)) * cw[j * 1536 + c];
                    a1 += bf2f((bf16_t)(z2 >> 16)) * cw[j * 1536 + c + 1];
                }
            }
            a0 = siluf_(a0); a1 = siluf_(a1);
            if (grp < 8) {
                const float ss = wave_sum(a0 * a0 + a1 * a1);
                float sc = rsqrtf(ss + EPSF);
                if (grp < 4) sc *= 0.08838834764831845f;
                a0 *= sc; a1 *= sc;
            }
            *(unsigned*)(QKVC + (size_t)row * 1536 + c) = pack2(a0, a1);
        }
        if (tid < 128) {
            const int tk = tid >> 4, q = tid & 15;
            const int d = q >> 3, s = (q >> 2) & 1, h = q & 3;
            const int row = row0 + tk;
            const float gv = bf2f(Z[(size_t)row * AB_PROJ + 2048 + q]);
            if (s == 0) {
                const float dec = -__expf(p.in[I_ALOG][d * 4 + h]) * softplusf_(gv + p.in[I_DTB][d * 4 + h]);
                G[((size_t)d * NT + row) * 4 + h] = dec;
            } else {
                BETA[((size_t)d * NT + row) * 4 + h] = sigmoidf_(gv);
            }
        }
        {
            const int c = tid;
#pragma unroll
            for (int tk = 0; tk < 8; ++tk) {
                const int row = row0 + tk;
                float a = 0.f;
#pragma unroll
                for (int j = 0; j < 4; ++j) {
                    const int r = row + j - 2;
                    if (r >= sbeg && r < send) a += bf2f(Z[(size_t)r * AB_PROJ + 2064 + c]) * cx[j * 512 + c];
                }
                xcs[tk * 512 + c] = a;
            }
        }
        __syncthreads();
        {
            const int c = tid, g = c >> 6, j = c & 63;
            float ar[2][8], ai[2][8];
#pragma unroll
            for (int d = 0; d < 2; ++d)
#pragma unroll
                for (int tk = 0; tk < 8; ++tk) { ar[d][tk] = 0.f; ai[d][tk] = 0.f; }
            const float* wr0 = p.in[I_RGWR] + ((size_t)(0 * 8 + g) * 64) * 64 + j;
            const float* wr1 = p.in[I_RGWR] + ((size_t)(1 * 8 + g) * 64) * 64 + j;
            const float* wi0 = p.in[I_RGWI] + ((size_t)(0 * 8 + g) * 64) * 64 + j;
            const float* wi1 = p.in[I_RGWI] + ((size_t)(1 * 8 + g) * 64) * 64 + j;
            for (int k = 0; k < 64; ++k) {
                const float r0 = wr0[k * 64], r1 = wr1[k * 64], i0 = wi0[k * 64], i1 = wi1[k * 64];
#pragma unroll
                for (int tk = 0; tk < 8; ++tk) {
                    const float x = xcs[tk * 512 + g * 64 + k];
                    ar[0][tk] += x * r0; ar[1][tk] += x * r1; ai[0][tk] += x * i0; ai[1][tk] += x * i1;
                }
            }
#pragma unroll
            for (int d = 0; d < 2; ++d) {
                const float br = p.in[I_RGBR][d * 512 + c], bi = p.in[I_RGBI][d * 512 + c];
                const float spl = softplusf_(-p.in[I_RGLAM][d * 512 + c]);
#pragma unroll
                for (int tk = 0; tk < 8; ++tk) {
                    const float r = sigmoidf_(ar[d][tk] + br), ig = sigmoidf_(ai[d][tk] + bi);
                    const float log_a = -8.0f * r * spl;
                    const float a = __expf(log_a);
                    const float bb = sqrtf(-expm1f(2.f * log_a)) * ig * xcs[tk * 512 + c];
                    const size_t o = ((size_t)d * NT + row0 + tk) * 512 + c;
                    LA[o] = a; LB[o] = bb;
                }
            }
        }
        __syncthreads();
    }
}

__device__ void delta_seq(const Params& p, int chain, char* smem) {
    const int tid = threadIdx.x;
    const int b = chain >> 3, h = (chain >> 1) & 3, dir = chain & 1;
    const bf16_t* QKVC = (const bf16_t*)(p.ws + OFF_QKVC);
    const float* G = (const float*)(p.ws + OFF_G) + (size_t)dir * NT * 4;
    const float* BETA = (const float*)(p.ws + OFF_BETA) + (size_t)dir * NT * 4;
    bf16_t* OA = (bf16_t*)(p.ws + OFF_OA) + (size_t)dir * NT * 512;
    float* kq = (float*)smem;
    float* vs = kq + 2 * 16 * 256;
    float* gbs = vs + 2 * 16 * 128;
    constexpr int NG = TSEQ / 16;
    auto stage = [&](int gi, int buf) {
        const int idx0 = tid - 256;
        for (int idx = idx0; idx < 384; idx += 256) {
            const int type = idx >> 7, d = idx & 127;
#pragma unroll 4
            for (int st = 0; st < 16; ++st) {
                const int row = scan_row(gi * 16 + st, dir, b);
                const float val = bf2f(QKVC[(size_t)row * 1536 + type * 512 + h * 128 + d]);
                if (type < 2) kq[(buf * 16 + st) * 256 + type * 128 + d] = val;
                else vs[(buf * 16 + st) * 128 + d] = val;
            }
        }
        if (idx0 < 32) {
            const int st = idx0 >> 1, wh = idx0 & 1;
            const int row = scan_row(gi * 16 + st, dir, b);
            gbs[(buf * 16 + st) * 2 + wh] = (wh ? BETA : G)[(size_t)row * 4 + h];
        }
    };
    float S[64];
#pragma unroll
    for (int d = 0; d < 64; ++d) S[d] = 0.f;
    if (tid >= 256) stage(0, 0);
    __syncthreads();
    for (int gi = 0; gi < NG; ++gi) {
        const int buf = gi & 1;
        if (tid >= 256) {
            if (gi + 1 < NG) stage(gi + 1, buf ^ 1);
        } else {
            const int e = tid >> 1, hf = tid & 1;
            for (int st = 0; st < 16; ++st) {
                const float* qp = kq + (buf * 16 + st) * 256 + hf * 64;
                const float* kp = qp + 128;
                const float g = gbs[(buf * 16 + st) * 2], beta = gbs[(buf * 16 + st) * 2 + 1];
                const float v = vs[(buf * 16 + st) * 128 + e];
                const float eg = __expf(g);
                float kS0 = 0.f, kS1 = 0.f;
#pragma unroll
                for (int d = 0; d < 64; d += 4) {
                    const float4 k4 = *(const float4*)(kp + d);
                    kS0 += k4.x * S[d] + k4.z * S[d + 2];
                    kS1 += k4.y * S[d + 1] + k4.w * S[d + 3];
                }
                float kS = kS0 + kS1;
                kS += __shfl_xor(kS, 1, 64);
                const float coef = beta * (v - eg * kS);
                float o0 = 0.f, o1 = 0.f;
#pragma unroll
                for (int d = 0; d < 64; d += 4) {
                    const float4 k4 = *(const float4*)(kp + d);
                    const float4 q4 = *(const float4*)(qp + d);
                    S[d] = eg * S[d] + coef * k4.x;
                    S[d + 1] = eg * S[d + 1] + coef * k4.y;
                    S[d + 2] = eg * S[d + 2] + coef * k4.z;
                    S[d + 3] = eg * S[d + 3] + coef * k4.w;
                    o0 += q4.x * S[d] + q4.z * S[d + 2];
                    o1 += q4.y * S[d + 1] + q4.w * S[d + 3];
                }
                float o = o0 + o1;
                o += __shfl_xor(o, 1, 64);
                if (hf == 0) {
                    const int row = scan_row(gi * 16 + st, dir, b);
                    OA[(size_t)row * 512 + h * 128 + e] = f2bf(o);
                }
            }
        }
        __syncthreads();
    }
}
__device__ void lru_seq(const Params& p, int li) {
    const int idx = li * NTHR + threadIdx.x;
    const int c = idx & 511, bd = idx >> 9, b = bd >> 1, dir = bd & 1;
    const float* LA = (const float*)(p.ws + OFF_LA) + (size_t)dir * NT * 512 + c;
    float* LB = (float*)(p.ws + OFF_LB) + (size_t)dir * NT * 512 + c;
    float hh = 0.f;
    for (int s0 = 0; s0 < TSEQ; s0 += 8) {
        float a[8], bb[8];
#pragma unroll
        for (int i = 0; i < 8; ++i) {
            const size_t o = (size_t)scan_row(s0 + i, dir, b) * 512;
            a[i] = LA[o]; bb[i] = LB[o];
        }
#pragma unroll
        for (int i = 0; i < 8; ++i) {
            hh = a[i] * hh + bb[i];
            LB[(size_t)scan_row(s0 + i, dir, b) * 512] = hh;
        }
    }
}
__device__ void ph_scan(const Params& p, char* smem) {
    for (int item = blockIdx.x; item < 80; item += gridDim.x) {
        if (item < 64) delta_seq(p, item, smem);
        else lru_seq(p, item - 64);
        __syncthreads();
    }
}

__device__ void ph_merge(const Params& p, char* smem) {
    const int tid = threadIdx.x, lane = tid & 63, wave = tid >> 6;
    const bf16_t* Z = (const bf16_t*)(p.ws + OFF_Z);
    const bf16_t* OA0 = (const bf16_t*)(p.ws + OFF_OA);
    const bf16_t* OA1 = OA0 + (size_t)NT * 512;
    const float* OB0 = (const float*)(p.ws + OFF_LB);
    const float* OB1 = OB0 + (size_t)NT * 512;
    bf16_t* M = (bf16_t*)(p.ws + OFF_H);
    const float* onorm = p.in[I_ONORM];
    for (int row = blockIdx.x * 8 + wave; row < NT; row += gridDim.x * 8) {
#pragma unroll
        for (int h = 0; h < 4; ++h) {
            const int c = h * 128 + lane * 2;
            const unsigned u0 = *(const unsigned*)(OA0 + (size_t)row * 512 + c);
            const unsigned u1 = *(const unsigned*)(OA1 + (size_t)row * 512 + c);
            const float o0 = bf2f((bf16_t)(u0 & 0xffff)) + bf2f((bf16_t)(u1 & 0xffff));
            const float o1 = bf2f((bf16_t)(u0 >> 16)) + bf2f((bf16_t)(u1 >> 16));
            const float ss = wave_sum(o0 * o0 + o1 * o1);
            const float rinv = rsqrtf(ss * (1.f / 128.f) + EPSF);
            const unsigned gz = *(const unsigned*)(Z + (size_t)row * AB_PROJ + 1536 + c);
            const float y0 = o0 * rinv * onorm[lane * 2] * siluf_(bf2f((bf16_t)(gz & 0xffff)));
            const float y1 = o1 * rinv * onorm[lane * 2 + 1] * siluf_(bf2f((bf16_t)(gz >> 16)));
            *(unsigned*)(M + (size_t)row * 1024 + c) = pack2(y0, y1);
        }
#pragma unroll
        for (int i = 0; i < 4; ++i) {
            const int c = i * 128 + lane * 2;
            const float2 b0 = *(const float2*)(OB0 + (size_t)row * 512 + c);
            const float2 b1 = *(const float2*)(OB1 + (size_t)row * 512 + c);
            const unsigned yz = *(const unsigned*)(Z + (size_t)row * AB_PROJ + 2576 + c);
            const float y0 = (b0.x + b1.x) * geluf_(bf2f((bf16_t)(yz & 0xffff)));
            const float y1 = (b0.y + b1.y) * geluf_(bf2f((bf16_t)(yz >> 16)));
            *(unsigned*)(M + (size_t)row * 1024 + 512 + c) = pack2(y0, y1);
        }
    }
}

__device__ void ph_qkprep(const Params& p, char* smem) {
    const int tid = threadIdx.x, lane = tid & 63, wave = tid >> 6;
    const bf16_t* ZQ = (const bf16_t*)(p.ws + OFF_ZQ);
    const bf16_t* ZC = (const bf16_t*)(p.ws + OFF_ZC);
    bf16_t* QA = (bf16_t*)(p.ws + OFF_QA);
    bf16_t* KA = (bf16_t*)(p.ws + OFF_KA);
    bf16_t* VT = (bf16_t*)(p.ws + OFF_VT);
    const float* qn = p.in[I_QNORM];
    const float* kn = p.in[I_KNORM];
    for (int row = blockIdx.x * 8 + wave; row < NT; row += gridDim.x * 8) {
        const bool lat = row < NL;
        const int b = lat ? (row >> 11) : ((row - NL) >> 8);
        const int t = lat ? (row & 2047) : ((row - NL) & 255);
        const int key = lat ? t : (SEQ + t);
        float cs = 1.f, sn = 0.f;
        if (lat) {
            const int f = lane & 31;
            const float pos = (lane < 32) ? (float)(t >> 6) : (float)(t & 63);
            const float inv = expf(-(float)f * (1.f / 32.f) * 9.210340371976184f);
            sincosf(pos * inv, &sn, &cs);
        }
        const bf16_t* src = lat ? ZQ + (size_t)row * 1536 : ZC + (size_t)(row - NL) * 512;
        const int koff = lat ? 1024 : 0;
        if (lat) {
#pragma unroll
            for (int h = 0; h < 8; ++h) {
                const unsigned u = *(const unsigned*)(src + h * 128 + lane * 2);
                float x1 = bf2f((bf16_t)(u & 0xffff)), x2 = bf2f((bf16_t)(u >> 16));
                const float ss = wave_sum(x1 * x1 + x2 * x2);
                const float rinv = rsqrtf(ss * (1.f / 128.f) + EPSF);
                x1 *= rinv * qn[lane * 2]; x2 *= rinv * qn[lane * 2 + 1];
                const float y1 = (x1 * cs - x2 * sn) * 0.08838834764831845f;
                const float y2 = (x1 * sn + x2 * cs) * 0.08838834764831845f;
                *(unsigned*)(QA + (size_t)row * 1024 + h * 128 + lane * 2) = pack2(y1, y2);
            }
        }
#pragma unroll
        for (int kh = 0; kh < 2; ++kh) {
            const unsigned u = *(const unsigned*)(src + koff + kh * 128 + lane * 2);
            float x1 = bf2f((bf16_t)(u & 0xffff)), x2 = bf2f((bf16_t)(u >> 16));
            const float ss = wave_sum(x1 * x1 + x2 * x2);
            const float rinv = rsqrtf(ss * (1.f / 128.f) + EPSF);
            x1 *= rinv * kn[lane * 2]; x2 *= rinv * kn[lane * 2 + 1];
            const float y1 = x1 * cs - x2 * sn;
            const float y2 = x1 * sn + x2 * cs;
            *(unsigned*)(KA + ((size_t)(b * 2 + kh) * TSEQ + key) * 128 + lane * 2) = pack2(y1, y2);
            const unsigned uv = *(const unsigned*)(src + koff + 256 + kh * 128 + lane * 2);
            bf16_t* vt = VT + ((size_t)(b * 2 + kh) * 128 + lane * 2) * TSEQ + key;
            vt[0] = (bf16_t)(uv & 0xffff);
            vt[TSEQ] = (bf16_t)(uv >> 16);
        }
    }
}

__device__ void ph_attn(const Params& p, char* smem) {
    const int tid = threadIdx.x, lane = tid & 63, wave = tid >> 6;
    const int l15 = lane & 15, lq = lane >> 4;
    const bf16_t* QA = (const bf16_t*)(p.ws + OFF_QA);
    const bf16_t* KA = (const bf16_t*)(p.ws + OFF_KA);
    const bf16_t* VT = (const bf16_t*)(p.ws + OFF_VT);
    bf16_t* O = (bf16_t*)(p.ws + OFF_O);
    bf16_t* Ks = (bf16_t*)smem;
    bf16_t* Vts = Ks + 64 * 136;
    bf16_t* Ps = Vts + 128 * 72 + wave * 16 * 72;
    for (int item = blockIdx.x; item < 8 * 8 * 16; item += gridDim.x) {
        const int qb = item & 15, h = (item >> 4) & 7, b = item >> 7, kvh = h >> 2;
        const int q0 = qb * 128 + wave * 16;
        bf16x8 qf[4];
#pragma unroll
        for (int kk = 0; kk < 4; ++kk)
            qf[kk] = *(const bf16x8*)(QA + (size_t)(b * SEQ + q0 + l15) * 1024 + h * 128 + kk * 32 + lq * 8);
        float mrow[4], lrow[4];
        f32x4 o[8];
#pragma unroll
        for (int j = 0; j < 4; ++j) { mrow[j] = -1.0e30f; lrow[j] = 0.f; }
#pragma unroll
        for (int nd = 0; nd < 8; ++nd) o[nd] = (f32x4){0.f, 0.f, 0.f, 0.f};
        const bf16_t* Kb = KA + (size_t)(b * 2 + kvh) * TSEQ * 128;
        const bf16_t* Vb = VT + (size_t)(b * 2 + kvh) * 128 * TSEQ;
        for (int kt = 0; kt < TSEQ / 64; ++kt) {
            const int key0 = kt * 64;
            __syncthreads();
#pragma unroll
            for (int r = 0; r < 2; ++r) {
                const int cI = tid + r * NTHR;
                { const int kr = cI >> 4, dc = (cI & 15) * 8;
                  *(uint4*)(Ks + kr * 136 + dc) = *(const uint4*)(Kb + (size_t)(key0 + kr) * 128 + dc); }
                { const int d = cI >> 3, kc = (cI & 7) * 8;
                  *(uint4*)(Vts + d * 72 + kc) = *(const uint4*)(Vb + (size_t)d * TSEQ + key0 + kc); }
            }
            __syncthreads();
            f32x4 s[4];
#pragma unroll
            for (int n = 0; n < 4; ++n) {
                s[n] = (f32x4){0.f, 0.f, 0.f, 0.f};
#pragma unroll
                for (int kk = 0; kk < 4; ++kk) {
                    const bf16x8 kf = *(const bf16x8*)(Ks + (n * 16 + l15) * 136 + kk * 32 + lq * 8);
                    s[n] = __builtin_amdgcn_mfma_f32_16x16x32_bf16(qf[kk], kf, s[n], 0, 0, 0);
                }
            }
#pragma unroll
            for (int j = 0; j < 4; ++j) {
                float mx = fmaxf(fmaxf(s[0][j], s[1][j]), fmaxf(s[2][j], s[3][j]));
                mx = fmaxf(mx, __shfl_xor(mx, 1, 64)); mx = fmaxf(mx, __shfl_xor(mx, 2, 64));
                mx = fmaxf(mx, __shfl_xor(mx, 4, 64)); mx = fmaxf(mx, __shfl_xor(mx, 8, 64));
                const float mn = fmaxf(mrow[j], mx);
                const float alpha = __expf(mrow[j] - mn);
                mrow[j] = mn;
                float ps = 0.f;
#pragma unroll
                for (int n = 0; n < 4; ++n) {
                    const float pv = __expf(s[n][j] - mn);
                    ps += pv;
                    Ps[(lq * 4 + j) * 72 + n * 16 + l15] = f2bf(pv);
                }
                lrow[j] = lrow[j] * alpha + ps;
#pragma unroll
                for (int nd = 0; nd < 8; ++nd) o[nd][j] *= alpha;
            }
            __syncthreads();
#pragma unroll
            for (int kk = 0; kk < 2; ++kk) {
                const bf16x8 pf = *(const bf16x8*)(Ps + l15 * 72 + kk * 32 + lq * 8);
#pragma unroll
                for (int nd = 0; nd < 8; ++nd) {
                    const bf16x8 vf = *(const bf16x8*)(Vts + (nd * 16 + l15) * 72 + kk * 32 + lq * 8);
                    o[nd] = __builtin_amdgcn_mfma_f32_16x16x32_bf16(pf, vf, o[nd], 0, 0, 0);
                }
            }
        }
#pragma unroll
        for (int j = 0; j < 4; ++j) {
            float l = lrow[j];
            l += __shfl_xor(l, 1, 64); l += __shfl_xor(l, 2, 64); l += __shfl_xor(l, 4, 64); l += __shfl_xor(l, 8, 64);
            const float inv = 1.f / l;
            const size_t orow = (size_t)(b * SEQ + q0 + lq * 4 + j) * 1024 + h * 128;
#pragma unroll
            for (int nd = 0; nd < 8; ++nd) O[orow + nd * 16 + l15] = f2bf(o[nd][j] * inv);
        }
    }
}

#define N_PHASES 19
template <int PH>
__device__ __forceinline__ void run_phase(const Params& p, char* smem) {
    if (PH == 0) ph_ada(p, smem);
    else if (PH == 1) ph_rows<0>(p, smem);
    else if (PH == 2) ph_gemm_in(p, smem);
    else if (PH == 3) ph_prep(p, smem);
    else if (PH == 4) ph_scan(p, smem);
    else if (PH == 5) ph_merge(p, smem);
    else if (PH == 6) ph_gemm_out<0>(p, smem);
    else if (PH == 7) ph_rows<1>(p, smem);
    else if (PH == 8) ph_moe_up<0>(p, smem);
    else if (PH == 9) ph_moe_down<0>(p, smem);
    else if (PH == 10) ph_rows<2>(p, smem);
    else if (PH == 11) ph_gemm_qkv(p, smem);
    else if (PH == 12) ph_qkprep(p, smem);
    else if (PH == 13) ph_attn(p, smem);
    else if (PH == 14) ph_gemm_out<1>(p, smem);
    else if (PH == 15) ph_rows<3>(p, smem);
    else if (PH == 16) ph_moe_up<1>(p, smem);
    else if (PH == 17) ph_moe_down<1>(p, smem);
    else if (PH == 18) ph_rows<4>(p, smem);
}

template <int PH>
__global__ void __launch_bounds__(NTHR, 2) k_phase(Params p) {
    __shared__ __attribute__((aligned(16))) char smem[65536];
    run_phase<PH>(p, smem);
}

#if ONE_LAUNCH
template <int PH>
__device__ __forceinline__ void run_all(const Params& p, char* smem, const XcdBarrier& bar) {
    run_phase<PH>(p, smem);
    if (PH + 1 < N_PHASES) {
        xcd_barrier(bar);
        run_all<(PH + 1 < N_PHASES) ? PH + 1 : PH>(p, smem, bar);
    }
}
template <>
__device__ __forceinline__ void run_all<N_PHASES - 1>(const Params& p, char* smem, const XcdBarrier& bar) {
    run_phase<N_PHASES - 1>(p, smem);
}

__global__ void __launch_bounds__(NTHR, 2) k_mega(Params p) {
    __shared__ __attribute__((aligned(16))) char smem[65536 - 16];
    __shared__ uint4 xb_words;
    if (threadIdx.x == 0) xb_words = make_uint4(0u, 0u, 0u, 0u);
    __syncthreads();
    XcdBarrier bar = xcd_barrier_post((unsigned*)(p.ws + OFF_ZERO), (volatile LAS unsigned*)&xb_words);
    run_all<0>(p, smem, bar);
}
#endif

template <int PH>
static void launch_phases(const Params& p, hipStream_t stream) {
    hipLaunchKernelGGL(k_phase<PH>, dim3(256), dim3(NTHR), 0, stream, p);
    if constexpr (PH + 1 < N_PHASES) launch_phases<PH + 1>(p, stream);
}

extern "C" void kernel_launch(void* const* d_in, const int* in_sizes, int n_in, void* d_out, int out_size, void* d_ws,
                              size_t ws_size, hipStream_t stream) {
    Params p{};
    for (int i = 0; i < 32; ++i) p.in[i] = (const float*)d_in[i];
    p.out = (float*)d_out;
    p.ws = (char*)d_ws;
    (void)hipMemsetAsync(d_ws, 0, ZERO_BYTES, stream);
#if ONE_LAUNCH
    hipLaunchKernelGGL(k_mega, dim3(256), dim3(NTHR), 0, stream, p);
#else
    launch_phases<0>(p, stream);
#endif
}
```

```cpp
#include <hip/hip_runtime.h>
#include <stdint.h>

#ifndef ONE_LAUNCH
#define ONE_LAUNCH 1
#endif

typedef unsigned short bf16_t;
typedef __attribute__((ext_vector_type(8))) short bf16x8;
typedef __attribute__((ext_vector_type(4))) float f32x4;

#define D_MODEL 1024
#define BATCH 8
#define SEQ 2048
#define CTXL 256
#define NL (BATCH * SEQ)
#define NC (BATCH * CTXL)
#define NT (NL + NC)
#define AB_PROJ 3088
#define TSEQ (SEQ + CTXL)
#define EPSF 1e-6f
#define NTHR 512

enum { I_X = 0, I_C, I_CTX, I_CCTX, I_ADAW, I_ADAB, I_NORM1, I_NORM2, I_FNORM, I_ABWIN, I_CONVQKV, I_ALOG, I_DTB,
       I_ONORM, I_CONVX, I_RGWR, I_RGBR, I_RGWI, I_RGBI, I_RGLAM, I_ABWOUT, I_ATWQKV, I_QNORM, I_KNORM, I_ATWOUT,
       I_WGRP, I_BGRP, I_WEXP, I_BEXP, I_WGATE, I_WUP, I_WDOWN };

#define AL256(x) (((size_t)(x) + 255) & ~(size_t)255)
#define OFF_ZERO 0
#define ZERO_BYTES 65536
#define OFF_CNT 16384
#define OFF_MOD (OFF_ZERO + ZERO_BYTES)
#define OFF_X AL256(OFF_MOD + 2 * 9 * 6144 * 4)
#define OFF_H AL256(OFF_X + (size_t)NT * 1024 * 4)
#define OFF_Z AL256(OFF_H + (size_t)NT * 1024 * 2)
#define OFF_QKVC AL256(OFF_Z + (size_t)NT * AB_PROJ * 2)
#define OFF_G AL256(OFF_QKVC + (size_t)NT * 1536 * 2)
#define OFF_BETA AL256(OFF_G + (size_t)2 * NT * 4 * 4)
#define OFF_LA AL256(OFF_BETA + (size_t)2 * NT * 4 * 4)
#define OFF_LB AL256(OFF_LA + (size_t)2 * NT * 512 * 4)
#define OFF_OA AL256(OFF_LB + (size_t)2 * NT * 512 * 4)
#define OFF_WSEL AL256(OFF_OA + (size_t)2 * NT * 512 * 2)
#define OFF_LIST AL256(OFF_WSEL + (size_t)2 * NT * 4)
#define OFF_END AL256(OFF_LIST + (size_t)32 * NT * 4)
#define OFF_ACT OFF_QKVC
#define OFF_YE OFF_LA
#define OFF_ZQ OFF_Z
#define OFF_ZC (OFF_Z + (size_t)NL * 1536 * 2)
#define OFF_QA OFF_LB
#define OFF_KA (OFF_QA + (size_t)NL * 1024 * 2)
#define OFF_VT (OFF_KA + (size_t)8 * 2 * TSEQ * 128 * 2)
#define OFF_O OFF_H

struct Params {
    const float* in[32];
    float* out;
    char* ws;
};

__device__ __forceinline__ bf16_t f2bf(float f) {
    unsigned u = __float_as_uint(f);
    u += 0x7fffu + ((u >> 16) & 1u);
    return (bf16_t)(u >> 16);
}
__device__ __forceinline__ float bf2f(bf16_t h) { return __uint_as_float(((unsigned)h) << 16); }
__device__ __forceinline__ unsigned pack2(float a, float b) { return (unsigned)f2bf(a) | ((unsigned)f2bf(b) << 16); }
__device__ __forceinline__ float sigmoidf_(float x) { return 1.f / (1.f + __expf(-x)); }
__device__ __forceinline__ float siluf_(float x) { return x / (1.f + __expf(-x)); }
__device__ __forceinline__ float softplusf_(float x) { return x > 20.f ? x : log1pf(__expf(x)); }
__device__ __forceinline__ float geluf_(float x) {
    const float u = 0.7978845608028654f * (x + 0.044715f * x * x * x);
    return 0.5f * x * (1.f + tanhf(u));
}
__device__ __forceinline__ float wave_sum(float v) {
#pragma unroll
    for (int o = 32; o >= 1; o >>= 1) v += __shfl_xor(v, o, 64);
    return v;
}
__device__ __forceinline__ int scan_row(int s, int dir, int b) {
    if (s < CTXL) { const int t = dir ? (CTXL - 1 - s) : s; return NL + b * CTXL + t; }
    const int u = s - CTXL; const int t = dir ? (SEQ - 1 - u) : u; return b * SEQ + t;
}

#define XB_TMO      128
#define XB_XCNT(j)  (256  + 64 * (j))
#define XB_XSUB(j)  (1280 + 64 * (j))
#define XB_XGEN(j)  (2304 + 64 * (j))
#define XB_TOP      3328
#define XB_TOPGEN   3392
#define XCD_BAR_WORDS 3456
#define XB_SPIN_CAP (1u << 22)
#define LAS __attribute__((address_space(3)))

__device__ __forceinline__ unsigned xb_ld(unsigned* p)              { return __hip_atomic_load(p, __ATOMIC_RELAXED, __HIP_MEMORY_SCOPE_AGENT); }
__device__ __forceinline__ unsigned xb_add(unsigned* p, unsigned v) { return __hip_atomic_fetch_add(p, v, __ATOMIC_RELAXED, __HIP_MEMORY_SCOPE_AGENT); }
__device__ __forceinline__ unsigned xb_xcc_id() { return (unsigned)__builtin_amdgcn_s_getreg((3 << 11) | 20) & 0xFu; }
#define XB_SPIN(cond, bar) do { unsigned _sp = 0; while (cond) { __builtin_amdgcn_s_sleep(1); \
    if ((++_sp & 255u) == 0u) { if (xb_ld(&(bar)[XB_TMO])) break; if (_sp > XB_SPIN_CAP) { atomicAdd(&(bar)[XB_TMO], 1u); break; } } } } while (0)

struct XcdBarrier {
    unsigned* bar; unsigned x;
    volatile LAS unsigned* st;
};
__device__ __forceinline__ XcdBarrier xcd_barrier_post(unsigned* bar, volatile LAS unsigned* st) {
    XcdBarrier b; b.bar = bar; b.x = xb_xcc_id(); b.st = st;
    if (threadIdx.x == 0) (void)xb_add(&bar[XB_XCNT(b.x)], 1u);
    return b;
}
__device__ __forceinline__ void xcd_barrier_complete(unsigned* bar, unsigned x, unsigned& nloc, unsigned& nx) {
    const unsigned G = gridDim.x * gridDim.y * gridDim.z;
    unsigned sum, cnt, mine, sp = 0u;
    for (;;) {
        sum = 0u; cnt = 0u; mine = 0u;
#pragma unroll
        for (unsigned j = 0; j < 16; ++j) { const unsigned c = xb_ld(&bar[XB_XCNT(j)]); sum += c; cnt += (c > 0u) ? 1u : 0u; mine = (j == x) ? c : mine; }
        if (sum == G) break;
        __builtin_amdgcn_s_sleep(1);
        if ((++sp & 255u) == 0u) { if (xb_ld(&bar[XB_TMO])) break; if (sp > XB_SPIN_CAP) { atomicAdd(&bar[XB_TMO], 1u); break; } }
    }
    nloc = mine > 0u ? mine : 1u; nx = cnt > 0u ? cnt : 1u;
}
__device__ __forceinline__ void xcd_barrier(const XcdBarrier& b) {
    asm volatile("s_waitcnt vmcnt(0)" ::: "memory");
    __syncthreads();
    if (threadIdx.x == 0) {
        unsigned* bar = b.bar;
        __builtin_amdgcn_s_waitcnt(0);
        unsigned nloc = b.st[0], nx = b.st[1];
        if (nloc == 0u) { xcd_barrier_complete(bar, b.x, nloc, nx); b.st[0] = nloc; b.st[1] = nx; }
        const unsigned old = xb_add(&bar[XB_XSUB(b.x)], 1u);
        const unsigned gen = old / nloc;
        if (old + 1u == (gen + 1u) * nloc) {
            __builtin_amdgcn_fence(__ATOMIC_RELEASE, "agent");
            asm volatile("s_waitcnt vmcnt(0)" ::: "memory");
            const unsigned og = xb_add(&bar[XB_TOP], 1u);
            const unsigned tg = og / nx;
            if (og + 1u == (tg + 1u) * nx) xb_add(&bar[XB_TOPGEN], 1u);
            else XB_SPIN(xb_ld(&bar[XB_TOPGEN]) == tg, bar);
            __builtin_amdgcn_fence(__ATOMIC_ACQUIRE, "agent");
            xb_add(&bar[XB_XGEN(b.x)], 1u);
            asm volatile("s_waitcnt vmcnt(0)" ::: "memory");
        } else {
            XB_SPIN(xb_ld(&bar[XB_XGEN(b.x)]) == gen, bar);
            __builtin_amdgcn_fence(__ATOMIC_ACQUIRE, "agent");
            asm volatile("s_waitcnt vmcnt(0)" ::: "memory");
        }
    }
    __syncthreads();
}

template <int NB, class RowPtr, class Epi>
__device__ __forceinline__ void gemm_tile(RowPtr rowptr, const float* __restrict__ B0, const float* __restrict__ B1,
                                          int ldb, int K, int n0, int N, Epi epi, char* smem) {
    constexpr int LDS_LD = 72;
    bf16_t* As = (bf16_t*)smem;
    bf16_t* Bs0 = As + 128 * LDS_LD;
    bf16_t* Bs1 = Bs0 + 128 * LDS_LD;
    const int tid = threadIdx.x, lane = tid & 63, wave = tid >> 6;
    const int wm = wave >> 1, wn = wave & 1;
    const int l15 = lane & 15, lq = lane >> 4;

    const bf16_t* arow0 = rowptr(tid >> 3);
    const bf16_t* arow1 = rowptr((tid >> 3) + 64);
    const int akc = (tid & 7) * 8;
    const int bn = tid & 127, bkg = tid >> 7;
    const bool bok = (n0 + bn) < N;
    const float* b0p = B0 + (size_t)(bkg * 8) * ldb + n0 + bn;
    const float* b1p = (NB == 2) ? (B1 + (size_t)(bkg * 8) * ldb + n0 + bn) : nullptr;

    f32x4 acc0[2][4], acc1[2][4];
#pragma unroll
    for (int i = 0; i < 2; ++i)
#pragma unroll
        for (int j = 0; j < 4; ++j) { acc0[i][j] = (f32x4){0.f, 0.f, 0.f, 0.f}; acc1[i][j] = (f32x4){0.f, 0.f, 0.f, 0.f}; }

    uint4 ra0, ra1;
    float rb0[16], rb1[16];
    const int nk = K >> 6;
    auto load_regs = [&](int kt) {
        const int k0 = kt * 64;
        ra0 = arow0 ? *(const uint4*)(arow0 + k0 + akc) : make_uint4(0, 0, 0, 0);
        ra1 = arow1 ? *(const uint4*)(arow1 + k0 + akc) : make_uint4(0, 0, 0, 0);
#pragma unroll
        for (int r = 0; r < 2; ++r)
#pragma unroll
            for (int j = 0; j < 8; ++j) {
                const size_t o = (size_t)(k0 + r * 32 + j) * ldb;
                rb0[r * 8 + j] = bok ? b0p[o] : 0.f;
                if (NB == 2) rb1[r * 8 + j] = bok ? b1p[o] : 0.f;
            }
    };
    load_regs(0);
    for (int kt = 0; kt < nk; ++kt) {
        __syncthreads();
        *(uint4*)(As + (tid >> 3) * LDS_LD + akc) = ra0;
        *(uint4*)(As + ((tid >> 3) + 64) * LDS_LD + akc) = ra1;
#pragma unroll
        for (int r = 0; r < 2; ++r) {
            uint4 w;
            w.x = pack2(rb0[r * 8 + 0], rb0[r * 8 + 1]); w.y = pack2(rb0[r * 8 + 2], rb0[r * 8 + 3]);
            w.z = pack2(rb0[r * 8 + 4], rb0[r * 8 + 5]); w.w = pack2(rb0[r * 8 + 6], rb0[r * 8 + 7]);
            *(uint4*)(Bs0 + bn * LDS_LD + bkg * 8 + r * 32) = w;
            if (NB == 2) {
                w.x = pack2(rb1[r * 8 + 0], rb1[r * 8 + 1]); w.y = pack2(rb1[r * 8 + 2], rb1[r * 8 + 3]);
                w.z = pack2(rb1[r * 8 + 4], rb1[r * 8 + 5]); w.w = pack2(rb1[r * 8 + 6], rb1[r * 8 + 7]);
                *(uint4*)(Bs1 + bn * LDS_LD + bkg * 8 + r * 32) = w;
            }
        }
        __syncthreads();
        if (kt + 1 < nk) load_regs(kt + 1);
#pragma unroll
        for (int kk = 0; kk < 2; ++kk) {
            bf16x8 af[2];
#pragma unroll
            for (int mi = 0; mi < 2; ++mi)
                af[mi] = *(const bf16x8*)(As + (wm * 32 + mi * 16 + l15) * LDS_LD + kk * 32 + lq * 8);
#pragma unroll
            for (int ni = 0; ni < 4; ++ni) {
                const bf16x8 bf0 = *(const bf16x8*)(Bs0 + (wn * 64 + ni * 16 + l15) * LDS_LD + kk * 32 + lq * 8);
#pragma unroll
                for (int mi = 0; mi < 2; ++mi) acc0[mi][ni] = __builtin_amdgcn_mfma_f32_16x16x32_bf16(af[mi], bf0, acc0[mi][ni], 0, 0, 0);
                if (NB == 2) {
                    const bf16x8 bf1 = *(const bf16x8*)(Bs1 + (wn * 64 + ni * 16 + l15) * LDS_LD + kk * 32 + lq * 8);
#pragma unroll
                    for (int mi = 0; mi < 2; ++mi) acc1[mi][ni] = __builtin_amdgcn_mfma_f32_16x16x32_bf16(af[mi], bf1, acc1[mi][ni], 0, 0, 0);
                }
            }
        }
    }
#pragma unroll
    for (int mi = 0; mi < 2; ++mi)
#pragma unroll
        for (int ni = 0; ni < 4; ++ni) {
            const int n = n0 + wn * 64 + ni * 16 + l15;
            if (n < N) {
#pragma unroll
                for (int j = 0; j < 4; ++j) epi(wm * 32 + mi * 16 + lq * 4 + j, n, acc0[mi][ni][j], acc1[mi][ni][j]);
            }
        }
}

__device__ void ph_ada(const Params& p, char* smem) {
    const int tid = threadIdx.x;
    float* scond = (float*)smem;
    float* red = scond + 9 * 1024;
    float* MOD = (float*)(p.ws + OFF_MOD);
    for (int i = tid; i < 9 * 1024; i += NTHR) {
        const int r = i >> 10, k = i & 1023;
        const float v = r < 8 ? p.in[I_C][r * 1024 + k] : p.in[I_CCTX][k];
        scond[i] = siluf_(v);
    }
    __syncthreads();
    for (int item = blockIdx.x; item < 192; item += gridDim.x) {
        const int l = item / 96, cg = item % 96;
        const int kq = tid >> 6, cl = tid & 63, col = cg * 64 + cl;
        const float* W = p.in[I_ADAW] + (size_t)l * 1024 * 6144;
        float acc[9];
#pragma unroll
        for (int r = 0; r < 9; ++r) acc[r] = 0.f;
        for (int k = kq * 128; k < kq * 128 + 128; ++k) {
            const float w = W[(size_t)k * 6144 + col];
#pragma unroll
            for (int r = 0; r < 9; ++r) acc[r] += scond[r * 1024 + k] * w;
        }
#pragma unroll
        for (int r = 0; r < 9; ++r) red[(kq * 9 + r) * 64 + cl] = acc[r];
        __syncthreads();
        for (int i = tid; i < 9 * 64; i += NTHR) {
            const int r = i >> 6, cc = i & 63;
            float s = 0.f;
#pragma unroll
            for (int q = 0; q < 8; ++q) s += red[(q * 9 + r) * 64 + cc];
            MOD[(size_t)(l * 9 + r) * 6144 + cg * 64 + cc] = s + p.in[I_ADAB][l * 6144 + cg * 64 + cc];
        }
        __syncthreads();
    }
}

template <int MODE>
__device__ void ph_rows(const Params& p, char* smem) {
    const int tid = threadIdx.x, lane = tid & 63, wave = tid >> 6;
    constexpr int L = (MODE >= 2) ? 1 : 0;
    constexpr int NROWS = (MODE >= 3) ? NL : NT;
    constexpr bool ROUTER = (MODE == 1 || MODE == 3);
    float* X = (float*)(p.ws + OFF_X);
    bf16_t* H = (bf16_t*)(p.ws + OFF_H);
    const bf16_t* YE = (const bf16_t*)(p.ws + OFF_YE);
    const float* MOD = (const float*)(p.ws + OFF_MOD);
    float* hs = (float*)smem + wave * 1024;
    float* lg = (float*)smem + 8 * 1024 + wave * 64;
    unsigned* cnt = (unsigned*)(p.ws + OFF_CNT) + L * 32;
    int* LIST = (int*)(p.ws + OFF_LIST);
    float* WSEL = (float*)(p.ws + OFF_WSEL);

    for (int row = blockIdx.x * 8 + wave; row < NROWS; row += gridDim.x * 8) {
        const int mr = row < NL ? (row >> 11) : 8;
        float v[16];
        if (MODE == 0) {
            const float* src = row < NL ? p.in[I_X] + (size_t)row * 1024 : p.in[I_CTX] + (size_t)(row - NL) * 1024;
#pragma unroll
            for (int i = 0; i < 4; ++i) {
                const float4 t = *(const float4*)(src + i * 256 + lane * 4);
                v[i * 4 + 0] = t.x; v[i * 4 + 1] = t.y; v[i * 4 + 2] = t.z; v[i * 4 + 3] = t.w;
            }
        } else {
#pragma unroll
            for (int i = 0; i < 4; ++i) {
                const float4 t = *(const float4*)(X + (size_t)row * 1024 + i * 256 + lane * 4);
                v[i * 4 + 0] = t.x; v[i * 4 + 1] = t.y; v[i * 4 + 2] = t.z; v[i * 4 + 3] = t.w;
            }
        }
        if (MODE == 2 || MODE == 4) {
            constexpr int LP = (MODE == 2) ? 0 : 1;
            const float* g2 = MOD + (size_t)(LP * 9 + mr) * 6144 + 5 * 1024;
#pragma unroll
            for (int i = 0; i < 4; ++i) {
                const int c = i * 256 + lane * 4;
                const uint2 a = *(const uint2*)(YE + (size_t)(2 * row) * 1024 + c);
                const uint2 b = *(const uint2*)(YE + (size_t)(2 * row + 1) * 1024 + c);
                const float4 g = *(const float4*)(g2 + c);
                v[i * 4 + 0] += g.x * (bf2f((bf16_t)(a.x & 0xffff)) + bf2f((bf16_t)(b.x & 0xffff)));
                v[i * 4 + 1] += g.y * (bf2f((bf16_t)(a.x >> 16)) + bf2f((bf16_t)(b.x >> 16)));
                v[i * 4 + 2] += g.z * (bf2f((bf16_t)(a.y & 0xffff)) + bf2f((bf16_t)(b.y & 0xffff)));
                v[i * 4 + 3] += g.w * (bf2f((bf16_t)(a.y >> 16)) + bf2f((bf16_t)(b.y >> 16)));
            }
        }
        if (MODE == 0 || MODE == 2) {
#pragma unroll
            for (int i = 0; i < 4; ++i)
                *(float4*)(X + (size_t)row * 1024 + i * 256 + lane * 4) = make_float4(v[i * 4], v[i * 4 + 1], v[i * 4 + 2], v[i * 4 + 3]);
        }
        float ss = 0.f;
#pragma unroll
        for (int i = 0; i < 16; ++i) ss += v[i] * v[i];
        ss = wave_sum(ss);
        const float rinv = rsqrtf(ss * (1.f / 1024.f) + EPSF);
        if (MODE == 4) {
#pragma unroll
            for (int i = 0; i < 4; ++i) {
                const int c = i * 256 + lane * 4;
                const float4 w = *(const float4*)(p.in[I_FNORM] + c);
                *(float4*)(p.out + (size_t)row * 1024 + c) =
                    make_float4(v[i * 4] * rinv * w.x, v[i * 4 + 1] * rinv * w.y, v[i * 4 + 2] * rinv * w.z, v[i * 4 + 3] * rinv * w.w);
            }
        } else {
            constexpr int SH = (MODE == 0 || MODE == 2) ? 0 : 3;
            const float* gain = p.in[(MODE == 0 || MODE == 2) ? I_NORM1 : I_NORM2] + L * 1024;
            const float* sh = MOD + (size_t)(L * 9 + mr) * 6144 + SH * 1024;
            const float* sc = sh + 1024;
#pragma unroll
            for (int i = 0; i < 4; ++i) {
                const int c = i * 256 + lane * 4;
                const float4 w = *(const float4*)(gain + c);
                const float4 s1 = *(const float4*)(sc + c);
                const float4 s0 = *(const float4*)(sh + c);
                float h0 = v[i * 4 + 0] * rinv * w.x * (1.f + s1.x) + s0.x;
                float h1 = v[i * 4 + 1] * rinv * w.y * (1.f + s1.y) + s0.y;
                float h2 = v[i * 4 + 2] * rinv * w.z * (1.f + s1.z) + s0.z;
                float h3 = v[i * 4 + 3] * rinv * w.w * (1.f + s1.w) + s0.w;
                uint2 o; o.x = pack2(h0, h1); o.y = pack2(h2, h3);
                *(uint2*)(H + (size_t)row * 1024 + c) = o;
                if (ROUTER) *(float4*)(hs + c) = make_float4(h0, h1, h2, h3);
            }
            if (ROUTER) {
                __builtin_amdgcn_wave_barrier();
                if (lane < 36) {
                    const float* W; int ld; float bias;
                    if (lane < 4) { W = p.in[I_WGRP] + (size_t)L * 1024 * 4 + lane; ld = 4; bias = p.in[I_BGRP][L * 4 + lane]; }
                    else { W = p.in[I_WEXP] + (size_t)L * 1024 * 32 + (lane - 4); ld = 32; bias = p.in[I_BEXP][L * 32 + lane - 4]; }
                    float a0 = 0.f, a1 = 0.f, a2 = 0.f, a3 = 0.f;
                    for (int k = 0; k < 1024; k += 4) {
                        a0 += hs[k] * W[(size_t)k * ld];
                        a1 += hs[k + 1] * W[(size_t)(k + 1) * ld];
                        a2 += hs[k + 2] * W[(size_t)(k + 2) * ld];
                        a3 += hs[k + 3] * W[(size_t)(k + 3) * ld];
                    }
                    lg[lane] = (a0 + a1) + (a2 + a3) + bias;
                }
                __builtin_amdgcn_wave_barrier();
                if (lane == 0) {
                    int gi = 0; float gm = lg[0];
#pragma unroll
                    for (int j = 1; j < 4; ++j) if (lg[j] > gm) { gm = lg[j]; gi = j; }
                    float gs = 0.f;
#pragma unroll
                    for (int j = 0; j < 4; ++j) gs += __expf(lg[j] - gm);
                    const float gw = 1.f / gs;
                    const float* el = lg + 4 + gi * 8;
                    int e0 = 0; float v0 = el[0];
#pragma unroll
                    for (int j = 1; j < 8; ++j) if (el[j] > v0) { v0 = el[j]; e0 = j; }
                    int e1 = -1; float v1 = -3.0e38f;
#pragma unroll
                    for (int j = 0; j < 8; ++j) if (j != e0 && el[j] > v1) { v1 = el[j]; e1 = j; }
                    const float t = __expf(v1 - v0);
                    const float w0 = gw / (1.f + t), w1 = gw * t / (1.f + t);
                    const int x0 = gi * 8 + e0, x1 = gi * 8 + e1;
                    const unsigned s0 = __hip_atomic_fetch_add(&cnt[x0], 1u, __ATOMIC_RELAXED, __HIP_MEMORY_SCOPE_AGENT);
                    const unsigned s1 = __hip_atomic_fetch_add(&cnt[x1], 1u, __ATOMIC_RELAXED, __HIP_MEMORY_SCOPE_AGENT);
                    LIST[(size_t)x0 * NT + s0] = 2 * row;
                    LIST[(size_t)x1 * NT + s1] = 2 * row + 1;
                    WSEL[2 * row] = w0;
                    WSEL[2 * row + 1] = w1;
                }
                __builtin_amdgcn_wave_barrier();
            }
        }
    }
}

__device__ void ph_gemm_in(const Params& p, char* smem) {
    const bf16_t* H = (const bf16_t*)(p.ws + OFF_H);
    bf16_t* Z = (bf16_t*)(p.ws + OFF_Z);
    constexpr int NTN = (AB_PROJ + 127) / 128;
    for (int w = blockIdx.x; w < (NT / 128) * NTN; w += gridDim.x) {
        const int mt = w / NTN, nt = w % NTN;
        const int m0 = mt * 128;
        gemm_tile<1>([&](int m) { return H + (size_t)(m0 + m) * 1024; }, p.in[I_ABWIN], nullptr, AB_PROJ, 1024, nt * 128, AB_PROJ,
                     [&](int m, int n, float v0, float) { Z[(size_t)(m0 + m) * AB_PROJ + n] = f2bf(v0); }, smem);
    }
}
template <int L>
__device__ void ph_gemm_out(const Params& p, char* smem) {
    const bf16_t* A = (const bf16_t*)(p.ws + OFF_H);
    float* X = (float*)(p.ws + OFF_X);
    const float* MOD = (const float*)(p.ws + OFF_MOD);
    const float* W = p.in[L == 0 ? I_ABWOUT : I_ATWOUT];
    constexpr int NROWS = (L == 0) ? NT : NL;
    for (int w = blockIdx.x; w < (NROWS / 128) * 8; w += gridDim.x) {
        const int mt = w >> 3, nt = w & 7;
        const int m0 = mt * 128;
        const int mr = m0 < NL ? (m0 >> 11) : 8;
        const float* g1 = MOD + (size_t)(L * 9 + mr) * 6144 + 2 * 1024;
        gemm_tile<1>([&](int m) { return A + (size_t)(m0 + m) * 1024; }, W, nullptr, 1024, 1024, nt * 128, 1024,
                     [&](int m, int n, float v0, float) { X[(size_t)(m0 + m) * 1024 + n] += g1[n] * v0; }, smem);
    }
}
__device__ void ph_gemm_qkv(const Params& p, char* smem) {
    const bf16_t* H = (const bf16_t*)(p.ws + OFF_H);
    bf16_t* ZQ = (bf16_t*)(p.ws + OFF_ZQ);
    bf16_t* ZC = (bf16_t*)(p.ws + OFF_ZC);
    const int n_lat = (NL / 128) * 12, n_ctx = (NC / 128) * 4;
    for (int w = blockIdx.x; w < n_lat + n_ctx; w += gridDim.x) {
        if (w < n_lat) {
            const int mt = w / 12, nt = w % 12, m0 = mt * 128;
            gemm_tile<1>([&](int m) { return H + (size_t)(m0 + m) * 1024; }, p.in[I_ATWQKV], nullptr, 1536, 1024, nt * 128, 1536,
                         [&](int m, int n, float v0, float) { ZQ[(size_t)(m0 + m) * 1536 + n] = f2bf(v0); }, smem);
        } else {
            const int w2 = w - n_lat;
            const int mt = w2 >> 2, nt = w2 & 3, m0 = mt * 128;
            gemm_tile<1>([&](int m) { return H + (size_t)(NL + m0 + m) * 1024; }, p.in[I_ATWQKV] + 1024, nullptr, 1536, 1024, nt * 128, 512,
                         [&](int m, int n, float v0, float) { ZC[(size_t)(m0 + m) * 512 + n] = f2bf(v0); }, smem);
        }
    }
}

__device__ __forceinline__ int moe_prefix(const Params& p, int L, int* pre  ) {
    unsigned* cnt = (unsigned*)(p.ws + OFF_CNT) + L * 32;
    __syncthreads();
    if (threadIdx.x == 0) {
        int s = 0;
        for (int e = 0; e < 32; ++e) { pre[e] = s; s += ((int)xb_ld(&cnt[e]) + 127) >> 7; }
        pre[32] = s;
    }
    __syncthreads();
    return pre[32];
}
template <int L>
__device__ void ph_moe_up(const Params& p, char* smem) {
    int* pre = (int*)(smem + 60 * 1024);
    const int total = moe_prefix(p, L, pre);
    const unsigned* cnt = (const unsigned*)(p.ws + OFF_CNT) + L * 32;
    const bf16_t* H = (const bf16_t*)(p.ws + OFF_H);
    bf16_t* ACT = (bf16_t*)(p.ws + OFF_ACT);
    const int* LIST = (const int*)(p.ws + OFF_LIST);
    const float* WSEL = (const float*)(p.ws + OFF_WSEL);
    for (int w = blockIdx.x; w < total * 4; w += gridDim.x) {
        const int mt = w >> 2, nt = w & 3;
        int e = 0;
        for (int j = 1; j < 32; ++j) if (pre[j] <= mt) e = j;
        const int m0 = (mt - pre[e]) * 128;
        const int mv = (int)cnt[e] - m0;
        const int* lst = LIST + (size_t)e * NT + m0;
        const float* Wg = p.in[I_WGATE] + ((size_t)L * 32 + e) * 1024 * 512;
        const float* Wu = p.in[I_WUP] + ((size_t)L * 32 + e) * 1024 * 512;
        gemm_tile<2>([&](int m) -> const bf16_t* { return m < mv ? H + (size_t)(lst[m] >> 1) * 1024 : nullptr; }, Wg, Wu, 512, 1024,
                     nt * 128, 512,
                     [&](int m, int n, float v0, float v1) {
                         if (m < mv) { const int r = lst[m]; ACT[(size_t)r * 512 + n] = f2bf(siluf_(v0) * v1 * WSEL[r]); }
                     }, smem);
    }
}
template <int L>
__device__ void ph_moe_down(const Params& p, char* smem) {
    int* pre = (int*)(smem + 60 * 1024);
    const int total = moe_prefix(p, L, pre);
    const unsigned* cnt = (const unsigned*)(p.ws + OFF_CNT) + L * 32;
    const bf16_t* ACT = (const bf16_t*)(p.ws + OFF_ACT);
    bf16_t* YE = (bf16_t*)(p.ws + OFF_YE);
    const int* LIST = (const int*)(p.ws + OFF_LIST);
    for (int w = blockIdx.x; w < total * 8; w += gridDim.x) {
        const int mt = w >> 3, nt = w & 7;
        int e = 0;
        for (int j = 1; j < 32; ++j) if (pre[j] <= mt) e = j;
        const int m0 = (mt - pre[e]) * 128;
        const int mv = (int)cnt[e] - m0;
        const int* lst = LIST + (size_t)e * NT + m0;
        const float* Wd = p.in[I_WDOWN] + ((size_t)L * 32 + e) * 512 * 1024;
        gemm_tile<1>([&](int m) -> const bf16_t* { return m < mv ? ACT + (size_t)lst[m] * 512 : nullptr; }, Wd, nullptr, 1024, 512,
                     nt * 128, 1024,
                     [&](int m, int n, float v0, float) {
                         if (m < mv) YE[(size_t)lst[m] * 1024 + n] = f2bf(v0);
                     }, smem);
    }
}

__device__ void ph_prep(const Params& p, char* smem) {
    const int tid = threadIdx.x, lane = tid & 63, wave = tid >> 6;
    const bf16_t* Z = (const bf16_t*)(p.ws + OFF_Z);
    bf16_t* QKVC = (bf16_t*)(p.ws + OFF_QKVC);
    float* G = (float*)(p.ws + OFF_G);
    float* BETA = (float*)(p.ws + OFF_BETA);
    float* LA = (float*)(p.ws + OFF_LA);
    float* LB = (float*)(p.ws + OFF_LB);
    float* xcs = (float*)smem;
    const float* cw = p.in[I_CONVQKV];
    const float* cx = p.in[I_CONVX];
    for (int item = blockIdx.x; item < NT / 8; item += gridDim.x) {
        const int row0 = item * 8;
        int sbeg, send;
        if (row0 < NL) { sbeg = (row0 >> 11) << 11; send = sbeg + SEQ; }
        else { sbeg = NL + (((row0 - NL) >> 8) << 8); send = sbeg + CTXL; }
        for (int u = wave; u < 96; u += 8) {
            const int tk = u / 12, grp = u % 12;
            const int row = row0 + tk;
            const int c = grp * 128 + lane * 2;
            float a0 = 0.f, a1 = 0.f;
#pragma unroll
            for (int j = 0; j < 4; ++j) {
                const int r = row + j - 2;
                if (r >= sbeg && r < send) {
                    const unsigned z2 = *(const unsigned*)(Z + (size_t)r * AB_PROJ + c);
                    a0 += bf2f((bf16_t)(z2 & 0xffff)) * cw[j * 1536 + c];
                    a1 += bf2f((bf16_t)(z2 >> 16)) * cw[j * 1536 + c + 1];
                }
            }
            a0 = siluf_(a0); a1 = siluf_(a1);
            if (grp < 8) {
                const float ss = wave_sum(a0 * a0 + a1 * a1);
                float sc = rsqrtf(ss + EPSF);
                if (grp < 4) sc *= 0.08838834764831845f;
                a0 *= sc; a1 *= sc;
            }
            *(unsigned*)(QKVC + (size_t)row * 1536 + c) = pack2(a0, a1);
        }
        if (tid < 128) {
            const int tk = tid >> 4, q = tid & 15;
            const int d = q >> 3, s = (q >> 2) & 1, h = q & 3;
            const int row = row0 + tk;
            const float gv = bf2f(Z[(size_t)row * AB_PROJ + 2048 + q]);
            if (s == 0) {
                const float dec = -__expf(p.in[I_ALOG][d * 4 + h]) * softplusf_(gv + p.in[I_DTB][d * 4 + h]);
                G[((size_t)d * NT + row) * 4 + h] = dec;
            } else {
                BETA[((size_t)d * NT + row) * 4 + h] = sigmoidf_(gv);
            }
        }
        {
            const int c = tid;
#pragma unroll
            for (int tk = 0; tk < 8; ++tk) {
                const int row = row0 + tk;
                float a = 0.f;
#pragma unroll
                for (int j = 0; j < 4; ++j) {
                    const int r = row + j - 2;
                    if (r >= sbeg && r < send) a += bf2f(Z[(size_t)r * AB_PROJ + 2064 + c]) * cx[j * 512 + c];
                }
                xcs[tk * 512 + c] = a;
            }
        }
        __syncthreads();
        {
            const int c = tid, g = c >> 6, j = c & 63;
            float ar[2][8], ai[2][8];
#pragma unroll
            for (int d = 0; d < 2; ++d)
#pragma unroll
                for (int tk = 0; tk < 8; ++tk) { ar[d][tk] = 0.f; ai[d][tk] = 0.f; }
            const float* wr0 = p.in[I_RGWR] + ((size_t)(0 * 8 + g) * 64) * 64 + j;
            const float* wr1 = p.in[I_RGWR] + ((size_t)(1 * 8 + g) * 64) * 64 + j;
            const float* wi0 = p.in[I_RGWI] + ((size_t)(0 * 8 + g) * 64) * 64 + j;
            const float* wi1 = p.in[I_RGWI] + ((size_t)(1 * 8 + g) * 64) * 64 + j;
            for (int k = 0; k < 64; ++k) {
                const float r0 = wr0[k * 64], r1 = wr1[k * 64], i0 = wi0[k * 64], i1 = wi1[k * 64];
#pragma unroll
                for (int tk = 0; tk < 8; ++tk) {
                    const float x = xcs[tk * 512 + g * 64 + k];
                    ar[0][tk] += x * r0; ar[1][tk] += x * r1; ai[0][tk] += x * i0; ai[1][tk] += x * i1;
                }
            }
#pragma unroll
            for (int d = 0; d < 2; ++d) {
                const float br = p.in[I_RGBR][d * 512 + c], bi = p.in[I_RGBI][d * 512 + c];
                const float spl = softplusf_(-p.in[I_RGLAM][d * 512 + c]);
#pragma unroll
                for (int tk = 0; tk < 8; ++tk) {
                    const float r = sigmoidf_(ar[d][tk] + br), ig = sigmoidf_(ai[d][tk] + bi);
                    const float log_a = -8.0f * r * spl;
                    const float a = __expf(log_a);
                    const float bb = sqrtf(-expm1f(2.f * log_a)) * ig * xcs[tk * 512 + c];
                    const size_t o = ((size_t)d * NT + row0 + tk) * 512 + c;
                    LA[o] = a; LB[o] = bb;
                }
            }
        }
        __syncthreads();
    }
}

__device__ void delta_seq(const Params& p, int chain, char* smem) {
    const int tid = threadIdx.x;
    const int b = chain >> 3, h = (chain >> 1) & 3, dir = chain & 1;
    const bf16_t* QKVC = (const bf16_t*)(p.ws + OFF_QKVC);
    const float* G = (const float*)(p.ws + OFF_G) + (size_t)dir * NT * 4;
    const float* BETA = (const float*)(p.ws + OFF_BETA) + (size_t)dir * NT * 4;
    bf16_t* OA = (bf16_t*)(p.ws + OFF_OA) + (size_t)dir * NT * 512;
    float* kq = (float*)smem;
    float* vs = kq + 2 * 16 * 256;
    float* gbs = vs + 2 * 16 * 128;
    constexpr int NG = TSEQ / 16;
    auto stage = [&](int gi, int buf) {
        const int idx0 = tid - 256;
        for (int idx = idx0; idx < 384; idx += 256) {
            const int type = idx >> 7, d = idx & 127;
#pragma unroll 4
            for (int st = 0; st < 16; ++st) {
                const int row = scan_row(gi * 16 + st, dir, b);
                const float val = bf2f(QKVC[(size_t)row * 1536 + type * 512 + h * 128 + d]);
                if (type < 2) kq[(buf * 16 + st) * 256 + type * 128 + d] = val;
                else vs[(buf * 16 + st) * 128 + d] = val;
            }
        }
        if (idx0 < 32) {
            const int st = idx0 >> 1, wh = idx0 & 1;
            const int row = scan_row(gi * 16 + st, dir, b);
            gbs[(buf * 16 + st) * 2 + wh] = (wh ? BETA : G)[(size_t)row * 4 + h];
        }
    };
    float S[64];
#pragma unroll
    for (int d = 0; d < 64; ++d) S[d] = 0.f;
    if (tid >= 256) stage(0, 0);
    __syncthreads();
    for (int gi = 0; gi < NG; ++gi) {
        const int buf = gi & 1;
        if (tid >= 256) {
            if (gi + 1 < NG) stage(gi + 1, buf ^ 1);
        } else {
            const int e = tid >> 1, hf = tid & 1;
            for (int st = 0; st < 16; ++st) {
                const float* qp = kq + (buf * 16 + st) * 256 + hf * 64;
                const float* kp = qp + 128;
                const float g = gbs[(buf * 16 + st) * 2], beta = gbs[(buf * 16 + st) * 2 + 1];
                const float v = vs[(buf * 16 + st) * 128 + e];
                const float eg = __expf(g);
                float kS0 = 0.f, kS1 = 0.f;
#pragma unroll
                for (int d = 0; d < 64; d += 4) {
                    const float4 k4 = *(const float4*)(kp + d);
                    kS0 += k4.x * S[d] + k4.z * S[d + 2];
                    kS1 += k4.y * S[d + 1] + k4.w * S[d + 3];
                }
                float kS = kS0 + kS1;
                kS += __shfl_xor(kS, 1, 64);
                const float coef = beta * (v - eg * kS);
                float o0 = 0.f, o1 = 0.f;
#pragma unroll
                for (int d = 0; d < 64; d += 4) {
                    const float4 k4 = *(const float4*)(kp + d);
                    const float4 q4 = *(const float4*)(qp + d);
                    S[d] = eg * S[d] + coef * k4.x;
                    S[d + 1] = eg * S[d + 1] + coef * k4.y;
                    S[d + 2] = eg * S[d + 2] + coef * k4.z;
                    S[d + 3] = eg * S[d + 3] + coef * k4.w;
                    o0 += q4.x * S[d] + q4.z * S[d + 2];
                    o1 += q4.y * S[d + 1] + q4.w * S[d + 3];
                }
                float o = o0 + o1;
                o += __shfl_xor(o, 1, 64);
                if (hf == 0) {
                    const int row = scan_row(gi * 16 + st, dir, b);
                    OA[(size_t)row * 512 + h * 128 + e] = f2bf(o);
                }
            }
        }
        __syncthreads();
    }
}
__device__ void lru_seq(const Params& p, int li) {
    const int idx = li * NTHR + threadIdx.x;
    const int c = idx & 511, bd = idx >> 9, b = bd >> 1, dir = bd & 1;
    const float* LA = (const float*)(p.ws + OFF_LA) + (size_t)dir * NT * 512 + c;
    float* LB = (float*)(p.ws + OFF_LB) + (size_t)dir * NT * 512 + c;
    float hh = 0.f;
    for (int s0 = 0; s0 < TSEQ; s0 += 8) {
        float a[8], bb[8];
#pragma unroll
        for (int i = 0; i < 8; ++i) {
            const size_t o = (size_t)scan_row(s0 + i, dir, b) * 512;
            a[i] = LA[o]; bb[i] = LB[o];
        }
#pragma unroll
        for (int i = 0; i < 8; ++i) {
            hh = a[i] * hh + bb[i];
            LB[(size_t)scan_row(s0 + i, dir, b) * 512] = hh;
        }
    }
}
__device__ void ph_scan(const Params& p, char* smem) {
    for (int item = blockIdx.x; item < 80; item += gridDim.x) {
        if (item < 64) delta_seq(p, item, smem);
        else lru_seq(p, item - 64);
        __syncthreads();
    }
}

__device__ void ph_merge(const Params& p, char* smem) {
    const int tid = threadIdx.x, lane = tid & 63, wave = tid >> 6;
    const bf16_t* Z = (const bf16_t*)(p.ws + OFF_Z);
    const bf16_t* OA0 = (const bf16_t*)(p.ws + OFF_OA);
    const bf16_t* OA1 = OA0 + (size_t)NT * 512;
    const float* OB0 = (const float*)(p.ws + OFF_LB);
    const float* OB1 = OB0 + (size_t)NT * 512;
    bf16_t* M = (bf16_t*)(p.ws + OFF_H);
    const float* onorm = p.in[I_ONORM];
    for (int row = blockIdx.x * 8 + wave; row < NT; row += gridDim.x * 8) {
#pragma unroll
        for (int h = 0; h < 4; ++h) {
            const int c = h * 128 + lane * 2;
            const unsigned u0 = *(const unsigned*)(OA0 + (size_t)row * 512 + c);
            const unsigned u1 = *(const unsigned*)(OA1 + (size_t)row * 512 + c);
            const float o0 = bf2f((bf16_t)(u0 & 0xffff)) + bf2f((bf16_t)(u1 & 0xffff));
            const float o1 = bf2f((bf16_t)(u0 >> 16)) + bf2f((bf16_t)(u1 >> 16));
            const float ss = wave_sum(o0 * o0 + o1 * o1);
            const float rinv = rsqrtf(ss * (1.f / 128.f) + EPSF);
            const unsigned gz = *(const unsigned*)(Z + (size_t)row * AB_PROJ + 1536 + c);
            const float y0 = o0 * rinv * onorm[lane * 2] * siluf_(bf2f((bf16_t)(gz & 0xffff)));
            const float y1 = o1 * rinv * onorm[lane * 2 + 1] * siluf_(bf2f((bf16_t)(gz >> 16)));
            *(unsigned*)(M + (size_t)row * 1024 + c) = pack2(y0, y1);
        }
#pragma unroll
        for (int i = 0; i < 4; ++i) {
            const int c = i * 128 + lane * 2;
            const float2 b0 = *(const float2*)(OB0 + (size_t)row * 512 + c);
            const float2 b1 = *(const float2*)(OB1 + (size_t)row * 512 + c);
            const unsigned yz = *(const unsigned*)(Z + (size_t)row * AB_PROJ + 2576 + c);
            const float y0 = (b0.x + b1.x) * geluf_(bf2f((bf16_t)(yz & 0xffff)));
            const float y1 = (b0.y + b1.y) * geluf_(bf2f((bf16_t)(yz >> 16)));
            *(unsigned*)(M + (size_t)row * 1024 + 512 + c) = pack2(y0, y1);
        }
    }
}

__device__ void ph_qkprep(const Params& p, char* smem) {
    const int tid = threadIdx.x, lane = tid & 63, wave = tid >> 6;
    const bf16_t* ZQ = (const bf16_t*)(p.ws + OFF_ZQ);
    const bf16_t* ZC = (const bf16_t*)(p.ws + OFF_ZC);
    bf16_t* QA = (bf16_t*)(p.ws + OFF_QA);
    bf16_t* KA = (bf16_t*)(p.ws + OFF_KA);
    bf16_t* VT = (bf16_t*)(p.ws + OFF_VT);
    const float* qn = p.in[I_QNORM];
    const float* kn = p.in[I_KNORM];
    for (int row = blockIdx.x * 8 + wave; row < NT; row += gridDim.x * 8) {
        const bool lat = row < NL;
        const int b = lat ? (row >> 11) : ((row - NL) >> 8);
        const int t = lat ? (row & 2047) : ((row - NL) & 255);
        const int key = lat ? t : (SEQ + t);
        float cs = 1.f, sn = 0.f;
        if (lat) {
            const int f = lane & 31;
            const float pos = (lane < 32) ? (float)(t >> 6) : (float)(t & 63);
            const float inv = expf(-(float)f * (1.f / 32.f) * 9.210340371976184f);
            sincosf(pos * inv, &sn, &cs);
        }
        const bf16_t* src = lat ? ZQ + (size_t)row * 1536 : ZC + (size_t)(row - NL) * 512;
        const int koff = lat ? 1024 : 0;
        if (lat) {
#pragma unroll
            for (int h = 0; h < 8; ++h) {
                const unsigned u = *(const unsigned*)(src + h * 128 + lane * 2);
                float x1 = bf2f((bf16_t)(u & 0xffff)), x2 = bf2f((bf16_t)(u >> 16));
                const float ss = wave_sum(x1 * x1 + x2 * x2);
                const float rinv = rsqrtf(ss * (1.f / 128.f) + EPSF);
                x1 *= rinv * qn[lane * 2]; x2 *= rinv * qn[lane * 2 + 1];
                const float y1 = (x1 * cs - x2 * sn) * 0.08838834764831845f;
                const float y2 = (x1 * sn + x2 * cs) * 0.08838834764831845f;
                *(unsigned*)(QA + (size_t)row * 1024 + h * 128 + lane * 2) = pack2(y1, y2);
            }
        }
#pragma unroll
        for (int kh = 0; kh < 2; ++kh) {
            const unsigned u = *(const unsigned*)(src + koff + kh * 128 + lane * 2);
            float x1 = bf2f((bf16_t)(u & 0xffff)), x2 = bf2f((bf16_t)(u >> 16));
            const float ss = wave_sum(x1 * x1 + x2 * x2);
            const float rinv = rsqrtf(ss * (1.f / 128.f) + EPSF);
            x1 *= rinv * kn[lane * 2]; x2 *= rinv * kn[lane * 2 + 1];
            const float y1 = x1 * cs - x2 * sn;
            const float y2 = x1 * sn + x2 * cs;
            *(unsigned*)(KA + ((size_t)(b * 2 + kh) * TSEQ + key) * 128 + lane * 2) = pack2(y1, y2);
            const unsigned uv = *(const unsigned*)(src + koff + 256 + kh * 128 + lane * 2);
            bf16_t* vt = VT + ((size_t)(b * 2 + kh) * 128 + lane * 2) * TSEQ + key;
            vt[0] = (bf16_t)(uv & 0xffff);
            vt[TSEQ] = (bf16_t)(uv >> 16);
        }
    }
}

__device__ void ph_attn(const Params& p, char* smem) {
    const int tid = threadIdx.x, lane = tid & 63, wave = tid >> 6;
    const int l15 = lane & 15, lq = lane >> 4;
    const bf16_t* QA = (const bf16_t*)(p.ws + OFF_QA);
    const bf16_t* KA = (const bf16_t*)(p.ws + OFF_KA);
    const bf16_t* VT = (const bf16_t*)(p.ws + OFF_VT);
    bf16_t* O = (bf16_t*)(p.ws + OFF_O);
    bf16_t* Ks = (bf16_t*)smem;
    bf16_t* Vts = Ks + 64 * 136;
    bf16_t* Ps = Vts + 128 * 72 + wave * 16 * 72;
    for (int item = blockIdx.x; item < 8 * 8 * 16; item += gridDim.x) {
        const int qb = item & 15, h = (item >> 4) & 7, b = item >> 7, kvh = h >> 2;
        const int q0 = qb * 128 + wave * 16;
        bf16x8 qf[4];
#pragma unroll
        for (int kk = 0; kk < 4; ++kk)
            qf[kk] = *(const bf16x8*)(QA + (size_t)(b * SEQ + q0 + l15) * 1024 + h * 128 + kk * 32 + lq * 8);
        float mrow[4], lrow[4];
        f32x4 o[8];
#pragma unroll
        for (int j = 0; j < 4; ++j) { mrow[j] = -1.0e30f; lrow[j] = 0.f; }
#pragma unroll
        for (int nd = 0; nd < 8; ++nd) o[nd] = (f32x4){0.f, 0.f, 0.f, 0.f};
        const bf16_t* Kb = KA + (size_t)(b * 2 + kvh) * TSEQ * 128;
        const bf16_t* Vb = VT + (size_t)(b * 2 + kvh) * 128 * TSEQ;
        for (int kt = 0; kt < TSEQ / 64; ++kt) {
            const int key0 = kt * 64;
            __syncthreads();
#pragma unroll
            for (int r = 0; r < 2; ++r) {
                const int cI = tid + r * NTHR;
                { const int kr = cI >> 4, dc = (cI & 15) * 8;
                  *(uint4*)(Ks + kr * 136 + dc) = *(const uint4*)(Kb + (size_t)(key0 + kr) * 128 + dc); }
                { const int d = cI >> 3, kc = (cI & 7) * 8;
                  *(uint4*)(Vts + d * 72 + kc) = *(const uint4*)(Vb + (size_t)d * TSEQ + key0 + kc); }
            }
            __syncthreads();
            f32x4 s[4];
#pragma unroll
            for (int n = 0; n < 4; ++n) {
                s[n] = (f32x4){0.f, 0.f, 0.f, 0.f};
#pragma unroll
                for (int kk = 0; kk < 4; ++kk) {
                    const bf16x8 kf = *(const bf16x8*)(Ks + (n * 16 + l15) * 136 + kk * 32 + lq * 8);
                    s[n] = __builtin_amdgcn_mfma_f32_16x16x32_bf16(qf[kk], kf, s[n], 0, 0, 0);
                }
            }
#pragma unroll
            for (int j = 0; j < 4; ++j) {
                float mx = fmaxf(fmaxf(s[0][j], s[1][j]), fmaxf(s[2][j], s[3][j]));
                mx = fmaxf(mx, __shfl_xor(mx, 1, 64)); mx = fmaxf(mx, __shfl_xor(mx, 2, 64));
                mx = fmaxf(mx, __shfl_xor(mx, 4, 64)); mx = fmaxf(mx, __shfl_xor(mx, 8, 64));
                const float mn = fmaxf(mrow[j], mx);
                const float alpha = __expf(mrow[j] - mn);
                mrow[j] = mn;
                float ps = 0.f;
#pragma unroll
                for (int n = 0; n < 4; ++n) {
                    const float pv = __expf(s[n][j] - mn);
                    ps += pv;
                    Ps[(lq * 4 + j) * 72 + n * 16 + l15] = f2bf(pv);
                }
                lrow[j] = lrow[j] * alpha + ps;
#pragma unroll
                for (int nd = 0; nd < 8; ++nd) o[nd][j] *= alpha;
            }
            __syncthreads();
#pragma unroll
            for (int kk = 0; kk < 2; ++kk) {
                const bf16x8 pf = *(const bf16x8*)(Ps + l15 * 72 + kk * 32 + lq * 8);
#pragma unroll
                for (int nd = 0; nd < 8; ++nd) {
                    const bf16x8 vf = *(const bf16x8*)(Vts + (nd * 16 + l15) * 72 + kk * 32 + lq * 8);
                    o[nd] = __builtin_amdgcn_mfma_f32_16x16x32_bf16(pf, vf, o[nd], 0, 0, 0);
                }
            }
        }
#pragma unroll
        for (int j = 0; j < 4; ++j) {
            float l = lrow[j];
            l += __shfl_xor(l, 1, 64); l += __shfl_xor(l, 2, 64); l += __shfl_xor(l, 4, 64); l += __shfl_xor(l, 8, 64);
            const float inv = 1.f / l;
            const size_t orow = (size_t)(b * SEQ + q0 + lq * 4 + j) * 1024 + h * 128;
#pragma unroll
            for (int nd = 0; nd < 8; ++nd) O[orow + nd * 16 + l15] = f2bf(o[nd][j] * inv);
        }
    }
}

#define N_PHASES 19
template <int PH>
__device__ __forceinline__ void run_phase(const Params& p, char* smem) {
    if (PH == 0) ph_ada(p, smem);
    else if (PH == 1) ph_rows<0>(p, smem);
    else if (PH == 2) ph_gemm_in(p, smem);
    else if (PH == 3) ph_prep(p, smem);
    else if (PH == 4) ph_scan(p, smem);
    else if (PH == 5) ph_merge(p, smem);
    else if (PH == 6) ph_gemm_out<0>(p, smem);
    else if (PH == 7) ph_rows<1>(p, smem);
    else if (PH == 8) ph_moe_up<0>(p, smem);
    else if (PH == 9) ph_moe_down<0>(p, smem);
    else if (PH == 10) ph_rows<2>(p, smem);
    else if (PH == 11) ph_gemm_qkv(p, smem);
    else if (PH == 12) ph_qkprep(p, smem);
    else if (PH == 13) ph_attn(p, smem);
    else if (PH == 14) ph_gemm_out<1>(p, smem);
    else if (PH == 15) ph_rows<3>(p, smem);
    else if (PH == 16) ph_moe_up<1>(p, smem);
    else if (PH == 17) ph_moe_down<1>(p, smem);
    else if (PH == 18) ph_rows<4>(p, smem);
}

template <int PH>
__global__ void __launch_bounds__(NTHR, 2) k_phase(Params p) {
    __shared__ __attribute__((aligned(16))) char smem[65536];
    run_phase<PH>(p, smem);
}

#if ONE_LAUNCH
template <int PH>
__device__ __forceinline__ void run_all(const Params& p, char* smem, const XcdBarrier& bar) {
    run_phase<PH>(p, smem);
    if (PH + 1 < N_PHASES) {
        xcd_barrier(bar);
        run_all<(PH + 1 < N_PHASES) ? PH + 1 : PH>(p, smem, bar);
    }
}
template <>
__device__ __forceinline__ void run_all<N_PHASES - 1>(const Params& p, char* smem, const XcdBarrier& bar) {
    run_phase<N_PHASES - 1>(p, smem);
}

__global__ void __launch_bounds__(NTHR, 2) k_mega(Params p) {
    __shared__ __attribute__((aligned(16))) char smem[65536 - 16];
    __shared__ uint4 xb_words;
    if (threadIdx.x == 0) xb_words = make_uint4(0u, 0u, 0u, 0u);
    __syncthreads();
    XcdBarrier bar = xcd_barrier_post((unsigned*)(p.ws + OFF_ZERO), (volatile LAS unsigned*)&xb_words);
    run_all<0>(p, smem, bar);
}
#endif

template <int PH>
static void launch_phases(const Params& p, hipStream_t stream) {
    hipLaunchKernelGGL(k_phase<PH>, dim3(256), dim3(NTHR), 0, stream, p);
    if constexpr (PH + 1 < N_PHASES) launch_phases<PH + 1>(p, stream);
}

extern "C" void kernel_launch(void* const* d_in, const int* in_sizes, int n_in, void* d_out, int out_size, void* d_ws,
                              size_t ws_size, hipStream_t stream) {
    Params p{};
    for (int i = 0; i < 32; ++i) p.in[i] = (const float*)d_in[i];
    p.out = (float*)d_out;
    p.ws = (char*)d_ws;
    (void)hipMemsetAsync(d_ws, 0, ZERO_BYTES, stream);
#if ONE_LAUNCH
    static int grid = 0;
    if (!grid) {
        int dev = 0, cus = 0, per_cu = 0;
        (void)hipGetDevice(&dev);
        (void)hipDeviceGetAttribute(&cus, hipDeviceAttributeMultiprocessorCount, dev);
        (void)hipOccupancyMaxActiveBlocksPerMultiprocessor(&per_cu, k_mega, NTHR, 0);
        if (cus <= 0) cus = 256;
        grid = cus * (per_cu < 1 ? per_cu : 1);
        if (grid <= 0) grid = cus;
    }
    hipLaunchKernelGGL(k_mega, dim3(grid), dim3(NTHR), 0, stream, p);
#else
    launch_phases<0>(p, stream);
#endif
}
```

```cpp
#include <hip/hip_runtime.h>
#include <stdint.h>

#ifndef ONE_LAUNCH
#define ONE_LAUNCH 1
#endif
#ifndef REP_PH
#define REP_PH -1
#endif

typedef unsigned short bf16_t;
typedef __attribute__((ext_vector_type(8))) short bf16x8;
typedef __attribute__((ext_vector_type(4))) float f32x4;

#define D_MODEL 1024
#define BATCH 8
#define SEQ 2048
#define CTXL 256
#define NL (BATCH * SEQ)
#define NC (BATCH * CTXL)
#define NT (NL + NC)
#define AB_PROJ 3088
#define TSEQ (SEQ + CTXL)
#define EPSF 1e-6f
#define NTHR 512

enum { I_X = 0, I_C, I_CTX, I_CCTX, I_ADAW, I_ADAB, I_NORM1, I_NORM2, I_FNORM, I_ABWIN, I_CONVQKV, I_ALOG, I_DTB,
       I_ONORM, I_CONVX, I_RGWR, I_RGBR, I_RGWI, I_RGBI, I_RGLAM, I_ABWOUT, I_ATWQKV, I_QNORM, I_KNORM, I_ATWOUT,
       I_WGRP, I_BGRP, I_WEXP, I_BEXP, I_WGATE, I_WUP, I_WDOWN };

#define AL256(x) (((size_t)(x) + 255) & ~(size_t)255)
#define ZW 3072
#define OFF_ZERO 0
#define ZERO_BYTES 65536
#define OFF_CNT 16384
#define OFF_MOD (OFF_ZERO + ZERO_BYTES)
#define OFF_X AL256(OFF_MOD + 2 * 9 * 6144 * 4)
#define OFF_H AL256(OFF_X + (size_t)NT * 1024 * 4)
#define OFF_Z AL256(OFF_H + (size_t)NT * 1024 * 2)
#define OFF_BTIN AL256(OFF_Z + (size_t)NT * ZW * 2)
#define OFF_BTOUT0 AL256(OFF_BTIN + (size_t)3072 * 1024 * 2)
#define OFF_BTQKV AL256(OFF_BTOUT0 + (size_t)1024 * 1024 * 2)
#define OFF_BTOUT1 AL256(OFF_BTQKV + (size_t)1536 * 1024 * 2)
#define OFF_WSEL AL256(OFF_BTOUT1 + (size_t)1024 * 1024 * 2)
#define OFF_LIST AL256(OFF_WSEL + (size_t)2 * NT * 4)
#define OFF_R1 AL256(OFF_LIST + (size_t)32 * NT * 4)
#define OFF_QKVC OFF_R1
#define OFF_G AL256(OFF_QKVC + (size_t)NT * 1536 * 2)
#define OFF_BETA AL256(OFF_G + (size_t)2 * NT * 4 * 4)
#define OFF_GATES AL256(OFF_BETA + (size_t)2 * NT * 4 * 4)
#define OFF_LA AL256(OFF_GATES + (size_t)NT * 16 * 4)
#define OFF_LB AL256(OFF_LA + (size_t)2 * NT * 512 * 4)
#define OFF_OA AL256(OFF_LB + (size_t)2 * NT * 512 * 4)
#define OFF_END AL256(OFF_OA + (size_t)2 * NT * 512 * 2)
#define OFF_BTGU OFF_R1
#define OFF_BTD AL256(OFF_BTGU + (size_t)32 * 1024 * 1024 * 2)
#define OFF_ACT AL256(OFF_BTD + (size_t)32 * 1024 * 512 * 2)
#define OFF_YE AL256(OFF_ACT + (size_t)2 * NT * 512 * 2)
#define OFF_ZQ OFF_Z
#define OFF_ZC (OFF_Z + (size_t)NL * 1536 * 2)
#define OFF_QA (OFF_ZC + (size_t)NC * 512 * 2)
#define OFF_KA (OFF_QA + (size_t)NL * 1024 * 2)
#define OFF_VT (OFF_KA + (size_t)8 * 2 * TSEQ * 128 * 2)
#define OFF_O OFF_H
static_assert(OFF_YE + (size_t)2 * NT * 1024 * 2 <= OFF_END, "MoE scratch must fit in R1");
static_assert(OFF_VT + (size_t)8 * 2 * TSEQ * 128 * 2 <= OFF_BTIN, "attention buffers must fit in the Z region");
static_assert(OFF_END < (size_t)530 * 1024 * 1024, "workspace budget");

#define DYN_LDS (131072 + 1024)
#define LDS_XB 131072
#define LDS_PRE (131072 + 64)

struct Params {
    const float* in[32];
    float* out;
    char* ws;
};

__device__ __forceinline__ bf16_t f2bf(float f) {
    unsigned u = __float_as_uint(f);
    u += 0x7fffu + ((u >> 16) & 1u);
    return (bf16_t)(u >> 16);
}
__device__ __forceinline__ float bf2f(bf16_t h) { return __uint_as_float(((unsigned)h) << 16); }
__device__ __forceinline__ unsigned pack2(float a, float b) { return (unsigned)f2bf(a) | ((unsigned)f2bf(b) << 16); }
__device__ __forceinline__ float sigmoidf_(float x) { return 1.f / (1.f + __expf(-x)); }
__device__ __forceinline__ float siluf_(float x) { return x / (1.f + __expf(-x)); }
__device__ __forceinline__ float softplusf_(float x) { return x > 20.f ? x : log1pf(__expf(x)); }
__device__ __forceinline__ float geluf_(float x) {
    const float u = 0.7978845608028654f * (x + 0.044715f * x * x * x);
    return 0.5f * x * (1.f + tanhf(u));
}
__device__ __forceinline__ float wave_sum(float v) {
#pragma unroll
    for (int o = 32; o >= 1; o >>= 1) v += __shfl_xor(v, o, 64);
    return v;
}
__device__ __forceinline__ int hide_tid() { int t = threadIdx.x; asm volatile("" : "+v"(t)); return t; }
__device__ __forceinline__ int scan_row(int s, int dir, int b) {
    if (s < CTXL) { const int t = dir ? (CTXL - 1 - s) : s; return NL + b * CTXL + t; }
    const int u = s - CTXL; const int t = dir ? (SEQ - 1 - u) : u; return b * SEQ + t;
}

#define XB_TMO      128
#define XB_XCNT(j)  (256  + 64 * (j))
#define XB_XSUB(j)  (1280 + 64 * (j))
#define XB_XGEN(j)  (2304 + 64 * (j))
#define XB_TOP      3328
#define XB_TOPGEN   3392
#define XCD_BAR_WORDS 3456
#define XB_SPIN_CAP (1u << 22)
#define LAS __attribute__((address_space(3)))

__device__ __forceinline__ unsigned xb_ld(unsigned* p)              { return __hip_atomic_load(p, __ATOMIC_RELAXED, __HIP_MEMORY_SCOPE_AGENT); }
__device__ __forceinline__ unsigned xb_add(unsigned* p, unsigned v) { return __hip_atomic_fetch_add(p, v, __ATOMIC_RELAXED, __HIP_MEMORY_SCOPE_AGENT); }
__device__ __forceinline__ unsigned xb_xcc_id() { return (unsigned)__builtin_amdgcn_s_getreg((3 << 11) | 20) & 0xFu; }
#define XB_SPIN(cond, bar) do { unsigned _sp = 0; while (cond) { __builtin_amdgcn_s_sleep(1); \
    if ((++_sp & 255u) == 0u) { if (xb_ld(&(bar)[XB_TMO])) break; if (_sp > XB_SPIN_CAP) { atomicAdd(&(bar)[XB_TMO], 1u); break; } } } } while (0)

struct XcdBarrier {
    unsigned* bar; unsigned x;
    volatile LAS unsigned* st;
};
__device__ __forceinline__ XcdBarrier xcd_barrier_post(unsigned* bar, volatile LAS unsigned* st) {
    XcdBarrier b; b.bar = bar; b.x = xb_xcc_id(); b.st = st;
    if (threadIdx.x == 0) (void)xb_add(&bar[XB_XCNT(b.x)], 1u);
    return b;
}
__device__ __forceinline__ void xcd_barrier_complete(unsigned* bar, unsigned x, unsigned& nloc, unsigned& nx) {
    const unsigned G = gridDim.x * gridDim.y * gridDim.z;
    unsigned sum, cnt, mine, sp = 0u;
    for (;;) {
        sum = 0u; cnt = 0u; mine = 0u;
#pragma unroll
        for (unsigned j = 0; j < 16; ++j) { const unsigned c = xb_ld(&bar[XB_XCNT(j)]); sum += c; cnt += (c > 0u) ? 1u : 0u; mine = (j == x) ? c : mine; }
        if (sum == G) break;
        __builtin_amdgcn_s_sleep(1);
        if ((++sp & 255u) == 0u) { if (xb_ld(&bar[XB_TMO])) break; if (sp > XB_SPIN_CAP) { atomicAdd(&bar[XB_TMO], 1u); break; } }
    }
    nloc = mine > 0u ? mine : 1u; nx = cnt > 0u ? cnt : 1u;
}
__device__ __forceinline__ void xcd_barrier(const XcdBarrier& b) {
    asm volatile("s_waitcnt vmcnt(0)" ::: "memory");
    __syncthreads();
    if (threadIdx.x == 0) {
        unsigned* bar = b.bar;
        __builtin_amdgcn_s_waitcnt(0);
        unsigned nloc = b.st[0], nx = b.st[1];
        if (nloc == 0u) { xcd_barrier_complete(bar, b.x, nloc, nx); b.st[0] = nloc; b.st[1] = nx; }
        const unsigned old = xb_add(&bar[XB_XSUB(b.x)], 1u);
        const unsigned gen = old / nloc;
        if (old + 1u == (gen + 1u) * nloc) {
            __builtin_amdgcn_fence(__ATOMIC_RELEASE, "agent");
            asm volatile("s_waitcnt vmcnt(0)" ::: "memory");
            const unsigned og = xb_add(&bar[XB_TOP], 1u);
            const unsigned tg = og / nx;
            if (og + 1u == (tg + 1u) * nx) xb_add(&bar[XB_TOPGEN], 1u);
            else XB_SPIN(xb_ld(&bar[XB_TOPGEN]) == tg, bar);
            __builtin_amdgcn_fence(__ATOMIC_ACQUIRE, "agent");
            xb_add(&bar[XB_XGEN(b.x)], 1u);
            asm volatile("s_waitcnt vmcnt(0)" ::: "memory");
        } else {
            XB_SPIN(xb_ld(&bar[XB_XGEN(b.x)]) == gen, bar);
            __builtin_amdgcn_fence(__ATOMIC_ACQUIRE, "agent");
            asm volatile("s_waitcnt vmcnt(0)" ::: "memory");
        }
    }
    __syncthreads();
}

template <int NB, class RowPtr, class Epi>
__device__ __forceinline__ void gemm_tile(RowPtr rowptr, const float* __restrict__ B0, const float* __restrict__ B1,
                                          int ldb, int K, int n0, int N, Epi epi, char* smem) {
    constexpr int LDS_LD = 72;
    bf16_t* As = (bf16_t*)smem;
    bf16_t* Bs0 = As + 128 * LDS_LD;
    bf16_t* Bs1 = Bs0 + 128 * LDS_LD;
    const int tid = hide_tid(), lane = tid & 63, wave = tid >> 6;
    const int wm = wave >> 1, wn = wave & 1;
    const int l15 = lane & 15, lq = lane >> 4;

    const bf16_t* arow0 = rowptr(tid >> 3);
    const bf16_t* arow1 = rowptr((tid >> 3) + 64);
    const int akc = (tid & 7) * 8;
    const int bn = tid & 127, bkg = tid >> 7;
    const bool bok = (n0 + bn) < N;
    const float* b0p = B0 + (size_t)(bkg * 8) * ldb + n0 + bn;
    const float* b1p = (NB == 2) ? (B1 + (size_t)(bkg * 8) * ldb + n0 + bn) : nullptr;

    f32x4 acc0[2][4], acc1[2][4];
#pragma unroll
    for (int i = 0; i < 2; ++i)
#pragma unroll
        for (int j = 0; j < 4; ++j) { acc0[i][j] = (f32x4){0.f, 0.f, 0.f, 0.f}; acc1[i][j] = (f32x4){0.f, 0.f, 0.f, 0.f}; }

    uint4 ra0, ra1;
    float rb0[16], rb1[16];
    const int nk = K >> 6;
    auto load_regs = [&](int kt) {
        const int k0 = kt * 64;
        ra0 = arow0 ? *(const uint4*)(arow0 + k0 + akc) : make_uint4(0, 0, 0, 0);
        ra1 = arow1 ? *(const uint4*)(arow1 + k0 + akc) : make_uint4(0, 0, 0, 0);
#pragma unroll
        for (int r = 0; r < 2; ++r)
#pragma unroll
            for (int j = 0; j < 8; ++j) {
                const size_t o = (size_t)(k0 + r * 32 + j) * ldb;
                rb0[r * 8 + j] = bok ? b0p[o] : 0.f;
                if (NB == 2) rb1[r * 8 + j] = bok ? b1p[o] : 0.f;
            }
    };
    load_regs(0);
    for (int kt = 0; kt < nk; ++kt) {
        __syncthreads();
        *(uint4*)(As + (tid >> 3) * LDS_LD + akc) = ra0;
        *(uint4*)(As + ((tid >> 3) + 64) * LDS_LD + akc) = ra1;
#pragma unroll
        for (int r = 0; r < 2; ++r) {
            uint4 w;
            w.x = pack2(rb0[r * 8 + 0], rb0[r * 8 + 1]); w.y = pack2(rb0[r * 8 + 2], rb0[r * 8 + 3]);
            w.z = pack2(rb0[r * 8 + 4], rb0[r * 8 + 5]); w.w = pack2(rb0[r * 8 + 6], rb0[r * 8 + 7]);
            *(uint4*)(Bs0 + bn * LDS_LD + bkg * 8 + r * 32) = w;
            if (NB == 2) {
                w.x = pack2(rb1[r * 8 + 0], rb1[r * 8 + 1]); w.y = pack2(rb1[r * 8 + 2], rb1[r * 8 + 3]);
                w.z = pack2(rb1[r * 8 + 4], rb1[r * 8 + 5]); w.w = pack2(rb1[r * 8 + 6], rb1[r * 8 + 7]);
                *(uint4*)(Bs1 + bn * LDS_LD + bkg * 8 + r * 32) = w;
            }
        }
        __syncthreads();
        if (kt + 1 < nk) load_regs(kt + 1);
#pragma unroll
        for (int kk = 0; kk < 2; ++kk) {
            bf16x8 af[2];
#pragma unroll
            for (int mi = 0; mi < 2; ++mi)
                af[mi] = *(const bf16x8*)(As + (wm * 32 + mi * 16 + l15) * LDS_LD + kk * 32 + lq * 8);
#pragma unroll
            for (int ni = 0; ni < 4; ++ni) {
                const bf16x8 bf0 = *(const bf16x8*)(Bs0 + (wn * 64 + ni * 16 + l15) * LDS_LD + kk * 32 + lq * 8);
#pragma unroll
                for (int mi = 0; mi < 2; ++mi) acc0[mi][ni] = __builtin_amdgcn_mfma_f32_16x16x32_bf16(af[mi], bf0, acc0[mi][ni], 0, 0, 0);
                if (NB == 2) {
                    const bf16x8 bf1 = *(const bf16x8*)(Bs1 + (wn * 64 + ni * 16 + l15) * LDS_LD + kk * 32 + lq * 8);
#pragma unroll
                    for (int mi = 0; mi < 2; ++mi) acc1[mi][ni] = __builtin_amdgcn_mfma_f32_16x16x32_bf16(af[mi], bf1, acc1[mi][ni], 0, 0, 0);
                }
            }
        }
    }
#pragma unroll
    for (int mi = 0; mi < 2; ++mi)
#pragma unroll
        for (int ni = 0; ni < 4; ++ni) {
            const int n = n0 + wn * 64 + ni * 16 + l15;
            if (n < N) {
#pragma unroll
                for (int j = 0; j < 4; ++j) epi(wm * 32 + mi * 16 + lq * 4 + j, n, acc0[mi][ni][j], acc1[mi][ni][j]);
            }
        }
}

namespace g8 {
constexpr int BM = 256, BK = 64, HALF = 128, HTB = HALF * BK * 2, STAGE_BYTES = 8 * HTB, NXCD = 8, WGM = 8;
typedef unsigned u32x4 __attribute__((ext_vector_type(4)));
__device__ __forceinline__ int lds_byte(int r, int c) { const int st = (r >> 4) * 2 + (c >> 5), rr = r & 15, cc = c & 31, ob = rr * 64 + cc * 2; return st * 1024 + (ob ^ (((ob >> 9) & 1) << 5)); }
__device__ __forceinline__ void stage_rc(int b, int& R, int& C) { const int st = b / 1024, sb = b % 1024, swz = sb ^ (((sb >> 9) & 1) << 5); R = (st >> 1) * 16 + swz / 64; C = (st & 1) * 32 + (swz % 64) / 2; }
__device__ __forceinline__ int perm32(int rho) { const int n = rho >> 4, i = rho & 15; return 8 * (i >> 2) + 4 * n + (i & 3); }
__device__ __forceinline__ unsigned cvt_pk_bf16(float lo, float hi) { unsigned r; asm volatile("v_cvt_pk_bf16_f32 %0, %1, %2" : "=v"(r) : "v"(lo), "v"(hi)); return r; }

struct Unit {
    const char* A;
    const char* Bt;
    const int* lst;
    int mv;
    int pm, pn;
    int aux;
};

__device__ __forceinline__ void static_order(int wgid, int nM, int nN, int& pm, int& pn) {
    const int nwg = nM * nN;
    { const int q = nwg / NXCD, r = nwg % NXCD, xcd = wgid % NXCD, off = wgid / NXCD; wgid = (xcd < r ? xcd * (q + 1) : r * (q + 1) + (xcd - r) * q) + off; }
    const int nig = WGM * nN, gid = wgid / nig, fm = gid * WGM, gsz = (nM - fm) < WGM ? (nM - fm) : WGM;
    pm = fm + ((wgid % nig) % gsz); pn = (wgid % nig) / gsz;
}

template <bool GATHER, int GSHIFT, class Epi, class Sched>
__device__ __forceinline__ void gemm_phase(LAS unsigned char* lds, const int K, const Sched& S, const Epi& E) {
    const int tid = hide_tid(), wid = __builtin_amdgcn_readfirstlane(tid >> 6), lane = tid & 63, wr = wid >> 2, wc = wid & 3, fr = lane & 15, fq = lane >> 4;
    const int nt = K / BK;
    unsigned voffA[2], voffB[2];
#pragma unroll
    for (int i = 0; i < 2; ++i) { int R, C; stage_rc(tid * 16 + i * 8192, R, C); const int Rb = Epi::PERM ? ((R & ~31) + perm32(R & 31)) : R;
        voffA[i] = (unsigned)(R * K + C) * 2u; voffB[i] = (unsigned)(Rb * K + C) * 2u; }
    const size_t kstep = (size_t)(BK * 2);
    const size_t hstep = (size_t)HALF * K * 2;
    const unsigned ldsw = (unsigned)wid * 1024u;
    const int aoff = lds_byte(wr * 64 + fr, fq * 8), boff = lds_byte(wc * 32 + fr, fq * 8);
    unsigned gcur[2][2], gnxt[2][2];
    auto gather_offs = [&](const Unit& u, unsigned (&g)[2][2]) {
#pragma unroll
        for (int h = 0; h < 2; ++h)
#pragma unroll
            for (int i = 0; i < 2; ++i) { int R, C; stage_rc(tid * 16 + i * 8192, R, C); int idx = h * 128 + R; idx = idx < u.mv ? idx : u.mv - 1;
                g[h][i] = (unsigned)(u.lst[idx] >> GSHIFT) * (unsigned)(K * 2) + (unsigned)(C * 2); }
    };
#define G8_SA(b, h) (((b) * 2 + (h)) * HTB)
#define G8_SB(b, h) ((4 + (b) * 2 + (h)) * HTB)
#define G8_STAGE(bufoff, gbase, voff) do { _Pragma("unroll") for (int _i = 0; _i < 2; ++_i) \
        __builtin_amdgcn_global_load_lds((const unsigned*)((const char*)(gbase) + (voff)[_i]), (LAS unsigned*)(lds + (bufoff) + ldsw + _i * 8192), 16, 0, 0); } while (0)
#define G8_LDA(dst, b, h) do { _Pragma("unroll") for (int m = 0; m < 4; ++m) _Pragma("unroll") for (int k = 0; k < 2; ++k) dst[m][k] = *(const LAS bf16x8*)(lds + G8_SA(b, h) + aoff + m * 2048 + k * 1024); } while (0)
#define G8_LDB(dst, b, h) do { _Pragma("unroll") for (int n = 0; n < 2; ++n) _Pragma("unroll") for (int k = 0; k < 2; ++k) dst[n][k] = *(const LAS bf16x8*)(lds + G8_SB(b, h) + boff + n * 2048 + k * 1024); } while (0)
#define G8_MMA(ai, bj, At, Bt) do { __builtin_amdgcn_s_setprio(1); _Pragma("unroll") for (int m = 0; m < 4; ++m) _Pragma("unroll") for (int n = 0; n < 2; ++n) _Pragma("unroll") for (int k = 0; k < 2; ++k) \
        acc[ai][bj][m][n] = __builtin_amdgcn_mfma_f32_16x16x32_bf16(Bt[n][k], At[m][k], acc[ai][bj][m][n], 0, 0, 0); __builtin_amdgcn_s_setprio(0); } while (0)
#define G8_WAIT_V(n) asm volatile("s_waitcnt vmcnt(" #n ")" ::: "memory")
#define G8_WAIT_L(n) asm volatile("s_waitcnt lgkmcnt(" #n ")" ::: "memory")
#define G8_BAR __builtin_amdgcn_s_barrier()
#define G8_SCHED __builtin_amdgcn_sched_barrier(0)
    Unit cur, nxt; int ui = 0;
    if (!S.next(0, cur)) return;
    f32x4 acc[2][2][4][2];
#pragma unroll
    for (int a = 0; a < 2; ++a)
#pragma unroll
        for (int b = 0; b < 2; ++b)
#pragma unroll
            for (int m = 0; m < 4; ++m)
#pragma unroll
                for (int n = 0; n < 2; ++n) acc[a][b][m][n] = (f32x4){0.f, 0.f, 0.f, 0.f};
    bf16x8 At[4][2], B0[2][2], B1[2][2];
    const char* cA = cur.A; const char* cB = cur.Bt;
    if (GATHER) gather_offs(cur, gcur);
#define G8_STAGE_A(bufoff, kp, h, g) do { if (GATHER) G8_STAGE(bufoff, kp, (g)[h]); else G8_STAGE(bufoff, (kp) + (h) * hstep, voffA); } while (0)
    G8_STAGE(G8_SB(0, 0), cB, voffB); G8_STAGE_A(G8_SA(0, 0), cA, 0, gcur); G8_STAGE(G8_SB(0, 1), cB + hstep, voffB); G8_STAGE_A(G8_SA(0, 1), cA, 1, gcur);
    if (wr == 1) G8_BAR;
    G8_WAIT_V(4); G8_BAR;
    G8_STAGE(G8_SB(1, 0), cB + kstep, voffB); G8_STAGE_A(G8_SA(1, 0), cA + kstep, 0, gcur); G8_STAGE(G8_SB(1, 1), cB + hstep + kstep, voffB);
    G8_WAIT_V(6); G8_BAR;
    for (;;) {
        const bool has_next = S.next(ui + 1, nxt);
        const char* nA = has_next ? nxt.A : cA; const char* nB = has_next ? nxt.Bt : cB;
        if (GATHER) {
            if (has_next) gather_offs(nxt, gnxt);
            else {
#pragma unroll
                for (int h = 0; h < 2; ++h)
#pragma unroll
                    for (int i = 0; i < 2; ++i) gnxt[h][i] = gcur[h][i];
            }
        }
        for (int t = 0; t < nt; t += 2) {
            const bool last = (t == nt - 2);
            const char* a1 = cA + (size_t)(t + 1) * kstep;
            const char* a2 = last ? nA : cA + (size_t)(t + 2) * kstep; const char* b2 = last ? nB : cB + (size_t)(t + 2) * kstep;
            const char* a3 = a2 + kstep; const char* b3 = b2 + kstep;
            unsigned g2[2][2];
            if (GATHER) {
#pragma unroll
                for (int h = 0; h < 2; ++h)
#pragma unroll
                    for (int i = 0; i < 2; ++i) g2[h][i] = last ? gnxt[h][i] : gcur[h][i];
            }
            G8_LDB(B0, 0, 0); G8_SCHED; G8_LDA(At, 0, 0); G8_STAGE_A(G8_SA(1, 1), a1, 1, gcur);
            G8_WAIT_L(8); G8_BAR; G8_WAIT_L(0); G8_MMA(0, 0, At, B0); G8_BAR; G8_SCHED;
            G8_LDB(B1, 0, 1); G8_STAGE(G8_SB(0, 0), b2, voffB);
            G8_BAR; G8_WAIT_L(0); G8_MMA(0, 1, At, B1); G8_BAR;
            G8_LDA(At, 0, 1); G8_STAGE_A(G8_SA(0, 0), a2, 0, g2);
            G8_BAR; G8_WAIT_L(0); G8_MMA(1, 0, At, B0); G8_BAR; G8_SCHED;
            G8_STAGE(G8_SB(0, 1), b2 + hstep, voffB);
            G8_WAIT_V(6); G8_BAR; G8_MMA(1, 1, At, B1); G8_BAR;
            G8_LDB(B0, 1, 0); G8_SCHED; G8_LDA(At, 1, 0); G8_STAGE_A(G8_SA(0, 1), a2, 1, g2);
            G8_WAIT_L(8); G8_BAR; G8_WAIT_L(0); G8_MMA(0, 0, At, B0); G8_BAR; G8_SCHED;
            G8_LDB(B1, 1, 1); G8_STAGE(G8_SB(1, 0), b3, voffB);
            G8_BAR; G8_WAIT_L(0); G8_MMA(0, 1, At, B1); G8_BAR;
            G8_LDA(At, 1, 1); G8_STAGE_A(G8_SA(1, 0), a3, 0, g2);
            G8_BAR; G8_WAIT_L(0); G8_MMA(1, 0, At, B0); G8_BAR; G8_SCHED;
            G8_STAGE(G8_SB(1, 1), b3 + hstep, voffB);
            G8_WAIT_V(6); G8_BAR; G8_MMA(1, 1, At, B1); G8_BAR;
        }
        E(acc, cur, wr, wc, fr, fq);
        if (!has_next) break;
#pragma unroll
        for (int a = 0; a < 2; ++a)
#pragma unroll
            for (int b = 0; b < 2; ++b)
#pragma unroll
                for (int m = 0; m < 4; ++m)
#pragma unroll
                    for (int n = 0; n < 2; ++n) acc[a][b][m][n] = (f32x4){0.f, 0.f, 0.f, 0.f};
        cur = nxt; cA = nA; cB = nB; ++ui;
        if (GATHER) {
#pragma unroll
            for (int h = 0; h < 2; ++h)
#pragma unroll
                for (int i = 0; i < 2; ++i) gcur[h][i] = gnxt[h][i];
        }
    }
    G8_WAIT_V(0);
    if (wr == 0) G8_BAR;
    G8_BAR;
#undef G8_SA
#undef G8_SB
#undef G8_STAGE
#undef G8_STAGE_A
#undef G8_LDA
#undef G8_LDB
#undef G8_MMA
#undef G8_WAIT_V
#undef G8_WAIT_L
#undef G8_BAR
#undef G8_SCHED
}

struct EpiBf16 {
    static constexpr bool PERM = true;
    bf16_t* O0; int ldc0; bf16_t* O1; int ldc1;
    __device__ __forceinline__ void operator()(const f32x4 (&acc)[2][2][4][2], const Unit& u, int wr, int wc, int fr, int fq) const {
        bf16_t* O = u.aux ? O1 : O0; const int ldc = u.aux ? ldc1 : ldc0;
        const int row0 = u.pm * BM + wr * 64 + fr, col0 = u.pn * BM + wc * 32 + 8 * fq;
#pragma unroll
        for (int ai = 0; ai < 2; ++ai)
#pragma unroll
            for (int m = 0; m < 4; ++m) { bf16_t* rowp = O + (size_t)(row0 + ai * HALF + m * 16) * ldc + col0;
#pragma unroll
                for (int bj = 0; bj < 2; ++bj) { const f32x4 v0 = acc[ai][bj][m][0], v1 = acc[ai][bj][m][1];
                    u32x4 w; w.x = cvt_pk_bf16(v0[0], v0[1]); w.y = cvt_pk_bf16(v0[2], v0[3]); w.z = cvt_pk_bf16(v1[0], v1[1]); w.w = cvt_pk_bf16(v1[2], v1[3]);
                    *(u32x4*)(rowp + bj * HALF) = w; } }
    }
};
struct EpiResid {
    static constexpr bool PERM = false;
    float* X; const float* g1base;
    __device__ __forceinline__ void operator()(const f32x4 (&acc)[2][2][4][2], const Unit& u, int wr, int wc, int fr, int fq) const {
        const int rt = u.pm * BM;
        const int mr = rt < NL ? (rt >> 11) : 8;
        const float* g1 = g1base + (size_t)mr * 6144;
        const int row0 = rt + wr * 64 + fr, col0 = u.pn * BM + wc * 32 + 4 * fq;
        f32x4 gv[2][2];
#pragma unroll
        for (int bj = 0; bj < 2; ++bj)
#pragma unroll
            for (int n = 0; n < 2; ++n) gv[bj][n] = *(const f32x4*)(g1 + col0 + bj * HALF + n * 16);
#pragma unroll
        for (int ai = 0; ai < 2; ++ai)
#pragma unroll
            for (int m = 0; m < 4; ++m) { float* rowp = X + (size_t)(row0 + ai * HALF + m * 16) * 1024 + col0;
#pragma unroll
                for (int bj = 0; bj < 2; ++bj)
#pragma unroll
                    for (int n = 0; n < 2; ++n) { f32x4* q = (f32x4*)(rowp + bj * HALF + n * 16); *q = *q + gv[bj][n] * acc[ai][bj][m][n]; } }
    }
};
struct EpiMoeUp {
    static constexpr bool PERM = true;
    bf16_t* ACT; const float* WSEL;
    __device__ __forceinline__ void operator()(const f32x4 (&acc)[2][2][4][2], const Unit& u, int wr, int wc, int fr, int fq) const {
        const int col0 = u.pn * 128 + wc * 32 + 8 * fq;
#pragma unroll
        for (int ai = 0; ai < 2; ++ai)
#pragma unroll
            for (int m = 0; m < 4; ++m) {
                const int ridx = ai * HALF + wr * 64 + m * 16 + fr;
                if (ridx < u.mv) {
                    const int r = u.lst[ridx];
                    const float w = WSEL[r];
                    float o[8];
#pragma unroll
                    for (int n = 0; n < 2; ++n)
#pragma unroll
                        for (int j = 0; j < 4; ++j) { const float g = acc[ai][0][m][n][j], uu = acc[ai][1][m][n][j]; o[n * 4 + j] = g / (1.f + __expf(-g)) * uu * w; }
                    u32x4 wv; wv.x = cvt_pk_bf16(o[0], o[1]); wv.y = cvt_pk_bf16(o[2], o[3]); wv.z = cvt_pk_bf16(o[4], o[5]); wv.w = cvt_pk_bf16(o[6], o[7]);
                    *(u32x4*)(ACT + (size_t)r * 512 + col0) = wv;
                }
            }
    }
};
struct EpiMoeDown {
    static constexpr bool PERM = true;
    bf16_t* YE;
    __device__ __forceinline__ void operator()(const f32x4 (&acc)[2][2][4][2], const Unit& u, int wr, int wc, int fr, int fq) const {
        const int col0 = u.pn * BM + wc * 32 + 8 * fq;
#pragma unroll
        for (int ai = 0; ai < 2; ++ai)
#pragma unroll
            for (int m = 0; m < 4; ++m) {
                const int ridx = ai * HALF + wr * 64 + m * 16 + fr;
                if (ridx < u.mv) {
                    const int r = u.lst[ridx];
#pragma unroll
                    for (int bj = 0; bj < 2; ++bj) { const f32x4 v0 = acc[ai][bj][m][0], v1 = acc[ai][bj][m][1];
                        u32x4 w; w.x = cvt_pk_bf16(v0[0], v0[1]); w.y = cvt_pk_bf16(v0[2], v0[3]); w.z = cvt_pk_bf16(v1[0], v1[1]); w.w = cvt_pk_bf16(v1[2], v1[3]);
                        *(u32x4*)(YE + (size_t)r * 1024 + col0 + bj * HALF) = w; }
                }
            }
    }
};

struct DenseSched {
    const char* A; const char* Bt; int nM, nN, K, G, c;
    __device__ __forceinline__ bool next(int i, Unit& u) const {
        const int L = i * G + c; if (L >= nM * nN) return false;
        int pm, pn; static_order(L, nM, nN, pm, pn);
        u.A = A + (size_t)pm * BM * K * 2; u.Bt = Bt + (size_t)pn * BM * K * 2; u.lst = nullptr; u.mv = 256; u.pm = pm; u.pn = pn; u.aux = 0;
        return true;
    }
};
struct QkvSched {
    const char* H; const char* Bt; int G, c;
    __device__ __forceinline__ bool next(int i, Unit& u) const {
        const int L = i * G + c;
        if (L < 384) { int pm, pn; static_order(L, 64, 6, pm, pn);
            u.A = H + (size_t)pm * BM * 2048; u.Bt = Bt + (size_t)pn * BM * 2048; u.pm = pm; u.pn = pn; u.aux = 0; }
        else if (L < 400) { const int q = L - 384, pm = q >> 1, pn = q & 1;
            u.A = H + (size_t)(NL + pm * BM) * 2048; u.Bt = Bt + (size_t)(1024 + pn * BM) * 2048; u.pm = pm; u.pn = pn; u.aux = 1; }
        else return false;
        u.lst = nullptr; u.mv = 256;
        return true;
    }
};
struct MoeSched {
    const char* A; const char* Bt; size_t bt_expert_bytes; int K; const int* LIST; const unsigned* cnt; const LAS int* pre; int NTN_SHIFT; int G, c;
    __device__ __forceinline__ bool next(int i, Unit& u) const {
        const int L = i * G + c; const int total = pre[32] << NTN_SHIFT; if (L >= total) return false;
        const int mt = L >> NTN_SHIFT, pn = L & ((1 << NTN_SHIFT) - 1);
        int e = 0;
#pragma unroll 1
        for (int j = 1; j < 32; ++j) if (pre[j] <= mt) e = j;
        const int m0 = (mt - pre[e]) * BM;
        int mv = (int)cnt[e] - m0; mv = mv > 256 ? 256 : mv;
        u.A = A; u.Bt = Bt + (size_t)e * bt_expert_bytes + (size_t)pn * BM * K * 2; u.lst = LIST + (size_t)e * NT + m0; u.mv = mv; u.pm = mt; u.pn = pn; u.aux = e;
        return true;
    }
};
}

__device__ __forceinline__ void cvt_tile(const float* __restrict__ src, int ld, bf16_t* __restrict__ dst, int K, int k0, char* smem) {
    bf16_t* T = (bf16_t*)smem;
    const int tid = hide_tid();
    __syncthreads();
#pragma unroll
    for (int r = 0; r < 2; ++r) {
        const int kk = (tid >> 4) + r * 32, n4 = (tid & 15) * 4;
        const float4 v = *(const float4*)(src + (size_t)(k0 + kk) * ld + n4);
        T[(n4 + 0) * 72 + kk] = f2bf(v.x); T[(n4 + 1) * 72 + kk] = f2bf(v.y); T[(n4 + 2) * 72 + kk] = f2bf(v.z); T[(n4 + 3) * 72 + kk] = f2bf(v.w);
    }
    __syncthreads();
    { const int nn = tid >> 3, kc = (tid & 7) * 8;
      *(uint4*)(dst + (size_t)nn * K + k0 + kc) = *(const uint4*)(T + nn * 72 + kc); }
}
__device__ void cvt_dense(const Params& p, char* smem) {
    for (int j = blockIdx.x; j < (48 + 16 + 24 + 16) * 16; j += gridDim.x) {
        const int grp = j >> 4, kt = j & 15;
        const float* src; int ld; bf16_t* dst;
        if (grp < 48) { const int c0 = grp * 64; src = p.in[I_ABWIN] + (c0 < 2048 ? c0 : c0 + 16); ld = AB_PROJ; dst = (bf16_t*)(p.ws + OFF_BTIN) + (size_t)c0 * 1024; }
        else if (grp < 64) { const int c0 = (grp - 48) * 64; src = p.in[I_ABWOUT] + c0; ld = 1024; dst = (bf16_t*)(p.ws + OFF_BTOUT0) + (size_t)c0 * 1024; }
        else if (grp < 88) { const int c0 = (grp - 64) * 64; src = p.in[I_ATWQKV] + c0; ld = 1536; dst = (bf16_t*)(p.ws + OFF_BTQKV) + (size_t)c0 * 1024; }
        else { const int c0 = (grp - 88) * 64; src = p.in[I_ATWOUT] + c0; ld = 1024; dst = (bf16_t*)(p.ws + OFF_BTOUT1) + (size_t)c0 * 1024; }
        cvt_tile(src, ld, dst, 1024, kt * 64, smem);
    }
}
__device__ void cvt_moe(const Params& p, int L, char* smem) {
    for (int j = blockIdx.x; j < 32 * 384; j += gridDim.x) {
        const int e = j / 384, q = j % 384;
        if (q < 256) {
            const int up = q >> 7, grp = (q >> 4) & 7, kt = q & 15;
            const float* src = p.in[up ? I_WUP : I_WGATE] + ((size_t)L * 32 + e) * 1024 * 512 + grp * 64;
            const int f0 = grp * 64;
            bf16_t* dst = (bf16_t*)(p.ws + OFF_BTGU) + ((size_t)e * 1024 + (f0 >> 7) * 256 + up * 128 + (f0 & 127)) * 1024;
            cvt_tile(src, 512, dst, 1024, kt * 64, smem);
        } else {
            const int q2 = q - 256, grp = q2 >> 3, kt = q2 & 7;
            const float* src = p.in[I_WDOWN] + ((size_t)L * 32 + e) * 512 * 1024 + grp * 64;
            bf16_t* dst = (bf16_t*)(p.ws + OFF_BTD) + ((size_t)e * 1024 + grp * 64) * 512;
            cvt_tile(src, 1024, dst, 512, kt * 64, smem);
        }
    }
}

__device__ void ph_ada(const Params& p, char* smem) {
    const int tid = hide_tid();
    float* scond = (float*)smem;
    float* red = scond + 9 * 1024;
    float* MOD = (float*)(p.ws + OFF_MOD);
    for (int i = tid; i < 9 * 1024; i += NTHR) {
        const int r = i >> 10, k = i & 1023;
        const float v = r < 8 ? p.in[I_C][r * 1024 + k] : p.in[I_CCTX][k];
        scond[i] = siluf_(v);
    }
    __syncthreads();
    for (int item = blockIdx.x; item < 192; item += gridDim.x) {
        const int l = item / 96, cg = item % 96;
        const int kq = tid >> 6, cl = tid & 63, col = cg * 64 + cl;
        const float* W = p.in[I_ADAW] + (size_t)l * 1024 * 6144;
        float acc[9];
#pragma unroll
        for (int r = 0; r < 9; ++r) acc[r] = 0.f;
        for (int k = kq * 128; k < kq * 128 + 128; ++k) {
            const float w = W[(size_t)k * 6144 + col];
#pragma unroll
            for (int r = 0; r < 9; ++r) acc[r] += scond[r * 1024 + k] * w;
        }
#pragma unroll
        for (int r = 0; r < 9; ++r) red[(kq * 9 + r) * 64 + cl] = acc[r];
        __syncthreads();
        for (int i = tid; i < 9 * 64; i += NTHR) {
            const int r = i >> 6, cc = i & 63;
            float s = 0.f;
#pragma unroll
            for (int q = 0; q < 8; ++q) s += red[(q * 9 + r) * 64 + cc];
            MOD[(size_t)(l * 9 + r) * 6144 + cg * 64 + cc] = s + p.in[I_ADAB][l * 6144 + cg * 64 + cc];
        }
        __syncthreads();
    }
}

#define HS_LD 1028
template <int MODE>
__device__ void ph_rows(const Params& p, char* smem) {
    const int tid = hide_tid(), lane = tid & 63, wave = tid >> 6;
    constexpr int L = (MODE >= 2) ? 1 : 0;
    constexpr int NROWS = (MODE >= 3) ? NL : NT;
    constexpr bool ROUTER = (MODE == 1 || MODE == 3);
    constexpr bool GATEP = (MODE == 0);
    constexpr bool LOGITS = ROUTER || GATEP;
    constexpr int NTL = GATEP ? 1 : 3;
    float* GATES = (float*)(p.ws + OFF_GATES);
    float* X = (float*)(p.ws + OFF_X);
    bf16_t* H = (bf16_t*)(p.ws + OFF_H);
    const bf16_t* YE = (const bf16_t*)(p.ws + OFF_YE);
    const float* MOD = (const float*)(p.ws + OFF_MOD);
    float* hsb = (float*)smem;
    float* part = hsb + 16 * HS_LD;
    float* lgs = part + 8 * 16 * 48;
    unsigned* cnt = (unsigned*)(p.ws + OFF_CNT) + L * 32;
    int* LIST = (int*)(p.ws + OFF_LIST);
    float* WSEL = (float*)(p.ws + OFF_WSEL);

    for (int base = blockIdx.x * 16; base < NROWS; base += gridDim.x * 16) {
#pragma unroll 1
        for (int rr = 0; rr < 2; ++rr) {
            const int row = base + wave * 2 + rr;
            float* hs = hsb + (wave * 2 + rr) * HS_LD;
            const int mr = row < NL ? (row >> 11) : 8;
            float v[16];
            if (MODE == 0) {
                const float* src = row < NL ? p.in[I_X] + (size_t)row * 1024 : p.in[I_CTX] + (size_t)(row - NL) * 1024;
#pragma unroll
                for (int i = 0; i < 4; ++i) {
                    const float4 t = *(const float4*)(src + i * 256 + lane * 4);
                    v[i * 4 + 0] = t.x; v[i * 4 + 1] = t.y; v[i * 4 + 2] = t.z; v[i * 4 + 3] = t.w;
                }
            } else {
#pragma unroll
                for (int i = 0; i < 4; ++i) {
                    const float4 t = *(const float4*)(X + (size_t)row * 1024 + i * 256 + lane * 4);
                    v[i * 4 + 0] = t.x; v[i * 4 + 1] = t.y; v[i * 4 + 2] = t.z; v[i * 4 + 3] = t.w;
                }
            }
            if (MODE == 2 || MODE == 4) {
                constexpr int LP = (MODE == 2) ? 0 : 1;
                const float* g2 = MOD + (size_t)(LP * 9 + mr) * 6144 + 5 * 1024;
#pragma unroll
                for (int i = 0; i < 4; ++i) {
                    const int c = i * 256 + lane * 4;
                    const uint2 a = *(const uint2*)(YE + (size_t)(2 * row) * 1024 + c);
                    const uint2 b = *(const uint2*)(YE + (size_t)(2 * row + 1) * 1024 + c);
                    const float4 g = *(const float4*)(g2 + c);
                    v[i * 4 + 0] += g.x * (bf2f((bf16_t)(a.x & 0xffff)) + bf2f((bf16_t)(b.x & 0xffff)));
                    v[i * 4 + 1] += g.y * (bf2f((bf16_t)(a.x >> 16)) + bf2f((bf16_t)(b.x >> 16)));
                    v[i * 4 + 2] += g.z * (bf2f((bf16_t)(a.y & 0xffff)) + bf2f((bf16_t)(b.y & 0xffff)));
                    v[i * 4 + 3] += g.w * (bf2f((bf16_t)(a.y >> 16)) + bf2f((bf16_t)(b.y >> 16)));
                }
            }
            if (MODE == 0 || MODE == 2) {
#pragma unroll
                for (int i = 0; i < 4; ++i)
                    *(float4*)(X + (size_t)row * 1024 + i * 256 + lane * 4) = make_float4(v[i * 4], v[i * 4 + 1], v[i * 4 + 2], v[i * 4 + 3]);
            }
            float ss = 0.f;
#pragma unroll
            for (int i = 0; i < 16; ++i) ss += v[i] * v[i];
            ss = wave_sum(ss);
            const float rinv = rsqrtf(ss * (1.f / 1024.f) + EPSF);
            if (MODE == 4) {
#pragma unroll
                for (int i = 0; i < 4; ++i) {
                    const int c = i * 256 + lane * 4;
                    const float4 w = *(const float4*)(p.in[I_FNORM] + c);
                    *(float4*)(p.out + (size_t)row * 1024 + c) =
                        make_float4(v[i * 4] * rinv * w.x, v[i * 4 + 1] * rinv * w.y, v[i * 4 + 2] * rinv * w.z, v[i * 4 + 3] * rinv * w.w);
                }
            } else {
                constexpr int SH = (MODE == 0 || MODE == 2) ? 0 : 3;
                const float* gain = p.in[(MODE == 0 || MODE == 2) ? I_NORM1 : I_NORM2] + L * 1024;
                const float* sh = MOD + (size_t)(L * 9 + mr) * 6144 + SH * 1024;
                const float* sc = sh + 1024;
#pragma unroll
                for (int i = 0; i < 4; ++i) {
                    const int c = i * 256 + lane * 4;
                    const float4 w = *(const float4*)(gain + c);
                    const float4 s1 = *(const float4*)(sc + c);
                    const float4 s0 = *(const float4*)(sh + c);
                    float h0 = v[i * 4 + 0] * rinv * w.x * (1.f + s1.x) + s0.x;
                    float h1 = v[i * 4 + 1] * rinv * w.y * (1.f + s1.y) + s0.y;
                    float h2 = v[i * 4 + 2] * rinv * w.z * (1.f + s1.z) + s0.z;
                    float h3 = v[i * 4 + 3] * rinv * w.w * (1.f + s1.w) + s0.w;
                    uint2 o; o.x = pack2(h0, h1); o.y = pack2(h2, h3);
                    *(uint2*)(H + (size_t)row * 1024 + c) = o;
                    if (LOGITS) *(float4*)(hs + c) = make_float4(h0, h1, h2, h3);
                }
            }
        }
        if (LOGITS) {
            __syncthreads();
            const int l15 = lane & 15, lq = lane >> 4;
            const float* wp[NTL]; int wld[NTL];
#pragma unroll
            for (int nt = 0; nt < NTL; ++nt) {
                const int c = nt * 16 + l15;
                if (GATEP) { wp[nt] = p.in[I_ABWIN] + 2048 + c; wld[nt] = AB_PROJ; }
                else if (c < 4) { wp[nt] = p.in[I_WGRP] + (size_t)L * 1024 * 4 + c; wld[nt] = 4; }
                else if (c < 36) { wp[nt] = p.in[I_WEXP] + (size_t)L * 1024 * 32 + (c - 4); wld[nt] = 32; }
                else { wp[nt] = nullptr; wld[nt] = 0; }
            }
            f32x4 acc[NTL];
#pragma unroll
            for (int nt = 0; nt < NTL; ++nt) acc[nt] = (f32x4){0.f, 0.f, 0.f, 0.f};
            const float* arow = hsb + l15 * HS_LD + wave * 128 + lq;
#pragma unroll 8
            for (int kk = 0; kk < 32; ++kk) {
                const int k = wave * 128 + kk * 4 + lq;
                const float a = arow[kk * 4];
#pragma unroll
                for (int nt = 0; nt < NTL; ++nt) {
                    const float bv = wp[nt] ? wp[nt][(size_t)k * wld[nt]] : 0.f;
                    acc[nt] = __builtin_amdgcn_mfma_f32_16x16x4f32(a, bv, acc[nt], 0, 0, 0);
                }
            }
#pragma unroll
            for (int nt = 0; nt < NTL; ++nt)
#pragma unroll
                for (int j = 0; j < 4; ++j) part[(wave * 16 + lq * 4 + j) * 48 + nt * 16 + l15] = acc[nt][j];
            __syncthreads();
            for (int t = tid; t < 16 * NTL * 16; t += NTHR) {
                const int r = t / (NTL * 16), c = t % (NTL * 16);
                float sacc = 0.f;
#pragma unroll
                for (int w = 0; w < 8; ++w) sacc += part[(w * 16 + r) * 48 + c];
                if (GATEP) GATES[(size_t)(base + r) * 16 + c] = sacc;
                else {
                    float bias = 0.f;
                    if (c < 4) bias = p.in[I_BGRP][L * 4 + c]; else if (c < 36) bias = p.in[I_BEXP][L * 32 + c - 4];
                    lgs[r * 48 + c] = sacc + bias;
                }
            }
            if (ROUTER) {
                __syncthreads();
                if (tid < 16) {
                    const int row = base + tid;
                    const float* lg = lgs + tid * 48;
                    int gi = 0; float gm = lg[0];
#pragma unroll
                    for (int j = 1; j < 4; ++j) if (lg[j] > gm) { gm = lg[j]; gi = j; }
                    float gs = 0.f;
#pragma unroll
                    for (int j = 0; j < 4; ++j) gs += __expf(lg[j] - gm);
                    const float gw = 1.f / gs;
                    const float* el = lg + 4 + gi * 8;
                    int e0 = 0; float v0 = el[0];
#pragma unroll
                    for (int j = 1; j < 8; ++j) if (el[j] > v0) { v0 = el[j]; e0 = j; }
                    int e1 = -1; float v1 = -3.0e38f;
#pragma unroll
                    for (int j = 0; j < 8; ++j) if (j != e0 && el[j] > v1) { v1 = el[j]; e1 = j; }
                    const float t = __expf(v1 - v0);
                    const float w0 = gw / (1.f + t), w1 = gw * t / (1.f + t);
                    const int x0 = gi * 8 + e0, x1 = gi * 8 + e1;
                    const unsigned s0 = __hip_atomic_fetch_add(&cnt[x0], 1u, __ATOMIC_RELAXED, __HIP_MEMORY_SCOPE_AGENT);
                    const unsigned s1 = __hip_atomic_fetch_add(&cnt[x1], 1u, __ATOMIC_RELAXED, __HIP_MEMORY_SCOPE_AGENT);
                    LIST[(size_t)x0 * NT + s0] = 2 * row;
                    LIST[(size_t)x1 * NT + s1] = 2 * row + 1;
                    WSEL[2 * row] = w0;
                    WSEL[2 * row + 1] = w1;
                }
            }
            __syncthreads();
        }
    }
}

__device__ void ph_gemm_in(const Params& p, LAS unsigned char* lds) {
    g8::DenseSched S{p.ws + OFF_H, p.ws + OFF_BTIN, NT / 256, ZW / 256, 1024, (int)gridDim.x, (int)blockIdx.x};
    g8::EpiBf16 E{(bf16_t*)(p.ws + OFF_Z), ZW, nullptr, 0};
    g8::gemm_phase<false, 0>(lds, 1024, S, E);
}
template <int L>
__device__ void ph_gemm_out(const Params& p, LAS unsigned char* lds) {
    g8::DenseSched S{p.ws + OFF_H, p.ws + (L == 0 ? OFF_BTOUT0 : OFF_BTOUT1), (L == 0 ? NT : NL) / 256, 4, 1024, (int)gridDim.x, (int)blockIdx.x};
    g8::EpiResid E{(float*)(p.ws + OFF_X), (const float*)(p.ws + OFF_MOD) + (size_t)(L * 9) * 6144 + 2 * 1024};
    g8::gemm_phase<false, 0>(lds, 1024, S, E);
}
__device__ void ph_gemm_qkv(const Params& p, LAS unsigned char* lds) {
    g8::QkvSched S{p.ws + OFF_H, p.ws + OFF_BTQKV, (int)gridDim.x, (int)blockIdx.x};
    g8::EpiBf16 E{(bf16_t*)(p.ws + OFF_ZQ), 1536, (bf16_t*)(p.ws + OFF_ZC), 512};
    g8::gemm_phase<false, 0>(lds, 1024, S, E);
}

__device__ __forceinline__ void moe_prefix(const Params& p, int L, LAS int* pre) {
    unsigned* cnt = (unsigned*)(p.ws + OFF_CNT) + L * 32;
    __syncthreads();
    if (hide_tid() == 0) {
        int s = 0;
        for (int e = 0; e < 32; ++e) { pre[e] = s; s += ((int)xb_ld(&cnt[e]) + 255) >> 8; }
        pre[32] = s;
    }
    __syncthreads();
}
__device__ void ph_moe_up(const Params& p, int L, LAS unsigned char* lds) {
    LAS int* pre = (LAS int*)(lds + LDS_PRE);
    moe_prefix(p, L, pre);
    g8::MoeSched S{p.ws + OFF_H, p.ws + OFF_BTGU, (size_t)1024 * 1024 * 2, 1024, (const int*)(p.ws + OFF_LIST),
                   (const unsigned*)(p.ws + OFF_CNT) + L * 32, pre, 2, (int)gridDim.x, (int)blockIdx.x};
    g8::EpiMoeUp E{(bf16_t*)(p.ws + OFF_ACT), (const float*)(p.ws + OFF_WSEL)};
    g8::gemm_phase<true, 1>(lds, 1024, S, E);
}
__device__ void ph_moe_down(const Params& p, int L, LAS unsigned char* lds) {
    LAS int* pre = (LAS int*)(lds + LDS_PRE);
    moe_prefix(p, L, pre);
    g8::MoeSched S{p.ws + OFF_ACT, p.ws + OFF_BTD, (size_t)1024 * 512 * 2, 512, (const int*)(p.ws + OFF_LIST),
                   (const unsigned*)(p.ws + OFF_CNT) + L * 32, pre, 2, (int)gridDim.x, (int)blockIdx.x};
    g8::EpiMoeDown E{(bf16_t*)(p.ws + OFF_YE)};
    g8::gemm_phase<true, 0>(lds, 512, S, E);
}

__device__ void ph_prep(const Params& p, char* smem) {
    const int tid = hide_tid(), lane = tid & 63, wave = tid >> 6;
    const bf16_t* Z = (const bf16_t*)(p.ws + OFF_Z);
    bf16_t* QKVC = (bf16_t*)(p.ws + OFF_QKVC);
    float* G = (float*)(p.ws + OFF_G);
    float* BETA = (float*)(p.ws + OFF_BETA);
    float* LA = (float*)(p.ws + OFF_LA);
    float* LB = (float*)(p.ws + OFF_LB);
    float* xcs = (float*)smem;
    const float* GATES = (const float*)(p.ws + OFF_GATES);
    const float* cw = p.in[I_CONVQKV];
    const float* cx = p.in[I_CONVX];
    for (int item = blockIdx.x; item < NT / 8; item += gridDim.x) {
        const int row0 = item * 8;
        int sbeg, send;
        if (row0 < NL) { sbeg = (row0 >> 11) << 11; send = sbeg + SEQ; }
        else { sbeg = NL + (((row0 - NL) >> 8) << 8); send = sbeg + CTXL; }
        for (int u = wave; u < 96; u += 8) {
            const int tk = u / 12, grp = u % 12;
            const int row = row0 + tk;
            const int c = grp * 128 + lane * 2;
            float a0 = 0.f, a1 = 0.f;
#pragma unroll
            for (int j = 0; j < 4; ++j) {
                const int r = row + j - 2;
                if (r >= sbeg && r < send) {
                    const unsigned z2 = *(const unsigned*)(Z + (size_t)r * ZW + c);
                    a0 += bf2f((bf16_t)(z2 & 0xffff)) * cw[j * 1536 + c];
                    a1 += bf2f((bf16_t)(z2 >> 16)) * cw[j * 1536 + c + 1];
                }
            }
            a0 = siluf_(a0); a1 = siluf_(a1);
            if (grp < 8) {
                const float ss = wave_sum(a0 * a0 + a1 * a1);
                float sc = rsqrtf(ss + EPSF);
                if (grp < 4) sc *= 0.08838834764831845f;
                a0 *= sc; a1 *= sc;
            }
            *(unsigned*)(QKVC + (size_t)row * 1536 + c) = pack2(a0, a1);
        }
        if (tid < 128) {
            const int tk = tid >> 4, q = tid & 15;
            const int d = q >> 3, s = (q >> 2) & 1, h = q & 3;
            const int row = row0 + tk;
            const float gv = GATES[(size_t)row * 16 + q];
            if (s == 0) {
                const float dec = -__expf(p.in[I_ALOG][d * 4 + h]) * softplusf_(gv + p.in[I_DTB][d * 4 + h]);
                G[((size_t)d * NT + row) * 4 + h] = dec;
            } else {
                BETA[((size_t)d * NT + row) * 4 + h] = sigmoidf_(gv);
            }
        }
        {
            const int c = tid;
#pragma unroll
            for (int tk = 0; tk < 8; ++tk) {
                const int row = row0 + tk;
                float a = 0.f;
#pragma unroll
                for (int j = 0; j < 4; ++j) {
                    const int r = row + j - 2;
                    if (r >= sbeg && r < send) a += bf2f(Z[(size_t)r * ZW + 2048 + c]) * cx[j * 512 + c];
                }
                xcs[tk * 512 + c] = a;
            }
        }
        __syncthreads();
        {
            const int c = tid, g = c >> 6, j = c & 63;
            float ar[2][8], ai[2][8];
#pragma unroll
            for (int d = 0; d < 2; ++d)
#pragma unroll
                for (int tk = 0; tk < 8; ++tk) { ar[d][tk] = 0.f; ai[d][tk] = 0.f; }
            const float* wr0 = p.in[I_RGWR] + ((size_t)(0 * 8 + g) * 64) * 64 + j;
            const float* wr1 = p.in[I_RGWR] + ((size_t)(1 * 8 + g) * 64) * 64 + j;
            const float* wi0 = p.in[I_RGWI] + ((size_t)(0 * 8 + g) * 64) * 64 + j;
            const float* wi1 = p.in[I_RGWI] + ((size_t)(1 * 8 + g) * 64) * 64 + j;
            for (int k = 0; k < 64; ++k) {
                const float r0 = wr0[k * 64], r1 = wr1[k * 64], i0 = wi0[k * 64], i1 = wi1[k * 64];
#pragma unroll
                for (int tk = 0; tk < 8; ++tk) {
                    const float x = xcs[tk * 512 + g * 64 + k];
                    ar[0][tk] += x * r0; ar[1][tk] += x * r1; ai[0][tk] += x * i0; ai[1][tk] += x * i1;
                }
            }
#pragma unroll
            for (int d = 0; d < 2; ++d) {
                const float br = p.in[I_RGBR][d * 512 + c], bi = p.in[I_RGBI][d * 512 + c];
                const float spl = softplusf_(-p.in[I_RGLAM][d * 512 + c]);
#pragma unroll
                for (int tk = 0; tk < 8; ++tk) {
                    const float r = sigmoidf_(ar[d][tk] + br), ig = sigmoidf_(ai[d][tk] + bi);
                    const float log_a = -8.0f * r * spl;
                    const float a = __expf(log_a);
                    const float bb = sqrtf(-expm1f(2.f * log_a)) * ig * xcs[tk * 512 + c];
                    const size_t o = ((size_t)d * NT + row0 + tk) * 512 + c;
                    LA[o] = a; LB[o] = bb;
                }
            }
        }
        __syncthreads();
    }
}

__device__ void delta_seq(const Params& p, int chain, char* smem) {
    const int tid = hide_tid();
    const int b = chain >> 3, h = (chain >> 1) & 3, dir = chain & 1;
    const bf16_t* QKVC = (const bf16_t*)(p.ws + OFF_QKVC);
    const float* G = (const float*)(p.ws + OFF_G) + (size_t)dir * NT * 4;
    const float* BETA = (const float*)(p.ws + OFF_BETA) + (size_t)dir * NT * 4;
    bf16_t* OA = (bf16_t*)(p.ws + OFF_OA) + (size_t)dir * NT * 512;
    float* kq = (float*)smem;
    float* vs = kq + 2 * 16 * 256;
    float* gbs = vs + 2 * 16 * 128;
    constexpr int NG = TSEQ / 16;
    auto stage = [&](int gi, int buf) {
        const int idx0 = tid - 256;
        for (int idx = idx0; idx < 384; idx += 256) {
            const int type = idx >> 7, d = idx & 127;
#pragma unroll 4
            for (int st = 0; st < 16; ++st) {
                const int row = scan_row(gi * 16 + st, dir, b);
                const float val = bf2f(QKVC[(size_t)row * 1536 + type * 512 + h * 128 + d]);
                if (type < 2) kq[(buf * 16 + st) * 256 + type * 128 + d] = val;
                else vs[(buf * 16 + st) * 128 + d] = val;
            }
        }
        if (idx0 < 32) {
            const int st = idx0 >> 1, wh = idx0 & 1;
            const int row = scan_row(gi * 16 + st, dir, b);
            gbs[(buf * 16 + st) * 2 + wh] = (wh ? BETA : G)[(size_t)row * 4 + h];
        }
    };
    float S[64];
#pragma unroll
    for (int d = 0; d < 64; ++d) S[d] = 0.f;
    if (tid >= 256) stage(0, 0);
    __syncthreads();
    for (int gi = 0; gi < NG; ++gi) {
        const int buf = gi & 1;
        if (tid >= 256) {
            if (gi + 1 < NG) stage(gi + 1, buf ^ 1);
        } else {
            const int e = tid >> 1, hf = tid & 1;
            for (int st = 0; st < 16; ++st) {
                const float* qp = kq + (buf * 16 + st) * 256 + hf * 64;
                const float* kp = qp + 128;
                const float g = gbs[(buf * 16 + st) * 2], beta = gbs[(buf * 16 + st) * 2 + 1];
                const float v = vs[(buf * 16 + st) * 128 + e];
                const float eg = __expf(g);
                float kS0 = 0.f, kS1 = 0.f;
#pragma unroll
                for (int d = 0; d < 64; d += 4) {
                    const float4 k4 = *(const float4*)(kp + d);
                    kS0 += k4.x * S[d] + k4.z * S[d + 2];
                    kS1 += k4.y * S[d + 1] + k4.w * S[d + 3];
                }
                float kS = kS0 + kS1;
                kS += __shfl_xor(kS, 1, 64);
                const float coef = beta * (v - eg * kS);
                float o0 = 0.f, o1 = 0.f;
#pragma unroll
                for (int d = 0; d < 64; d += 4) {
                    const float4 k4 = *(const float4*)(kp + d);
                    const float4 q4 = *(const float4*)(qp + d);
                    S[d] = eg * S[d] + coef * k4.x;
                    S[d + 1] = eg * S[d + 1] + coef * k4.y;
                    S[d + 2] = eg * S[d + 2] + coef * k4.z;
                    S[d + 3] = eg * S[d + 3] + coef * k4.w;
                    o0 += q4.x * S[d] + q4.z * S[d + 2];
                    o1 += q4.y * S[d + 1] + q4.w * S[d + 3];
                }
                float o = o0 + o1;
                o += __shfl_xor(o, 1, 64);
                if (hf == 0) {
                    const int row = scan_row(gi * 16 + st, dir, b);
                    OA[(size_t)row * 512 + h * 128 + e] = f2bf(o);
                }
            }
        }
        __syncthreads();
    }
}
__device__ void lru_seq(const Params& p, int li) {
    const int idx = li * NTHR + hide_tid();
    const int c = idx & 511, bd = idx >> 9, b = bd >> 1, dir = bd & 1;
    const float* LA = (const float*)(p.ws + OFF_LA) + (size_t)dir * NT * 512 + c;
    float* LB = (float*)(p.ws + OFF_LB) + (size_t)dir * NT * 512 + c;
    float hh = 0.f;
    for (int s0 = 0; s0 < TSEQ; s0 += 8) {
        float a[8], bb[8];
#pragma unroll
        for (int i = 0; i < 8; ++i) {
            const size_t o = (size_t)scan_row(s0 + i, dir, b) * 512;
            a[i] = LA[o]; bb[i] = LB[o];
        }
#pragma unroll
        for (int i = 0; i < 8; ++i) {
            hh = a[i] * hh + bb[i];
            LB[(size_t)scan_row(s0 + i, dir, b) * 512] = hh;
        }
    }
}
__device__ void ph_scan(const Params& p, char* smem, int nitems = 80) {
    for (int item = blockIdx.x; item < nitems; item += gridDim.x) {
        if (item < 64) delta_seq(p, item, smem);
        else lru_seq(p, item - 64);
        __syncthreads();
    }
}

__device__ void ph_merge(const Params& p, char* smem) {
    const int tid = hide_tid(), lane = tid & 63, wave = tid >> 6;
    const bf16_t* Z = (const bf16_t*)(p.ws + OFF_Z);
    const bf16_t* OA0 = (const bf16_t*)(p.ws + OFF_OA);
    const bf16_t* OA1 = OA0 + (size_t)NT * 512;
    const float* OB0 = (const float*)(p.ws + OFF_LB);
    const float* OB1 = OB0 + (size_t)NT * 512;
    bf16_t* M = (bf16_t*)(p.ws + OFF_H);
    const float* onorm = p.in[I_ONORM];
    for (int row = blockIdx.x * 8 + wave; row < NT; row += gridDim.x * 8) {
#pragma unroll
        for (int h = 0; h < 4; ++h) {
            const int c = h * 128 + lane * 2;
            const unsigned u0 = *(const unsigned*)(OA0 + (size_t)row * 512 + c);
            const unsigned u1 = *(const unsigned*)(OA1 + (size_t)row * 512 + c);
            const float o0 = bf2f((bf16_t)(u0 & 0xffff)) + bf2f((bf16_t)(u1 & 0xffff));
            const float o1 = bf2f((bf16_t)(u0 >> 16)) + bf2f((bf16_t)(u1 >> 16));
            const float ss = wave_sum(o0 * o0 + o1 * o1);
            const float rinv = rsqrtf(ss * (1.f / 128.f) + EPSF);
            const unsigned gz = *(const unsigned*)(Z + (size_t)row * ZW + 1536 + c);
            const float y0 = o0 * rinv * onorm[lane * 2] * siluf_(bf2f((bf16_t)(gz & 0xffff)));
            const float y1 = o1 * rinv * onorm[lane * 2 + 1] * siluf_(bf2f((bf16_t)(gz >> 16)));
            *(unsigned*)(M + (size_t)row * 1024 + c) = pack2(y0, y1);
        }
#pragma unroll
        for (int i = 0; i < 4; ++i) {
            const int c = i * 128 + lane * 2;
            const float2 b0 = *(const float2*)(OB0 + (size_t)row * 512 + c);
            const float2 b1 = *(const float2*)(OB1 + (size_t)row * 512 + c);
            const unsigned yz = *(const unsigned*)(Z + (size_t)row * ZW + 2560 + c);
            const float y0 = (b0.x + b1.x) * geluf_(bf2f((bf16_t)(yz & 0xffff)));
            const float y1 = (b0.y + b1.y) * geluf_(bf2f((bf16_t)(yz >> 16)));
            *(unsigned*)(M + (size_t)row * 1024 + 512 + c) = pack2(y0, y1);
        }
    }
}

__device__ void ph_qkprep(const Params& p, char* smem) {
    const int tid = hide_tid(), lane = tid & 63, wave = tid >> 6;
    const bf16_t* ZQ = (const bf16_t*)(p.ws + OFF_ZQ);
    const bf16_t* ZC = (const bf16_t*)(p.ws + OFF_ZC);
    bf16_t* QA = (bf16_t*)(p.ws + OFF_QA);
    bf16_t* KA = (bf16_t*)(p.ws + OFF_KA);
    bf16_t* VT = (bf16_t*)(p.ws + OFF_VT);
    const float* qn = p.in[I_QNORM];
    const float* kn = p.in[I_KNORM];
    for (int row = blockIdx.x * 8 + wave; row < NT; row += gridDim.x * 8) {
        const bool lat = row < NL;
        const int b = lat ? (row >> 11) : ((row - NL) >> 8);
        const int t = lat ? (row & 2047) : ((row - NL) & 255);
        const int key = lat ? t : (SEQ + t);
        float cs = 1.f, sn = 0.f;
        if (lat) {
            const int f = lane & 31;
            const float pos = (lane < 32) ? (float)(t >> 6) : (float)(t & 63);
            const float inv = expf(-(float)f * (1.f / 32.f) * 9.210340371976184f);
            sincosf(pos * inv, &sn, &cs);
        }
        const bf16_t* src = lat ? ZQ + (size_t)row * 1536 : ZC + (size_t)(row - NL) * 512;
        const int koff = lat ? 1024 : 0;
        if (lat) {
#pragma unroll
            for (int h = 0; h < 8; ++h) {
                const unsigned u = *(const unsigned*)(src + h * 128 + lane * 2);
                float x1 = bf2f((bf16_t)(u & 0xffff)), x2 = bf2f((bf16_t)(u >> 16));
                const float ss = wave_sum(x1 * x1 + x2 * x2);
                const float rinv = rsqrtf(ss * (1.f / 128.f) + EPSF);
                x1 *= rinv * qn[lane * 2]; x2 *= rinv * qn[lane * 2 + 1];
                const float y1 = (x1 * cs - x2 * sn) * 0.08838834764831845f;
                const float y2 = (x1 * sn + x2 * cs) * 0.08838834764831845f;
                *(unsigned*)(QA + (size_t)row * 1024 + h * 128 + lane * 2) = pack2(y1, y2);
            }
        }
#pragma unroll
        for (int kh = 0; kh < 2; ++kh) {
            const unsigned u = *(const unsigned*)(src + koff + kh * 128 + lane * 2);
            float x1 = bf2f((bf16_t)(u & 0xffff)), x2 = bf2f((bf16_t)(u >> 16));
            const float ss = wave_sum(x1 * x1 + x2 * x2);
            const float rinv = rsqrtf(ss * (1.f / 128.f) + EPSF);
            x1 *= rinv * kn[lane * 2]; x2 *= rinv * kn[lane * 2 + 1];
            const float y1 = x1 * cs - x2 * sn;
            const float y2 = x1 * sn + x2 * cs;
            *(unsigned*)(KA + ((size_t)(b * 2 + kh) * TSEQ + key) * 128 + lane * 2) = pack2(y1, y2);
            const unsigned uv = *(const unsigned*)(src + koff + 256 + kh * 128 + lane * 2);
            bf16_t* vt = VT + ((size_t)(b * 2 + kh) * 128 + lane * 2) * TSEQ + key;
            vt[0] = (bf16_t)(uv & 0xffff);
            vt[TSEQ] = (bf16_t)(uv >> 16);
        }
    }
}

__device__ void ph_attn(const Params& p, char* smem) {
    const int tid = hide_tid(), lane = tid & 63, wave = tid >> 6;
    const int l15 = lane & 15, lq = lane >> 4;
    const bf16_t* QA = (const bf16_t*)(p.ws + OFF_QA);
    const bf16_t* KA = (const bf16_t*)(p.ws + OFF_KA);
    const bf16_t* VT = (const bf16_t*)(p.ws + OFF_VT);
    bf16_t* O = (bf16_t*)(p.ws + OFF_O);
    bf16_t* Ks = (bf16_t*)smem;
    bf16_t* Vts = Ks + 64 * 136;
    bf16_t* Ps = Vts + 128 * 72 + wave * 16 * 72;
    for (int item = blockIdx.x; item < 8 * 8 * 16; item += gridDim.x) {
        const int qb = item & 15, h = (item >> 4) & 7, b = item >> 7, kvh = h >> 2;
        const int q0 = qb * 128 + wave * 16;
        bf16x8 qf[4];
#pragma unroll
        for (int kk = 0; kk < 4; ++kk)
            qf[kk] = *(const bf16x8*)(QA + (size_t)(b * SEQ + q0 + l15) * 1024 + h * 128 + kk * 32 + lq * 8);
        float mrow[4], lrow[4];
        f32x4 o[8];
#pragma unroll
        for (int j = 0; j < 4; ++j) { mrow[j] = -1.0e30f; lrow[j] = 0.f; }
#pragma unroll
        for (int nd = 0; nd < 8; ++nd) o[nd] = (f32x4){0.f, 0.f, 0.f, 0.f};
        const bf16_t* Kb = KA + (size_t)(b * 2 + kvh) * TSEQ * 128;
        const bf16_t* Vb = VT + (size_t)(b * 2 + kvh) * 128 * TSEQ;
        for (int kt = 0; kt < TSEQ / 64; ++kt) {
            const int key0 = kt * 64;
            __syncthreads();
#pragma unroll
            for (int r = 0; r < 2; ++r) {
                const int cI = tid + r * NTHR;
                { const int kr = cI >> 4, dc = (cI & 15) * 8;
                  *(uint4*)(Ks + kr * 136 + dc) = *(const uint4*)(Kb + (size_t)(key0 + kr) * 128 + dc); }
                { const int d = cI >> 3, kc = (cI & 7) * 8;
                  *(uint4*)(Vts + d * 72 + kc) = *(const uint4*)(Vb + (size_t)d * TSEQ + key0 + kc); }
            }
            __syncthreads();
            f32x4 s[4];
#pragma unroll
            for (int n = 0; n < 4; ++n) {
                s[n] = (f32x4){0.f, 0.f, 0.f, 0.f};
#pragma unroll
                for (int kk = 0; kk < 4; ++kk) {
                    const bf16x8 kf = *(const bf16x8*)(Ks + (n * 16 + l15) * 136 + kk * 32 + lq * 8);
                    s[n] = __builtin_amdgcn_mfma_f32_16x16x32_bf16(qf[kk], kf, s[n], 0, 0, 0);
                }
            }
#pragma unroll
            for (int j = 0; j < 4; ++j) {
                float mx = fmaxf(fmaxf(s[0][j], s[1][j]), fmaxf(s[2][j], s[3][j]));
                mx = fmaxf(mx, __shfl_xor(mx, 1, 64)); mx = fmaxf(mx, __shfl_xor(mx, 2, 64));
                mx = fmaxf(mx, __shfl_xor(mx, 4, 64)); mx = fmaxf(mx, __shfl_xor(mx, 8, 64));
                const float mn = fmaxf(mrow[j], mx);
                const float alpha = __expf(mrow[j] - mn);
                mrow[j] = mn;
                float ps = 0.f;
#pragma unroll
                for (int n = 0; n < 4; ++n) {
                    const float pv = __expf(s[n][j] - mn);
                    ps += pv;
                    Ps[(lq * 4 + j) * 72 + n * 16 + l15] = f2bf(pv);
                }
                lrow[j] = lrow[j] * alpha + ps;
#pragma unroll
                for (int nd = 0; nd < 8; ++nd) o[nd][j] *= alpha;
            }
            __syncthreads();
#pragma unroll
            for (int kk = 0; kk < 2; ++kk) {
                const bf16x8 pf = *(const bf16x8*)(Ps + l15 * 72 + kk * 32 + lq * 8);
#pragma unroll
                for (int nd = 0; nd < 8; ++nd) {
                    const bf16x8 vf = *(const bf16x8*)(Vts + (nd * 16 + l15) * 72 + kk * 32 + lq * 8);
                    o[nd] = __builtin_amdgcn_mfma_f32_16x16x32_bf16(pf, vf, o[nd], 0, 0, 0);
                }
            }
        }
#pragma unroll
        for (int j = 0; j < 4; ++j) {
            float l = lrow[j];
            l += __shfl_xor(l, 1, 64); l += __shfl_xor(l, 2, 64); l += __shfl_xor(l, 4, 64); l += __shfl_xor(l, 8, 64);
            const float inv = 1.f / l;
            const size_t orow = (size_t)(b * SEQ + q0 + lq * 4 + j) * 1024 + h * 128;
#pragma unroll
            for (int nd = 0; nd < 8; ++nd) O[orow + nd * 16 + l15] = f2bf(o[nd][j] * inv);
        }
    }
}

#define N_PHASES 19
template <int PH>
__device__ __forceinline__ void run_phase(const Params& p, LAS unsigned char* lds, int rep = 0) {
    char* smem = (char*)lds;
    if (PH == 0) { ph_ada(p, smem); cvt_dense(p, smem); }
    else if (PH == 1) ph_rows<0>(p, smem);
    else if (PH == 2) ph_gemm_in(p, lds);
    else if (PH == 3) ph_prep(p, smem);
    else if (PH == 4) ph_scan(p, smem, rep ? 64 : 80);
    else if (PH == 5) ph_merge(p, smem);
    else if (PH == 6) { ph_gemm_out<0>(p, lds); cvt_moe(p, 0, smem); }
    else if (PH == 7) ph_rows<1>(p, smem);
    else if (PH == 8) ph_moe_up(p, 0, lds);
    else if (PH == 9) ph_moe_down(p, 0, lds);
    else if (PH == 10) ph_rows<2>(p, smem);
    else if (PH == 11) ph_gemm_qkv(p, lds);
    else if (PH == 12) { ph_qkprep(p, smem); cvt_moe(p, 1, smem); }
    else if (PH == 13) ph_attn(p, smem);
    else if (PH == 14) ph_gemm_out<1>(p, lds);
    else if (PH == 15) ph_rows<3>(p, smem);
    else if (PH == 16) ph_moe_up(p, 1, lds);
    else if (PH == 17) ph_moe_down(p, 1, lds);
    else if (PH == 18) ph_rows<4>(p, smem);
}

extern __shared__ __attribute__((aligned(16))) unsigned char dyn_lds[];
template <int PH>
__global__ void __launch_bounds__(NTHR, 2) k_phase(Params p) {
    run_phase<PH>(p, (LAS unsigned char*)dyn_lds);
}

#if ONE_LAUNCH
template <int PH>
__device__ __forceinline__ void run_all(const Params& p, LAS unsigned char* lds, const XcdBarrier& bar) {
    if (PH == REP_PH) {
        int nrep = 2; asm volatile("" : "+s"(nrep));
#pragma unroll 1
        for (int r = 0; r < nrep; ++r) { run_phase<PH>(p, lds, r); if (r + 1 < nrep) xcd_barrier(bar); }
    } else run_phase<PH>(p, lds);
    if (PH + 1 < N_PHASES) {
        xcd_barrier(bar);
        run_all<(PH + 1 < N_PHASES) ? PH + 1 : PH>(p, lds, bar);
    }
}
template <>
__device__ __forceinline__ void run_all<N_PHASES - 1>(const Params& p, LAS unsigned char* lds, const XcdBarrier& bar) {
    run_phase<N_PHASES - 1>(p, lds);
}

__global__ void __launch_bounds__(NTHR, 2) k_mega(Params p) {
    LAS unsigned char* lds = (LAS unsigned char*)dyn_lds;
    if (threadIdx.x < 4) ((LAS unsigned*)(lds + LDS_XB))[threadIdx.x] = 0u;
    __syncthreads();
    XcdBarrier bar = xcd_barrier_post((unsigned*)(p.ws + OFF_ZERO), (volatile LAS unsigned*)(lds + LDS_XB));
    run_all<0>(p, lds, bar);
}
#endif

template <int PH>
static void launch_phases(const Params& p, hipStream_t stream) {
    static bool attr_set = false;
    if (!attr_set) { (void)hipFuncSetAttribute((const void*)k_phase<PH>, hipFuncAttributeMaxDynamicSharedMemorySize, DYN_LDS); attr_set = true; }
    hipLaunchKernelGGL(k_phase<PH>, dim3(256), dim3(NTHR), DYN_LDS, stream, p);
    if constexpr (PH + 1 < N_PHASES) launch_phases<PH + 1>(p, stream);
}

extern "C" void kernel_launch(void* const* d_in, const int* in_sizes, int n_in, void* d_out, int out_size, void* d_ws,
                              size_t ws_size, hipStream_t stream) {
    Params p{};
    for (int i = 0; i < 32; ++i) p.in[i] = (const float*)d_in[i];
    p.out = (float*)d_out;
    p.ws = (char*)d_ws;
    (void)hipMemsetAsync(d_ws, 0, ZERO_BYTES, stream);
#if ONE_LAUNCH
    static int grid = 0;
    if (!grid) {
        int dev = 0, cus = 0, per_cu = 0;
        (void)hipGetDevice(&dev);
        (void)hipDeviceGetAttribute(&cus, hipDeviceAttributeMultiprocessorCount, dev);
        (void)hipFuncSetAttribute((const void*)k_mega, hipFuncAttributeMaxDynamicSharedMemorySize, DYN_LDS);
        (void)hipOccupancyMaxActiveBlocksPerMultiprocessor(&per_cu, k_mega, NTHR, DYN_LDS);
        if (cus <= 0) cus = 256;
        grid = cus * (per_cu < 1 ? per_cu : 1);
        if (grid <= 0) grid = cus;
    }
    hipLaunchKernelGGL(k_mega, dim3(grid), dim3(NTHR), DYN_LDS, stream, p);
#else
    launch_phases<0>(p, stream);
#endif
}
```

```cpp
#include <hip/hip_runtime.h>
#include <stdint.h>

#ifndef ONE_LAUNCH
#define ONE_LAUNCH 1
#endif
#ifndef REP_PH
#define REP_PH -1
#endif

typedef unsigned short bf16_t;
typedef __attribute__((ext_vector_type(8))) short bf16x8;
typedef __attribute__((ext_vector_type(4))) float f32x4;

#define D_MODEL 1024
#define BATCH 8
#define SEQ 2048
#define CTXL 256
#define NL (BATCH * SEQ)
#define NC (BATCH * CTXL)
#define NT (NL + NC)
#define AB_PROJ 3088
#define TSEQ (SEQ + CTXL)
#define EPSF 1e-6f
#define NTHR 512

enum { I_X = 0, I_C, I_CTX, I_CCTX, I_ADAW, I_ADAB, I_NORM1, I_NORM2, I_FNORM, I_ABWIN, I_CONVQKV, I_ALOG, I_DTB,
       I_ONORM, I_CONVX, I_RGWR, I_RGBR, I_RGWI, I_RGBI, I_RGLAM, I_ABWOUT, I_ATWQKV, I_QNORM, I_KNORM, I_ATWOUT,
       I_WGRP, I_BGRP, I_WEXP, I_BEXP, I_WGATE, I_WUP, I_WDOWN };

#define AL256(x) (((size_t)(x) + 255) & ~(size_t)255)
#define ZW 3072
#define OFF_ZERO 0
#define ZERO_BYTES 65536
#define OFF_CNT 16384
#define OFF_MOD (OFF_ZERO + ZERO_BYTES)
#define OFF_X AL256(OFF_MOD + 2 * 9 * 6144 * 4)
#define OFF_H AL256(OFF_X + (size_t)NT * 1024 * 4)
#define OFF_Z AL256(OFF_H + (size_t)NT * 1024 * 2)
#define OFF_BTIN AL256(OFF_Z + (size_t)NT * ZW * 2)
#define OFF_BTOUT0 AL256(OFF_BTIN + (size_t)3072 * 1024 * 2)
#define OFF_BTQKV AL256(OFF_BTOUT0 + (size_t)1024 * 1024 * 2)
#define OFF_BTOUT1 AL256(OFF_BTQKV + (size_t)1536 * 1024 * 2)
#define OFF_WRG AL256(OFF_BTOUT1 + (size_t)1024 * 1024 * 2)
#define OFF_WSEL AL256(OFF_WRG + (size_t)8 * 256 * 64 * 2)
#define OFF_LIST AL256(OFF_WSEL + (size_t)2 * NT * 4)
#define OFF_R1 AL256(OFF_LIST + (size_t)32 * NT * 4)
#define OFF_GATES OFF_R1
#define OFF_QG AL256(OFF_GATES + (size_t)NT * 16 * 4)
#define OFF_KG AL256(OFF_QG + (size_t)1152 * 8192 * 2)
#define OFF_VG AL256(OFF_KG + (size_t)1152 * 8192 * 2)
#define OFF_KTG AL256(OFF_VG + (size_t)1152 * 8192 * 2)
#define OFF_TT AL256(OFF_KTG + (size_t)1152 * 8192 * 2)
#define OFF_ATT AL256(OFF_TT + (size_t)1152 * 2 * 4096 * 2)
#define OFF_VEC AL256(OFF_ATT + (size_t)1152 * 2 * 4096 * 2)
#define OFF_EGL AL256(OFF_VEC + (size_t)1152 * 2 * 256 * 4)
#define OFF_HLOC AL256(OFF_EGL + (size_t)1152 * 2 * 4)
#define OFF_ACUM AL256(OFF_HLOC + (size_t)2 * NT * 512 * 2)
#define OFF_LTOT AL256(OFF_ACUM + (size_t)2 * NT * 512 * 2)
#define OFF_CIN AL256(OFF_LTOT + (size_t)2 * 288 * 512 * 2 * 4)
#define OFF_OA AL256(OFF_CIN + (size_t)2 * 288 * 512 * 4)
#define OFF_END AL256(OFF_OA + (size_t)2 * NT * 512 * 2)
#define OFF_BTGU OFF_R1
#define OFF_BTD AL256(OFF_BTGU + (size_t)32 * 1024 * 1024 * 2)
#define OFF_ACT AL256(OFF_BTD + (size_t)32 * 1024 * 512 * 2)
#define OFF_YE AL256(OFF_ACT + (size_t)2 * NT * 512 * 2)
#define OFF_ZQ OFF_Z
#define OFF_ZC (OFF_Z + (size_t)NL * 1536 * 2)
#define OFF_QA (OFF_ZC + (size_t)NC * 512 * 2)
#define OFF_KA (OFF_QA + (size_t)NL * 1024 * 2)
#define OFF_VT (OFF_KA + (size_t)8 * 2 * TSEQ * 128 * 2)
#define OFF_O OFF_H
static_assert(OFF_YE + (size_t)2 * NT * 1024 * 2 <= OFF_END, "MoE scratch must fit in R1");
static_assert(OFF_VT + (size_t)8 * 2 * TSEQ * 128 * 2 <= OFF_BTIN, "attention buffers must fit in the Z region");
static_assert(OFF_END < (size_t)530 * 1024 * 1024, "workspace budget");

#define DYN_LDS (131072 + 1024)
#define LDS_XB 131072
#define LDS_PRE (131072 + 64)

struct Params {
    const float* in[32];
    float* out;
    char* ws;
};

__device__ __forceinline__ bf16_t f2bf(float f) {
    unsigned u = __float_as_uint(f);
    u += 0x7fffu + ((u >> 16) & 1u);
    return (bf16_t)(u >> 16);
}
__device__ __forceinline__ float bf2f(bf16_t h) { return __uint_as_float(((unsigned)h) << 16); }
__device__ __forceinline__ unsigned pack2(float a, float b) { return (unsigned)f2bf(a) | ((unsigned)f2bf(b) << 16); }
__device__ __forceinline__ float sigmoidf_(float x) { return 1.f / (1.f + __expf(-x)); }
__device__ __forceinline__ float siluf_(float x) { return x / (1.f + __expf(-x)); }
__device__ __forceinline__ float softplusf_(float x) { return x > 20.f ? x : log1pf(__expf(x)); }
__device__ __forceinline__ float geluf_(float x) {
    const float u = 0.7978845608028654f * (x + 0.044715f * x * x * x);
    return 0.5f * x * (1.f + tanhf(u));
}
__device__ __forceinline__ float wave_sum(float v) {
#pragma unroll
    for (int o = 32; o >= 1; o >>= 1) v += __shfl_xor(v, o, 64);
    return v;
}
__device__ __forceinline__ int hide_tid() { int t = threadIdx.x; asm volatile("" : "+v"(t)); return t; }
__device__ __forceinline__ int scan_row(int s, int dir, int b) {
    if (s < CTXL) { const int t = dir ? (CTXL - 1 - s) : s; return NL + b * CTXL + t; }
    const int u = s - CTXL; const int t = dir ? (SEQ - 1 - u) : u; return b * SEQ + t;
}

#define XB_TMO      128
#define XB_XCNT(j)  (256  + 64 * (j))
#define XB_XSUB(j)  (1280 + 64 * (j))
#define XB_XGEN(j)  (2304 + 64 * (j))
#define XB_TOP      3328
#define XB_TOPGEN   3392
#define XCD_BAR_WORDS 3456
#define XB_SPIN_CAP (1u << 22)
#define LAS __attribute__((address_space(3)))

__device__ __forceinline__ unsigned xb_ld(unsigned* p)              { return __hip_atomic_load(p, __ATOMIC_RELAXED, __HIP_MEMORY_SCOPE_AGENT); }
__device__ __forceinline__ unsigned xb_add(unsigned* p, unsigned v) { return __hip_atomic_fetch_add(p, v, __ATOMIC_RELAXED, __HIP_MEMORY_SCOPE_AGENT); }
__device__ __forceinline__ unsigned xb_xcc_id() { return (unsigned)__builtin_amdgcn_s_getreg((3 << 11) | 20) & 0xFu; }
#define XB_SPIN(cond, bar) do { unsigned _sp = 0; while (cond) { __builtin_amdgcn_s_sleep(1); \
    if ((++_sp & 255u) == 0u) { if (xb_ld(&(bar)[XB_TMO])) break; if (_sp > XB_SPIN_CAP) { atomicAdd(&(bar)[XB_TMO], 1u); break; } } } } while (0)

struct XcdBarrier {
    unsigned* bar; unsigned x;
    volatile LAS unsigned* st;
};
__device__ __forceinline__ XcdBarrier xcd_barrier_post(unsigned* bar, volatile LAS unsigned* st) {
    XcdBarrier b; b.bar = bar; b.x = xb_xcc_id(); b.st = st;
    if (threadIdx.x == 0) (void)xb_add(&bar[XB_XCNT(b.x)], 1u);
    return b;
}
__device__ __forceinline__ void xcd_barrier_complete(unsigned* bar, unsigned x, unsigned& nloc, unsigned& nx) {
    const unsigned G = gridDim.x * gridDim.y * gridDim.z;
    unsigned sum, cnt, mine, sp = 0u;
    for (;;) {
        sum = 0u; cnt = 0u; mine = 0u;
#pragma unroll
        for (unsigned j = 0; j < 16; ++j) { const unsigned c = xb_ld(&bar[XB_XCNT(j)]); sum += c; cnt += (c > 0u) ? 1u : 0u; mine = (j == x) ? c : mine; }
        if (sum == G) break;
        __builtin_amdgcn_s_sleep(1);
        if ((++sp & 255u) == 0u) { if (xb_ld(&bar[XB_TMO])) break; if (sp > XB_SPIN_CAP) { atomicAdd(&bar[XB_TMO], 1u); break; } }
    }
    nloc = mine > 0u ? mine : 1u; nx = cnt > 0u ? cnt : 1u;
}
__device__ __forceinline__ void xcd_barrier(const XcdBarrier& b) {
    asm volatile("s_waitcnt vmcnt(0)" ::: "memory");
    __syncthreads();
    if (threadIdx.x == 0) {
        unsigned* bar = b.bar;
        __builtin_amdgcn_s_waitcnt(0);
        unsigned nloc = b.st[0], nx = b.st[1];
        if (nloc == 0u) { xcd_barrier_complete(bar, b.x, nloc, nx); b.st[0] = nloc; b.st[1] = nx; }
        const unsigned old = xb_add(&bar[XB_XSUB(b.x)], 1u);
        const unsigned gen = old / nloc;
        if (old + 1u == (gen + 1u) * nloc) {
            __builtin_amdgcn_fence(__ATOMIC_RELEASE, "agent");
            asm volatile("s_waitcnt vmcnt(0)" ::: "memory");
            const unsigned og = xb_add(&bar[XB_TOP], 1u);
            const unsigned tg = og / nx;
            if (og + 1u == (tg + 1u) * nx) xb_add(&bar[XB_TOPGEN], 1u);
            else XB_SPIN(xb_ld(&bar[XB_TOPGEN]) == tg, bar);
            __builtin_amdgcn_fence(__ATOMIC_ACQUIRE, "agent");
            xb_add(&bar[XB_XGEN(b.x)], 1u);
            asm volatile("s_waitcnt vmcnt(0)" ::: "memory");
        } else {
            XB_SPIN(xb_ld(&bar[XB_XGEN(b.x)]) == gen, bar);
            __builtin_amdgcn_fence(__ATOMIC_ACQUIRE, "agent");
            asm volatile("s_waitcnt vmcnt(0)" ::: "memory");
        }
    }
    __syncthreads();
}

template <int NB, class RowPtr, class Epi>
__device__ __forceinline__ void gemm_tile(RowPtr rowptr, const float* __restrict__ B0, const float* __restrict__ B1,
                                          int ldb, int K, int n0, int N, Epi epi, char* smem) {
    constexpr int LDS_LD = 72;
    bf16_t* As = (bf16_t*)smem;
    bf16_t* Bs0 = As + 128 * LDS_LD;
    bf16_t* Bs1 = Bs0 + 128 * LDS_LD;
    const int tid = hide_tid(), lane = tid & 63, wave = tid >> 6;
    const int wm = wave >> 1, wn = wave & 1;
    const int l15 = lane & 15, lq = lane >> 4;

    const bf16_t* arow0 = rowptr(tid >> 3);
    const bf16_t* arow1 = rowptr((tid >> 3) + 64);
    const int akc = (tid & 7) * 8;
    const int bn = tid & 127, bkg = tid >> 7;
    const bool bok = (n0 + bn) < N;
    const float* b0p = B0 + (size_t)(bkg * 8) * ldb + n0 + bn;
    const float* b1p = (NB == 2) ? (B1 + (size_t)(bkg * 8) * ldb + n0 + bn) : nullptr;

    f32x4 acc0[2][4], acc1[2][4];
#pragma unroll
    for (int i = 0; i < 2; ++i)
#pragma unroll
        for (int j = 0; j < 4; ++j) { acc0[i][j] = (f32x4){0.f, 0.f, 0.f, 0.f}; acc1[i][j] = (f32x4){0.f, 0.f, 0.f, 0.f}; }

    uint4 ra0, ra1;
    float rb0[16], rb1[16];
    const int nk = K >> 6;
    auto load_regs = [&](int kt) {
        const int k0 = kt * 64;
        ra0 = arow0 ? *(const uint4*)(arow0 + k0 + akc) : make_uint4(0, 0, 0, 0);
        ra1 = arow1 ? *(const uint4*)(arow1 + k0 + akc) : make_uint4(0, 0, 0, 0);
#pragma unroll
        for (int r = 0; r < 2; ++r)
#pragma unroll
            for (int j = 0; j < 8; ++j) {
                const size_t o = (size_t)(k0 + r * 32 + j) * ldb;
                rb0[r * 8 + j] = bok ? b0p[o] : 0.f;
                if (NB == 2) rb1[r * 8 + j] = bok ? b1p[o] : 0.f;
            }
    };
    load_regs(0);
    for (int kt = 0; kt < nk; ++kt) {
        __syncthreads();
        *(uint4*)(As + (tid >> 3) * LDS_LD + akc) = ra0;
        *(uint4*)(As + ((tid >> 3) + 64) * LDS_LD + akc) = ra1;
#pragma unroll
        for (int r = 0; r < 2; ++r) {
            uint4 w;
            w.x = pack2(rb0[r * 8 + 0], rb0[r * 8 + 1]); w.y = pack2(rb0[r * 8 + 2], rb0[r * 8 + 3]);
            w.z = pack2(rb0[r * 8 + 4], rb0[r * 8 + 5]); w.w = pack2(rb0[r * 8 + 6], rb0[r * 8 + 7]);
            *(uint4*)(Bs0 + bn * LDS_LD + bkg * 8 + r * 32) = w;
            if (NB == 2) {
                w.x = pack2(rb1[r * 8 + 0], rb1[r * 8 + 1]); w.y = pack2(rb1[r * 8 + 2], rb1[r * 8 + 3]);
                w.z = pack2(rb1[r * 8 + 4], rb1[r * 8 + 5]); w.w = pack2(rb1[r * 8 + 6], rb1[r * 8 + 7]);
                *(uint4*)(Bs1 + bn * LDS_LD + bkg * 8 + r * 32) = w;
            }
        }
        __syncthreads();
        if (kt + 1 < nk) load_regs(kt + 1);
#pragma unroll
        for (int kk = 0; kk < 2; ++kk) {
            bf16x8 af[2];
#pragma unroll
            for (int mi = 0; mi < 2; ++mi)
                af[mi] = *(const bf16x8*)(As + (wm * 32 + mi * 16 + l15) * LDS_LD + kk * 32 + lq * 8);
#pragma unroll
            for (int ni = 0; ni < 4; ++ni) {
                const bf16x8 bf0 = *(const bf16x8*)(Bs0 + (wn * 64 + ni * 16 + l15) * LDS_LD + kk * 32 + lq * 8);
#pragma unroll
                for (int mi = 0; mi < 2; ++mi) acc0[mi][ni] = __builtin_amdgcn_mfma_f32_16x16x32_bf16(af[mi], bf0, acc0[mi][ni], 0, 0, 0);
                if (NB == 2) {
                    const bf16x8 bf1 = *(const bf16x8*)(Bs1 + (wn * 64 + ni * 16 + l15) * LDS_LD + kk * 32 + lq * 8);
#pragma unroll
                    for (int mi = 0; mi < 2; ++mi) acc1[mi][ni] = __builtin_amdgcn_mfma_f32_16x16x32_bf16(af[mi], bf1, acc1[mi][ni], 0, 0, 0);
                }
            }
        }
    }
#pragma unroll
    for (int mi = 0; mi < 2; ++mi)
#pragma unroll
        for (int ni = 0; ni < 4; ++ni) {
            const int n = n0 + wn * 64 + ni * 16 + l15;
            if (n < N) {
#pragma unroll
                for (int j = 0; j < 4; ++j) epi(wm * 32 + mi * 16 + lq * 4 + j, n, acc0[mi][ni][j], acc1[mi][ni][j]);
            }
        }
}

namespace g8 {
constexpr int BM = 256, BK = 64, HALF = 128, HTB = HALF * BK * 2, STAGE_BYTES = 8 * HTB, NXCD = 8, WGM = 8;
typedef unsigned u32x4 __attribute__((ext_vector_type(4)));
__device__ __forceinline__ int lds_byte(int r, int c) { const int st = (r >> 4) * 2 + (c >> 5), rr = r & 15, cc = c & 31, ob = rr * 64 + cc * 2; return st * 1024 + (ob ^ (((ob >> 9) & 1) << 5)); }
__device__ __forceinline__ void stage_rc(int b, int& R, int& C) { const int st = b / 1024, sb = b % 1024, swz = sb ^ (((sb >> 9) & 1) << 5); R = (st >> 1) * 16 + swz / 64; C = (st & 1) * 32 + (swz % 64) / 2; }
__device__ __forceinline__ int perm32(int rho) { const int n = rho >> 4, i = rho & 15; return 8 * (i >> 2) + 4 * n + (i & 3); }
__device__ __forceinline__ unsigned cvt_pk_bf16(float lo, float hi) { unsigned r; asm volatile("v_cvt_pk_bf16_f32 %0, %1, %2" : "=v"(r) : "v"(lo), "v"(hi)); return r; }

struct Unit {
    const char* A;
    const char* Bt;
    const int* lst;
    int mv;
    int pm, pn;
    int aux;
};

__device__ __forceinline__ void static_order(int wgid, int nM, int nN, int& pm, int& pn) {
    const int nwg = nM * nN;
    { const int q = nwg / NXCD, r = nwg % NXCD, xcd = wgid % NXCD, off = wgid / NXCD; wgid = (xcd < r ? xcd * (q + 1) : r * (q + 1) + (xcd - r) * q) + off; }
    const int nig = WGM * nN, gid = wgid / nig, fm = gid * WGM, gsz = (nM - fm) < WGM ? (nM - fm) : WGM;
    pm = fm + ((wgid % nig) % gsz); pn = (wgid % nig) / gsz;
}

template <bool GATHER, int GSHIFT, class Epi, class Sched>
__device__ __forceinline__ void gemm_phase(LAS unsigned char* lds, const int K, const Sched& S, const Epi& E) {
    const int tid = hide_tid(), wid = __builtin_amdgcn_readfirstlane(tid >> 6), lane = tid & 63, wr = wid >> 2, wc = wid & 3, fr = lane & 15, fq = lane >> 4;
    const int nt = K / BK;
    unsigned voffA[2], voffB[2];
#pragma unroll
    for (int i = 0; i < 2; ++i) { int R, C; stage_rc(tid * 16 + i * 8192, R, C); const int Rb = Epi::PERM ? ((R & ~31) + perm32(R & 31)) : R;
        voffA[i] = (unsigned)(R * K + C) * 2u; voffB[i] = (unsigned)(Rb * K + C) * 2u; }
    const size_t kstep = (size_t)(BK * 2);
    const size_t hstep = (size_t)HALF * K * 2;
    const unsigned ldsw = (unsigned)wid * 1024u;
    const int aoff = lds_byte(wr * 64 + fr, fq * 8), boff = lds_byte(wc * 32 + fr, fq * 8);
    unsigned gcur[2][2], gnxt[2][2];
    auto gather_offs = [&](const Unit& u, unsigned (&g)[2][2]) {
#pragma unroll
        for (int h = 0; h < 2; ++h)
#pragma unroll
            for (int i = 0; i < 2; ++i) { int R, C; stage_rc(tid * 16 + i * 8192, R, C); int idx = h * 128 + R; idx = idx < u.mv ? idx : u.mv - 1;
                g[h][i] = (unsigned)(u.lst[idx] >> GSHIFT) * (unsigned)(K * 2) + (unsigned)(C * 2); }
    };
#define G8_SA(b, h) (((b) * 2 + (h)) * HTB)
#define G8_SB(b, h) ((4 + (b) * 2 + (h)) * HTB)
#define G8_STAGE(bufoff, gbase, voff) do { _Pragma("unroll") for (int _i = 0; _i < 2; ++_i) \
        __builtin_amdgcn_global_load_lds((const unsigned*)((const char*)(gbase) + (voff)[_i]), (LAS unsigned*)(lds + (bufoff) + ldsw + _i * 8192), 16, 0, 0); } while (0)
#define G8_LDA(dst, b, h) do { _Pragma("unroll") for (int m = 0; m < 4; ++m) _Pragma("unroll") for (int k = 0; k < 2; ++k) dst[m][k] = *(const LAS bf16x8*)(lds + G8_SA(b, h) + aoff + m * 2048 + k * 1024); } while (0)
#define G8_LDB(dst, b, h) do { _Pragma("unroll") for (int n = 0; n < 2; ++n) _Pragma("unroll") for (int k = 0; k < 2; ++k) dst[n][k] = *(const LAS bf16x8*)(lds + G8_SB(b, h) + boff + n * 2048 + k * 1024); } while (0)
#define G8_MMA(ai, bj, At, Bt) do { __builtin_amdgcn_s_setprio(1); _Pragma("unroll") for (int m = 0; m < 4; ++m) _Pragma("unroll") for (int n = 0; n < 2; ++n) _Pragma("unroll") for (int k = 0; k < 2; ++k) \
        acc[ai][bj][m][n] = __builtin_amdgcn_mfma_f32_16x16x32_bf16(Bt[n][k], At[m][k], acc[ai][bj][m][n], 0, 0, 0); __builtin_amdgcn_s_setprio(0); } while (0)
#define G8_WAIT_V(n) asm volatile("s_waitcnt vmcnt(" #n ")" ::: "memory")
#define G8_WAIT_L(n) asm volatile("s_waitcnt lgkmcnt(" #n ")" ::: "memory")
#define G8_BAR __builtin_amdgcn_s_barrier()
#define G8_SCHED __builtin_amdgcn_sched_barrier(0)
    Unit cur, nxt; int ui = 0;
    if (!S.next(0, cur)) return;
    f32x4 acc[2][2][4][2];
#pragma unroll
    for (int a = 0; a < 2; ++a)
#pragma unroll
        for (int b = 0; b < 2; ++b)
#pragma unroll
            for (int m = 0; m < 4; ++m)
#pragma unroll
                for (int n = 0; n < 2; ++n) acc[a][b][m][n] = (f32x4){0.f, 0.f, 0.f, 0.f};
    bf16x8 At[4][2], B0[2][2], B1[2][2];
    const char* cA = cur.A; const char* cB = cur.Bt;
    if (GATHER) gather_offs(cur, gcur);
#define G8_STAGE_A(bufoff, kp, h, g) do { if (GATHER) G8_STAGE(bufoff, kp, (g)[h]); else G8_STAGE(bufoff, (kp) + (h) * hstep, voffA); } while (0)
    G8_STAGE(G8_SB(0, 0), cB, voffB); G8_STAGE_A(G8_SA(0, 0), cA, 0, gcur); G8_STAGE(G8_SB(0, 1), cB + hstep, voffB); G8_STAGE_A(G8_SA(0, 1), cA, 1, gcur);
    if (wr == 1) G8_BAR;
    G8_WAIT_V(4); G8_BAR;
    G8_STAGE(G8_SB(1, 0), cB + kstep, voffB); G8_STAGE_A(G8_SA(1, 0), cA + kstep, 0, gcur); G8_STAGE(G8_SB(1, 1), cB + hstep + kstep, voffB);
    G8_WAIT_V(6); G8_BAR;
    for (;;) {
        const bool has_next = S.next(ui + 1, nxt);
        const char* nA = has_next ? nxt.A : cA; const char* nB = has_next ? nxt.Bt : cB;
        if (GATHER) {
            if (has_next) gather_offs(nxt, gnxt);
            else {
#pragma unroll
                for (int h = 0; h < 2; ++h)
#pragma unroll
                    for (int i = 0; i < 2; ++i) gnxt[h][i] = gcur[h][i];
            }
        }
        for (int t = 0; t < nt; t += 2) {
            const bool last = (t == nt - 2);
            const char* a1 = cA + (size_t)(t + 1) * kstep;
            const char* a2 = last ? nA : cA + (size_t)(t + 2) * kstep; const char* b2 = last ? nB : cB + (size_t)(t + 2) * kstep;
            const char* a3 = a2 + kstep; const char* b3 = b2 + kstep;
            unsigned g2[2][2];
            if (GATHER) {
#pragma unroll
                for (int h = 0; h < 2; ++h)
#pragma unroll
                    for (int i = 0; i < 2; ++i) g2[h][i] = last ? gnxt[h][i] : gcur[h][i];
            }
            G8_LDB(B0, 0, 0); G8_SCHED; G8_LDA(At, 0, 0); G8_STAGE_A(G8_SA(1, 1), a1, 1, gcur);
            G8_WAIT_L(8); G8_BAR; G8_WAIT_L(0); G8_MMA(0, 0, At, B0); G8_BAR; G8_SCHED;
            G8_LDB(B1, 0, 1); G8_STAGE(G8_SB(0, 0), b2, voffB);
            G8_BAR; G8_WAIT_L(0); G8_MMA(0, 1, At, B1); G8_BAR;
            G8_LDA(At, 0, 1); G8_STAGE_A(G8_SA(0, 0), a2, 0, g2);
            G8_BAR; G8_WAIT_L(0); G8_MMA(1, 0, At, B0); G8_BAR; G8_SCHED;
            G8_STAGE(G8_SB(0, 1), b2 + hstep, voffB);
            G8_WAIT_V(6); G8_BAR; G8_MMA(1, 1, At, B1); G8_BAR;
            G8_LDB(B0, 1, 0); G8_SCHED; G8_LDA(At, 1, 0); G8_STAGE_A(G8_SA(0, 1), a2, 1, g2);
            G8_WAIT_L(8); G8_BAR; G8_WAIT_L(0); G8_MMA(0, 0, At, B0); G8_BAR; G8_SCHED;
            G8_LDB(B1, 1, 1); G8_STAGE(G8_SB(1, 0), b3, voffB);
            G8_BAR; G8_WAIT_L(0); G8_MMA(0, 1, At, B1); G8_BAR;
            G8_LDA(At, 1, 1); G8_STAGE_A(G8_SA(1, 0), a3, 0, g2);
            G8_BAR; G8_WAIT_L(0); G8_MMA(1, 0, At, B0); G8_BAR; G8_SCHED;
            G8_STAGE(G8_SB(1, 1), b3 + hstep, voffB);
            G8_WAIT_V(6); G8_BAR; G8_MMA(1, 1, At, B1); G8_BAR;
        }
        E(acc, cur, wr, wc, fr, fq);
        if (!has_next) break;
#pragma unroll
        for (int a = 0; a < 2; ++a)
#pragma unroll
            for (int b = 0; b < 2; ++b)
#pragma unroll
                for (int m = 0; m < 4; ++m)
#pragma unroll
                    for (int n = 0; n < 2; ++n) acc[a][b][m][n] = (f32x4){0.f, 0.f, 0.f, 0.f};
        cur = nxt; cA = nA; cB = nB; ++ui;
        if (GATHER) {
#pragma unroll
            for (int h = 0; h < 2; ++h)
#pragma unroll
                for (int i = 0; i < 2; ++i) gcur[h][i] = gnxt[h][i];
        }
    }
    G8_WAIT_V(0);
    if (wr == 0) G8_BAR;
    G8_BAR;
#undef G8_SA
#undef G8_SB
#undef G8_STAGE
#undef G8_STAGE_A
#undef G8_LDA
#undef G8_LDB
#undef G8_MMA
#undef G8_WAIT_V
#undef G8_WAIT_L
#undef G8_BAR
#undef G8_SCHED
}

struct EpiBf16 {
    static constexpr bool PERM = true;
    bf16_t* O0; int ldc0; bf16_t* O1; int ldc1;
    __device__ __forceinline__ void operator()(const f32x4 (&acc)[2][2][4][2], const Unit& u, int wr, int wc, int fr, int fq) const {
        bf16_t* O = u.aux ? O1 : O0; const int ldc = u.aux ? ldc1 : ldc0;
        const int row0 = u.pm * BM + wr * 64 + fr, col0 = u.pn * BM + wc * 32 + 8 * fq;
#pragma unroll
        for (int ai = 0; ai < 2; ++ai)
#pragma unroll
            for (int m = 0; m < 4; ++m) { bf16_t* rowp = O + (size_t)(row0 + ai * HALF + m * 16) * ldc + col0;
#pragma unroll
                for (int bj = 0; bj < 2; ++bj) { const f32x4 v0 = acc[ai][bj][m][0], v1 = acc[ai][bj][m][1];
                    u32x4 w; w.x = cvt_pk_bf16(v0[0], v0[1]); w.y = cvt_pk_bf16(v0[2], v0[3]); w.z = cvt_pk_bf16(v1[0], v1[1]); w.w = cvt_pk_bf16(v1[2], v1[3]);
                    *(u32x4*)(rowp + bj * HALF) = w; } }
    }
};
struct EpiResid {
    static constexpr bool PERM = false;
    float* X; const float* g1base;
    __device__ __forceinline__ void operator()(const f32x4 (&acc)[2][2][4][2], const Unit& u, int wr, int wc, int fr, int fq) const {
        const int rt = u.pm * BM;
        const int mr = rt < NL ? (rt >> 11) : 8;
        const float* g1 = g1base + (size_t)mr * 6144;
        const int row0 = rt + wr * 64 + fr, col0 = u.pn * BM + wc * 32 + 4 * fq;
        f32x4 gv[2][2];
#pragma unroll
        for (int bj = 0; bj < 2; ++bj)
#pragma unroll
            for (int n = 0; n < 2; ++n) gv[bj][n] = *(const f32x4*)(g1 + col0 + bj * HALF + n * 16);
#pragma unroll
        for (int ai = 0; ai < 2; ++ai)
#pragma unroll
            for (int m = 0; m < 4; ++m) { float* rowp = X + (size_t)(row0 + ai * HALF + m * 16) * 1024 + col0;
#pragma unroll
                for (int bj = 0; bj < 2; ++bj)
#pragma unroll
                    for (int n = 0; n < 2; ++n) { f32x4* q = (f32x4*)(rowp + bj * HALF + n * 16); *q = *q + gv[bj][n] * acc[ai][bj][m][n]; } }
    }
};
struct EpiMoeUp {
    static constexpr bool PERM = true;
    bf16_t* ACT; const float* WSEL;
    __device__ __forceinline__ void operator()(const f32x4 (&acc)[2][2][4][2], const Unit& u, int wr, int wc, int fr, int fq) const {
        const int col0 = u.pn * 128 + wc * 32 + 8 * fq;
#pragma unroll
        for (int ai = 0; ai < 2; ++ai)
#pragma unroll
            for (int m = 0; m < 4; ++m) {
                const int ridx = ai * HALF + wr * 64 + m * 16 + fr;
                if (ridx < u.mv) {
                    const int r = u.lst[ridx];
                    const float w = WSEL[r];
                    float o[8];
#pragma unroll
                    for (int n = 0; n < 2; ++n)
#pragma unroll
                        for (int j = 0; j < 4; ++j) { const float g = acc[ai][0][m][n][j], uu = acc[ai][1][m][n][j]; o[n * 4 + j] = g / (1.f + __expf(-g)) * uu * w; }
                    u32x4 wv; wv.x = cvt_pk_bf16(o[0], o[1]); wv.y = cvt_pk_bf16(o[2], o[3]); wv.z = cvt_pk_bf16(o[4], o[5]); wv.w = cvt_pk_bf16(o[6], o[7]);
                    *(u32x4*)(ACT + (size_t)r * 512 + col0) = wv;
                }
            }
    }
};
struct EpiMoeDown {
    static constexpr bool PERM = true;
    bf16_t* YE;
    __device__ __forceinline__ void operator()(const f32x4 (&acc)[2][2][4][2], const Unit& u, int wr, int wc, int fr, int fq) const {
        const int col0 = u.pn * BM + wc * 32 + 8 * fq;
#pragma unroll
        for (int ai = 0; ai < 2; ++ai)
#pragma unroll
            for (int m = 0; m < 4; ++m) {
                const int ridx = ai * HALF + wr * 64 + m * 16 + fr;
                if (ridx < u.mv) {
                    const int r = u.lst[ridx];
#pragma unroll
                    for (int bj = 0; bj < 2; ++bj) { const f32x4 v0 = acc[ai][bj][m][0], v1 = acc[ai][bj][m][1];
                        u32x4 w; w.x = cvt_pk_bf16(v0[0], v0[1]); w.y = cvt_pk_bf16(v0[2], v0[3]); w.z = cvt_pk_bf16(v1[0], v1[1]); w.w = cvt_pk_bf16(v1[2], v1[3]);
                        *(u32x4*)(YE + (size_t)r * 1024 + col0 + bj * HALF) = w; }
                }
            }
    }
};

struct DenseSched {
    const char* A; const char* Bt; int nM, nN, K, G, c;
    __device__ __forceinline__ bool next(int i, Unit& u) const {
        const int L = i * G + c; if (L >= nM * nN) return false;
        int pm, pn; static_order(L, nM, nN, pm, pn);
        u.A = A + (size_t)pm * BM * K * 2; u.Bt = Bt + (size_t)pn * BM * K * 2; u.lst = nullptr; u.mv = 256; u.pm = pm; u.pn = pn; u.aux = 0;
        return true;
    }
};
struct QkvSched {
    const char* H; const char* Bt; int G, c;
    __device__ __forceinline__ bool next(int i, Unit& u) const {
        const int L = i * G + c;
        if (L < 384) { int pm, pn; static_order(L, 64, 6, pm, pn);
            u.A = H + (size_t)pm * BM * 2048; u.Bt = Bt + (size_t)pn * BM * 2048; u.pm = pm; u.pn = pn; u.aux = 0; }
        else if (L < 400) { const int q = L - 384, pm = q >> 1, pn = q & 1;
            u.A = H + (size_t)(NL + pm * BM) * 2048; u.Bt = Bt + (size_t)(1024 + pn * BM) * 2048; u.pm = pm; u.pn = pn; u.aux = 1; }
        else return false;
        u.lst = nullptr; u.mv = 256;
        return true;
    }
};
struct MoeSched {
    const char* A; const char* Bt; size_t bt_expert_bytes; int K; const int* LIST; const unsigned* cnt; const LAS int* pre; int NTN_SHIFT; int G, c;
    __device__ __forceinline__ bool next(int i, Unit& u) const {
        const int L = i * G + c; const int total = pre[32] << NTN_SHIFT; if (L >= total) return false;
        const int mt = L >> NTN_SHIFT, pn = L & ((1 << NTN_SHIFT) - 1);
        int e = 0;
#pragma unroll 1
        for (int j = 1; j < 32; ++j) if (pre[j] <= mt) e = j;
        const int m0 = (mt - pre[e]) * BM;
        int mv = (int)cnt[e] - m0; mv = mv > 256 ? 256 : mv;
        u.A = A; u.Bt = Bt + (size_t)e * bt_expert_bytes + (size_t)pn * BM * K * 2; u.lst = LIST + (size_t)e * NT + m0; u.mv = mv; u.pm = mt; u.pn = pn; u.aux = e;
        return true;
    }
};
}

__device__ __forceinline__ void cvt_tile(const float* __restrict__ src, int ld, bf16_t* __restrict__ dst, int K, int k0, char* smem) {
    bf16_t* T = (bf16_t*)smem;
    const int tid = hide_tid();
    __syncthreads();
#pragma unroll
    for (int r = 0; r < 2; ++r) {
        const int kk = (tid >> 4) + r * 32, n4 = (tid & 15) * 4;
        const float4 v = *(const float4*)(src + (size_t)(k0 + kk) * ld + n4);
        T[(n4 + 0) * 72 + kk] = f2bf(v.x); T[(n4 + 1) * 72 + kk] = f2bf(v.y); T[(n4 + 2) * 72 + kk] = f2bf(v.z); T[(n4 + 3) * 72 + kk] = f2bf(v.w);
    }
    __syncthreads();
    { const int nn = tid >> 3, kc = (tid & 7) * 8;
      *(uint4*)(dst + (size_t)nn * K + k0 + kc) = *(const uint4*)(T + nn * 72 + kc); }
}
__device__ void cvt_dense(const Params& p, char* smem) {
    {
        bf16_t* WRG = (bf16_t*)(p.ws + OFF_WRG);
        for (int i = blockIdx.x * NTHR + hide_tid(); i < 8 * 256 * 64; i += gridDim.x * NTHR) {
            const int k = i & 63, n = (i >> 6) & 255, g = i >> 14;
            const int d = n >> 7, ri = (n >> 6) & 1, j = n & 63;
            WRG[i] = f2bf(p.in[ri ? I_RGWI : I_RGWR][((size_t)(d * 8 + g) * 64 + k) * 64 + j]);
        }
    }
    for (int j = blockIdx.x; j < (48 + 16 + 24 + 16) * 16; j += gridDim.x) {
        const int grp = j >> 4, kt = j & 15;
        const float* src; int ld; bf16_t* dst;
        if (grp < 48) { const int c0 = grp * 64; src = p.in[I_ABWIN] + (c0 < 2048 ? c0 : c0 + 16); ld = AB_PROJ; dst = (bf16_t*)(p.ws + OFF_BTIN) + (size_t)c0 * 1024; }
        else if (grp < 64) { const int c0 = (grp - 48) * 64; src = p.in[I_ABWOUT] + c0; ld = 1024; dst = (bf16_t*)(p.ws + OFF_BTOUT0) + (size_t)c0 * 1024; }
        else if (grp < 88) { const int c0 = (grp - 64) * 64; src = p.in[I_ATWQKV] + c0; ld = 1536; dst = (bf16_t*)(p.ws + OFF_BTQKV) + (size_t)c0 * 1024; }
        else { const int c0 = (grp - 88) * 64; src = p.in[I_ATWOUT] + c0; ld = 1024; dst = (bf16_t*)(p.ws + OFF_BTOUT1) + (size_t)c0 * 1024; }
        cvt_tile(src, ld, dst, 1024, kt * 64, smem);
    }
}
__device__ void cvt_moe(const Params& p, int L, char* smem) {
    for (int j = blockIdx.x; j < 32 * 384; j += gridDim.x) {
        const int e = j / 384, q = j % 384;
        if (q < 256) {
            const int up = q >> 7, grp = (q >> 4) & 7, kt = q & 15;
            const float* src = p.in[up ? I_WUP : I_WGATE] + ((size_t)L * 32 + e) * 1024 * 512 + grp * 64;
            const int f0 = grp * 64;
            bf16_t* dst = (bf16_t*)(p.ws + OFF_BTGU) + ((size_t)e * 1024 + (f0 >> 7) * 256 + up * 128 + (f0 & 127)) * 1024;
            cvt_tile(src, 512, dst, 1024, kt * 64, smem);
        } else {
            const int q2 = q - 256, grp = q2 >> 3, kt = q2 & 7;
            const float* src = p.in[I_WDOWN] + ((size_t)L * 32 + e) * 512 * 1024 + grp * 64;
            bf16_t* dst = (bf16_t*)(p.ws + OFF_BTD) + ((size_t)e * 1024 + grp * 64) * 512;
            cvt_tile(src, 1024, dst, 512, kt * 64, smem);
        }
    }
}

__device__ void ph_ada(const Params& p, char* smem) {
    const int tid = hide_tid();
    float* scond = (float*)smem;
    float* red = scond + 9 * 1024;
    float* MOD = (float*)(p.ws + OFF_MOD);
    for (int i = tid; i < 9 * 1024; i += NTHR) {
        const int r = i >> 10, k = i & 1023;
        const float v = r < 8 ? p.in[I_C][r * 1024 + k] : p.in[I_CCTX][k];
        scond[i] = siluf_(v);
    }
    __syncthreads();
    for (int item = blockIdx.x; item < 192; item += gridDim.x) {
        const int l = item / 96, cg = item % 96;
        const int kq = tid >> 6, cl = tid & 63, col = cg * 64 + cl;
        const float* W = p.in[I_ADAW] + (size_t)l * 1024 * 6144;
        float acc[9];
#pragma unroll
        for (int r = 0; r < 9; ++r) acc[r] = 0.f;
        for (int k = kq * 128; k < kq * 128 + 128; ++k) {
            const float w = W[(size_t)k * 6144 + col];
#pragma unroll
            for (int r = 0; r < 9; ++r) acc[r] += scond[r * 1024 + k] * w;
        }
#pragma unroll
        for (int r = 0; r < 9; ++r) red[(kq * 9 + r) * 64 + cl] = acc[r];
        __syncthreads();
        for (int i = tid; i < 9 * 64; i += NTHR) {
            const int r = i >> 6, cc = i & 63;
            float s = 0.f;
#pragma unroll
            for (int q = 0; q < 8; ++q) s += red[(q * 9 + r) * 64 + cc];
            MOD[(size_t)(l * 9 + r) * 6144 + cg * 64 + cc] = s + p.in[I_ADAB][l * 6144 + cg * 64 + cc];
        }
        __syncthreads();
    }
}

#define HS_LD 1028
template <int MODE>
__device__ void ph_rows(const Params& p, char* smem) {
    const int tid = hide_tid(), lane = tid & 63, wave = tid >> 6;
    constexpr int L = (MODE >= 2) ? 1 : 0;
    constexpr int NROWS = (MODE >= 3) ? NL : NT;
    constexpr bool ROUTER = (MODE == 1 || MODE == 3);
    constexpr bool GATEP = (MODE == 0);
    constexpr bool LOGITS = ROUTER || GATEP;
    constexpr int NTL = GATEP ? 1 : 3;
    float* GATES = (float*)(p.ws + OFF_GATES);
    float* X = (float*)(p.ws + OFF_X);
    bf16_t* H = (bf16_t*)(p.ws + OFF_H);
    const bf16_t* YE = (const bf16_t*)(p.ws + OFF_YE);
    const float* MOD = (const float*)(p.ws + OFF_MOD);
    float* hsb = (float*)smem;
    float* part = hsb + 16 * HS_LD;
    float* lgs = part + 8 * 16 * 48;
    unsigned* cnt = (unsigned*)(p.ws + OFF_CNT) + L * 32;
    int* LIST = (int*)(p.ws + OFF_LIST);
    float* WSEL = (float*)(p.ws + OFF_WSEL);

    for (int base = blockIdx.x * 16; base < NROWS; base += gridDim.x * 16) {
#pragma unroll 1
        for (int rr = 0; rr < 2; ++rr) {
            const int row = base + wave * 2 + rr;
            float* hs = hsb + (wave * 2 + rr) * HS_LD;
            const int mr = row < NL ? (row >> 11) : 8;
            float v[16];
            if (MODE == 0) {
                const float* src = row < NL ? p.in[I_X] + (size_t)row * 1024 : p.in[I_CTX] + (size_t)(row - NL) * 1024;
#pragma unroll
                for (int i = 0; i < 4; ++i) {
                    const float4 t = *(const float4*)(src + i * 256 + lane * 4);
                    v[i * 4 + 0] = t.x; v[i * 4 + 1] = t.y; v[i * 4 + 2] = t.z; v[i * 4 + 3] = t.w;
                }
            } else {
#pragma unroll
                for (int i = 0; i < 4; ++i) {
                    const float4 t = *(const float4*)(X + (size_t)row * 1024 + i * 256 + lane * 4);
                    v[i * 4 + 0] = t.x; v[i * 4 + 1] = t.y; v[i * 4 + 2] = t.z; v[i * 4 + 3] = t.w;
                }
            }
            if (MODE == 2 || MODE == 4) {
                constexpr int LP = (MODE == 2) ? 0 : 1;
                const float* g2 = MOD + (size_t)(LP * 9 + mr) * 6144 + 5 * 1024;
#pragma unroll
                for (int i = 0; i < 4; ++i) {
                    const int c = i * 256 + lane * 4;
                    const uint2 a = *(const uint2*)(YE + (size_t)(2 * row) * 1024 + c);
                    const uint2 b = *(const uint2*)(YE + (size_t)(2 * row + 1) * 1024 + c);
                    const float4 g = *(const float4*)(g2 + c);
                    v[i * 4 + 0] += g.x * (bf2f((bf16_t)(a.x & 0xffff)) + bf2f((bf16_t)(b.x & 0xffff)));
                    v[i * 4 + 1] += g.y * (bf2f((bf16_t)(a.x >> 16)) + bf2f((bf16_t)(b.x >> 16)));
                    v[i * 4 + 2] += g.z * (bf2f((bf16_t)(a.y & 0xffff)) + bf2f((bf16_t)(b.y & 0xffff)));
                    v[i * 4 + 3] += g.w * (bf2f((bf16_t)(a.y >> 16)) + bf2f((bf16_t)(b.y >> 16)));
                }
            }
            if (MODE == 0 || MODE == 2) {
#pragma unroll
                for (int i = 0; i < 4; ++i)
                    *(float4*)(X + (size_t)row * 1024 + i * 256 + lane * 4) = make_float4(v[i * 4], v[i * 4 + 1], v[i * 4 + 2], v[i * 4 + 3]);
            }
            float ss = 0.f;
#pragma unroll
            for (int i = 0; i < 16; ++i) ss += v[i] * v[i];
            ss = wave_sum(ss);
            const float rinv = rsqrtf(ss * (1.f / 1024.f) + EPSF);
            if (MODE == 4) {
#pragma unroll
                for (int i = 0; i < 4; ++i) {
                    const int c = i * 256 + lane * 4;
                    const float4 w = *(const float4*)(p.in[I_FNORM] + c);
                    *(float4*)(p.out + (size_t)row * 1024 + c) =
                        make_float4(v[i * 4] * rinv * w.x, v[i * 4 + 1] * rinv * w.y, v[i * 4 + 2] * rinv * w.z, v[i * 4 + 3] * rinv * w.w);
                }
            } else {
                constexpr int SH = (MODE == 0 || MODE == 2) ? 0 : 3;
                const float* gain = p.in[(MODE == 0 || MODE == 2) ? I_NORM1 : I_NORM2] + L * 1024;
                const float* sh = MOD + (size_t)(L * 9 + mr) * 6144 + SH * 1024;
                const float* sc = sh + 1024;
#pragma unroll
                for (int i = 0; i < 4; ++i) {
                    const int c = i * 256 + lane * 4;
                    const float4 w = *(const float4*)(gain + c);
                    const float4 s1 = *(const float4*)(sc + c);
                    const float4 s0 = *(const float4*)(sh + c);
                    float h0 = v[i * 4 + 0] * rinv * w.x * (1.f + s1.x) + s0.x;
                    float h1 = v[i * 4 + 1] * rinv * w.y * (1.f + s1.y) + s0.y;
                    float h2 = v[i * 4 + 2] * rinv * w.z * (1.f + s1.z) + s0.z;
                    float h3 = v[i * 4 + 3] * rinv * w.w * (1.f + s1.w) + s0.w;
                    uint2 o; o.x = pack2(h0, h1); o.y = pack2(h2, h3);
                    *(uint2*)(H + (size_t)row * 1024 + c) = o;
                    if (LOGITS) *(float4*)(hs + c) = make_float4(h0, h1, h2, h3);
                }
            }
        }
        if (LOGITS) {
            __syncthreads();
            const int l15 = lane & 15, lq = lane >> 4;
            const float* wp[NTL]; int wld[NTL];
#pragma unroll
            for (int nt = 0; nt < NTL; ++nt) {
                const int c = nt * 16 + l15;
                if (GATEP) { wp[nt] = p.in[I_ABWIN] + 2048 + c; wld[nt] = AB_PROJ; }
                else if (c < 4) { wp[nt] = p.in[I_WGRP] + (size_t)L * 1024 * 4 + c; wld[nt] = 4; }
                else if (c < 36) { wp[nt] = p.in[I_WEXP] + (size_t)L * 1024 * 32 + (c - 4); wld[nt] = 32; }
                else { wp[nt] = nullptr; wld[nt] = 0; }
            }
            f32x4 acc[NTL];
#pragma unroll
            for (int nt = 0; nt < NTL; ++nt) acc[nt] = (f32x4){0.f, 0.f, 0.f, 0.f};
            const float* arow = hsb + l15 * HS_LD + wave * 128 + lq;
#pragma unroll 8
            for (int kk = 0; kk < 32; ++kk) {
                const int k = wave * 128 + kk * 4 + lq;
                const float a = arow[kk * 4];
#pragma unroll
                for (int nt = 0; nt < NTL; ++nt) {
                    const float bv = wp[nt] ? wp[nt][(size_t)k * wld[nt]] : 0.f;
                    acc[nt] = __builtin_amdgcn_mfma_f32_16x16x4f32(a, bv, acc[nt], 0, 0, 0);
                }
            }
#pragma unroll
            for (int nt = 0; nt < NTL; ++nt)
#pragma unroll
                for (int j = 0; j < 4; ++j) part[(wave * 16 + lq * 4 + j) * 48 + nt * 16 + l15] = acc[nt][j];
            __syncthreads();
            for (int t = tid; t < 16 * NTL * 16; t += NTHR) {
                const int r = t / (NTL * 16), c = t % (NTL * 16);
                float sacc = 0.f;
#pragma unroll
                for (int w = 0; w < 8; ++w) sacc += part[(w * 16 + r) * 48 + c];
                if (GATEP) GATES[(size_t)(base + r) * 16 + c] = sacc;
                else {
                    float bias = 0.f;
                    if (c < 4) bias = p.in[I_BGRP][L * 4 + c]; else if (c < 36) bias = p.in[I_BEXP][L * 32 + c - 4];
                    lgs[r * 48 + c] = sacc + bias;
                }
            }
            if (ROUTER) {
                __syncthreads();
                if (tid < 16) {
                    const int row = base + tid;
                    const float* lg = lgs + tid * 48;
                    int gi = 0; float gm = lg[0];
#pragma unroll
                    for (int j = 1; j < 4; ++j) if (lg[j] > gm) { gm = lg[j]; gi = j; }
                    float gs = 0.f;
#pragma unroll
                    for (int j = 0; j < 4; ++j) gs += __expf(lg[j] - gm);
                    const float gw = 1.f / gs;
                    const float* el = lg + 4 + gi * 8;
                    int e0 = 0; float v0 = el[0];
#pragma unroll
                    for (int j = 1; j < 8; ++j) if (el[j] > v0) { v0 = el[j]; e0 = j; }
                    int e1 = -1; float v1 = -3.0e38f;
#pragma unroll
                    for (int j = 0; j < 8; ++j) if (j != e0 && el[j] > v1) { v1 = el[j]; e1 = j; }
                    const float t = __expf(v1 - v0);
                    const float w0 = gw / (1.f + t), w1 = gw * t / (1.f + t);
                    const int x0 = gi * 8 + e0, x1 = gi * 8 + e1;
                    const unsigned s0 = __hip_atomic_fetch_add(&cnt[x0], 1u, __ATOMIC_RELAXED, __HIP_MEMORY_SCOPE_AGENT);
                    const unsigned s1 = __hip_atomic_fetch_add(&cnt[x1], 1u, __ATOMIC_RELAXED, __HIP_MEMORY_SCOPE_AGENT);
                    LIST[(size_t)x0 * NT + s0] = 2 * row;
                    LIST[(size_t)x1 * NT + s1] = 2 * row + 1;
                    WSEL[2 * row] = w0;
                    WSEL[2 * row + 1] = w1;
                }
            }
            __syncthreads();
        }
    }
}

__device__ void ph_gemm_in(const Params& p, LAS unsigned char* lds) {
    g8::DenseSched S{p.ws + OFF_H, p.ws + OFF_BTIN, NT / 256, ZW / 256, 1024, (int)gridDim.x, (int)blockIdx.x};
    g8::EpiBf16 E{(bf16_t*)(p.ws + OFF_Z), ZW, nullptr, 0};
    g8::gemm_phase<false, 0>(lds, 1024, S, E);
}
template <int L>
__device__ void ph_gemm_out(const Params& p, LAS unsigned char* lds) {
    g8::DenseSched S{p.ws + OFF_H, p.ws + (L == 0 ? OFF_BTOUT0 : OFF_BTOUT1), (L == 0 ? NT : NL) / 256, 4, 1024, (int)gridDim.x, (int)blockIdx.x};
    g8::EpiResid E{(float*)(p.ws + OFF_X), (const float*)(p.ws + OFF_MOD) + (size_t)(L * 9) * 6144 + 2 * 1024};
    g8::gemm_phase<false, 0>(lds, 1024, S, E);
}
__device__ void ph_gemm_qkv(const Params& p, LAS unsigned char* lds) {
    g8::QkvSched S{p.ws + OFF_H, p.ws + OFF_BTQKV, (int)gridDim.x, (int)blockIdx.x};
    g8::EpiBf16 E{(bf16_t*)(p.ws + OFF_ZQ), 1536, (bf16_t*)(p.ws + OFF_ZC), 512};
    g8::gemm_phase<false, 0>(lds, 1024, S, E);
}

__device__ __forceinline__ void moe_prefix(const Params& p, int L, LAS int* pre) {
    unsigned* cnt = (unsigned*)(p.ws + OFF_CNT) + L * 32;
    __syncthreads();
    if (hide_tid() == 0) {
        int s = 0;
        for (int e = 0; e < 32; ++e) { pre[e] = s; s += ((int)xb_ld(&cnt[e]) + 255) >> 8; }
        pre[32] = s;
    }
    __syncthreads();
}
__device__ void ph_moe_up(const Params& p, int L, LAS unsigned char* lds) {
    LAS int* pre = (LAS int*)(lds + LDS_PRE);
    moe_prefix(p, L, pre);
    g8::MoeSched S{p.ws + OFF_H, p.ws + OFF_BTGU, (size_t)1024 * 1024 * 2, 1024, (const int*)(p.ws + OFF_LIST),
                   (const unsigned*)(p.ws + OFF_CNT) + L * 32, pre, 2, (int)gridDim.x, (int)blockIdx.x};
    g8::EpiMoeUp E{(bf16_t*)(p.ws + OFF_ACT), (const float*)(p.ws + OFF_WSEL)};
    g8::gemm_phase<true, 1>(lds, 1024, S, E);
}
__device__ void ph_moe_down(const Params& p, int L, LAS unsigned char* lds) {
    LAS int* pre = (LAS int*)(lds + LDS_PRE);
    moe_prefix(p, L, pre);
    g8::MoeSched S{p.ws + OFF_ACT, p.ws + OFF_BTD, (size_t)1024 * 512 * 2, 512, (const int*)(p.ws + OFF_LIST),
                   (const unsigned*)(p.ws + OFF_CNT) + L * 32, pre, 2, (int)gridDim.x, (int)blockIdx.x};
    g8::EpiMoeDown E{(bf16_t*)(p.ws + OFF_YE)};
    g8::gemm_phase<true, 0>(lds, 512, S, E);
}

__device__ __forceinline__ int unit_row0(int b, int cidx) { return cidx < 4 ? (NL + b * CTXL + cidx * 64) : (b * SEQ + (cidx - 4) * 64); }
__device__ __forceinline__ int tile_row0(int tl) { return tl < 256 ? tl * 64 : NL + (tl - 256) * 64; }

__device__ void lru_tile(const Params& p, int tl, char* smem) {
    const int tid = hide_tid(), lane = tid & 63, wave = tid >> 6, l15 = lane & 15, lq = lane >> 4;
    const bf16_t* Z = (const bf16_t*)(p.ws + OFF_Z);
    const bf16_t* WRG = (const bf16_t*)(p.ws + OFF_WRG);
    bf16_t* HLOC = (bf16_t*)(p.ws + OFF_HLOC);
    bf16_t* ACUM = (bf16_t*)(p.ws + OFF_ACUM);
    float* LTOT = (float*)(p.ws + OFF_LTOT);
    constexpr int XLD = 520;
    bf16_t* XC = (bf16_t*)smem;
    const int row0 = tile_row0(tl);
    int sbeg, send;
    if (row0 < NL) { sbeg = (row0 >> 11) << 11; send = sbeg + SEQ; }
    else { sbeg = NL + (((row0 - NL) >> 8) << 8); send = sbeg + CTXL; }
    __syncthreads();
    {
        const int c = tid;
        const float w0 = p.in[I_CONVX][c], w1 = p.in[I_CONVX][512 + c], w2 = p.in[I_CONVX][1024 + c], w3 = p.in[I_CONVX][1536 + c];
        auto ldz = [&](int r) -> float { return (r >= sbeg && r < send) ? bf2f(Z[(size_t)r * ZW + 2048 + c]) : 0.f; };
        float zm2 = ldz(row0 - 2), zm1 = ldz(row0 - 1), z0 = ldz(row0);
#pragma unroll 8
        for (int tk = 0; tk < 64; ++tk) {
            const float zp1 = ldz(row0 + tk + 1);
            XC[tk * XLD + c] = f2bf(zm2 * w0 + zm1 * w1 + z0 * w2 + zp1 * w3);
            zm2 = zm1; zm1 = z0; z0 = zp1;
        }
    }
    __syncthreads();
    const int g = wave;
    bf16x8 af[4][2];
#pragma unroll
    for (int mi = 0; mi < 4; ++mi)
#pragma unroll
        for (int kk = 0; kk < 2; ++kk) af[mi][kk] = *(const bf16x8*)(XC + (mi * 16 + l15) * XLD + g * 64 + kk * 32 + lq * 8);
#pragma unroll
    for (int d = 0; d < 2; ++d) {
#pragma unroll 1
        for (int ni = 0; ni < 4; ++ni) {
            f32x4 accr[4], acci[4];
#pragma unroll
            for (int mi = 0; mi < 4; ++mi) { accr[mi] = (f32x4){0.f, 0.f, 0.f, 0.f}; acci[mi] = (f32x4){0.f, 0.f, 0.f, 0.f}; }
            {
                const bf16_t* wr_ = WRG + ((size_t)(g * 256 + d * 128 + ni * 16 + l15)) * 64 + lq * 8;
#pragma unroll
                for (int kk = 0; kk < 2; ++kk) {
                    const bf16x8 br_ = *(const bf16x8*)(wr_ + kk * 32);
                    const bf16x8 bi_ = *(const bf16x8*)(wr_ + 64 * 64 + kk * 32);
#pragma unroll
                    for (int mi = 0; mi < 4; ++mi) {
                        accr[mi] = __builtin_amdgcn_mfma_f32_16x16x32_bf16(af[mi][kk], br_, accr[mi], 0, 0, 0);
                        acci[mi] = __builtin_amdgcn_mfma_f32_16x16x32_bf16(af[mi][kk], bi_, acci[mi], 0, 0, 0);
                    }
                }
            }
            const int c = g * 64 + ni * 16 + l15;
            const float br = p.in[I_RGBR][d * 512 + c], bi = p.in[I_RGBI][d * 512 + c];
            const float spl = softplusf_(-p.in[I_RGLAM][d * 512 + c]);
            float A[4][4], Bv[4][4];
#pragma unroll
            for (int mi = 0; mi < 4; ++mi)
#pragma unroll
                for (int j = 0; j < 4; ++j) {
                    const float r = sigmoidf_(accr[mi][j] + br), ig = sigmoidf_(acci[mi][j] + bi);
                    const float la = -8.0f * r * spl;
                    const float a = __expf(la);
                    const float xc = bf2f(XC[(mi * 16 + lq * 4 + j) * XLD + c]);
                    A[mi][j] = a;
                    Bv[mi][j] = sqrtf(-expm1f(2.f * la)) * ig * xc;
                }
            float P[4][4], Hh[4][4];
#pragma unroll
            for (int mi = 0; mi < 4; ++mi) {
                if (d == 0) {
                    P[mi][0] = A[mi][0]; Hh[mi][0] = Bv[mi][0];
#pragma unroll
                    for (int j = 1; j < 4; ++j) { P[mi][j] = A[mi][j] * P[mi][j - 1]; Hh[mi][j] = A[mi][j] * Hh[mi][j - 1] + Bv[mi][j]; }
                } else {
                    P[mi][3] = A[mi][3]; Hh[mi][3] = Bv[mi][3];
#pragma unroll
                    for (int j = 2; j >= 0; --j) { P[mi][j] = A[mi][j] * P[mi][j + 1]; Hh[mi][j] = A[mi][j] * Hh[mi][j + 1] + Bv[mi][j]; }
                }
            }
            float cP = 1.f, cH = 0.f;
#pragma unroll
            for (int mm = 0; mm < 4; ++mm) {
                const int mi = d == 0 ? mm : 3 - mm;
                const float sP = d == 0 ? P[mi][3] : P[mi][0], sH = d == 0 ? Hh[mi][3] : Hh[mi][0];
                float iP = sP, iH = sH;
#pragma unroll
                for (int dist = 1; dist <= 2; dist <<= 1) {
                    const int src = d == 0 ? lane - 16 * dist : lane + 16 * dist;
                    const float pP = __shfl(iP, src & 63, 64), pH = __shfl(iH, src & 63, 64);
                    const bool ok = d == 0 ? (lq >= dist) : (lq <= 3 - dist);
                    if (ok) { iH = iP * pH + iH; iP = iP * pP; }
                }
                const int srcx = d == 0 ? lane - 16 : lane + 16;
                float eP = __shfl(iP, srcx & 63, 64), eH = __shfl(iH, srcx & 63, 64);
                const bool first = d == 0 ? (lq == 0) : (lq == 3);
                if (first) { eP = 1.f; eH = 0.f; }
                const float bP = eP * cP, bH = eP * cH + eH;
#pragma unroll
                for (int j = 0; j < 4; ++j) {
                    const float hval = P[mi][j] * bH + Hh[mi][j];
                    const float aval = P[mi][j] * bP;
                    const size_t o = ((size_t)d * NT + row0 + mi * 16 + lq * 4 + j) * 512 + c;
                    HLOC[o] = f2bf(hval); ACUM[o] = f2bf(aval);
                    Hh[mi][j] = hval; P[mi][j] = aval;
                }
                const int lastl = d == 0 ? 48 + l15 : l15;
                const float tP = __shfl(iP, lastl, 64), tH = __shfl(iH, lastl, 64);
                cH = tP * cH + tH; cP = tP * cP;
            }
            if (d == 0 ? (lq == 3) : (lq == 0)) {
                const float aT = d == 0 ? P[3][3] : P[0][0], hT = d == 0 ? Hh[3][3] : Hh[0][0];
                float* o = LTOT + (((size_t)d * 288 + tl) * 512 + c) * 2;
                o[0] = aT; o[1] = hT;
            }
        }
    }
}

__device__ void delta_unit(const Params& p, int u, char* smem) {
    const int tid = hide_tid(), lane = tid & 63, wave = tid >> 6, l15 = lane & 15, lq = lane >> 4;
    const int cidx = u % 36, bh = u / 36, h = bh & 3, b = bh >> 2;
    const int row0 = unit_row0(b, cidx);
    const int sbeg = cidx < 4 ? NL + b * CTXL : b * SEQ, send = cidx < 4 ? sbeg + CTXL : sbeg + SEQ;
    const bf16_t* Z = (const bf16_t*)(p.ws + OFF_Z);
    const float* GATES = (const float*)(p.ws + OFF_GATES);
    bf16_t* QG = (bf16_t*)(p.ws + OFF_QG) + (size_t)u * 64 * 128;
    bf16_t* KG = (bf16_t*)(p.ws + OFF_KG) + (size_t)u * 64 * 128;
    bf16_t* VG = (bf16_t*)(p.ws + OFF_VG) + (size_t)u * 64 * 128;
    bf16_t* KTG = (bf16_t*)(p.ws + OFF_KTG) + (size_t)u * 128 * 64;
    bf16_t* TT = (bf16_t*)(p.ws + OFF_TT) + (size_t)u * 2 * 4096;
    bf16_t* ATT = (bf16_t*)(p.ws + OFF_ATT) + (size_t)u * 2 * 4096;
    float* VEC = (float*)(p.ws + OFF_VEC) + (size_t)u * 2 * 256;
    float* EGL = (float*)(p.ws + OFF_EGL) + (size_t)u * 2;
    constexpr int QLD = 136, LLD = 68;
    bf16_t* Qs = (bf16_t*)smem;
    bf16_t* Ks = Qs + 64 * QLD;
    float* Lm = (float*)(Ks + 64 * QLD);
    float* gcs = Lm + 2 * 64 * LLD;
    float* bts = gcs + 128;
    __syncthreads();
    if (wave < 6) {
        const int part = wave >> 1, t0 = (wave & 1) * 32;
        const int c = part * 512 + h * 128 + lane * 2;
        const float* cw = p.in[I_CONVQKV] + c;
        const float w00 = cw[0], w01 = cw[1], w10 = cw[1536], w11 = cw[1537], w20 = cw[3072], w21 = cw[3073], w30 = cw[4608], w31 = cw[4609];
        auto ldz = [&](int r) -> unsigned { return (r >= sbeg && r < send) ? *(const unsigned*)(Z + (size_t)r * ZW + c) : 0u; };
        unsigned zm2 = ldz(row0 + t0 - 2), zm1 = ldz(row0 + t0 - 1), z0 = ldz(row0 + t0);
#pragma unroll 4
        for (int tk = 0; tk < 32; ++tk) {
            const unsigned zp1 = ldz(row0 + t0 + tk + 1);
            float a0 = bf2f((bf16_t)(zm2 & 0xffff)) * w00 + bf2f((bf16_t)(zm1 & 0xffff)) * w10 + bf2f((bf16_t)(z0 & 0xffff)) * w20 + bf2f((bf16_t)(zp1 & 0xffff)) * w30;
            float a1 = bf2f((bf16_t)(zm2 >> 16)) * w01 + bf2f((bf16_t)(zm1 >> 16)) * w11 + bf2f((bf16_t)(z0 >> 16)) * w21 + bf2f((bf16_t)(zp1 >> 16)) * w31;
            zm2 = zm1; zm1 = z0; z0 = zp1;
            a0 = siluf_(a0); a1 = siluf_(a1);
            const int tok = t0 + tk;
            if (part < 2) {
                const float ss = wave_sum(a0 * a0 + a1 * a1);
                float sc = rsqrtf(ss + EPSF);
                if (part == 0) sc *= 0.08838834764831845f;
                a0 *= sc; a1 *= sc;
                const unsigned pk = pack2(a0, a1);
                *(unsigned*)((part == 0 ? Qs : Ks) + tok * QLD + lane * 2) = pk;
                *(unsigned*)((part == 0 ? QG : KG) + tok * 128 + lane * 2) = pk;
            } else {
                *(unsigned*)(VG + tok * 128 + lane * 2) = pack2(a0, a1);
            }
        }
    } else {
        const int d = wave - 6;
        const int row = row0 + lane;
        const float gv = GATES[(size_t)row * 16 + d * 8 + h], bv = GATES[(size_t)row * 16 + d * 8 + 4 + h];
        const float gdec = -__expf(p.in[I_ALOG][d * 4 + h]) * softplusf_(gv + p.in[I_DTB][d * 4 + h]);
        const float beta = sigmoidf_(bv);
        float gc = gdec;
#pragma unroll
        for (int dist = 1; dist < 64; dist <<= 1) {
            const int src = d == 0 ? lane - dist : lane + dist;
            const float o = __shfl(gc, src & 63, 64);
            if (d == 0 ? (lane >= dist) : (lane + dist < 64)) gc += o;
        }
        const float gl = __shfl(gc, d == 0 ? 63 : 0, 64);
        gcs[d * 64 + lane] = gc; bts[d * 64 + lane] = beta;
        const float egc = __expf(gc);
        VEC[d * 256 + 0 * 64 + lane] = beta * egc;
        VEC[d * 256 + 1 * 64 + lane] = egc;
        VEC[d * 256 + 2 * 64 + lane] = __expf(gl - gc);
        VEC[d * 256 + 3 * 64 + lane] = beta;
        if (lane == 0) EGL[d] = __expf(gl);
    }
    __syncthreads();
    {
        const int mi = wave >> 1, ni0 = (wave & 1) * 2;
        f32x4 kk_acc[2], qk_acc[2];
#pragma unroll
        for (int n = 0; n < 2; ++n) { kk_acc[n] = (f32x4){0.f, 0.f, 0.f, 0.f}; qk_acc[n] = (f32x4){0.f, 0.f, 0.f, 0.f}; }
#pragma unroll
        for (int kk = 0; kk < 4; ++kk) {
            const bf16x8 ak = *(const bf16x8*)(Ks + (mi * 16 + l15) * QLD + kk * 32 + lq * 8);
            const bf16x8 aq = *(const bf16x8*)(Qs + (mi * 16 + l15) * QLD + kk * 32 + lq * 8);
#pragma unroll
            for (int n = 0; n < 2; ++n) {
                const bf16x8 bk = *(const bf16x8*)(Ks + ((ni0 + n) * 16 + l15) * QLD + kk * 32 + lq * 8);
                kk_acc[n] = __builtin_amdgcn_mfma_f32_16x16x32_bf16(ak, bk, kk_acc[n], 0, 0, 0);
                qk_acc[n] = __builtin_amdgcn_mfma_f32_16x16x32_bf16(aq, bk, qk_acc[n], 0, 0, 0);
            }
        }
#pragma unroll
        for (int n = 0; n < 2; ++n)
#pragma unroll
            for (int j = 0; j < 4; ++j) {
                const int i = mi * 16 + lq * 4 + j, jc = (ni0 + n) * 16 + l15;
                {
                    const float e = (i >= jc) ? __expf(gcs[i] - gcs[jc]) : 0.f;
                    if (i > jc) Lm[i * LLD + jc] = bts[i] * kk_acc[n][j] * e;
                    ATT[i * 64 + jc] = f2bf(qk_acc[n][j] * e);
                }
                {
                    const float e = (i <= jc) ? __expf(gcs[64 + i] - gcs[64 + jc]) : 0.f;
                    if (i < jc) Lm[64 * LLD + (63 - i) * LLD + (63 - jc)] = bts[64 + i] * kk_acc[n][j] * e;
                    ATT[4096 + i * 64 + jc] = f2bf(qk_acc[n][j] * e);
                }
            }
    }
    __syncthreads();
    if (wave < 2) {
        const int d = wave;
        const float* Lr = Lm + d * 64 * LLD;
        float T[64];
#pragma unroll
        for (int i = 0; i < 64; ++i) {
            float a0 = (i == lane) ? 1.f : 0.f, a1 = 0.f, a2 = 0.f, a3 = 0.f;
#pragma unroll
            for (int j4 = 0; j4 + 4 <= i; j4 += 4) {
                const float4 l4 = *(const float4*)(Lr + i * LLD + j4);
                a0 -= l4.x * T[j4]; a1 -= l4.y * T[j4 + 1]; a2 -= l4.z * T[j4 + 2]; a3 -= l4.w * T[j4 + 3];
            }
#pragma unroll
            for (int j = (i & ~3); j < i; ++j) a0 -= Lr[i * LLD + j] * T[j];
            T[i] = (a0 + a1) + (a2 + a3);
        }
#pragma unroll
        for (int i = 0; i < 64; ++i) {
            const int ri = d == 0 ? i : 63 - i, rc = d == 0 ? lane : 63 - lane;
            TT[d * 4096 + ri * 64 + rc] = f2bf(T[i]);
        }
    } else {
        for (int q = tid - 128; q < 1024; q += 384) {
            const int dk = q & 127, tg = q >> 7;
            unsigned short e[8];
#pragma unroll
            for (int x = 0; x < 8; ++x) e[x] = Ks[(tg * 8 + x) * QLD + dk];
            uint4 w; w.x = e[0] | ((unsigned)e[1] << 16); w.y = e[2] | ((unsigned)e[3] << 16); w.z = e[4] | ((unsigned)e[5] << 16); w.w = e[6] | ((unsigned)e[7] << 16);
            *(uint4*)(KTG + dk * 64 + tg * 8) = w;
        }
    }
}

__device__ void ph_prep(const Params& p, char* smem) {
    for (int item = blockIdx.x; item < 288 + 1152; item += gridDim.x) {
        if (item < 288) lru_tile(p, item, smem);
        else delta_unit(p, item - 288, smem);
    }
}

__device__ void lru_carry(const Params& p, int li) {
    const int idx = li * NTHR + hide_tid();
    const int c = idx & 511, bd = idx >> 9, b = bd >> 1, d = bd & 1;
    const float* LTOT = (const float*)(p.ws + OFF_LTOT);
    float* CIN = (float*)(p.ws + OFF_CIN);
    float s = 0.f;
#pragma unroll 12
    for (int st = 0; st < 36; ++st) {
        int tl;
        if (st < 4) tl = 256 + b * 4 + (d ? 3 - st : st);
        else tl = b * 32 + (d ? 35 - st : st - 4);
        const float2 ah = *(const float2*)(LTOT + (((size_t)d * 288 + tl) * 512 + c) * 2);
        CIN[((size_t)d * 288 + tl) * 512 + c] = s;
        s = ah.x * s + ah.y;
    }
}
struct DFrags { bf16x8 k[4], q[4], t[2], a[2], kt[2]; unsigned v[4]; float4 rs1, rs2, rs3, bt; float egl; };
__device__ void delta_chain(const Params& p, int item, char* smem) {
    const int tid = hide_tid(), lane = tid & 63, wave = tid >> 6, l15 = lane & 15, lq = lane >> 4;
    const int chain = item >> 2, sl = item & 3;
    const int b = chain >> 3, h = (chain >> 1) & 3, dir = chain & 1;
    const int mi = wave >> 1, ni = wave & 1;
    const bf16_t* QG = (const bf16_t*)(p.ws + OFF_QG);
    const bf16_t* KG = (const bf16_t*)(p.ws + OFF_KG);
    const bf16_t* VG = (const bf16_t*)(p.ws + OFF_VG);
    const bf16_t* KTG = (const bf16_t*)(p.ws + OFF_KTG);
    const bf16_t* TT = (const bf16_t*)(p.ws + OFF_TT);
    const bf16_t* ATT = (const bf16_t*)(p.ws + OFF_ATT);
    const float* VEC = (const float*)(p.ws + OFF_VEC);
    const float* EGL = (const float*)(p.ws + OFF_EGL);
    bf16_t* OA = (bf16_t*)(p.ws + OFF_OA) + (size_t)dir * NT * 512;
    constexpr int SLD = 136, RLD = 72;
    bf16_t* ST = (bf16_t*)smem;
    bf16_t* RT = ST + 32 * SLD;
    bf16_t* VNT = RT + 32 * RLD;
    bf16_t* VST = VNT + 32 * RLD;
    __syncthreads();
    for (int i = tid; i < 32 * SLD / 2; i += NTHR) ((unsigned*)ST)[i] = 0u;
    auto unit_of = [&](int s) -> int { const int cidx = dir ? (s < 4 ? 3 - s : 39 - s) : s; return (b * 4 + h) * 36 + cidx; };
    auto load = [&](int s, DFrags& f) {
        const int u = unit_of(s);
        const bf16_t* kq = KG + (size_t)u * 8192 + (mi * 16 + l15) * 128 + lq * 8;
        const bf16_t* qq = QG + (size_t)u * 8192 + (mi * 16 + l15) * 128 + lq * 8;
#pragma unroll
        for (int kk = 0; kk < 4; ++kk) { f.k[kk] = *(const bf16x8*)(kq + kk * 32); f.q[kk] = *(const bf16x8*)(qq + kk * 32); }
        const bf16_t* tp = TT + ((size_t)u * 2 + dir) * 4096 + (mi * 16 + l15) * 64 + lq * 8;
        const bf16_t* ap = ATT + ((size_t)u * 2 + dir) * 4096 + (mi * 16 + l15) * 64 + lq * 8;
        const bf16_t* ktp = KTG + (size_t)u * 8192 + (wave * 16 + l15) * 64 + lq * 8;
#pragma unroll
        for (int kk = 0; kk < 2; ++kk) { f.t[kk] = *(const bf16x8*)(tp + kk * 32); f.a[kk] = *(const bf16x8*)(ap + kk * 32); f.kt[kk] = *(const bf16x8*)(ktp + kk * 32); }
        const bf16_t* vp = VG + (size_t)u * 8192 + (mi * 16 + lq * 4) * 128 + sl * 32 + ni * 16 + l15;
#pragma unroll
        for (int j = 0; j < 4; ++j) f.v[j] = vp[j * 128];
        const float* vec = VEC + ((size_t)u * 2 + dir) * 256 + mi * 16 + lq * 4;
        f.rs1 = *(const float4*)(vec); f.rs2 = *(const float4*)(vec + 64); f.rs3 = *(const float4*)(vec + 128); f.bt = *(const float4*)(vec + 192);
        f.egl = EGL[(size_t)u * 2 + dir];
    };
    f32x4 Sacc[2];
    Sacc[0] = (f32x4){0.f, 0.f, 0.f, 0.f}; Sacc[1] = (f32x4){0.f, 0.f, 0.f, 0.f};
    DFrags cur, nxt;
    load(0, cur);
    __syncthreads();
#pragma unroll 1
    for (int s = 0; s < 36; ++s) {
        if (s + 1 < 36) load(s + 1, nxt);
        f32x4 kS = (f32x4){0.f, 0.f, 0.f, 0.f}, qS = (f32x4){0.f, 0.f, 0.f, 0.f};
#pragma unroll
        for (int kk = 0; kk < 4; ++kk) {
            const bf16x8 sb = *(const bf16x8*)(ST + (ni * 16 + l15) * SLD + kk * 32 + lq * 8);
            kS = __builtin_amdgcn_mfma_f32_16x16x32_bf16(cur.k[kk], sb, kS, 0, 0, 0);
            qS = __builtin_amdgcn_mfma_f32_16x16x32_bf16(cur.q[kk], sb, qS, 0, 0, 0);
        }
        {
            const float r0 = cur.bt.x * bf2f((bf16_t)cur.v[0]) - cur.rs1.x * kS[0];
            const float r1 = cur.bt.y * bf2f((bf16_t)cur.v[1]) - cur.rs1.y * kS[1];
            const float r2 = cur.bt.z * bf2f((bf16_t)cur.v[2]) - cur.rs1.z * kS[2];
            const float r3 = cur.bt.w * bf2f((bf16_t)cur.v[3]) - cur.rs1.w * kS[3];
            uint2 w; w.x = pack2(r0, r1); w.y = pack2(r2, r3);
            *(uint2*)(RT + (ni * 16 + l15) * RLD + mi * 16 + lq * 4) = w;
        }
        __syncthreads();
        f32x4 vn = (f32x4){0.f, 0.f, 0.f, 0.f};
#pragma unroll
        for (int kk = 0; kk < 2; ++kk) {
            const bf16x8 rb = *(const bf16x8*)(RT + (ni * 16 + l15) * RLD + kk * 32 + lq * 8);
            vn = __builtin_amdgcn_mfma_f32_16x16x32_bf16(cur.t[kk], rb, vn, 0, 0, 0);
        }
        {
            uint2 w; w.x = pack2(vn[0], vn[1]); w.y = pack2(vn[2], vn[3]);
            *(uint2*)(VNT + (ni * 16 + l15) * RLD + mi * 16 + lq * 4) = w;
            uint2 w2; w2.x = pack2(vn[0] * cur.rs3.x, vn[1] * cur.rs3.y); w2.y = pack2(vn[2] * cur.rs3.z, vn[3] * cur.rs3.w);
            *(uint2*)(VST + (ni * 16 + l15) * RLD + mi * 16 + lq * 4) = w2;
        }
        __syncthreads();
        f32x4 o;
        o[0] = cur.rs2.x * qS[0]; o[1] = cur.rs2.y * qS[1]; o[2] = cur.rs2.z * qS[2]; o[3] = cur.rs2.w * qS[3];
#pragma unroll
        for (int kk = 0; kk < 2; ++kk) {
            const bf16x8 vb = *(const bf16x8*)(VNT + (ni * 16 + l15) * RLD + kk * 32 + lq * 8);
            o = __builtin_amdgcn_mfma_f32_16x16x32_bf16(cur.a[kk], vb, o, 0, 0, 0);
        }
        {
            const int u = unit_of(s);
            const int cidx = u % 36;
            const int rowb = unit_row0(b, cidx) + mi * 16 + lq * 4;
            bf16_t* op = OA + (size_t)rowb * 512 + h * 128 + sl * 32 + ni * 16 + l15;
#pragma unroll
            for (int j = 0; j < 4; ++j) op[(size_t)j * 512] = f2bf(o[j]);
        }
#pragma unroll
        for (int n2 = 0; n2 < 2; ++n2) {
            Sacc[n2] = Sacc[n2] * cur.egl;
#pragma unroll
            for (int kk = 0; kk < 2; ++kk) {
                const bf16x8 vb = *(const bf16x8*)(VST + (n2 * 16 + l15) * RLD + kk * 32 + lq * 8);
                Sacc[n2] = __builtin_amdgcn_mfma_f32_16x16x32_bf16(cur.kt[kk], vb, Sacc[n2], 0, 0, 0);
            }
            uint2 w; w.x = pack2(Sacc[n2][0], Sacc[n2][1]); w.y = pack2(Sacc[n2][2], Sacc[n2][3]);
            *(uint2*)(ST + (n2 * 16 + l15) * SLD + wave * 16 + lq * 4) = w;
        }
        __syncthreads();
        cur = nxt;
    }
}
__device__ void ph_scan(const Params& p, char* smem, int rep = 0) {
    for (int item = blockIdx.x; item < 16 + 256; item += gridDim.x) {
        if (item < 16) { if (!rep) lru_carry(p, item); }
        else delta_chain(p, item - 16, smem);
    }
}

__device__ void ph_merge(const Params& p, char* smem) {
    const int tid = hide_tid(), lane = tid & 63, wave = tid >> 6;
    const bf16_t* Z = (const bf16_t*)(p.ws + OFF_Z);
    const bf16_t* OA0 = (const bf16_t*)(p.ws + OFF_OA);
    const bf16_t* OA1 = OA0 + (size_t)NT * 512;
    const bf16_t* HL0 = (const bf16_t*)(p.ws + OFF_HLOC);
    const bf16_t* HL1 = HL0 + (size_t)NT * 512;
    const bf16_t* AC0 = (const bf16_t*)(p.ws + OFF_ACUM);
    const bf16_t* AC1 = AC0 + (size_t)NT * 512;
    const float* CIN = (const float*)(p.ws + OFF_CIN);
    bf16_t* M = (bf16_t*)(p.ws + OFF_H);
    const float* onorm = p.in[I_ONORM];
    for (int row = blockIdx.x * 8 + wave; row < NT; row += gridDim.x * 8) {
#pragma unroll
        for (int h = 0; h < 4; ++h) {
            const int c = h * 128 + lane * 2;
            const unsigned u0 = *(const unsigned*)(OA0 + (size_t)row * 512 + c);
            const unsigned u1 = *(const unsigned*)(OA1 + (size_t)row * 512 + c);
            const float o0 = bf2f((bf16_t)(u0 & 0xffff)) + bf2f((bf16_t)(u1 & 0xffff));
            const float o1 = bf2f((bf16_t)(u0 >> 16)) + bf2f((bf16_t)(u1 >> 16));
            const float ss = wave_sum(o0 * o0 + o1 * o1);
            const float rinv = rsqrtf(ss * (1.f / 128.f) + EPSF);
            const unsigned gz = *(const unsigned*)(Z + (size_t)row * ZW + 1536 + c);
            const float y0 = o0 * rinv * onorm[lane * 2] * siluf_(bf2f((bf16_t)(gz & 0xffff)));
            const float y1 = o1 * rinv * onorm[lane * 2 + 1] * siluf_(bf2f((bf16_t)(gz >> 16)));
            *(unsigned*)(M + (size_t)row * 1024 + c) = pack2(y0, y1);
        }
        const int tl = row < NL ? (row >> 6) : 256 + ((row - NL) >> 6);
#pragma unroll
        for (int i = 0; i < 4; ++i) {
            const int c = i * 128 + lane * 2;
            const unsigned h0 = *(const unsigned*)(HL0 + (size_t)row * 512 + c), h1 = *(const unsigned*)(HL1 + (size_t)row * 512 + c);
            const unsigned a0 = *(const unsigned*)(AC0 + (size_t)row * 512 + c), a1 = *(const unsigned*)(AC1 + (size_t)row * 512 + c);
            const float2 c0 = *(const float2*)(CIN + ((size_t)0 * 288 + tl) * 512 + c);
            const float2 c1 = *(const float2*)(CIN + ((size_t)1 * 288 + tl) * 512 + c);
            const float hx = (bf2f((bf16_t)(h0 & 0xffff)) + bf2f((bf16_t)(a0 & 0xffff)) * c0.x) + (bf2f((bf16_t)(h1 & 0xffff)) + bf2f((bf16_t)(a1 & 0xffff)) * c1.x);
            const float hy = (bf2f((bf16_t)(h0 >> 16)) + bf2f((bf16_t)(a0 >> 16)) * c0.y) + (bf2f((bf16_t)(h1 >> 16)) + bf2f((bf16_t)(a1 >> 16)) * c1.y);
            const unsigned yz = *(const unsigned*)(Z + (size_t)row * ZW + 2560 + c);
            const float y0 = hx * geluf_(bf2f((bf16_t)(yz & 0xffff)));
            const float y1 = hy * geluf_(bf2f((bf16_t)(yz >> 16)));
            *(unsigned*)(M + (size_t)row * 1024 + 512 + c) = pack2(y0, y1);
        }
    }
}

__device__ void ph_qkprep(const Params& p, char* smem) {
    const int tid = hide_tid(), lane = tid & 63, wave = tid >> 6;
    const bf16_t* ZQ = (const bf16_t*)(p.ws + OFF_ZQ);
    const bf16_t* ZC = (const bf16_t*)(p.ws + OFF_ZC);
    bf16_t* QA = (bf16_t*)(p.ws + OFF_QA);
    bf16_t* KA = (bf16_t*)(p.ws + OFF_KA);
    bf16_t* VT = (bf16_t*)(p.ws + OFF_VT);
    const float* qn = p.in[I_QNORM];
    const float* kn = p.in[I_KNORM];
    for (int row = blockIdx.x * 8 + wave; row < NT; row += gridDim.x * 8) {
        const bool lat = row < NL;
        const int b = lat ? (row >> 11) : ((row - NL) >> 8);
        const int t = lat ? (row & 2047) : ((row - NL) & 255);
        const int key = lat ? t : (SEQ + t);
        float cs = 1.f, sn = 0.f;
        if (lat) {
            const int f = lane & 31;
            const float pos = (lane < 32) ? (float)(t >> 6) : (float)(t & 63);
            const float inv = expf(-(float)f * (1.f / 32.f) * 9.210340371976184f);
            sincosf(pos * inv, &sn, &cs);
        }
        const bf16_t* src = lat ? ZQ + (size_t)row * 1536 : ZC + (size_t)(row - NL) * 512;
        const int koff = lat ? 1024 : 0;
        if (lat) {
#pragma unroll
            for (int h = 0; h < 8; ++h) {
                const unsigned u = *(const unsigned*)(src + h * 128 + lane * 2);
                float x1 = bf2f((bf16_t)(u & 0xffff)), x2 = bf2f((bf16_t)(u >> 16));
                const float ss = wave_sum(x1 * x1 + x2 * x2);
                const float rinv = rsqrtf(ss * (1.f / 128.f) + EPSF);
                x1 *= rinv * qn[lane * 2]; x2 *= rinv * qn[lane * 2 + 1];
                const float y1 = (x1 * cs - x2 * sn) * 0.08838834764831845f;
                const float y2 = (x1 * sn + x2 * cs) * 0.08838834764831845f;
                *(unsigned*)(QA + (size_t)row * 1024 + h * 128 + lane * 2) = pack2(y1, y2);
            }
        }
#pragma unroll
        for (int kh = 0; kh < 2; ++kh) {
            const unsigned u = *(const unsigned*)(src + koff + kh * 128 + lane * 2);
            float x1 = bf2f((bf16_t)(u & 0xffff)), x2 = bf2f((bf16_t)(u >> 16));
            const float ss = wave_sum(x1 * x1 + x2 * x2);
            const float rinv = rsqrtf(ss * (1.f / 128.f) + EPSF);
            x1 *= rinv * kn[lane * 2]; x2 *= rinv * kn[lane * 2 + 1];
            const float y1 = x1 * cs - x2 * sn;
            const float y2 = x1 * sn + x2 * cs;
            *(unsigned*)(KA + ((size_t)(b * 2 + kh) * TSEQ + key) * 128 + lane * 2) = pack2(y1, y2);
            const unsigned uv = *(const unsigned*)(src + koff + 256 + kh * 128 + lane * 2);
            bf16_t* vt = VT + ((size_t)(b * 2 + kh) * 128 + lane * 2) * TSEQ + key;
            vt[0] = (bf16_t)(uv & 0xffff);
            vt[TSEQ] = (bf16_t)(uv >> 16);
        }
    }
}

__device__ void ph_attn(const Params& p, char* smem) {
    const int tid = hide_tid(), lane = tid & 63, wave = tid >> 6;
    const int l15 = lane & 15, lq = lane >> 4;
    const bf16_t* QA = (const bf16_t*)(p.ws + OFF_QA);
    const bf16_t* KA = (const bf16_t*)(p.ws + OFF_KA);
    const bf16_t* VT = (const bf16_t*)(p.ws + OFF_VT);
    bf16_t* O = (bf16_t*)(p.ws + OFF_O);
    bf16_t* Ks = (bf16_t*)smem;
    bf16_t* Vts = Ks + 64 * 136;
    bf16_t* Ps = Vts + 128 * 72 + wave * 16 * 72;
    for (int item = blockIdx.x; item < 8 * 8 * 16; item += gridDim.x) {
        const int qb = item & 15, h = (item >> 4) & 7, b = item >> 7, kvh = h >> 2;
        const int q0 = qb * 128 + wave * 16;
        bf16x8 qf[4];
#pragma unroll
        for (int kk = 0; kk < 4; ++kk)
            qf[kk] = *(const bf16x8*)(QA + (size_t)(b * SEQ + q0 + l15) * 1024 + h * 128 + kk * 32 + lq * 8);
        float mrow[4], lrow[4];
        f32x4 o[8];
#pragma unroll
        for (int j = 0; j < 4; ++j) { mrow[j] = -1.0e30f; lrow[j] = 0.f; }
#pragma unroll
        for (int nd = 0; nd < 8; ++nd) o[nd] = (f32x4){0.f, 0.f, 0.f, 0.f};
        const bf16_t* Kb = KA + (size_t)(b * 2 + kvh) * TSEQ * 128;
        const bf16_t* Vb = VT + (size_t)(b * 2 + kvh) * 128 * TSEQ;
        for (int kt = 0; kt < TSEQ / 64; ++kt) {
            const int key0 = kt * 64;
            __syncthreads();
#pragma unroll
            for (int r = 0; r < 2; ++r) {
                const int cI = tid + r * NTHR;
                { const int kr = cI >> 4, dc = (cI & 15) * 8;
                  *(uint4*)(Ks + kr * 136 + dc) = *(const uint4*)(Kb + (size_t)(key0 + kr) * 128 + dc); }
                { const int d = cI >> 3, kc = (cI & 7) * 8;
                  *(uint4*)(Vts + d * 72 + kc) = *(const uint4*)(Vb + (size_t)d * TSEQ + key0 + kc); }
            }
            __syncthreads();
            f32x4 s[4];
#pragma unroll
            for (int n = 0; n < 4; ++n) {
                s[n] = (f32x4){0.f, 0.f, 0.f, 0.f};
#pragma unroll
                for (int kk = 0; kk < 4; ++kk) {
                    const bf16x8 kf = *(const bf16x8*)(Ks + (n * 16 + l15) * 136 + kk * 32 + lq * 8);
                    s[n] = __builtin_amdgcn_mfma_f32_16x16x32_bf16(qf[kk], kf, s[n], 0, 0, 0);
                }
            }
#pragma unroll
            for (int j = 0; j < 4; ++j) {
                float mx = fmaxf(fmaxf(s[0][j], s[1][j]), fmaxf(s[2][j], s[3][j]));
                mx = fmaxf(mx, __shfl_xor(mx, 1, 64)); mx = fmaxf(mx, __shfl_xor(mx, 2, 64));
                mx = fmaxf(mx, __shfl_xor(mx, 4, 64)); mx = fmaxf(mx, __shfl_xor(mx, 8, 64));
                const float mn = fmaxf(mrow[j], mx);
                const float alpha = __expf(mrow[j] - mn);
                mrow[j] = mn;
                float ps = 0.f;
#pragma unroll
                for (int n = 0; n < 4; ++n) {
                    const float pv = __expf(s[n][j] - mn);
                    ps += pv;
                    Ps[(lq * 4 + j) * 72 + n * 16 + l15] = f2bf(pv);
                }
                lrow[j] = lrow[j] * alpha + ps;
#pragma unroll
                for (int nd = 0; nd < 8; ++nd) o[nd][j] *= alpha;
            }
            __syncthreads();
#pragma unroll
            for (int kk = 0; kk < 2; ++kk) {
                const bf16x8 pf = *(const bf16x8*)(Ps + l15 * 72 + kk * 32 + lq * 8);
#pragma unroll
                for (int nd = 0; nd < 8; ++nd) {
                    const bf16x8 vf = *(const bf16x8*)(Vts + (nd * 16 + l15) * 72 + kk * 32 + lq * 8);
                    o[nd] = __builtin_amdgcn_mfma_f32_16x16x32_bf16(pf, vf, o[nd], 0, 0, 0);
                }
            }
        }
#pragma unroll
        for (int j = 0; j < 4; ++j) {
            float l = lrow[j];
            l += __shfl_xor(l, 1, 64); l += __shfl_xor(l, 2, 64); l += __shfl_xor(l, 4, 64); l += __shfl_xor(l, 8, 64);
            const float inv = 1.f / l;
            const size_t orow = (size_t)(b * SEQ + q0 + lq * 4 + j) * 1024 + h * 128;
#pragma unroll
            for (int nd = 0; nd < 8; ++nd) O[orow + nd * 16 + l15] = f2bf(o[nd][j] * inv);
        }
    }
}

#define N_PHASES 19
template <int PH>
__device__ __forceinline__ void run_phase(const Params& p, LAS unsigned char* lds, int rep = 0) {
    char* smem = (char*)lds;
    if (PH == 0) { ph_ada(p, smem); cvt_dense(p, smem); }
    else if (PH == 1) ph_rows<0>(p, smem);
    else if (PH == 2) ph_gemm_in(p, lds);
    else if (PH == 3) ph_prep(p, smem);
    else if (PH == 4) ph_scan(p, smem, rep);
    else if (PH == 5) ph_merge(p, smem);
    else if (PH == 6) { ph_gemm_out<0>(p, lds); cvt_moe(p, 0, smem); }
    else if (PH == 7) ph_rows<1>(p, smem);
    else if (PH == 8) ph_moe_up(p, 0, lds);
    else if (PH == 9) ph_moe_down(p, 0, lds);
    else if (PH == 10) ph_rows<2>(p, smem);
    else if (PH == 11) ph_gemm_qkv(p, lds);
    else if (PH == 12) { ph_qkprep(p, smem); cvt_moe(p, 1, smem); }
    else if (PH == 13) ph_attn(p, smem);
    else if (PH == 14) ph_gemm_out<1>(p, lds);
    else if (PH == 15) ph_rows<3>(p, smem);
    else if (PH == 16) ph_moe_up(p, 1, lds);
    else if (PH == 17) ph_moe_down(p, 1, lds);
    else if (PH == 18) ph_rows<4>(p, smem);
}

extern __shared__ __attribute__((aligned(16))) unsigned char dyn_lds[];
template <int PH>
__global__ void __launch_bounds__(NTHR, 2) k_phase(Params p) {
    run_phase<PH>(p, (LAS unsigned char*)dyn_lds);
}

#if ONE_LAUNCH
template <int PH>
__device__ __forceinline__ void run_all(const Params& p, LAS unsigned char* lds, const XcdBarrier& bar) {
    if (PH == REP_PH) {
        int nrep = 2; asm volatile("" : "+s"(nrep));
#pragma unroll 1
        for (int r = 0; r < nrep; ++r) { run_phase<PH>(p, lds, r); if (r + 1 < nrep) xcd_barrier(bar); }
    } else run_phase<PH>(p, lds);
    if (PH + 1 < N_PHASES) {
        xcd_barrier(bar);
        run_all<(PH + 1 < N_PHASES) ? PH + 1 : PH>(p, lds, bar);
    }
}
template <>
__device__ __forceinline__ void run_all<N_PHASES - 1>(const Params& p, LAS unsigned char* lds, const XcdBarrier& bar) {
    run_phase<N_PHASES - 1>(p, lds);
}

__global__ void __launch_bounds__(NTHR, 2) k_mega(Params p) {
    LAS unsigned char* lds = (LAS unsigned char*)dyn_lds;
    if (threadIdx.x < 4) ((LAS unsigned*)(lds + LDS_XB))[threadIdx.x] = 0u;
    __syncthreads();
    XcdBarrier bar = xcd_barrier_post((unsigned*)(p.ws + OFF_ZERO), (volatile LAS unsigned*)(lds + LDS_XB));
    run_all<0>(p, lds, bar);
}
#endif

template <int PH>
static void launch_phases(const Params& p, hipStream_t stream) {
    static bool attr_set = false;
    if (!attr_set) { (void)hipFuncSetAttribute((const void*)k_phase<PH>, hipFuncAttributeMaxDynamicSharedMemorySize, DYN_LDS); attr_set = true; }
    hipLaunchKernelGGL(k_phase<PH>, dim3(256), dim3(NTHR), DYN_LDS, stream, p);
    if constexpr (PH + 1 < N_PHASES) launch_phases<PH + 1>(p, stream);
}

extern "C" void kernel_launch(void* const* d_in, const int* in_sizes, int n_in, void* d_out, int out_size, void* d_ws,
                              size_t ws_size, hipStream_t stream) {
    Params p{};
    for (int i = 0; i < 32; ++i) p.in[i] = (const float*)d_in[i];
    p.out = (float*)d_out;
    p.ws = (char*)d_ws;
    (void)hipMemsetAsync(d_ws, 0, ZERO_BYTES, stream);
#if ONE_LAUNCH
    static int grid = 0;
    if (!grid) {
        int dev = 0, cus = 0, per_cu = 0;
        (void)hipGetDevice(&dev);
        (void)hipDeviceGetAttribute(&cus, hipDeviceAttributeMultiprocessorCount, dev);
        (void)hipFuncSetAttribute((const void*)k_mega, hipFuncAttributeMaxDynamicSharedMemorySize, DYN_LDS);
        (void)hipOccupancyMaxActiveBlocksPerMultiprocessor(&per_cu, k_mega, NTHR, DYN_LDS);
        if (cus <= 0) cus = 256;
        grid = cus * (per_cu < 1 ? per_cu : 1);
        if (grid <= 0) grid = cus;
    }
    hipLaunchKernelGGL(k_mega, dim3(grid), dim3(NTHR), DYN_LDS, stream, p);
#else
    launch_phases<0>(p, stream);
#endif
}
```

```cpp
#include <hip/hip_runtime.h>
#include <stdint.h>

#ifndef ONE_LAUNCH
#define ONE_LAUNCH 1
#endif
#ifndef REP_SUB
#define REP_SUB 0
#endif
#ifndef REP_PH
#define REP_PH -1
#endif

typedef unsigned short bf16_t;
typedef __attribute__((ext_vector_type(8))) short bf16x8;
typedef __attribute__((ext_vector_type(4))) float f32x4;

#define D_MODEL 1024
#define BATCH 8
#define SEQ 2048
#define CTXL 256
#define NL (BATCH * SEQ)
#define NC (BATCH * CTXL)
#define NT (NL + NC)
#define AB_PROJ 3088
#define TSEQ (SEQ + CTXL)
#define EPSF 1e-6f
#define NTHR 512

enum { I_X = 0, I_C, I_CTX, I_CCTX, I_ADAW, I_ADAB, I_NORM1, I_NORM2, I_FNORM, I_ABWIN, I_CONVQKV, I_ALOG, I_DTB,
       I_ONORM, I_CONVX, I_RGWR, I_RGBR, I_RGWI, I_RGBI, I_RGLAM, I_ABWOUT, I_ATWQKV, I_QNORM, I_KNORM, I_ATWOUT,
       I_WGRP, I_BGRP, I_WEXP, I_BEXP, I_WGATE, I_WUP, I_WDOWN };

#define AL256(x) (((size_t)(x) + 255) & ~(size_t)255)
#define ZW 3072
#define OFF_ZERO 0
#define ZERO_BYTES 65536
#define OFF_CNT 16384
#define OFF_MOD (OFF_ZERO + ZERO_BYTES)
#define OFF_X AL256(OFF_MOD + 2 * 9 * 6144 * 4)
#define OFF_H AL256(OFF_X + (size_t)NT * 1024 * 4)
#define OFF_Z AL256(OFF_H + (size_t)NT * 1024 * 2)
#define OFF_BTIN AL256(OFF_Z + (size_t)NT * ZW * 2)
#define OFF_BTOUT0 AL256(OFF_BTIN + (size_t)3072 * 1024 * 2)
#define OFF_BTQKV AL256(OFF_BTOUT0 + (size_t)1024 * 1024 * 2)
#define OFF_BTOUT1 AL256(OFF_BTQKV + (size_t)1536 * 1024 * 2)
#define OFF_WRG AL256(OFF_BTOUT1 + (size_t)1024 * 1024 * 2)
#define OFF_WSEL AL256(OFF_WRG + (size_t)8 * 256 * 64 * 2)
#define OFF_LIST AL256(OFF_WSEL + (size_t)2 * NT * 4)
#define OFF_R1 AL256(OFF_LIST + (size_t)32 * NT * 4)
#define OFF_GATES OFF_R1
#define OFF_QG AL256(OFF_GATES + (size_t)NT * 16 * 4)
#define OFF_KG AL256(OFF_QG + (size_t)1152 * 8192 * 2)
#define OFF_VG AL256(OFF_KG + (size_t)1152 * 8192 * 2)
#define OFF_KTG AL256(OFF_VG + (size_t)1152 * 8192 * 2)
#define OFF_TT AL256(OFF_KTG + (size_t)1152 * 8192 * 2)
#define OFF_ATT AL256(OFF_TT + (size_t)1152 * 2 * 4096 * 2)
#define OFF_VEC AL256(OFF_ATT + (size_t)1152 * 2 * 4096 * 2)
#define OFF_EGL AL256(OFF_VEC + (size_t)1152 * 2 * 256 * 4)
#define OFF_HLOC AL256(OFF_EGL + (size_t)1152 * 2 * 4)
#define OFF_ACUM AL256(OFF_HLOC + (size_t)2 * NT * 512 * 2)
#define OFF_LTOT AL256(OFF_ACUM + (size_t)2 * NT * 512 * 2)
#define OFF_CIN AL256(OFF_LTOT + (size_t)2 * 288 * 512 * 2 * 4)
#define OFF_OA AL256(OFF_CIN + (size_t)2 * 288 * 512 * 4)
#define OFF_END AL256(OFF_OA + (size_t)2 * NT * 512 * 2)
#define OFF_BTGU OFF_R1
#define OFF_BTD AL256(OFF_BTGU + (size_t)32 * 1024 * 1024 * 2)
#define OFF_ACT AL256(OFF_BTD + (size_t)32 * 1024 * 512 * 2)
#define OFF_YE AL256(OFF_ACT + (size_t)2 * NT * 512 * 2)
#define OFF_ZQ OFF_Z
#define OFF_ZC (OFF_Z + (size_t)NL * 1536 * 2)
#define OFF_QA (OFF_ZC + (size_t)NC * 512 * 2)
#define OFF_KA (OFF_QA + (size_t)NL * 1024 * 2)
#define OFF_VT (OFF_KA + (size_t)8 * 2 * TSEQ * 128 * 2)
#define OFF_O OFF_H
static_assert(OFF_YE + (size_t)2 * NT * 1024 * 2 <= OFF_END, "MoE scratch must fit in R1");
static_assert(OFF_VT + (size_t)8 * 2 * TSEQ * 128 * 2 <= OFF_BTIN, "attention buffers must fit in the Z region");
static_assert(OFF_END < (size_t)530 * 1024 * 1024, "workspace budget");

#define DYN_LDS (131072 + 1024)
#define LDS_XB 131072
#define LDS_PRE (131072 + 64)

struct Params {
    const float* in[32];
    float* out;
    char* ws;
};

__device__ __forceinline__ bf16_t f2bf(float f) {
    unsigned u = __float_as_uint(f);
    u += 0x7fffu + ((u >> 16) & 1u);
    return (bf16_t)(u >> 16);
}
__device__ __forceinline__ float bf2f(bf16_t h) { return __uint_as_float(((unsigned)h) << 16); }
__device__ __forceinline__ unsigned pack2(float a, float b) { return (unsigned)f2bf(a) | ((unsigned)f2bf(b) << 16); }
__device__ __forceinline__ float frcp_(float x) { return __builtin_amdgcn_rcpf(x); }
__device__ __forceinline__ float sigmoidf_(float x) { return frcp_(1.f + __expf(-x)); }
__device__ __forceinline__ float siluf_(float x) { return x * frcp_(1.f + __expf(-x)); }
__device__ __forceinline__ float softplusf_(float x) { return x > 20.f ? x : log1pf(__expf(x)); }
__device__ __forceinline__ float geluf_(float x) {
    const float u = 0.7978845608028654f * (x + 0.044715f * x * x * x);
    return x * frcp_(1.f + __expf(-2.f * u));
}
__device__ __forceinline__ float neg_expm1_small(float x) {
    float q = 1.f / 5040.f;
    q = q * x + 1.f / 720.f; q = q * x + 1.f / 120.f; q = q * x + 1.f / 24.f; q = q * x + 1.f / 6.f; q = q * x + 0.5f; q = q * x + 1.f;
    return x < -0.5f ? 1.f - __expf(x) : -x * q;
}
#define DPP_F(v, ctrl) __int_as_float(__builtin_amdgcn_update_dpp(0, __float_as_int(v), ctrl, 0xF, 0xF, true))
__device__ __forceinline__ float row16_sum(float v) {
    v += DPP_F(v, 0xB1);
    v += DPP_F(v, 0x4E);
    v += DPP_F(v, 0x141);
    v += DPP_F(v, 0x140);
    return v;
}
__device__ __forceinline__ float row16_max(float v) {
    v = fmaxf(v, DPP_F(v, 0xB1)); v = fmaxf(v, DPP_F(v, 0x4E)); v = fmaxf(v, DPP_F(v, 0x141)); v = fmaxf(v, DPP_F(v, 0x140));
    return v;
}
__device__ __forceinline__ float wave_sum(float v) {
    v = row16_sum(v);
    const float a = __int_as_float(__builtin_amdgcn_readlane(__float_as_int(v), 0));
    const float b = __int_as_float(__builtin_amdgcn_readlane(__float_as_int(v), 16));
    const float c = __int_as_float(__builtin_amdgcn_readlane(__float_as_int(v), 32));
    const float d = __int_as_float(__builtin_amdgcn_readlane(__float_as_int(v), 48));
    return (a + b) + (c + d);
}
__device__ __forceinline__ int hide_tid() { int t = threadIdx.x; asm volatile("" : "+v"(t)); return t & 511; }
__device__ __forceinline__ int scan_row(int s, int dir, int b) {
    if (s < CTXL) { const int t = dir ? (CTXL - 1 - s) : s; return NL + b * CTXL + t; }
    const int u = s - CTXL; const int t = dir ? (SEQ - 1 - u) : u; return b * SEQ + t;
}

#define XB_TMO      128
#define XB_XCNT(j)  (256  + 64 * (j))
#define XB_XSUB(j)  (1280 + 64 * (j))
#define XB_XGEN(j)  (2304 + 64 * (j))
#define XB_TOP      3328
#define XB_TOPGEN   3392
#define XCD_BAR_WORDS 3456
#define XB_SPIN_CAP (1u << 22)
#define LAS __attribute__((address_space(3)))

__device__ __forceinline__ unsigned xb_ld(unsigned* p)              { return __hip_atomic_load(p, __ATOMIC_RELAXED, __HIP_MEMORY_SCOPE_AGENT); }
__device__ __forceinline__ unsigned xb_add(unsigned* p, unsigned v) { return __hip_atomic_fetch_add(p, v, __ATOMIC_RELAXED, __HIP_MEMORY_SCOPE_AGENT); }
__device__ __forceinline__ unsigned xb_xcc_id() { return (unsigned)__builtin_amdgcn_s_getreg((3 << 11) | 20) & 0xFu; }
#define XB_SPIN(cond, bar) do { unsigned _sp = 0; while (cond) { __builtin_amdgcn_s_sleep(1); \
    if ((++_sp & 255u) == 0u) { if (xb_ld(&(bar)[XB_TMO])) break; if (_sp > XB_SPIN_CAP) { atomicAdd(&(bar)[XB_TMO], 1u); break; } } } } while (0)

struct XcdBarrier {
    unsigned* bar; unsigned x;
    volatile LAS unsigned* st;
};
__device__ __forceinline__ XcdBarrier xcd_barrier_post(unsigned* bar, volatile LAS unsigned* st) {
    XcdBarrier b; b.bar = bar; b.x = xb_xcc_id(); b.st = st;
    if (threadIdx.x == 0) (void)xb_add(&bar[XB_XCNT(b.x)], 1u);
    return b;
}
__device__ __forceinline__ void xcd_barrier_complete(unsigned* bar, unsigned x, unsigned& nloc, unsigned& nx) {
    const unsigned G = gridDim.x * gridDim.y * gridDim.z;
    unsigned sum, cnt, mine, sp = 0u;
    for (;;) {
        sum = 0u; cnt = 0u; mine = 0u;
#pragma unroll
        for (unsigned j = 0; j < 16; ++j) { const unsigned c = xb_ld(&bar[XB_XCNT(j)]); sum += c; cnt += (c > 0u) ? 1u : 0u; mine = (j == x) ? c : mine; }
        if (sum == G) break;
        __builtin_amdgcn_s_sleep(1);
        if ((++sp & 255u) == 0u) { if (xb_ld(&bar[XB_TMO])) break; if (sp > XB_SPIN_CAP) { atomicAdd(&bar[XB_TMO], 1u); break; } }
    }
    nloc = mine > 0u ? mine : 1u; nx = cnt > 0u ? cnt : 1u;
}
__device__ __forceinline__ void xcd_barrier(const XcdBarrier& b) {
    asm volatile("s_waitcnt vmcnt(0)" ::: "memory");
    __syncthreads();
    if (threadIdx.x == 0) {
        unsigned* bar = b.bar;
        __builtin_amdgcn_s_waitcnt(0);
        unsigned nloc = b.st[0], nx = b.st[1];
        if (nloc == 0u) { xcd_barrier_complete(bar, b.x, nloc, nx); b.st[0] = nloc; b.st[1] = nx; }
        const unsigned old = xb_add(&bar[XB_XSUB(b.x)], 1u);
        const unsigned gen = old / nloc;
        if (old + 1u == (gen + 1u) * nloc) {
            __builtin_amdgcn_fence(__ATOMIC_RELEASE, "agent");
            asm volatile("s_waitcnt vmcnt(0)" ::: "memory");
            const unsigned og = xb_add(&bar[XB_TOP], 1u);
            const unsigned tg = og / nx;
            if (og + 1u == (tg + 1u) * nx) xb_add(&bar[XB_TOPGEN], 1u);
            else XB_SPIN(xb_ld(&bar[XB_TOPGEN]) == tg, bar);
            __builtin_amdgcn_fence(__ATOMIC_ACQUIRE, "agent");
            xb_add(&bar[XB_XGEN(b.x)], 1u);
            asm volatile("s_waitcnt vmcnt(0)" ::: "memory");
        } else {
            XB_SPIN(xb_ld(&bar[XB_XGEN(b.x)]) == gen, bar);
            __builtin_amdgcn_fence(__ATOMIC_ACQUIRE, "agent");
            asm volatile("s_waitcnt vmcnt(0)" ::: "memory");
        }
    }
    __syncthreads();
}

template <int NB, class RowPtr, class Epi>
__device__ __forceinline__ void gemm_tile(RowPtr rowptr, const float* __restrict__ B0, const float* __restrict__ B1,
                                          int ldb, int K, int n0, int N, Epi epi, char* smem) {
    constexpr int LDS_LD = 72;
    bf16_t* As = (bf16_t*)smem;
    bf16_t* Bs0 = As + 128 * LDS_LD;
    bf16_t* Bs1 = Bs0 + 128 * LDS_LD;
    const int tid = hide_tid(), lane = tid & 63, wave = tid >> 6;
    const int wm = wave >> 1, wn = wave & 1;
    const int l15 = lane & 15, lq = lane >> 4;

    const bf16_t* arow0 = rowptr(tid >> 3);
    const bf16_t* arow1 = rowptr((tid >> 3) + 64);
    const int akc = (tid & 7) * 8;
    const int bn = tid & 127, bkg = tid >> 7;
    const bool bok = (n0 + bn) < N;
    const float* b0p = B0 + (size_t)(bkg * 8) * ldb + n0 + bn;
    const float* b1p = (NB == 2) ? (B1 + (size_t)(bkg * 8) * ldb + n0 + bn) : nullptr;

    f32x4 acc0[2][4], acc1[2][4];
#pragma unroll
    for (int i = 0; i < 2; ++i)
#pragma unroll
        for (int j = 0; j < 4; ++j) { acc0[i][j] = (f32x4){0.f, 0.f, 0.f, 0.f}; acc1[i][j] = (f32x4){0.f, 0.f, 0.f, 0.f}; }

    uint4 ra0, ra1;
    float rb0[16], rb1[16];
    const int nk = K >> 6;
    auto load_regs = [&](int kt) {
        const int k0 = kt * 64;
        ra0 = arow0 ? *(const uint4*)(arow0 + k0 + akc) : make_uint4(0, 0, 0, 0);
        ra1 = arow1 ? *(const uint4*)(arow1 + k0 + akc) : make_uint4(0, 0, 0, 0);
#pragma unroll
        for (int r = 0; r < 2; ++r)
#pragma unroll
            for (int j = 0; j < 8; ++j) {
                const size_t o = (size_t)(k0 + r * 32 + j) * ldb;
                rb0[r * 8 + j] = bok ? b0p[o] : 0.f;
                if (NB == 2) rb1[r * 8 + j] = bok ? b1p[o] : 0.f;
            }
    };
    load_regs(0);
    for (int kt = 0; kt < nk; ++kt) {
        __syncthreads();
        *(uint4*)(As + (tid >> 3) * LDS_LD + akc) = ra0;
        *(uint4*)(As + ((tid >> 3) + 64) * LDS_LD + akc) = ra1;
#pragma unroll
        for (int r = 0; r < 2; ++r) {
            uint4 w;
            w.x = pack2(rb0[r * 8 + 0], rb0[r * 8 + 1]); w.y = pack2(rb0[r * 8 + 2], rb0[r * 8 + 3]);
            w.z = pack2(rb0[r * 8 + 4], rb0[r * 8 + 5]); w.w = pack2(rb0[r * 8 + 6], rb0[r * 8 + 7]);
            *(uint4*)(Bs0 + bn * LDS_LD + bkg * 8 + r * 32) = w;
            if (NB == 2) {
                w.x = pack2(rb1[r * 8 + 0], rb1[r * 8 + 1]); w.y = pack2(rb1[r * 8 + 2], rb1[r * 8 + 3]);
                w.z = pack2(rb1[r * 8 + 4], rb1[r * 8 + 5]); w.w = pack2(rb1[r * 8 + 6], rb1[r * 8 + 7]);
                *(uint4*)(Bs1 + bn * LDS_LD + bkg * 8 + r * 32) = w;
            }
        }
        __syncthreads();
        if (kt + 1 < nk) load_regs(kt + 1);
#pragma unroll
        for (int kk = 0; kk < 2; ++kk) {
            bf16x8 af[2];
#pragma unroll
            for (int mi = 0; mi < 2; ++mi)
                af[mi] = *(const bf16x8*)(As + (wm * 32 + mi * 16 + l15) * LDS_LD + kk * 32 + lq * 8);
#pragma unroll
            for (int ni = 0; ni < 4; ++ni) {
                const bf16x8 bf0 = *(const bf16x8*)(Bs0 + (wn * 64 + ni * 16 + l15) * LDS_LD + kk * 32 + lq * 8);
#pragma unroll
                for (int mi = 0; mi < 2; ++mi) acc0[mi][ni] = __builtin_amdgcn_mfma_f32_16x16x32_bf16(af[mi], bf0, acc0[mi][ni], 0, 0, 0);
                if (NB == 2) {
                    const bf16x8 bf1 = *(const bf16x8*)(Bs1 + (wn * 64 + ni * 16 + l15) * LDS_LD + kk * 32 + lq * 8);
#pragma unroll
                    for (int mi = 0; mi < 2; ++mi) acc1[mi][ni] = __builtin_amdgcn_mfma_f32_16x16x32_bf16(af[mi], bf1, acc1[mi][ni], 0, 0, 0);
                }
            }
        }
    }
#pragma unroll
    for (int mi = 0; mi < 2; ++mi)
#pragma unroll
        for (int ni = 0; ni < 4; ++ni) {
            const int n = n0 + wn * 64 + ni * 16 + l15;
            if (n < N) {
#pragma unroll
                for (int j = 0; j < 4; ++j) epi(wm * 32 + mi * 16 + lq * 4 + j, n, acc0[mi][ni][j], acc1[mi][ni][j]);
            }
        }
}

namespace g8 {
constexpr int BM = 256, BK = 64, HALF = 128, HTB = HALF * BK * 2, STAGE_BYTES = 8 * HTB, NXCD = 8, WGM = 8;
typedef unsigned u32x4 __attribute__((ext_vector_type(4)));
__device__ __forceinline__ int lds_byte(int r, int c) { const int st = (r >> 4) * 2 + (c >> 5), rr = r & 15, cc = c & 31, ob = rr * 64 + cc * 2; return st * 1024 + (ob ^ (((ob >> 9) & 1) << 5)); }
__device__ __forceinline__ void stage_rc(int b, int& R, int& C) { const int st = b / 1024, sb = b % 1024, swz = sb ^ (((sb >> 9) & 1) << 5); R = (st >> 1) * 16 + swz / 64; C = (st & 1) * 32 + (swz % 64) / 2; }
__device__ __forceinline__ int perm32(int rho) { const int n = rho >> 4, i = rho & 15; return 8 * (i >> 2) + 4 * n + (i & 3); }
__device__ __forceinline__ unsigned cvt_pk_bf16(float lo, float hi) { unsigned r; asm volatile("v_cvt_pk_bf16_f32 %0, %1, %2" : "=v"(r) : "v"(lo), "v"(hi)); return r; }

struct Unit {
    const char* A;
    const char* Bt;
    const int* lst;
    int mv;
    int pm, pn;
    int aux;
};

__device__ __forceinline__ void static_order(int wgid, int nM, int nN, int& pm, int& pn) {
    const int nwg = nM * nN;
    { const int q = nwg / NXCD, r = nwg % NXCD, xcd = wgid % NXCD, off = wgid / NXCD; wgid = (xcd < r ? xcd * (q + 1) : r * (q + 1) + (xcd - r) * q) + off; }
    const int nig = WGM * nN, gid = wgid / nig, fm = gid * WGM, gsz = (nM - fm) < WGM ? (nM - fm) : WGM;
    pm = fm + ((wgid % nig) % gsz); pn = (wgid % nig) / gsz;
}

template <bool GATHER, int GSHIFT, class Epi, class Sched>
__device__ __forceinline__ void gemm_phase(LAS unsigned char* lds, const int K, const Sched& S, const Epi& E) {
    const int tid = hide_tid(), wid = __builtin_amdgcn_readfirstlane(tid >> 6), lane = tid & 63, wr = wid >> 2, wc = wid & 3, fr = lane & 15, fq = lane >> 4;
    const int nt = K / BK;
    unsigned voffA[2], voffB[2];
#pragma unroll
    for (int i = 0; i < 2; ++i) { int R, C; stage_rc(tid * 16 + i * 8192, R, C); const int Rb = Epi::PERM ? ((R & ~31) + perm32(R & 31)) : R;
        voffA[i] = (unsigned)(R * K + C) * 2u; voffB[i] = (unsigned)(Rb * K + C) * 2u; }
    const size_t kstep = (size_t)(BK * 2);
    const size_t hstep = (size_t)HALF * K * 2;
    const unsigned ldsw = (unsigned)wid * 1024u;
    const int aoff = lds_byte(wr * 64 + fr, fq * 8), boff = lds_byte(wc * 32 + fr, fq * 8);
    unsigned gcur[2][2];
    auto gather_offs = [&](const Unit& u, unsigned (&g)[2][2]) {
#pragma unroll
        for (int h = 0; h < 2; ++h)
#pragma unroll
            for (int i = 0; i < 2; ++i) { int R, C; stage_rc(tid * 16 + i * 8192, R, C); int idx = h * 128 + R; idx = idx < u.mv ? idx : u.mv - 1;
                g[h][i] = (unsigned)(u.lst[idx] >> GSHIFT) * (unsigned)(K * 2) + (unsigned)(C * 2); }
    };
#define G8_SA(b, h) (((b) * 2 + (h)) * HTB)
#define G8_SB(b, h) ((4 + (b) * 2 + (h)) * HTB)
#define G8_STAGE(bufoff, gbase, voff) do { _Pragma("unroll") for (int _i = 0; _i < 2; ++_i) \
        __builtin_amdgcn_global_load_lds((const unsigned*)((const char*)(gbase) + (voff)[_i]), (LAS unsigned*)(lds + (bufoff) + ldsw + _i * 8192), 16, 0, 0); } while (0)
#define G8_LDA(dst, b, h) do { _Pragma("unroll") for (int m = 0; m < 4; ++m) _Pragma("unroll") for (int k = 0; k < 2; ++k) dst[m][k] = *(const LAS bf16x8*)(lds + G8_SA(b, h) + aoff + m * 2048 + k * 1024); } while (0)
#define G8_LDB(dst, b, h) do { _Pragma("unroll") for (int n = 0; n < 2; ++n) _Pragma("unroll") for (int k = 0; k < 2; ++k) dst[n][k] = *(const LAS bf16x8*)(lds + G8_SB(b, h) + boff + n * 2048 + k * 1024); } while (0)
#define G8_MMA(ai, bj, At, Bt) do { __builtin_amdgcn_s_setprio(1); _Pragma("unroll") for (int m = 0; m < 4; ++m) _Pragma("unroll") for (int n = 0; n < 2; ++n) _Pragma("unroll") for (int k = 0; k < 2; ++k) \
        acc[ai][bj][m][n] = __builtin_amdgcn_mfma_f32_16x16x32_bf16(Bt[n][k], At[m][k], acc[ai][bj][m][n], 0, 0, 0); __builtin_amdgcn_s_setprio(0); } while (0)
#define G8_WAIT_V(n) asm volatile("s_waitcnt vmcnt(" #n ")" ::: "memory")
#define G8_WAIT_L(n) asm volatile("s_waitcnt lgkmcnt(" #n ")" ::: "memory")
#define G8_BAR __builtin_amdgcn_s_barrier()
#define G8_SCHED __builtin_amdgcn_sched_barrier(0)
    Unit cur, nxt; int ui = 0;
    if (!S.next(0, cur)) return;
    f32x4 acc[2][2][4][2];
#pragma unroll
    for (int a = 0; a < 2; ++a)
#pragma unroll
        for (int b = 0; b < 2; ++b)
#pragma unroll
            for (int m = 0; m < 4; ++m)
#pragma unroll
                for (int n = 0; n < 2; ++n) acc[a][b][m][n] = (f32x4){0.f, 0.f, 0.f, 0.f};
    bf16x8 At[4][2], B0[2][2], B1[2][2];
    const char* cA = cur.A; const char* cB = cur.Bt;
    if (GATHER) gather_offs(cur, gcur);
#define G8_STAGE_A(bufoff, kp, h, g) do { if (GATHER) G8_STAGE(bufoff, kp, (g)[h]); else G8_STAGE(bufoff, (kp) + (h) * hstep, voffA); } while (0)
    G8_STAGE(G8_SB(0, 0), cB, voffB); G8_STAGE_A(G8_SA(0, 0), cA, 0, gcur); G8_STAGE(G8_SB(0, 1), cB + hstep, voffB); G8_STAGE_A(G8_SA(0, 1), cA, 1, gcur);
    if (wr == 1) G8_BAR;
    G8_WAIT_V(4); G8_BAR;
    G8_STAGE(G8_SB(1, 0), cB + kstep, voffB); G8_STAGE_A(G8_SA(1, 0), cA + kstep, 0, gcur); G8_STAGE(G8_SB(1, 1), cB + hstep + kstep, voffB);
    G8_WAIT_V(6); G8_BAR;
    for (;;) {
        const bool has_next = S.next(ui + 1, nxt);
        const char* nA = has_next ? nxt.A : cA; const char* nB = has_next ? nxt.Bt : cB;
        for (int t = 0; t < nt; t += 2) {
            const bool last = (t == nt - 2);
            const char* a1 = cA + (size_t)(t + 1) * kstep;
            const char* a2 = last ? nA : cA + (size_t)(t + 2) * kstep; const char* b2 = last ? nB : cB + (size_t)(t + 2) * kstep;
            const char* a3 = a2 + kstep; const char* b3 = b2 + kstep;
            G8_LDB(B0, 0, 0); G8_SCHED; G8_LDA(At, 0, 0); G8_STAGE_A(G8_SA(1, 1), a1, 1, gcur);
            G8_WAIT_L(8); G8_BAR; G8_WAIT_L(0); G8_MMA(0, 0, At, B0); G8_BAR; G8_SCHED;
            if (GATHER) { if (last && has_next) gather_offs(nxt, gcur); }
            G8_LDB(B1, 0, 1); G8_STAGE(G8_SB(0, 0), b2, voffB);
            G8_BAR; G8_WAIT_L(0); G8_MMA(0, 1, At, B1); G8_BAR;
            G8_LDA(At, 0, 1); G8_STAGE_A(G8_SA(0, 0), a2, 0, gcur);
            G8_BAR; G8_WAIT_L(0); G8_MMA(1, 0, At, B0); G8_BAR; G8_SCHED;
            G8_STAGE(G8_SB(0, 1), b2 + hstep, voffB);
            G8_WAIT_V(6); G8_BAR; G8_MMA(1, 1, At, B1); G8_BAR;
            G8_LDB(B0, 1, 0); G8_SCHED; G8_LDA(At, 1, 0); G8_STAGE_A(G8_SA(0, 1), a2, 1, gcur);
            G8_WAIT_L(8); G8_BAR; G8_WAIT_L(0); G8_MMA(0, 0, At, B0); G8_BAR; G8_SCHED;
            G8_LDB(B1, 1, 1); G8_STAGE(G8_SB(1, 0), b3, voffB);
            G8_BAR; G8_WAIT_L(0); G8_MMA(0, 1, At, B1); G8_BAR;
            G8_LDA(At, 1, 1); G8_STAGE_A(G8_SA(1, 0), a3, 0, gcur);
            G8_BAR; G8_WAIT_L(0); G8_MMA(1, 0, At, B0); G8_BAR; G8_SCHED;
            G8_STAGE(G8_SB(1, 1), b3 + hstep, voffB);
            G8_WAIT_V(6); G8_BAR; G8_MMA(1, 1, At, B1); G8_BAR;
        }
        E(acc, cur, wr, wc, fr, fq);
        if (!has_next) break;
#pragma unroll
        for (int a = 0; a < 2; ++a)
#pragma unroll
            for (int b = 0; b < 2; ++b)
#pragma unroll
                for (int m = 0; m < 4; ++m)
#pragma unroll
                    for (int n = 0; n < 2; ++n) acc[a][b][m][n] = (f32x4){0.f, 0.f, 0.f, 0.f};
        cur = nxt; cA = nA; cB = nB; ++ui;
    }
    G8_WAIT_V(0);
    if (wr == 0) G8_BAR;
    G8_BAR;
#undef G8_SA
#undef G8_SB
#undef G8_STAGE
#undef G8_STAGE_A
#undef G8_LDA
#undef G8_LDB
#undef G8_MMA
#undef G8_WAIT_V
#undef G8_WAIT_L
#undef G8_BAR
#undef G8_SCHED
}

struct EpiBf16 {
    static constexpr bool PERM = true;
    bf16_t* O0; int ldc0; bf16_t* O1; int ldc1;
    __device__ __forceinline__ void operator()(const f32x4 (&acc)[2][2][4][2], const Unit& u, int wr, int wc, int fr, int fq) const {
        bf16_t* O = u.aux ? O1 : O0; const int ldc = u.aux ? ldc1 : ldc0;
        const int row0 = u.pm * BM + wr * 64 + fr, col0 = u.pn * BM + wc * 32 + 8 * fq;
#pragma unroll
        for (int ai = 0; ai < 2; ++ai)
#pragma unroll
            for (int m = 0; m < 4; ++m) { bf16_t* rowp = O + (size_t)(row0 + ai * HALF + m * 16) * ldc + col0;
#pragma unroll
                for (int bj = 0; bj < 2; ++bj) { const f32x4 v0 = acc[ai][bj][m][0], v1 = acc[ai][bj][m][1];
                    u32x4 w; w.x = cvt_pk_bf16(v0[0], v0[1]); w.y = cvt_pk_bf16(v0[2], v0[3]); w.z = cvt_pk_bf16(v1[0], v1[1]); w.w = cvt_pk_bf16(v1[2], v1[3]);
                    *(u32x4*)(rowp + bj * HALF) = w; } }
    }
};
struct EpiResid {
    static constexpr bool PERM = false;
    float* X; const float* g1base;
    __device__ __forceinline__ void operator()(const f32x4 (&acc)[2][2][4][2], const Unit& u, int wr, int wc, int fr, int fq) const {
        const int rt = u.pm * BM;
        const int mr = rt < NL ? (rt >> 11) : 8;
        const float* g1 = g1base + (size_t)mr * 6144;
        const int row0 = rt + wr * 64 + fr, col0 = u.pn * BM + wc * 32 + 4 * fq;
        f32x4 gv[2][2];
#pragma unroll
        for (int bj = 0; bj < 2; ++bj)
#pragma unroll
            for (int n = 0; n < 2; ++n) gv[bj][n] = *(const f32x4*)(g1 + col0 + bj * HALF + n * 16);
#pragma unroll
        for (int ai = 0; ai < 2; ++ai)
#pragma unroll
            for (int m = 0; m < 4; ++m) { float* rowp = X + (size_t)(row0 + ai * HALF + m * 16) * 1024 + col0;
#pragma unroll
                for (int bj = 0; bj < 2; ++bj)
#pragma unroll
                    for (int n = 0; n < 2; ++n) { f32x4* q = (f32x4*)(rowp + bj * HALF + n * 16); *q = *q + gv[bj][n] * acc[ai][bj][m][n]; } }
    }
};
struct EpiMoeUp {
    static constexpr bool PERM = true;
    bf16_t* ACT; const float* WSEL;
    __device__ __forceinline__ void operator()(const f32x4 (&acc)[2][2][4][2], const Unit& u, int wr, int wc, int fr, int fq) const {
        const int col0 = u.pn * 128 + wc * 32 + 8 * fq;
#pragma unroll
        for (int ai = 0; ai < 2; ++ai)
#pragma unroll
            for (int m = 0; m < 4; ++m) {
                const int ridx = ai * HALF + wr * 64 + m * 16 + fr;
                if (ridx < u.mv) {
                    const int r = u.lst[ridx];
                    const float w = WSEL[r];
                    float o[8];
#pragma unroll
                    for (int n = 0; n < 2; ++n)
#pragma unroll
                        for (int j = 0; j < 4; ++j) { const float g = acc[ai][0][m][n][j], uu = acc[ai][1][m][n][j]; o[n * 4 + j] = g / (1.f + __expf(-g)) * uu * w; }
                    u32x4 wv; wv.x = cvt_pk_bf16(o[0], o[1]); wv.y = cvt_pk_bf16(o[2], o[3]); wv.z = cvt_pk_bf16(o[4], o[5]); wv.w = cvt_pk_bf16(o[6], o[7]);
                    *(u32x4*)(ACT + (size_t)r * 512 + col0) = wv;
                }
            }
    }
};
struct EpiMoeDown {
    static constexpr bool PERM = true;
    bf16_t* YE;
    __device__ __forceinline__ void operator()(const f32x4 (&acc)[2][2][4][2], const Unit& u, int wr, int wc, int fr, int fq) const {
        const int col0 = u.pn * BM + wc * 32 + 8 * fq;
#pragma unroll
        for (int ai = 0; ai < 2; ++ai)
#pragma unroll
            for (int m = 0; m < 4; ++m) {
                const int ridx = ai * HALF + wr * 64 + m * 16 + fr;
                if (ridx < u.mv) {
                    const int r = u.lst[ridx];
#pragma unroll
                    for (int bj = 0; bj < 2; ++bj) { const f32x4 v0 = acc[ai][bj][m][0], v1 = acc[ai][bj][m][1];
                        u32x4 w; w.x = cvt_pk_bf16(v0[0], v0[1]); w.y = cvt_pk_bf16(v0[2], v0[3]); w.z = cvt_pk_bf16(v1[0], v1[1]); w.w = cvt_pk_bf16(v1[2], v1[3]);
                        *(u32x4*)(YE + (size_t)r * 1024 + col0 + bj * HALF) = w; }
                }
            }
    }
};

struct DenseSched {
    const char* A; const char* Bt; int nM, nN, K, G, c;
    __device__ __forceinline__ bool next(int i, Unit& u) const {
        const int L = i * G + c; if (L >= nM * nN) return false;
        int pm, pn; static_order(L, nM, nN, pm, pn);
        u.A = A + (size_t)pm * BM * K * 2; u.Bt = Bt + (size_t)pn * BM * K * 2; u.lst = nullptr; u.mv = 256; u.pm = pm; u.pn = pn; u.aux = 0;
        return true;
    }
};
struct QkvSched {
    const char* H; const char* Bt; int G, c;
    __device__ __forceinline__ bool next(int i, Unit& u) const {
        const int L = i * G + c;
        if (L < 384) { int pm, pn; static_order(L, 64, 6, pm, pn);
            u.A = H + (size_t)pm * BM * 2048; u.Bt = Bt + (size_t)pn * BM * 2048; u.pm = pm; u.pn = pn; u.aux = 0; }
        else if (L < 400) { const int q = L - 384, pm = q >> 1, pn = q & 1;
            u.A = H + (size_t)(NL + pm * BM) * 2048; u.Bt = Bt + (size_t)(1024 + pn * BM) * 2048; u.pm = pm; u.pn = pn; u.aux = 1; }
        else return false;
        u.lst = nullptr; u.mv = 256;
        return true;
    }
};
template <bool UP>
struct MoeSched {
    char* ws; int L; const LAS int* pre; int G, c;
    static constexpr int K = UP ? 1024 : 512;
    __device__ __forceinline__ bool next(int i, Unit& u) const {
        const int Lx = i * G + c; const int total = pre[32] << 2; if (Lx >= total) return false;
        const int mt = Lx >> 2, pn = Lx & 3;
        int e = 0;
#pragma unroll 1
        for (int j = 1; j < 32; ++j) if (pre[j] <= mt) e = j;
        const int m0 = (mt - pre[e]) * BM;
        int mv = (int)((const unsigned*)(ws + OFF_CNT))[L * 32 + e] - m0; mv = mv > 256 ? 256 : mv;
        u.A = ws + (UP ? OFF_H : OFF_ACT);
        u.Bt = ws + (UP ? OFF_BTGU : OFF_BTD) + ((size_t)e * 1024 + (size_t)pn * BM) * K * 2;
        u.lst = (const int*)(ws + OFF_LIST) + (size_t)e * NT + m0; u.mv = mv; u.pm = mt; u.pn = pn; u.aux = e;
        return true;
    }
};
}

__device__ __forceinline__ void cvt_job(const float* __restrict__ src, int ld, bf16_t* __restrict__ dst, int K, int k0, int tid) {
    const int n = tid & 127, kq = tid >> 7;
    const float* sp = src + (size_t)(k0 + kq * 32) * ld + n;
    float v[32];
#pragma unroll
    for (int r = 0; r < 32; ++r) v[r] = sp[(size_t)r * ld];
    bf16_t* dp = dst + (size_t)n * K + k0 + kq * 32;
#pragma unroll
    for (int q = 0; q < 4; ++q) {
        uint4 w;
        w.x = pack2(v[q * 8 + 0], v[q * 8 + 1]); w.y = pack2(v[q * 8 + 2], v[q * 8 + 3]);
        w.z = pack2(v[q * 8 + 4], v[q * 8 + 5]); w.w = pack2(v[q * 8 + 6], v[q * 8 + 7]);
        *(uint4*)(dp + q * 8) = w;
    }
}
__device__ __forceinline__ void cvt_dense(const Params& p, char* smem) {
    const int tid = hide_tid();
    {
        bf16_t* WRG = (bf16_t*)(p.ws + OFF_WRG);
        for (int i = blockIdx.x * NTHR + tid; i < 8 * 256 * 64; i += gridDim.x * NTHR) {
            const int k = i & 63, n = (i >> 6) & 255, g = i >> 14;
            const int d = n >> 7, ri = (n >> 6) & 1, j = n & 63;
            WRG[i] = f2bf(p.in[ri ? I_RGWI : I_RGWR][((size_t)(d * 8 + g) * 64 + k) * 64 + j]);
        }
    }
    for (int j = blockIdx.x; j < (24 + 8 + 12 + 8) * 8; j += gridDim.x) {
        const int grp = j >> 3, kb = j & 7;
        const float* src; int ld; bf16_t* dst;
        if (grp < 24) { const int c0 = grp * 128; src = p.in[I_ABWIN] + (c0 < 2048 ? c0 : c0 + 16); ld = AB_PROJ; dst = (bf16_t*)(p.ws + OFF_BTIN) + (size_t)c0 * 1024; }
        else if (grp < 32) { const int c0 = (grp - 24) * 128; src = p.in[I_ABWOUT] + c0; ld = 1024; dst = (bf16_t*)(p.ws + OFF_BTOUT0) + (size_t)c0 * 1024; }
        else if (grp < 44) { const int c0 = (grp - 32) * 128; src = p.in[I_ATWQKV] + c0; ld = 1536; dst = (bf16_t*)(p.ws + OFF_BTQKV) + (size_t)c0 * 1024; }
        else { const int c0 = (grp - 44) * 128; src = p.in[I_ATWOUT] + c0; ld = 1024; dst = (bf16_t*)(p.ws + OFF_BTOUT1) + (size_t)c0 * 1024; }
        cvt_job(src, ld, dst, 1024, kb * 128, tid);
    }
}
__device__ __forceinline__ void cvt_moe(const Params& p, int L, char* smem) {
    const int tid = hide_tid();
    for (int j = blockIdx.x; j < 32 * 96; j += gridDim.x) {
        const int e = j / 96, q = j % 96;
        if (q < 64) {
            const int up = q >> 5, grp = (q >> 3) & 3, kb = q & 7;
            const float* src = p.in[up ? I_WUP : I_WGATE] + ((size_t)L * 32 + e) * 1024 * 512 + grp * 128;
            bf16_t* dst = (bf16_t*)(p.ws + OFF_BTGU) + ((size_t)e * 1024 + grp * 256 + up * 128) * 1024;
            cvt_job(src, 512, dst, 1024, kb * 128, tid);
        } else {
            const int q2 = q - 64, grp = q2 >> 2, kb = q2 & 3;
            const float* src = p.in[I_WDOWN] + ((size_t)L * 32 + e) * 512 * 1024 + grp * 128;
            bf16_t* dst = (bf16_t*)(p.ws + OFF_BTD) + ((size_t)e * 1024 + grp * 128) * 512;
            cvt_job(src, 1024, dst, 512, kb * 128, tid);
        }
    }
}

__device__ __forceinline__ void ph_ada(const Params& p, char* smem) {
    const int tid = hide_tid();
    float* scond = (float*)smem;
    float* red = scond + 9 * 1024;
    float* MOD = (float*)(p.ws + OFF_MOD);
    for (int i = tid; i < 9 * 1024; i += NTHR) {
        const int r = i >> 10, k = i & 1023;
        const float v = r < 8 ? p.in[I_C][r * 1024 + k] : p.in[I_CCTX][k];
        scond[i] = siluf_(v);
    }
    __syncthreads();
    for (int item = blockIdx.x; item < 192; item += gridDim.x) {
        const int l = item / 96, cg = item % 96;
        const int kq = tid >> 6, cl = tid & 63, col = cg * 64 + cl;
        const float* W = p.in[I_ADAW] + (size_t)l * 1024 * 6144;
        float acc[9];
#pragma unroll
        for (int r = 0; r < 9; ++r) acc[r] = 0.f;
        for (int k = kq * 128; k < kq * 128 + 128; ++k) {
            const float w = W[(size_t)k * 6144 + col];
#pragma unroll
            for (int r = 0; r < 9; ++r) acc[r] += scond[r * 1024 + k] * w;
        }
#pragma unroll
        for (int r = 0; r < 9; ++r) red[(kq * 9 + r) * 64 + cl] = acc[r];
        __syncthreads();
        for (int i = tid; i < 9 * 64; i += NTHR) {
            const int r = i >> 6, cc = i & 63;
            float s = 0.f;
#pragma unroll
            for (int q = 0; q < 8; ++q) s += red[(q * 9 + r) * 64 + cc];
            MOD[(size_t)(l * 9 + r) * 6144 + cg * 64 + cc] = s + p.in[I_ADAB][l * 6144 + cg * 64 + cc];
        }
        __syncthreads();
    }
}

#define HS_LD 1028
template <int MODE>
__device__ __forceinline__ void ph_rows(const Params& p, char* smem) {
    const int tid = hide_tid(), lane = tid & 63, wave = tid >> 6;
    constexpr int L = (MODE >= 2) ? 1 : 0;
    constexpr int NROWS = (MODE >= 3) ? NL : NT;
    constexpr bool ROUTER = (MODE == 1 || MODE == 3);
    constexpr bool GATEP = (MODE == 0);
    constexpr bool LOGITS = ROUTER || GATEP;
    constexpr int NTL = GATEP ? 1 : 3;
    float* GATES = (float*)(p.ws + OFF_GATES);
    float* X = (float*)(p.ws + OFF_X);
    bf16_t* H = (bf16_t*)(p.ws + OFF_H);
    const bf16_t* YE = (const bf16_t*)(p.ws + OFF_YE);
    const float* MOD = (const float*)(p.ws + OFF_MOD);
    float* hsb = (float*)smem;
    float* part = hsb + 16 * HS_LD;
    float* lgs = part + 8 * 16 * 48;
    unsigned* cnt = (unsigned*)(p.ws + OFF_CNT) + L * 32;
    int* LIST = (int*)(p.ws + OFF_LIST);
    float* WSEL = (float*)(p.ws + OFF_WSEL);

    for (int base = blockIdx.x * 16; base < NROWS; base += gridDim.x * 16) {
#pragma unroll 1
        for (int rr = 0; rr < 2; ++rr) {
            const int row = base + wave * 2 + rr;
            float* hs = hsb + (wave * 2 + rr) * HS_LD;
            const int mr = row < NL ? (row >> 11) : 8;
            float v[16];
            if (MODE == 0) {
                const float* src = row < NL ? p.in[I_X] + (size_t)row * 1024 : p.in[I_CTX] + (size_t)(row - NL) * 1024;
#pragma unroll
                for (int i = 0; i < 4; ++i) {
                    const float4 t = *(const float4*)(src + i * 256 + lane * 4);
                    v[i * 4 + 0] = t.x; v[i * 4 + 1] = t.y; v[i * 4 + 2] = t.z; v[i * 4 + 3] = t.w;
                }
            } else {
#pragma unroll
                for (int i = 0; i < 4; ++i) {
                    const float4 t = *(const float4*)(X + (size_t)row * 1024 + i * 256 + lane * 4);
                    v[i * 4 + 0] = t.x; v[i * 4 + 1] = t.y; v[i * 4 + 2] = t.z; v[i * 4 + 3] = t.w;
                }
            }
            if (MODE == 2 || MODE == 4) {
                constexpr int LP = (MODE == 2) ? 0 : 1;
                const float* g2 = MOD + (size_t)(LP * 9 + mr) * 6144 + 5 * 1024;
#pragma unroll
                for (int i = 0; i < 4; ++i) {
                    const int c = i * 256 + lane * 4;
                    const uint2 a = *(const uint2*)(YE + (size_t)(2 * row) * 1024 + c);
                    const uint2 b = *(const uint2*)(YE + (size_t)(2 * row + 1) * 1024 + c);
                    const float4 g = *(const float4*)(g2 + c);
                    v[i * 4 + 0] += g.x * (bf2f((bf16_t)(a.x & 0xffff)) + bf2f((bf16_t)(b.x & 0xffff)));
                    v[i * 4 + 1] += g.y * (bf2f((bf16_t)(a.x >> 16)) + bf2f((bf16_t)(b.x >> 16)));
                    v[i * 4 + 2] += g.z * (bf2f((bf16_t)(a.y & 0xffff)) + bf2f((bf16_t)(b.y & 0xffff)));
                    v[i * 4 + 3] += g.w * (bf2f((bf16_t)(a.y >> 16)) + bf2f((bf16_t)(b.y >> 16)));
                }
            }
            if (MODE == 0 || MODE == 2) {
#pragma unroll
                for (int i = 0; i < 4; ++i)
                    *(float4*)(X + (size_t)row * 1024 + i * 256 + lane * 4) = make_float4(v[i * 4], v[i * 4 + 1], v[i * 4 + 2], v[i * 4 + 3]);
            }
            float ss = 0.f;
#pragma unroll
            for (int i = 0; i < 16; ++i) ss += v[i] * v[i];
            ss = wave_sum(ss);
            const float rinv = rsqrtf(ss * (1.f / 1024.f) + EPSF);
            if (MODE == 4) {
#pragma unroll
                for (int i = 0; i < 4; ++i) {
                    const int c = i * 256 + lane * 4;
                    const float4 w = *(const float4*)(p.in[I_FNORM] + c);
                    *(float4*)(p.out + (size_t)row * 1024 + c) =
                        make_float4(v[i * 4] * rinv * w.x, v[i * 4 + 1] * rinv * w.y, v[i * 4 + 2] * rinv * w.z, v[i * 4 + 3] * rinv * w.w);
                }
            } else {
                constexpr int SH = (MODE == 0 || MODE == 2) ? 0 : 3;
                const float* gain = p.in[(MODE == 0 || MODE == 2) ? I_NORM1 : I_NORM2] + L * 1024;
                const float* sh = MOD + (size_t)(L * 9 + mr) * 6144 + SH * 1024;
                const float* sc = sh + 1024;
#pragma unroll
                for (int i = 0; i < 4; ++i) {
                    const int c = i * 256 + lane * 4;
                    const float4 w = *(const float4*)(gain + c);
                    const float4 s1 = *(const float4*)(sc + c);
                    const float4 s0 = *(const float4*)(sh + c);
                    float h0 = v[i * 4 + 0] * rinv * w.x * (1.f + s1.x) + s0.x;
                    float h1 = v[i * 4 + 1] * rinv * w.y * (1.f + s1.y) + s0.y;
                    float h2 = v[i * 4 + 2] * rinv * w.z * (1.f + s1.z) + s0.z;
                    float h3 = v[i * 4 + 3] * rinv * w.w * (1.f + s1.w) + s0.w;
                    uint2 o; o.x = pack2(h0, h1); o.y = pack2(h2, h3);
                    *(uint2*)(H + (size_t)row * 1024 + c) = o;
                    if (LOGITS) *(float4*)(hs + c) = make_float4(h0, h1, h2, h3);
                }
            }
        }
        if (LOGITS) {
            __syncthreads();
            const int l15 = lane & 15, lq = lane >> 4;
            const float* wp[NTL]; int wld[NTL];
#pragma unroll
            for (int nt = 0; nt < NTL; ++nt) {
                const int c = nt * 16 + l15;
                if (GATEP) { wp[nt] = p.in[I_ABWIN] + 2048 + c; wld[nt] = AB_PROJ; }
                else if (c < 4) { wp[nt] = p.in[I_WGRP] + (size_t)L * 1024 * 4 + c; wld[nt] = 4; }
                else if (c < 36) { wp[nt] = p.in[I_WEXP] + (size_t)L * 1024 * 32 + (c - 4); wld[nt] = 32; }
                else { wp[nt] = nullptr; wld[nt] = 0; }
            }
            f32x4 acc[NTL];
#pragma unroll
            for (int nt = 0; nt < NTL; ++nt) acc[nt] = (f32x4){0.f, 0.f, 0.f, 0.f};
            const float* arow = hsb + l15 * HS_LD + wave * 128 + lq;
#pragma unroll 8
            for (int kk = 0; kk < 32; ++kk) {
                const int k = wave * 128 + kk * 4 + lq;
                const float a = arow[kk * 4];
#pragma unroll
                for (int nt = 0; nt < NTL; ++nt) {
                    const float bv = wp[nt] ? wp[nt][(size_t)k * wld[nt]] : 0.f;
                    acc[nt] = __builtin_amdgcn_mfma_f32_16x16x4f32(a, bv, acc[nt], 0, 0, 0);
                }
            }
#pragma unroll
            for (int nt = 0; nt < NTL; ++nt)
#pragma unroll
                for (int j = 0; j < 4; ++j) part[(wave * 16 + lq * 4 + j) * 48 + nt * 16 + l15] = acc[nt][j];
            __syncthreads();
            for (int t = tid; t < 16 * NTL * 16; t += NTHR) {
                const int r = t / (NTL * 16), c = t % (NTL * 16);
                float sacc = 0.f;
#pragma unroll
                for (int w = 0; w < 8; ++w) sacc += part[(w * 16 + r) * 48 + c];
                if (GATEP) GATES[(size_t)(base + r) * 16 + c] = sacc;
                else {
                    float bias = 0.f;
                    if (c < 4) bias = p.in[I_BGRP][L * 4 + c]; else if (c < 36) bias = p.in[I_BEXP][L * 32 + c - 4];
                    lgs[r * 48 + c] = sacc + bias;
                }
            }
            if (ROUTER) {
                __syncthreads();
                if (tid < 16) {
                    const int row = base + tid;
                    const float* lg = lgs + tid * 48;
                    int gi = 0; float gm = lg[0];
#pragma unroll
                    for (int j = 1; j < 4; ++j) if (lg[j] > gm) { gm = lg[j]; gi = j; }
                    float gs = 0.f;
#pragma unroll
                    for (int j = 0; j < 4; ++j) gs += __expf(lg[j] - gm);
                    const float gw = 1.f / gs;
                    const float* el = lg + 4 + gi * 8;
                    int e0 = 0; float v0 = el[0];
#pragma unroll
                    for (int j = 1; j < 8; ++j) if (el[j] > v0) { v0 = el[j]; e0 = j; }
                    int e1 = -1; float v1 = -3.0e38f;
#pragma unroll
                    for (int j = 0; j < 8; ++j) if (j != e0 && el[j] > v1) { v1 = el[j]; e1 = j; }
                    const float t = __expf(v1 - v0);
                    const float w0 = gw / (1.f + t), w1 = gw * t / (1.f + t);
                    const int x0 = gi * 8 + e0, x1 = gi * 8 + e1;
                    const unsigned s0 = __hip_atomic_fetch_add(&cnt[x0], 1u, __ATOMIC_RELAXED, __HIP_MEMORY_SCOPE_AGENT);
                    const unsigned s1 = __hip_atomic_fetch_add(&cnt[x1], 1u, __ATOMIC_RELAXED, __HIP_MEMORY_SCOPE_AGENT);
                    LIST[(size_t)x0 * NT + s0] = 2 * row;
                    LIST[(size_t)x1 * NT + s1] = 2 * row + 1;
                    WSEL[2 * row] = w0;
                    WSEL[2 * row + 1] = w1;
                }
            }
            __syncthreads();
        }
    }
}

__device__ __forceinline__ void ph_gemm_in(const Params& p, LAS unsigned char* lds) {
    g8::DenseSched S{p.ws + OFF_H, p.ws + OFF_BTIN, NT / 256, ZW / 256, 1024, (int)gridDim.x, (int)blockIdx.x};
    g8::EpiBf16 E{(bf16_t*)(p.ws + OFF_Z), ZW, nullptr, 0};
    g8::gemm_phase<false, 0>(lds, 1024, S, E);
}
template <int L>
__device__ __forceinline__ void ph_gemm_out(const Params& p, LAS unsigned char* lds) {
    g8::DenseSched S{p.ws + OFF_H, p.ws + (L == 0 ? OFF_BTOUT0 : OFF_BTOUT1), (L == 0 ? NT : NL) / 256, 4, 1024, (int)gridDim.x, (int)blockIdx.x};
    g8::EpiResid E{(float*)(p.ws + OFF_X), (const float*)(p.ws + OFF_MOD) + (size_t)(L * 9) * 6144 + 2 * 1024};
    g8::gemm_phase<false, 0>(lds, 1024, S, E);
}
__device__ __forceinline__ void ph_gemm_qkv(const Params& p, LAS unsigned char* lds) {
    g8::QkvSched S{p.ws + OFF_H, p.ws + OFF_BTQKV, (int)gridDim.x, (int)blockIdx.x};
    g8::EpiBf16 E{(bf16_t*)(p.ws + OFF_ZQ), 1536, (bf16_t*)(p.ws + OFF_ZC), 512};
    g8::gemm_phase<false, 0>(lds, 1024, S, E);
}

__device__ __forceinline__ void moe_prefix(const Params& p, int L, LAS int* pre) {
    unsigned* cnt = (unsigned*)(p.ws + OFF_CNT) + L * 32;
    __syncthreads();
    if (hide_tid() == 0) {
        int s = 0;
        for (int e = 0; e < 32; ++e) { pre[e] = s; s += ((int)xb_ld(&cnt[e]) + 255) >> 8; }
        pre[32] = s;
    }
    __syncthreads();
}
__device__ __forceinline__ void ph_moe_up(const Params& p, int L, LAS unsigned char* lds) {
    LAS int* pre = (LAS int*)(lds + LDS_PRE);
    moe_prefix(p, L, pre);
    g8::MoeSched<true> S{p.ws, L, pre, (int)gridDim.x, (int)blockIdx.x};
    g8::EpiMoeUp E{(bf16_t*)(p.ws + OFF_ACT), (const float*)(p.ws + OFF_WSEL)};
    g8::gemm_phase<true, 1>(lds, 1024, S, E);
}
__device__ __forceinline__ void ph_moe_down(const Params& p, int L, LAS unsigned char* lds) {
    LAS int* pre = (LAS int*)(lds + LDS_PRE);
    moe_prefix(p, L, pre);
    g8::MoeSched<false> S{p.ws, L, pre, (int)gridDim.x, (int)blockIdx.x};
    g8::EpiMoeDown E{(bf16_t*)(p.ws + OFF_YE)};
    g8::gemm_phase<true, 0>(lds, 512, S, E);
}

__device__ __forceinline__ int unit_row0(int b, int cidx) { return cidx < 4 ? (NL + b * CTXL + cidx * 64) : (b * SEQ + (cidx - 4) * 64); }
__device__ __forceinline__ int tile_row0(int tl) { return tl < 256 ? tl * 64 : NL + (tl - 256) * 64; }

__device__ __forceinline__ void lru_tile(const Params& p, int tl, char* smem) {
    const int tid = hide_tid(), lane = tid & 63, wave = tid >> 6, l15 = lane & 15, lq = lane >> 4;
    const bf16_t* Z = (const bf16_t*)(p.ws + OFF_Z);
    const bf16_t* WRG = (const bf16_t*)(p.ws + OFF_WRG);
    bf16_t* HLOC = (bf16_t*)(p.ws + OFF_HLOC);
    bf16_t* ACUM = (bf16_t*)(p.ws + OFF_ACUM);
    float* LTOT = (float*)(p.ws + OFF_LTOT);
    constexpr int XLD = 520;
    bf16_t* XC = (bf16_t*)smem;
    const int row0 = tile_row0(tl);
    int sbeg, send;
    if (row0 < NL) { sbeg = (row0 >> 11) << 11; send = sbeg + SEQ; }
    else { sbeg = NL + (((row0 - NL) >> 8) << 8); send = sbeg + CTXL; }
    __syncthreads();
    {
        const int c = tid;
        const float w0 = p.in[I_CONVX][c], w1 = p.in[I_CONVX][512 + c], w2 = p.in[I_CONVX][1024 + c], w3 = p.in[I_CONVX][1536 + c];
        unsigned mlo = (row0 > sbeg) ? 0xffffu : 0u, mhi = (row0 + 64 < send) ? 0xffffu : 0u;
        asm volatile("" : "+v"(mlo), "+v"(mhi));
        const bf16_t* zc = Z + 2048 + c;
        const int rlo = row0 > sbeg ? row0 - 2 : row0, rhi = row0 + 64 < send ? row0 + 64 : row0 + 63;
        float zm2 = bf2f((bf16_t)(zc[(size_t)rlo * ZW] & mlo)), zm1 = bf2f((bf16_t)(zc[(size_t)(rlo + 1) * ZW] & mlo)), z0 = bf2f(zc[(size_t)row0 * ZW]);
#pragma unroll
        for (int t0 = 0; t0 < 64; t0 += 32) {
            bf16_t nz[32];
#pragma unroll
            for (int q = 0; q < 32; ++q) {
                const int tk = t0 + q;
                nz[q] = tk == 63 ? (bf16_t)(zc[(size_t)rhi * ZW] & mhi) : zc[(size_t)(row0 + tk + 1) * ZW];
            }
#pragma unroll
            for (int q = 0; q < 32; ++q) {
                const float zp1 = bf2f(nz[q]);
                XC[(t0 + q) * XLD + c] = f2bf(zm2 * w0 + zm1 * w1 + z0 * w2 + zp1 * w3);
                zm2 = zm1; zm1 = z0; z0 = zp1;
            }
        }
    }
    __syncthreads();
    const int g = wave;
    bf16x8 af[4][2];
#pragma unroll
    for (int mi = 0; mi < 4; ++mi)
#pragma unroll
        for (int kk = 0; kk < 2; ++kk) af[mi][kk] = *(const bf16x8*)(XC + (mi * 16 + l15) * XLD + g * 64 + kk * 32 + lq * 8);
#pragma unroll
    for (int d = 0; d < 2; ++d) {
#pragma unroll 1
        for (int ni = 0; ni < 4; ++ni) {
            f32x4 accr[4], acci[4];
#pragma unroll
            for (int mi = 0; mi < 4; ++mi) { accr[mi] = (f32x4){0.f, 0.f, 0.f, 0.f}; acci[mi] = (f32x4){0.f, 0.f, 0.f, 0.f}; }
            {
                const bf16_t* wr_ = WRG + ((size_t)(g * 256 + d * 128 + ni * 16 + l15)) * 64 + lq * 8;
#pragma unroll
                for (int kk = 0; kk < 2; ++kk) {
                    const bf16x8 br_ = *(const bf16x8*)(wr_ + kk * 32);
                    const bf16x8 bi_ = *(const bf16x8*)(wr_ + 64 * 64 + kk * 32);
#pragma unroll
                    for (int mi = 0; mi < 4; ++mi) {
                        accr[mi] = __builtin_amdgcn_mfma_f32_16x16x32_bf16(af[mi][kk], br_, accr[mi], 0, 0, 0);
                        acci[mi] = __builtin_amdgcn_mfma_f32_16x16x32_bf16(af[mi][kk], bi_, acci[mi], 0, 0, 0);
                    }
                }
            }
            const int c = g * 64 + ni * 16 + l15;
            const float br = p.in[I_RGBR][d * 512 + c], bi = p.in[I_RGBI][d * 512 + c];
            const float spl = softplusf_(-p.in[I_RGLAM][d * 512 + c]);
            float A[4][4], Bv[4][4];
#pragma unroll
            for (int mi = 0; mi < 4; ++mi)
#pragma unroll
                for (int j = 0; j < 4; ++j) {
                    const float r = sigmoidf_(accr[mi][j] + br), ig = sigmoidf_(acci[mi][j] + bi);
                    const float la = -8.0f * r * spl;
                    const float a = __expf(la);
                    const float xc = bf2f(XC[(mi * 16 + lq * 4 + j) * XLD + c]);
                    A[mi][j] = a;
                    Bv[mi][j] = __builtin_amdgcn_sqrtf(neg_expm1_small(2.f * la)) * ig * xc;
                }
            float P[4][4], Hh[4][4];
#pragma unroll
            for (int mi = 0; mi < 4; ++mi) {
                if (d == 0) {
                    P[mi][0] = A[mi][0]; Hh[mi][0] = Bv[mi][0];
#pragma unroll
                    for (int j = 1; j < 4; ++j) { P[mi][j] = A[mi][j] * P[mi][j - 1]; Hh[mi][j] = A[mi][j] * Hh[mi][j - 1] + Bv[mi][j]; }
                } else {
                    P[mi][3] = A[mi][3]; Hh[mi][3] = Bv[mi][3];
#pragma unroll
                    for (int j = 2; j >= 0; --j) { P[mi][j] = A[mi][j] * P[mi][j + 1]; Hh[mi][j] = A[mi][j] * Hh[mi][j + 1] + Bv[mi][j]; }
                }
            }
            float cP = 1.f, cH = 0.f;
#pragma unroll
            for (int mm = 0; mm < 4; ++mm) {
                const int mi = d == 0 ? mm : 3 - mm;
                const float sP = d == 0 ? P[mi][3] : P[mi][0], sH = d == 0 ? Hh[mi][3] : Hh[mi][0];
                float iP = sP, iH = sH;
#pragma unroll
                for (int dist = 1; dist <= 2; dist <<= 1) {
                    const int src = d == 0 ? lane - 16 * dist : lane + 16 * dist;
                    const float pP = __shfl(iP, src & 63, 64), pH = __shfl(iH, src & 63, 64);
                    const bool ok = d == 0 ? (lq >= dist) : (lq <= 3 - dist);
                    if (ok) { iH = iP * pH + iH; iP = iP * pP; }
                }
                const int srcx = d == 0 ? lane - 16 : lane + 16;
                float eP = __shfl(iP, srcx & 63, 64), eH = __shfl(iH, srcx & 63, 64);
                const bool first = d == 0 ? (lq == 0) : (lq == 3);
                if (first) { eP = 1.f; eH = 0.f; }
                const float bP = eP * cP, bH = eP * cH + eH;
#pragma unroll
                for (int j = 0; j < 4; ++j) {
                    const float hval = P[mi][j] * bH + Hh[mi][j];
                    const float aval = P[mi][j] * bP;
                    const size_t o = ((size_t)d * NT + row0 + mi * 16 + lq * 4 + j) * 512 + c;
                    HLOC[o] = f2bf(hval); ACUM[o] = f2bf(aval);
                    Hh[mi][j] = hval; P[mi][j] = aval;
                }
                const int lastl = d == 0 ? 48 + l15 : l15;
                const float tP = __shfl(iP, lastl, 64), tH = __shfl(iH, lastl, 64);
                cH = tP * cH + tH; cP = tP * cP;
            }
            if (d == 0 ? (lq == 3) : (lq == 0)) {
                const float aT = d == 0 ? P[3][3] : P[0][0], hT = d == 0 ? Hh[3][3] : Hh[0][0];
                float* o = LTOT + (((size_t)d * 288 + tl) * 512 + c) * 2;
                o[0] = aT; o[1] = hT;
            }
        }
    }
}

__device__ __forceinline__ void delta_unit(const Params& p, int u, char* smem) {
    const int tid = hide_tid(), lane = tid & 63, wave = tid >> 6, l15 = lane & 15, lq = lane >> 4;
    const int cidx = u % 36, bh = u / 36, h = bh & 3, b = bh >> 2;
    const int row0 = unit_row0(b, cidx);
    const int sbeg = cidx < 4 ? NL + b * CTXL : b * SEQ, send = cidx < 4 ? sbeg + CTXL : sbeg + SEQ;
    const bf16_t* Z = (const bf16_t*)(p.ws + OFF_Z);
    const float* GATES = (const float*)(p.ws + OFF_GATES);
    bf16_t* QG = (bf16_t*)(p.ws + OFF_QG) + (size_t)u * 64 * 128;
    bf16_t* KG = (bf16_t*)(p.ws + OFF_KG) + (size_t)u * 64 * 128;
    bf16_t* VG = (bf16_t*)(p.ws + OFF_VG) + (size_t)u * 64 * 128;
    bf16_t* KTG = (bf16_t*)(p.ws + OFF_KTG) + (size_t)u * 128 * 64;
    bf16_t* TT = (bf16_t*)(p.ws + OFF_TT) + (size_t)u * 2 * 4096;
    bf16_t* ATT = (bf16_t*)(p.ws + OFF_ATT) + (size_t)u * 2 * 4096;
    float* VEC = (float*)(p.ws + OFF_VEC) + (size_t)u * 2 * 256;
    float* EGL = (float*)(p.ws + OFF_EGL) + (size_t)u * 2;
    constexpr int QLD = 136, LLD = 68;
    bf16_t* Qs = (bf16_t*)smem;
    bf16_t* Ks = Qs + 64 * QLD;
    float* Lm = (float*)(Ks + 64 * QLD);
    float* gcs = Lm + 2 * 64 * LLD;
    float* bts = gcs + 128;
    __syncthreads();
    if (wave < 6) {
        const int part = wave >> 1, t0 = (wave & 1) * 32;
        const int c = part * 512 + h * 128 + lane * 2;
        const float* cw = p.in[I_CONVQKV] + c;
        const float w00 = cw[0], w01 = cw[1], w10 = cw[1536], w11 = cw[1537], w20 = cw[3072], w21 = cw[3073], w30 = cw[4608], w31 = cw[4609];
        const int rb = row0 + t0;
        unsigned mlo = (rb > sbeg) ? 0xffffffffu : 0u, mhi = (rb + 32 < send) ? 0xffffffffu : 0u;
        asm volatile("" : "+v"(mlo), "+v"(mhi));
        const bf16_t* zc = Z + c;
        const int rlo = rb > sbeg ? rb - 2 : rb, rhi = rb + 32 < send ? rb + 32 : rb + 31;
        unsigned zw[35];
        zw[0] = *(const unsigned*)(zc + (size_t)rlo * ZW) & mlo; zw[1] = *(const unsigned*)(zc + (size_t)(rlo + 1) * ZW) & mlo;
#pragma unroll
        for (int q = 0; q < 32; ++q) zw[2 + q] = *(const unsigned*)(zc + (size_t)(rb + q) * ZW);
        zw[34] = *(const unsigned*)(zc + (size_t)rhi * ZW) & mhi;
#pragma unroll
        for (int tk = 0; tk < 32; ++tk) {
            const unsigned zm2 = zw[tk], zm1 = zw[tk + 1], z0 = zw[tk + 2], zp1 = zw[tk + 3];
            float a0 = bf2f((bf16_t)(zm2 & 0xffff)) * w00 + bf2f((bf16_t)(zm1 & 0xffff)) * w10 + bf2f((bf16_t)(z0 & 0xffff)) * w20 + bf2f((bf16_t)(zp1 & 0xffff)) * w30;
            float a1 = bf2f((bf16_t)(zm2 >> 16)) * w01 + bf2f((bf16_t)(zm1 >> 16)) * w11 + bf2f((bf16_t)(z0 >> 16)) * w21 + bf2f((bf16_t)(zp1 >> 16)) * w31;
            a0 = siluf_(a0); a1 = siluf_(a1);
            const int tok = t0 + tk;
            if (part < 2) {
                const float ss = wave_sum(a0 * a0 + a1 * a1);
                float sc = rsqrtf(ss + EPSF);
                if (part == 0) sc *= 0.08838834764831845f;
                a0 *= sc; a1 *= sc;
                const unsigned pk = pack2(a0, a1);
                *(unsigned*)((part == 0 ? Qs : Ks) + tok * QLD + lane * 2) = pk;
                *(unsigned*)((part == 0 ? QG : KG) + tok * 128 + lane * 2) = pk;
            } else {
                *(unsigned*)(VG + tok * 128 + lane * 2) = pack2(a0, a1);
            }
        }
    } else {
        const int d = wave - 6;
        const int row = row0 + lane;
        const float gv = GATES[(size_t)row * 16 + d * 8 + h], bv = GATES[(size_t)row * 16 + d * 8 + 4 + h];
        const float gdec = -__expf(p.in[I_ALOG][d * 4 + h]) * softplusf_(gv + p.in[I_DTB][d * 4 + h]);
        const float beta = sigmoidf_(bv);
        float gc = gdec;
#pragma unroll
        for (int dist = 1; dist < 64; dist <<= 1) {
            const int src = d == 0 ? lane - dist : lane + dist;
            const float o = __shfl(gc, src & 63, 64);
            if (d == 0 ? (lane >= dist) : (lane + dist < 64)) gc += o;
        }
        const float gl = __shfl(gc, d == 0 ? 63 : 0, 64);
        gcs[d * 64 + lane] = gc; bts[d * 64 + lane] = beta;
        const float egc = __expf(gc);
        VEC[d * 256 + 0 * 64 + lane] = beta * egc;
        VEC[d * 256 + 1 * 64 + lane] = egc;
        VEC[d * 256 + 2 * 64 + lane] = __expf(gl - gc);
        VEC[d * 256 + 3 * 64 + lane] = beta;
        if (lane == 0) EGL[d] = __expf(gl);
    }
    __syncthreads();
    {
        const int mi = wave >> 1, ni0 = (wave & 1) * 2;
        f32x4 kk_acc[2], qk_acc[2];
#pragma unroll
        for (int n = 0; n < 2; ++n) { kk_acc[n] = (f32x4){0.f, 0.f, 0.f, 0.f}; qk_acc[n] = (f32x4){0.f, 0.f, 0.f, 0.f}; }
#pragma unroll
        for (int kk = 0; kk < 4; ++kk) {
            const bf16x8 ak = *(const bf16x8*)(Ks + (mi * 16 + l15) * QLD + kk * 32 + lq * 8);
            const bf16x8 aq = *(const bf16x8*)(Qs + (mi * 16 + l15) * QLD + kk * 32 + lq * 8);
#pragma unroll
            for (int n = 0; n < 2; ++n) {
                const bf16x8 bk = *(const bf16x8*)(Ks + ((ni0 + n) * 16 + l15) * QLD + kk * 32 + lq * 8);
                kk_acc[n] = __builtin_amdgcn_mfma_f32_16x16x32_bf16(ak, bk, kk_acc[n], 0, 0, 0);
                qk_acc[n] = __builtin_amdgcn_mfma_f32_16x16x32_bf16(aq, bk, qk_acc[n], 0, 0, 0);
            }
        }
#pragma unroll
        for (int n = 0; n < 2; ++n)
#pragma unroll
            for (int j = 0; j < 4; ++j) {
                const int i = mi * 16 + lq * 4 + j, jc = (ni0 + n) * 16 + l15;
                {
                    const float e = (i >= jc) ? __expf(gcs[i] - gcs[jc]) : 0.f;
                    if (i > jc) Lm[i * LLD + jc] = bts[i] * kk_acc[n][j] * e;
                    ATT[i * 64 + jc] = f2bf(qk_acc[n][j] * e);
                }
                {
                    const float e = (i <= jc) ? __expf(gcs[64 + i] - gcs[64 + jc]) : 0.f;
                    if (i < jc) Lm[64 * LLD + (63 - i) * LLD + (63 - jc)] = bts[64 + i] * kk_acc[n][j] * e;
                    ATT[4096 + i * 64 + jc] = f2bf(qk_acc[n][j] * e);
                }
            }
    }
    __syncthreads();
    if (wave < 2) {
        const int d = wave;
        const float* Lr = Lm + d * 64 * LLD;
        float T[64];
#pragma unroll
        for (int i = 0; i < 64; ++i) {
            float a0 = (i == lane) ? 1.f : 0.f, a1 = 0.f, a2 = 0.f, a3 = 0.f;
#pragma unroll
            for (int j4 = 0; j4 + 4 <= i; j4 += 4) {
                const float4 l4 = *(const float4*)(Lr + i * LLD + j4);
                a0 -= l4.x * T[j4]; a1 -= l4.y * T[j4 + 1]; a2 -= l4.z * T[j4 + 2]; a3 -= l4.w * T[j4 + 3];
            }
#pragma unroll
            for (int j = (i & ~3); j < i; ++j) a0 -= Lr[i * LLD + j] * T[j];
            T[i] = (a0 + a1) + (a2 + a3);
        }
#pragma unroll
        for (int i = 0; i < 64; ++i) {
            const int ri = d == 0 ? i : 63 - i, rc = d == 0 ? lane : 63 - lane;
            TT[d * 4096 + ri * 64 + rc] = f2bf(T[i]);
        }
    } else {
        for (int q = tid - 128; q < 1024; q += 384) {
            const int dk = q & 127, tg = q >> 7;
            unsigned short e[8];
#pragma unroll
            for (int x = 0; x < 8; ++x) e[x] = Ks[(tg * 8 + x) * QLD + dk];
            uint4 w; w.x = e[0] | ((unsigned)e[1] << 16); w.y = e[2] | ((unsigned)e[3] << 16); w.z = e[4] | ((unsigned)e[5] << 16); w.w = e[6] | ((unsigned)e[7] << 16);
            *(uint4*)(KTG + dk * 64 + tg * 8) = w;
        }
    }
}

__device__ __forceinline__ void ph_prep(const Params& p, char* smem, int rep = 0) {
    const int lo = (rep && REP_SUB == 2) ? 288 : 0, hi = (rep && REP_SUB == 1) ? 288 : 288 + 1152;
    for (int item = lo + blockIdx.x; item < hi; item += gridDim.x) {
        if (item < 288) lru_tile(p, item, smem);
        else delta_unit(p, item - 288, smem);
    }
}

__device__ __forceinline__ void lru_carry(const Params& p, int li) {
    const int idx = li * NTHR + hide_tid();
    const int c = idx & 511, bd = idx >> 9, b = bd >> 1, d = bd & 1;
    const float* LTOT = (const float*)(p.ws + OFF_LTOT);
    float* CIN = (float*)(p.ws + OFF_CIN);
    float s = 0.f;
#pragma unroll 12
    for (int st = 0; st < 36; ++st) {
        int tl;
        if (st < 4) tl = 256 + b * 4 + (d ? 3 - st : st);
        else tl = b * 32 + (d ? 35 - st : st - 4);
        const float2 ah = *(const float2*)(LTOT + (((size_t)d * 288 + tl) * 512 + c) * 2);
        CIN[((size_t)d * 288 + tl) * 512 + c] = s;
        s = ah.x * s + ah.y;
    }
}
struct DFrags { bf16x8 k[4], q[4], t[2], a[2], kt[2]; unsigned v[4]; float4 rs1, rs2, rs3, bt; float egl; };
__device__ __forceinline__ void delta_chain(const Params& p, int item, char* smem) {
    const int tid = hide_tid(), lane = tid & 63, wave = tid >> 6, l15 = lane & 15, lq = lane >> 4;
    const int chain = item >> 2, sl = item & 3;
    const int b = chain >> 3, h = (chain >> 1) & 3, dir = chain & 1;
    const int mi = wave >> 1, ni = wave & 1;
    const bf16_t* QG = (const bf16_t*)(p.ws + OFF_QG);
    const bf16_t* KG = (const bf16_t*)(p.ws + OFF_KG);
    const bf16_t* VG = (const bf16_t*)(p.ws + OFF_VG);
    const bf16_t* KTG = (const bf16_t*)(p.ws + OFF_KTG);
    const bf16_t* TT = (const bf16_t*)(p.ws + OFF_TT);
    const bf16_t* ATT = (const bf16_t*)(p.ws + OFF_ATT);
    const float* VEC = (const float*)(p.ws + OFF_VEC);
    const float* EGL = (const float*)(p.ws + OFF_EGL);
    bf16_t* OA = (bf16_t*)(p.ws + OFF_OA) + (size_t)dir * NT * 512;
    constexpr int SLD = 136, RLD = 72;
    bf16_t* ST = (bf16_t*)smem;
    bf16_t* RT = ST + 32 * SLD;
    bf16_t* VNT = RT + 32 * RLD;
    bf16_t* VST = VNT + 32 * RLD;
    __syncthreads();
    for (int i = tid; i < 32 * SLD / 2; i += NTHR) ((unsigned*)ST)[i] = 0u;
    auto unit_of = [&](int s) -> int { const int cidx = dir ? (s < 4 ? 3 - s : 39 - s) : s; return (b * 4 + h) * 36 + cidx; };
    auto load = [&](int s, DFrags& f) {
        const int u = unit_of(s);
        const bf16_t* kq = KG + (size_t)u * 8192 + (mi * 16 + l15) * 128 + lq * 8;
        const bf16_t* qq = QG + (size_t)u * 8192 + (mi * 16 + l15) * 128 + lq * 8;
#pragma unroll
        for (int kk = 0; kk < 4; ++kk) { f.k[kk] = *(const bf16x8*)(kq + kk * 32); f.q[kk] = *(const bf16x8*)(qq + kk * 32); }
        const bf16_t* tp = TT + ((size_t)u * 2 + dir) * 4096 + (mi * 16 + l15) * 64 + lq * 8;
        const bf16_t* ap = ATT + ((size_t)u * 2 + dir) * 4096 + (mi * 16 + l15) * 64 + lq * 8;
        const bf16_t* ktp = KTG + (size_t)u * 8192 + (wave * 16 + l15) * 64 + lq * 8;
#pragma unroll
        for (int kk = 0; kk < 2; ++kk) { f.t[kk] = *(const bf16x8*)(tp + kk * 32); f.a[kk] = *(const bf16x8*)(ap + kk * 32); f.kt[kk] = *(const bf16x8*)(ktp + kk * 32); }
        const bf16_t* vp = VG + (size_t)u * 8192 + (mi * 16 + lq * 4) * 128 + sl * 32 + ni * 16 + l15;
#pragma unroll
        for (int j = 0; j < 4; ++j) f.v[j] = vp[j * 128];
        const float* vec = VEC + ((size_t)u * 2 + dir) * 256 + mi * 16 + lq * 4;
        f.rs1 = *(const float4*)(vec); f.rs2 = *(const float4*)(vec + 64); f.rs3 = *(const float4*)(vec + 128); f.bt = *(const float4*)(vec + 192);
        f.egl = EGL[(size_t)u * 2 + dir];
    };
    f32x4 Sacc[2];
    Sacc[0] = (f32x4){0.f, 0.f, 0.f, 0.f}; Sacc[1] = (f32x4){0.f, 0.f, 0.f, 0.f};
    DFrags cur, nxt;
    load(0, cur);
    __syncthreads();
#pragma unroll 1
    for (int s = 0; s < 36; ++s) {
        if (s + 1 < 36) load(s + 1, nxt);
        f32x4 kS = (f32x4){0.f, 0.f, 0.f, 0.f}, qS = (f32x4){0.f, 0.f, 0.f, 0.f};
#pragma unroll
        for (int kk = 0; kk < 4; ++kk) {
            const bf16x8 sb = *(const bf16x8*)(ST + (ni * 16 + l15) * SLD + kk * 32 + lq * 8);
            kS = __builtin_amdgcn_mfma_f32_16x16x32_bf16(cur.k[kk], sb, kS, 0, 0, 0);
            qS = __builtin_amdgcn_mfma_f32_16x16x32_bf16(cur.q[kk], sb, qS, 0, 0, 0);
        }
        {
            const float r0 = cur.bt.x * bf2f((bf16_t)cur.v[0]) - cur.rs1.x * kS[0];
            const float r1 = cur.bt.y * bf2f((bf16_t)cur.v[1]) - cur.rs1.y * kS[1];
            const float r2 = cur.bt.z * bf2f((bf16_t)cur.v[2]) - cur.rs1.z * kS[2];
            const float r3 = cur.bt.w * bf2f((bf16_t)cur.v[3]) - cur.rs1.w * kS[3];
            uint2 w; w.x = pack2(r0, r1); w.y = pack2(r2, r3);
            *(uint2*)(RT + (ni * 16 + l15) * RLD + mi * 16 + lq * 4) = w;
        }
        __syncthreads();
        f32x4 vn = (f32x4){0.f, 0.f, 0.f, 0.f};
#pragma unroll
        for (int kk = 0; kk < 2; ++kk) {
            const bf16x8 rb = *(const bf16x8*)(RT + (ni * 16 + l15) * RLD + kk * 32 + lq * 8);
            vn = __builtin_amdgcn_mfma_f32_16x16x32_bf16(cur.t[kk], rb, vn, 0, 0, 0);
        }
        {
            uint2 w; w.x = pack2(vn[0], vn[1]); w.y = pack2(vn[2], vn[3]);
            *(uint2*)(VNT + (ni * 16 + l15) * RLD + mi * 16 + lq * 4) = w;
            uint2 w2; w2.x = pack2(vn[0] * cur.rs3.x, vn[1] * cur.rs3.y); w2.y = pack2(vn[2] * cur.rs3.z, vn[3] * cur.rs3.w);
            *(uint2*)(VST + (ni * 16 + l15) * RLD + mi * 16 + lq * 4) = w2;
        }
        __syncthreads();
        f32x4 o;
        o[0] = cur.rs2.x * qS[0]; o[1] = cur.rs2.y * qS[1]; o[2] = cur.rs2.z * qS[2]; o[3] = cur.rs2.w * qS[3];
#pragma unroll
        for (int kk = 0; kk < 2; ++kk) {
            const bf16x8 vb = *(const bf16x8*)(VNT + (ni * 16 + l15) * RLD + kk * 32 + lq * 8);
            o = __builtin_amdgcn_mfma_f32_16x16x32_bf16(cur.a[kk], vb, o, 0, 0, 0);
        }
        {
            const int u = unit_of(s);
            const int cidx = u % 36;
            const int rowb = unit_row0(b, cidx) + mi * 16 + lq * 4;
            bf16_t* op = OA + (size_t)rowb * 512 + h * 128 + sl * 32 + ni * 16 + l15;
#pragma unroll
            for (int j = 0; j < 4; ++j) op[(size_t)j * 512] = f2bf(o[j]);
        }
#pragma unroll
        for (int n2 = 0; n2 < 2; ++n2) {
            Sacc[n2] = Sacc[n2] * cur.egl;
#pragma unroll
            for (int kk = 0; kk < 2; ++kk) {
                const bf16x8 vb = *(const bf16x8*)(VST + (n2 * 16 + l15) * RLD + kk * 32 + lq * 8);
                Sacc[n2] = __builtin_amdgcn_mfma_f32_16x16x32_bf16(cur.kt[kk], vb, Sacc[n2], 0, 0, 0);
            }
            uint2 w; w.x = pack2(Sacc[n2][0], Sacc[n2][1]); w.y = pack2(Sacc[n2][2], Sacc[n2][3]);
            *(uint2*)(ST + (n2 * 16 + l15) * SLD + wave * 16 + lq * 4) = w;
        }
        __syncthreads();
        cur = nxt;
    }
}
__device__ __forceinline__ void ph_scan(const Params& p, char* smem, int rep = 0) {
    for (int item = blockIdx.x; item < 16 + 256; item += gridDim.x) {
        if (item < 16) { if (!rep) lru_carry(p, item); }
        else delta_chain(p, item - 16, smem);
    }
}

__device__ __forceinline__ void ph_merge(const Params& p, char* smem) {
    const int tid = hide_tid(), lane = tid & 63, wave = tid >> 6;
    const bf16_t* Z = (const bf16_t*)(p.ws + OFF_Z);
    const bf16_t* OA0 = (const bf16_t*)(p.ws + OFF_OA);
    const bf16_t* OA1 = OA0 + (size_t)NT * 512;
    const bf16_t* HL0 = (const bf16_t*)(p.ws + OFF_HLOC);
    const bf16_t* HL1 = HL0 + (size_t)NT * 512;
    const bf16_t* AC0 = (const bf16_t*)(p.ws + OFF_ACUM);
    const bf16_t* AC1 = AC0 + (size_t)NT * 512;
    const float* CIN = (const float*)(p.ws + OFF_CIN);
    bf16_t* M = (bf16_t*)(p.ws + OFF_H);
    const float* onorm = p.in[I_ONORM];
    for (int row = blockIdx.x * 8 + wave; row < NT; row += gridDim.x * 8) {
#pragma unroll
        for (int h = 0; h < 4; ++h) {
            const int c = h * 128 + lane * 2;
            const unsigned u0 = *(const unsigned*)(OA0 + (size_t)row * 512 + c);
            const unsigned u1 = *(const unsigned*)(OA1 + (size_t)row * 512 + c);
            const float o0 = bf2f((bf16_t)(u0 & 0xffff)) + bf2f((bf16_t)(u1 & 0xffff));
            const float o1 = bf2f((bf16_t)(u0 >> 16)) + bf2f((bf16_t)(u1 >> 16));
            const float ss = wave_sum(o0 * o0 + o1 * o1);
            const float rinv = rsqrtf(ss * (1.f / 128.f) + EPSF);
            const unsigned gz = *(const unsigned*)(Z + (size_t)row * ZW + 1536 + c);
            const float y0 = o0 * rinv * onorm[lane * 2] * siluf_(bf2f((bf16_t)(gz & 0xffff)));
            const float y1 = o1 * rinv * onorm[lane * 2 + 1] * siluf_(bf2f((bf16_t)(gz >> 16)));
            *(unsigned*)(M + (size_t)row * 1024 + c) = pack2(y0, y1);
        }
        const int tl = row < NL ? (row >> 6) : 256 + ((row - NL) >> 6);
#pragma unroll
        for (int i = 0; i < 4; ++i) {
            const int c = i * 128 + lane * 2;
            const unsigned h0 = *(const unsigned*)(HL0 + (size_t)row * 512 + c), h1 = *(const unsigned*)(HL1 + (size_t)row * 512 + c);
            const unsigned a0 = *(const unsigned*)(AC0 + (size_t)row * 512 + c), a1 = *(const unsigned*)(AC1 + (size_t)row * 512 + c);
            const float2 c0 = *(const float2*)(CIN + ((size_t)0 * 288 + tl) * 512 + c);
            const float2 c1 = *(const float2*)(CIN + ((size_t)1 * 288 + tl) * 512 + c);
            const float hx = (bf2f((bf16_t)(h0 & 0xffff)) + bf2f((bf16_t)(a0 & 0xffff)) * c0.x) + (bf2f((bf16_t)(h1 & 0xffff)) + bf2f((bf16_t)(a1 & 0xffff)) * c1.x);
            const float hy = (bf2f((bf16_t)(h0 >> 16)) + bf2f((bf16_t)(a0 >> 16)) * c0.y) + (bf2f((bf16_t)(h1 >> 16)) + bf2f((bf16_t)(a1 >> 16)) * c1.y);
            const unsigned yz = *(const unsigned*)(Z + (size_t)row * ZW + 2560 + c);
            const float y0 = hx * geluf_(bf2f((bf16_t)(yz & 0xffff)));
            const float y1 = hy * geluf_(bf2f((bf16_t)(yz >> 16)));
            *(unsigned*)(M + (size_t)row * 1024 + 512 + c) = pack2(y0, y1);
        }
    }
}

__device__ __forceinline__ void ph_qkprep(const Params& p, char* smem) {
    const int tid = hide_tid(), lane = tid & 63, wave = tid >> 6;
    const bf16_t* ZQ = (const bf16_t*)(p.ws + OFF_ZQ);
    const bf16_t* ZC = (const bf16_t*)(p.ws + OFF_ZC);
    bf16_t* QA = (bf16_t*)(p.ws + OFF_QA);
    bf16_t* KA = (bf16_t*)(p.ws + OFF_KA);
    bf16_t* VT = (bf16_t*)(p.ws + OFF_VT);
    const float* qn = p.in[I_QNORM];
    const float* kn = p.in[I_KNORM];
    for (int row = blockIdx.x * 8 + wave; row < NT; row += gridDim.x * 8) {
        const bool lat = row < NL;
        const int b = lat ? (row >> 11) : ((row - NL) >> 8);
        const int t = lat ? (row & 2047) : ((row - NL) & 255);
        const int key = lat ? t : (SEQ + t);
        float cs = 1.f, sn = 0.f;
        if (lat) {
            const int f = lane & 31;
            const float pos = (lane < 32) ? (float)(t >> 6) : (float)(t & 63);
            const float inv = expf(-(float)f * (1.f / 32.f) * 9.210340371976184f);
            sincosf(pos * inv, &sn, &cs);
        }
        const bf16_t* src = lat ? ZQ + (size_t)row * 1536 : ZC + (size_t)(row - NL) * 512;
        const int koff = lat ? 1024 : 0;
        if (lat) {
#pragma unroll
            for (int h = 0; h < 8; ++h) {
                const unsigned u = *(const unsigned*)(src + h * 128 + lane * 2);
                float x1 = bf2f((bf16_t)(u & 0xffff)), x2 = bf2f((bf16_t)(u >> 16));
                const float ss = wave_sum(x1 * x1 + x2 * x2);
                const float rinv = rsqrtf(ss * (1.f / 128.f) + EPSF);
                x1 *= rinv * qn[lane * 2]; x2 *= rinv * qn[lane * 2 + 1];
                const float y1 = x1 * cs - x2 * sn;
                const float y2 = x1 * sn + x2 * cs;
                *(unsigned*)(QA + (size_t)row * 1024 + h * 128 + lane * 2) = pack2(y1, y2);
            }
        }
#pragma unroll
        for (int kh = 0; kh < 2; ++kh) {
            const unsigned u = *(const unsigned*)(src + koff + kh * 128 + lane * 2);
            float x1 = bf2f((bf16_t)(u & 0xffff)), x2 = bf2f((bf16_t)(u >> 16));
            const float ss = wave_sum(x1 * x1 + x2 * x2);
            const float rinv = rsqrtf(ss * (1.f / 128.f) + EPSF);
            x1 *= rinv * kn[lane * 2]; x2 *= rinv * kn[lane * 2 + 1];
            const float y1 = x1 * cs - x2 * sn;
            const float y2 = x1 * sn + x2 * cs;
            *(unsigned*)(KA + ((size_t)(b * 2 + kh) * TSEQ + key) * 128 + lane * 2) = pack2(y1, y2);
            const unsigned uv = *(const unsigned*)(src + koff + 256 + kh * 128 + lane * 2);
            *(unsigned*)(VT + ((size_t)(b * 2 + kh) * TSEQ + key) * 128 + lane * 2) = uv;
        }
    }
}

namespace att {
constexpr int D = 128, NW = 8, QBLK = 32, KVBLK = 64;
constexpr float SCALE = 0.088388347648318440f;
constexpr float THR = 8.f;
constexpr int LDQ = 1024, LDK = 128, LDO = 1024;
constexpr size_t SHM_V = KVBLK * D * 2, SHM_K = KVBLK * D * 2, SHM_ATTN = 2 * SHM_V + 2 * SHM_K + NW * 64 * 4;
using s16x4  = __attribute__((ext_vector_type(4))) short;
using f32x16 = __attribute__((ext_vector_type(16))) float;
using u32x4  = __attribute__((ext_vector_type(4))) unsigned;
#define KSWZ(row, colB) ((row) * 256 + ((colB) ^ (((row) & 7) << 4)))
#define SBAR() __builtin_amdgcn_sched_barrier(0)
__device__ __forceinline__ int crow(int r, int hi) { return (r & 3) + 8 * (r >> 2) + 4 * hi; }
__device__ __forceinline__ unsigned cvtpk(float lo, float hi) {
  unsigned r; asm volatile("v_cvt_pk_bf16_f32 %0, %1, %2" : "=v"(r) : "v"(lo), "v"(hi)); return r;
}
__device__ __forceinline__ void partialSM(f32x16& p0, f32x16& p1, float& m_reg, float& mn, float& alpha) {
  constexpr float C = SCALE * 1.4426950408889634f;
  float pmax = p0[0];
#pragma unroll
  for (int r = 1; r < 16; ++r) pmax = fmaxf(pmax, p0[r]);
#pragma unroll
  for (int r = 0; r < 16; ++r) pmax = fmaxf(pmax, p1[r]);
  { auto rr = __builtin_amdgcn_permlane32_swap(__float_as_uint(pmax), __float_as_uint(pmax), false, false);
    pmax = fmaxf(__uint_as_float(rr[0]), __uint_as_float(rr[1])); }
  if (__builtin_expect(__all(pmax - m_reg <= THR / SCALE), 1)) { mn = m_reg; alpha = 1.f; }
  else { mn = fmaxf(m_reg, pmax); alpha = __builtin_amdgcn_exp2f((m_reg - mn) * C); m_reg = mn; }
  float mnC = -mn * C;
#pragma unroll
  for (int r = 0; r < 16; ++r) p0[r] = fmaf(p0[r], C, mnC);
#pragma unroll
  for (int r = 0; r < 16; ++r) p1[r] = fmaf(p1[r], C, mnC);
#pragma unroll
  for (int r = 0; r < 16; ++r) p0[r] = __builtin_amdgcn_exp2f(p0[r]);
}
__device__ __forceinline__ void finishSM(f32x16& p0, f32x16& p1, float alpha, float& l_reg, bf16x8& pa0, bf16x8& pa1, bf16x8& pa2, bf16x8& pa3) {
#pragma unroll
  for (int r = 0; r < 16; ++r) p1[r] = __builtin_amdgcn_exp2f(p1[r]);
  float ps = 0;
#pragma unroll
  for (int r = 0; r < 16; ++r) ps += p0[r];
#pragma unroll
  for (int r = 0; r < 16; ++r) ps += p1[r];
  { auto rr = __builtin_amdgcn_permlane32_swap(__float_as_uint(ps), __float_as_uint(ps), false, false);
    ps = __uint_as_float(rr[0]) + __uint_as_float(rr[1]); }
  l_reg = l_reg * alpha + ps;
#define PK4(P, BASE, OUT) do { unsigned a0 = cvtpk(P[BASE + 0], P[BASE + 1]), a1 = cvtpk(P[BASE + 2], P[BASE + 3]);   \
    unsigned b0 = cvtpk(P[BASE + 4], P[BASE + 5]), b1 = cvtpk(P[BASE + 6], P[BASE + 7]);                              \
    auto r0 = __builtin_amdgcn_permlane32_swap(a0, b0, false, false); auto r1 = __builtin_amdgcn_permlane32_swap(a1, b1, false, false); \
    u32x4 w = {r0[0], r1[0], r0[1], r1[1]}; OUT = *reinterpret_cast<bf16x8*>(&w); } while (0)
  PK4(p0, 0, pa0); PK4(p0, 8, pa1); PK4(p1, 0, pa2); PK4(p1, 8, pa3);
#undef PK4
}
__device__ __forceinline__ void qkt(f32x16& p0, f32x16& p1, const bf16_t* Ks, const bf16x8* qr, int r32, int hi) {
  p0 = f32x16{}; p1 = f32x16{};
#pragma unroll
  for (int d0 = 0; d0 < 8; ++d0) { int cb = (d0 * 16 + hi * 8) * 2;
    bf16x8 b0 = *reinterpret_cast<const bf16x8*>((const char*)Ks + KSWZ(r32, cb));
    bf16x8 b1 = *reinterpret_cast<const bf16x8*>((const char*)Ks + KSWZ(32 + r32, cb));
    p0 = __builtin_amdgcn_mfma_f32_32x32x16_bf16(b0, qr[d0], p0, 0, 0, 0);
    p1 = __builtin_amdgcn_mfma_f32_32x32x16_bf16(b1, qr[d0], p1, 0, 0, 0); }
}
__device__ __forceinline__ int v_st(int k, int c) { const int kk = (k & ~0xC) | ((k & 4) << 1) | ((k & 8) >> 1); return ((kk >> 3) * 4 + (c >> 5)) * 512 + ((kk & 7) * 32 + (c & 31)) * 2; }
__device__ __forceinline__ int v_rd_base(int lane) { return ((lane & 3) << 3) | (((lane >> 2) & 3) << 6) | (((lane >> 4) & 1) << 5) | (((lane >> 5) & 1) << 8); }
constexpr int v_rd_off(int d0, int ks, int half) { return d0 * 512 + ks * 4096 + half * 2048; }
template <int OFF> __device__ __forceinline__ s16x4 tr_read(int vb) {
  s16x4 r; asm volatile("ds_read_b64_tr_b16 %0, %1 offset:%2" : "=&v"(r) : "v"(vb), "i"(OFF) : "memory"); return r;
}
template <int D0> __device__ __forceinline__ void pv_one(f32x16& od, int vb, bf16x8 pa0, bf16x8 pa1, bf16x8 pa2, bf16x8 pa3) {
  const s16x4 l0 = tr_read<v_rd_off(D0, 0, 0)>(vb), h0 = tr_read<v_rd_off(D0, 0, 1)>(vb), l1 = tr_read<v_rd_off(D0, 1, 0)>(vb), h1 = tr_read<v_rd_off(D0, 1, 1)>(vb);
  const s16x4 l2 = tr_read<v_rd_off(D0, 2, 0)>(vb), h2 = tr_read<v_rd_off(D0, 2, 1)>(vb), l3 = tr_read<v_rd_off(D0, 3, 0)>(vb), h3 = tr_read<v_rd_off(D0, 3, 1)>(vb);
  asm volatile("s_waitcnt lgkmcnt(0)" ::: "memory"); SBAR();
#define PK(L, H) (bf16x8){L[0], L[1], L[2], L[3], H[0], H[1], H[2], H[3]}
  od = __builtin_amdgcn_mfma_f32_32x32x16_bf16(pa0, PK(l0, h0), od, 0, 0, 0);
  od = __builtin_amdgcn_mfma_f32_32x32x16_bf16(pa1, PK(l1, h1), od, 0, 0, 0);
  od = __builtin_amdgcn_mfma_f32_32x32x16_bf16(pa2, PK(l2, h2), od, 0, 0, 0);
  od = __builtin_amdgcn_mfma_f32_32x32x16_bf16(pa3, PK(l3, h3), od, 0, 0, 0);
#undef PK
}
__device__ __forceinline__ void pv_d0(f32x16* o, int vb, bf16x8 pa0, bf16x8 pa1, bf16x8 pa2, bf16x8 pa3) {
  pv_one<0>(o[0], vb, pa0, pa1, pa2, pa3); pv_one<1>(o[1], vb, pa0, pa1, pa2, pa3); pv_one<2>(o[2], vb, pa0, pa1, pa2, pa3); pv_one<3>(o[3], vb, pa0, pa1, pa2, pa3);
}
__device__ __forceinline__ void attn_dense_body(const bf16_t* __restrict__ Qb, const bf16_t* __restrict__ Kh, const bf16_t* __restrict__ Vh,
                                                bf16_t* __restrict__ Ob, int seq, char* lds) {
  const int tid = hide_tid(), wid = tid >> 6, lane = tid & 63, r32 = lane & 31, hi = lane >> 5;
  bf16_t* V_lds = (bf16_t*)lds; bf16_t* K_lds = (bf16_t*)(lds + 2 * SHM_V);
  float* ws = (float*)(lds + 2 * SHM_V + 2 * SHM_K) + wid * 64; float* li_l = ws; float* al_l = ws + 32;
  float m_reg = -1e30f, l_reg = 0; f32x16 o[4] = {}; bf16x8 qr[8];
  const bf16_t* Qw = Qb + (long)(wid * QBLK + r32) * LDQ + hi * 8;
#pragma unroll
  for (int d0 = 0; d0 < 8; ++d0) qr[d0] = *reinterpret_cast<const bf16x8*>(Qw + d0 * 16);
  const int sr = tid >> 4, sc = (tid & 15) * 8, vst0 = v_st(sr, sc), vst1 = v_st(32 + sr, sc);
  const int vb0 = (int)(uintptr_t)V_lds + v_rd_base(lane);
  struct { bf16x8 vs0, vs1, ks0, ks1; } sr_[2];
#define SLOAD(i, k0) do { sr_[i].vs0 = *reinterpret_cast<const bf16x8*>(&Vh[(long)((k0) + sr) * LDK + sc]); sr_[i].vs1 = *reinterpret_cast<const bf16x8*>(&Vh[(long)((k0) + 32 + sr) * LDK + sc]); \
    sr_[i].ks0 = *reinterpret_cast<const bf16x8*>(&Kh[(long)((k0) + sr) * LDK + sc]); sr_[i].ks1 = *reinterpret_cast<const bf16x8*>(&Kh[(long)((k0) + 32 + sr) * LDK + sc]); } while (0)
#define SWRITE(b, i) do { *(bf16x8*)((char*)V_lds + (b) * SHM_V + vst0) = sr_[i].vs0;          \
    *(bf16x8*)((char*)V_lds + (b) * SHM_V + vst1) = sr_[i].vs1; int kc = sc * 2;               \
    *(bf16x8*)((char*)K_lds + (b) * SHM_K + KSWZ(sr, kc)) = sr_[i].ks0;                       \
    *(bf16x8*)((char*)K_lds + (b) * SHM_K + KSWZ(32 + sr, kc)) = sr_[i].ks1; } while (0)
#define SWAIT() asm volatile("s_waitcnt vmcnt(4)" ::: "memory")
#define RESC(a) do { if (__any((a) < 1.f)) { if (hi == 0) al_l[r32] = (a); asm volatile("s_waitcnt lgkmcnt(0)" ::: "memory"); \
    _Pragma("unroll") for (int d = 0; d < 4; ++d) _Pragma("unroll") for (int r = 0; r < 16; ++r) o[d][r] *= al_l[crow(r, hi)]; } } while (0)
  f32x16 pA0, pA1, pB0, pB1; float mnA, mnB, alA, alB; bf16x8 pa0, pa1, pa2, pa3; const int NKT = seq / KVBLK;
  constexpr int SE = 0, SO = 1;
  SLOAD(SE, 0); asm volatile("s_waitcnt vmcnt(0)" ::: "memory"); SWRITE(0, SE); __syncthreads();
  qkt(pA0, pA1, K_lds, qr, r32, hi); partialSM(pA0, pA1, m_reg, mnA, alA);
  SLOAD(SO, KVBLK); if (2 < NKT) SLOAD(SE, 2 * KVBLK);
  SWAIT(); SWRITE(1, SO); __syncthreads();
  for (int j = 1; j + 1 < NKT; j += 2) {
    SBAR(); qkt(pB0, pB1, (bf16_t*)((char*)K_lds + SHM_K), qr, r32, hi);
    finishSM(pA0, pA1, alA, l_reg, pa0, pa1, pa2, pa3); SBAR();
    SLOAD(SO, (j + 2) * KVBLK); SBAR();
    pv_d0(o, vb0, pa0, pa1, pa2, pa3); partialSM(pB0, pB1, m_reg, mnB, alB);
    __syncthreads(); SWAIT(); SWRITE(0, SE);
    RESC(alB); __syncthreads();
    SBAR(); qkt(pA0, pA1, K_lds, qr, r32, hi);
    finishSM(pB0, pB1, alB, l_reg, pa0, pa1, pa2, pa3); SBAR();
    if (j + 3 < NKT) SLOAD(SE, (j + 3) * KVBLK); SBAR();
    pv_d0(o, vb0 + (int)SHM_V, pa0, pa1, pa2, pa3); partialSM(pA0, pA1, m_reg, mnA, alA);
    __syncthreads(); SWAIT(); SWRITE(1, SO);
    RESC(alA); __syncthreads();
  }
  SBAR(); qkt(pB0, pB1, (bf16_t*)((char*)K_lds + SHM_K), qr, r32, hi);
  finishSM(pA0, pA1, alA, l_reg, pa0, pa1, pa2, pa3); SBAR();
  pv_d0(o, vb0, pa0, pa1, pa2, pa3); partialSM(pB0, pB1, m_reg, mnB, alB);
  __syncthreads(); RESC(alB);
  finishSM(pB0, pB1, alB, l_reg, pa0, pa1, pa2, pa3); SBAR();
  pv_d0(o, vb0 + (int)SHM_V, pa0, pa1, pa2, pa3);
  if (hi == 0) li_l[r32] = l_reg; asm volatile("s_waitcnt lgkmcnt(0)" ::: "memory");
  bf16_t* Ow = Ob + (long)(wid * QBLK) * LDO + r32;
#pragma unroll
  for (int r = 0; r < 16; ++r) { const int orow = crow(r, hi); const float rl = __builtin_amdgcn_rcpf(li_l[orow]);
#pragma unroll
    for (int d0 = 0; d0 < 4; ++d0) Ow[(long)orow * LDO + d0 * 32] = (bf16_t)cvtpk(o[d0][r] * rl, 0.f); }
  __syncthreads();
#undef SLOAD
#undef SWRITE
#undef SWAIT
#undef RESC
}
#undef KSWZ
#undef SBAR
}

__device__ __forceinline__ void ph_attn(const Params& p, char* smem) {
    const bf16_t* QA = (const bf16_t*)(p.ws + OFF_QA);
    const bf16_t* KA = (const bf16_t*)(p.ws + OFF_KA);
    const bf16_t* VA = (const bf16_t*)(p.ws + OFF_VT);
    bf16_t* O = (bf16_t*)(p.ws + OFF_O);
    for (int item = blockIdx.x; item < 8 * 8 * 8; item += gridDim.x) {
        const int qb = item & 7, h = (item >> 3) & 7, b = item >> 6, kvh = h >> 2;
        const size_t qoff = (size_t)(b * SEQ + qb * 256) * 1024 + h * 128;
        const size_t koff = (size_t)(b * 2 + kvh) * TSEQ * 128;
        att::attn_dense_body(QA + qoff, KA + koff, VA + koff, O + qoff, TSEQ, smem);
    }
}

#define N_PHASES 19
template <int PH>
__device__ __forceinline__ void run_phase(const Params& p, LAS unsigned char* lds, int rep = 0) {
    char* smem = (char*)lds;
    if (PH == 0) { if (!(rep && REP_SUB == 2)) ph_ada(p, smem); if (!(rep && REP_SUB == 1)) cvt_dense(p, smem); }
    else if (PH == 1) ph_rows<0>(p, smem);
    else if (PH == 2) ph_gemm_in(p, lds);
    else if (PH == 3) ph_prep(p, smem, rep);
    else if (PH == 4) ph_scan(p, smem, rep);
    else if (PH == 5) ph_merge(p, smem);
    else if (PH == 6) { ph_gemm_out<0>(p, lds); cvt_moe(p, 0, smem); }
    else if (PH == 7) ph_rows<1>(p, smem);
    else if (PH == 8) ph_moe_up(p, 0, lds);
    else if (PH == 9) ph_moe_down(p, 0, lds);
    else if (PH == 10) ph_rows<2>(p, smem);
    else if (PH == 11) ph_gemm_qkv(p, lds);
    else if (PH == 12) { if (!(rep && REP_SUB == 2)) ph_qkprep(p, smem); if (!(rep && REP_SUB == 1)) cvt_moe(p, 1, smem); }
    else if (PH == 13) ph_attn(p, smem);
    else if (PH == 14) ph_gemm_out<1>(p, lds);
    else if (PH == 15) ph_rows<3>(p, smem);
    else if (PH == 16) ph_moe_up(p, 1, lds);
    else if (PH == 17) ph_moe_down(p, 1, lds);
    else if (PH == 18) ph_rows<4>(p, smem);
}

extern __shared__ __attribute__((aligned(16))) unsigned char dyn_lds[];
template <int PH>
__global__ void __launch_bounds__(NTHR, 2) k_phase(Params p) {
    run_phase<PH>(p, (LAS unsigned char*)dyn_lds);
}

#if ONE_LAUNCH
template <int PH>
__device__ __forceinline__ void run_all(const Params& p, LAS unsigned char* lds, const XcdBarrier& bar) {
    if (PH == REP_PH) {
        int nrep = 2; asm volatile("" : "+s"(nrep));
#pragma unroll 1
        for (int r = 0; r < nrep; ++r) { run_phase<PH>(p, lds, r); if (r + 1 < nrep) xcd_barrier(bar); }
    } else run_phase<PH>(p, lds);
    if (PH + 1 < N_PHASES) {
        xcd_barrier(bar);
        run_all<(PH + 1 < N_PHASES) ? PH + 1 : PH>(p, lds, bar);
    }
}
template <>
__device__ __forceinline__ void run_all<N_PHASES - 1>(const Params& p, LAS unsigned char* lds, const XcdBarrier& bar) {
    run_phase<N_PHASES - 1>(p, lds);
}

__global__ void __launch_bounds__(NTHR, 2) k_mega(Params p) {
    LAS unsigned char* lds = (LAS unsigned char*)dyn_lds;
    if (threadIdx.x < 4) ((LAS unsigned*)(lds + LDS_XB))[threadIdx.x] = 0u;
    __syncthreads();
    XcdBarrier bar = xcd_barrier_post((unsigned*)(p.ws + OFF_ZERO), (volatile LAS unsigned*)(lds + LDS_XB));
    run_all<0>(p, lds, bar);
}
#endif

template <int PH>
static void launch_phases(const Params& p, hipStream_t stream) {
    static bool attr_set = false;
    if (!attr_set) { (void)hipFuncSetAttribute((const void*)k_phase<PH>, hipFuncAttributeMaxDynamicSharedMemorySize, DYN_LDS); attr_set = true; }
    hipLaunchKernelGGL(k_phase<PH>, dim3(256), dim3(NTHR), DYN_LDS, stream, p);
    if constexpr (PH + 1 < N_PHASES) launch_phases<PH + 1>(p, stream);
}

extern "C" void kernel_launch(void* const* d_in, const int* in_sizes, int n_in, void* d_out, int out_size, void* d_ws,
                              size_t ws_size, hipStream_t stream) {
    Params p{};
    for (int i = 0; i < 32; ++i) p.in[i] = (const float*)d_in[i];
    p.out = (float*)d_out;
    p.ws = (char*)d_ws;
    (void)hipMemsetAsync(d_ws, 0, ZERO_BYTES, stream);
#if ONE_LAUNCH
    static int grid = 0;
    if (!grid) {
        int dev = 0, cus = 0, per_cu = 0;
        (void)hipGetDevice(&dev);
        (void)hipDeviceGetAttribute(&cus, hipDeviceAttributeMultiprocessorCount, dev);
        (void)hipFuncSetAttribute((const void*)k_mega, hipFuncAttributeMaxDynamicSharedMemorySize, DYN_LDS);
        (void)hipOccupancyMaxActiveBlocksPerMultiprocessor(&per_cu, k_mega, NTHR, DYN_LDS);
        if (cus <= 0) cus = 256;
        grid = cus * (per_cu < 1 ? per_cu : 1);
        if (grid <= 0) grid = cus;
    }
    hipLaunchKernelGGL(k_mega, dim3(grid), dim3(NTHR), DYN_LDS, stream, p);
#else
    launch_phases<0>(p, stream);
#endif
}
```

```cpp
#include <hip/hip_runtime.h>
#include <stdint.h>

#ifndef ONE_LAUNCH
#define ONE_LAUNCH 1
#endif
#ifndef REP_SUB
#define REP_SUB 0
#endif
#ifndef REP_PH
#define REP_PH -1
#endif

typedef unsigned short bf16_t;
typedef __attribute__((ext_vector_type(8))) short bf16x8;
typedef __attribute__((ext_vector_type(4))) float f32x4;

#define D_MODEL 1024
#define BATCH 8
#define SEQ 2048
#define CTXL 256
#define NL (BATCH * SEQ)
#define NC (BATCH * CTXL)
#define NT (NL + NC)
#define AB_PROJ 3088
#define TSEQ (SEQ + CTXL)
#define EPSF 1e-6f
#define NTHR 512

enum { I_X = 0, I_C, I_CTX, I_CCTX, I_ADAW, I_ADAB, I_NORM1, I_NORM2, I_FNORM, I_ABWIN, I_CONVQKV, I_ALOG, I_DTB,
       I_ONORM, I_CONVX, I_RGWR, I_RGBR, I_RGWI, I_RGBI, I_RGLAM, I_ABWOUT, I_ATWQKV, I_QNORM, I_KNORM, I_ATWOUT,
       I_WGRP, I_BGRP, I_WEXP, I_BEXP, I_WGATE, I_WUP, I_WDOWN };

#define AL256(x) (((size_t)(x) + 255) & ~(size_t)255)
#define ZW 3072
#define OFF_ZERO 0
#define ZERO_BYTES 65536
#define OFF_CNT 16384
#define OFF_MOD (OFF_ZERO + ZERO_BYTES)
#define OFF_X AL256(OFF_MOD + 2 * 9 * 6144 * 4)
#define OFF_H AL256(OFF_X + (size_t)NT * 1024 * 4)
#define OFF_Z AL256(OFF_H + (size_t)NT * 1024 * 2)
#define OFF_BTIN AL256(OFF_Z + (size_t)NT * ZW * 2)
#define OFF_BTOUT0 AL256(OFF_BTIN + (size_t)3072 * 1024 * 2)
#define OFF_BTQKV AL256(OFF_BTOUT0 + (size_t)1024 * 1024 * 2)
#define OFF_BTOUT1 AL256(OFF_BTQKV + (size_t)1536 * 1024 * 2)
#define OFF_WRG AL256(OFF_BTOUT1 + (size_t)1024 * 1024 * 2)
#define OFF_WSEL AL256(OFF_WRG + (size_t)8 * 256 * 64 * 2)
#define OFF_LIST AL256(OFF_WSEL + (size_t)2 * NT * 4)
#define OFF_R1 AL256(OFF_LIST + (size_t)32 * NT * 4)
#define OFF_GATES OFF_R1
#define OFF_QG AL256(OFF_GATES + (size_t)NT * 16 * 4)
#define OFF_KG AL256(OFF_QG + (size_t)1152 * 8192 * 2)
#define OFF_VG AL256(OFF_KG + (size_t)1152 * 8192 * 2)
#define OFF_KTG AL256(OFF_VG + (size_t)1152 * 8192 * 2)
#define OFF_TT AL256(OFF_KTG + (size_t)1152 * 8192 * 2)
#define OFF_ATT AL256(OFF_TT + (size_t)1152 * 2 * 4096 * 2)
#define OFF_VEC AL256(OFF_ATT + (size_t)1152 * 2 * 4096 * 2)
#define OFF_EGL AL256(OFF_VEC + (size_t)1152 * 2 * 256 * 4)
#define OFF_HLOC AL256(OFF_EGL + (size_t)1152 * 2 * 4)
#define OFF_ACUM AL256(OFF_HLOC + (size_t)2 * NT * 512 * 2)
#define OFF_LTOT AL256(OFF_ACUM + (size_t)2 * NT * 512 * 2)
#define OFF_CIN AL256(OFF_LTOT + (size_t)2 * 288 * 512 * 2 * 4)
#define OFF_OA AL256(OFF_CIN + (size_t)2 * 288 * 512 * 4)
#define OFF_END AL256(OFF_OA + (size_t)2 * NT * 512 * 2)
#define OFF_BTGU OFF_R1
#define OFF_BTD AL256(OFF_BTGU + (size_t)32 * 1024 * 1024 * 2)
#define OFF_ACT AL256(OFF_BTD + (size_t)32 * 1024 * 512 * 2)
#define OFF_YE AL256(OFF_ACT + (size_t)2 * NT * 512 * 2)
#define OFF_ZQ OFF_Z
#define OFF_ZC (OFF_Z + (size_t)NL * 1536 * 2)
#define OFF_QA (OFF_ZC + (size_t)NC * 512 * 2)
#define OFF_KA (OFF_QA + (size_t)NL * 1024 * 2)
#define OFF_VT (OFF_KA + (size_t)8 * 2 * TSEQ * 128 * 2)
#define OFF_O OFF_H
static_assert(OFF_YE + (size_t)2 * NT * 1024 * 2 <= OFF_END, "MoE scratch must fit in R1");
static_assert(OFF_VT + (size_t)8 * 2 * TSEQ * 128 * 2 <= OFF_BTIN, "attention buffers must fit in the Z region");
static_assert(OFF_END < (size_t)530 * 1024 * 1024, "workspace budget");

#define DYN_LDS (131072 + 1024)
#define LDS_XB 131072
#define LDS_PRE (131072 + 64)

struct Params {
    const float* in[32];
    float* out;
    char* ws;
};

__device__ __forceinline__ bf16_t f2bf(float f) {
    unsigned u = __float_as_uint(f);
    u += 0x7fffu + ((u >> 16) & 1u);
    return (bf16_t)(u >> 16);
}
__device__ __forceinline__ float bf2f(bf16_t h) { return __uint_as_float(((unsigned)h) << 16); }
__device__ __forceinline__ unsigned pack2(float a, float b) { return (unsigned)f2bf(a) | ((unsigned)f2bf(b) << 16); }
__device__ __forceinline__ float frcp_(float x) { return __builtin_amdgcn_rcpf(x); }
__device__ __forceinline__ float sigmoidf_(float x) { return frcp_(1.f + __expf(-x)); }
__device__ __forceinline__ float siluf_(float x) { return x * frcp_(1.f + __expf(-x)); }
__device__ __forceinline__ float softplusf_(float x) { return x > 20.f ? x : log1pf(__expf(x)); }
__device__ __forceinline__ float geluf_(float x) {
    const float u = 0.7978845608028654f * (x + 0.044715f * x * x * x);
    return x * frcp_(1.f + __expf(-2.f * u));
}
__device__ __forceinline__ float neg_expm1_small(float x) {
    float q = 1.f / 5040.f;
    q = q * x + 1.f / 720.f; q = q * x + 1.f / 120.f; q = q * x + 1.f / 24.f; q = q * x + 1.f / 6.f; q = q * x + 0.5f; q = q * x + 1.f;
    return x < -0.5f ? 1.f - __expf(x) : -x * q;
}
#define DPP_F(v, ctrl) __int_as_float(__builtin_amdgcn_update_dpp(0, __float_as_int(v), ctrl, 0xF, 0xF, true))
__device__ __forceinline__ float row16_sum(float v) {
    v += DPP_F(v, 0xB1);
    v += DPP_F(v, 0x4E);
    v += DPP_F(v, 0x141);
    v += DPP_F(v, 0x140);
    return v;
}
__device__ __forceinline__ float row16_max(float v) {
    v = fmaxf(v, DPP_F(v, 0xB1)); v = fmaxf(v, DPP_F(v, 0x4E)); v = fmaxf(v, DPP_F(v, 0x141)); v = fmaxf(v, DPP_F(v, 0x140));
    return v;
}
__device__ __forceinline__ float wave_sum(float v) {
    v = row16_sum(v);
    const float a = __int_as_float(__builtin_amdgcn_readlane(__float_as_int(v), 0));
    const float b = __int_as_float(__builtin_amdgcn_readlane(__float_as_int(v), 16));
    const float c = __int_as_float(__builtin_amdgcn_readlane(__float_as_int(v), 32));
    const float d = __int_as_float(__builtin_amdgcn_readlane(__float_as_int(v), 48));
    return (a + b) + (c + d);
}
__device__ __forceinline__ int hide_tid() { int t = threadIdx.x; asm volatile("" : "+v"(t)); return t & 511; }
__device__ __forceinline__ int scan_row(int s, int dir, int b) {
    if (s < CTXL) { const int t = dir ? (CTXL - 1 - s) : s; return NL + b * CTXL + t; }
    const int u = s - CTXL; const int t = dir ? (SEQ - 1 - u) : u; return b * SEQ + t;
}

#define XB_TMO      128
#define XB_XCNT(j)  (256  + 64 * (j))
#define XB_XSUB(j)  (1280 + 64 * (j))
#define XB_XGEN(j)  (2304 + 64 * (j))
#define XB_TOP      3328
#define XB_TOPGEN   3392
#define XCD_BAR_WORDS 3456
#define XB_SPIN_CAP (1u << 22)
#define LAS __attribute__((address_space(3)))

__device__ __forceinline__ unsigned xb_ld(unsigned* p)              { return __hip_atomic_load(p, __ATOMIC_RELAXED, __HIP_MEMORY_SCOPE_AGENT); }
__device__ __forceinline__ unsigned xb_add(unsigned* p, unsigned v) { return __hip_atomic_fetch_add(p, v, __ATOMIC_RELAXED, __HIP_MEMORY_SCOPE_AGENT); }
__device__ __forceinline__ unsigned xb_xcc_id() { return (unsigned)__builtin_amdgcn_s_getreg((3 << 11) | 20) & 0xFu; }
#define XB_SPIN(cond, bar) do { unsigned _sp = 0; while (cond) { __builtin_amdgcn_s_sleep(1); \
    if ((++_sp & 255u) == 0u) { if (xb_ld(&(bar)[XB_TMO])) break; if (_sp > XB_SPIN_CAP) { atomicAdd(&(bar)[XB_TMO], 1u); break; } } } } while (0)

struct XcdBarrier {
    unsigned* bar; unsigned x;
    volatile LAS unsigned* st;
};
__device__ __forceinline__ XcdBarrier xcd_barrier_post(unsigned* bar, volatile LAS unsigned* st) {
    XcdBarrier b; b.bar = bar; b.x = xb_xcc_id(); b.st = st;
    if (threadIdx.x == 0) (void)xb_add(&bar[XB_XCNT(b.x)], 1u);
    return b;
}
__device__ __forceinline__ void xcd_barrier_complete(unsigned* bar, unsigned x, unsigned& nloc, unsigned& nx) {
    const unsigned G = gridDim.x * gridDim.y * gridDim.z;
    unsigned sum, cnt, mine, sp = 0u;
    for (;;) {
        sum = 0u; cnt = 0u; mine = 0u;
#pragma unroll
        for (unsigned j = 0; j < 16; ++j) { const unsigned c = xb_ld(&bar[XB_XCNT(j)]); sum += c; cnt += (c > 0u) ? 1u : 0u; mine = (j == x) ? c : mine; }
        if (sum == G) break;
        __builtin_amdgcn_s_sleep(1);
        if ((++sp & 255u) == 0u) { if (xb_ld(&bar[XB_TMO])) break; if (sp > XB_SPIN_CAP) { atomicAdd(&bar[XB_TMO], 1u); break; } }
    }
    nloc = mine > 0u ? mine : 1u; nx = cnt > 0u ? cnt : 1u;
}
__device__ __forceinline__ void xcd_barrier(const XcdBarrier& b) {
    asm volatile("s_waitcnt vmcnt(0)" ::: "memory");
    __syncthreads();
    if (threadIdx.x == 0) {
        unsigned* bar = b.bar;
        __builtin_amdgcn_s_waitcnt(0);
        unsigned nloc = b.st[0], nx = b.st[1];
        if (nloc == 0u) { xcd_barrier_complete(bar, b.x, nloc, nx); b.st[0] = nloc; b.st[1] = nx; }
        const unsigned old = xb_add(&bar[XB_XSUB(b.x)], 1u);
        const unsigned gen = old / nloc;
        if (old + 1u == (gen + 1u) * nloc) {
            __builtin_amdgcn_fence(__ATOMIC_RELEASE, "agent");
            asm volatile("s_waitcnt vmcnt(0)" ::: "memory");
            const unsigned og = xb_add(&bar[XB_TOP], 1u);
            const unsigned tg = og / nx;
            if (og + 1u == (tg + 1u) * nx) xb_add(&bar[XB_TOPGEN], 1u);
            else XB_SPIN(xb_ld(&bar[XB_TOPGEN]) == tg, bar);
            __builtin_amdgcn_fence(__ATOMIC_ACQUIRE, "agent");
            xb_add(&bar[XB_XGEN(b.x)], 1u);
            asm volatile("s_waitcnt vmcnt(0)" ::: "memory");
        } else {
            XB_SPIN(xb_ld(&bar[XB_XGEN(b.x)]) == gen, bar);
            __builtin_amdgcn_fence(__ATOMIC_ACQUIRE, "agent");
            asm volatile("s_waitcnt vmcnt(0)" ::: "memory");
        }
    }
    __syncthreads();
}

template <int NB, class RowPtr, class Epi>
__device__ __forceinline__ void gemm_tile(RowPtr rowptr, const float* __restrict__ B0, const float* __restrict__ B1,
                                          int ldb, int K, int n0, int N, Epi epi, char* smem) {
    constexpr int LDS_LD = 72;
    bf16_t* As = (bf16_t*)smem;
    bf16_t* Bs0 = As + 128 * LDS_LD;
    bf16_t* Bs1 = Bs0 + 128 * LDS_LD;
    const int tid = hide_tid(), lane = tid & 63, wave = tid >> 6;
    const int wm = wave >> 1, wn = wave & 1;
    const int l15 = lane & 15, lq = lane >> 4;

    const bf16_t* arow0 = rowptr(tid >> 3);
    const bf16_t* arow1 = rowptr((tid >> 3) + 64);
    const int akc = (tid & 7) * 8;
    const int bn = tid & 127, bkg = tid >> 7;
    const bool bok = (n0 + bn) < N;
    const float* b0p = B0 + (size_t)(bkg * 8) * ldb + n0 + bn;
    const float* b1p = (NB == 2) ? (B1 + (size_t)(bkg * 8) * ldb + n0 + bn) : nullptr;

    f32x4 acc0[2][4], acc1[2][4];
#pragma unroll
    for (int i = 0; i < 2; ++i)
#pragma unroll
        for (int j = 0; j < 4; ++j) { acc0[i][j] = (f32x4){0.f, 0.f, 0.f, 0.f}; acc1[i][j] = (f32x4){0.f, 0.f, 0.f, 0.f}; }

    uint4 ra0, ra1;
    float rb0[16], rb1[16];
    const int nk = K >> 6;
    auto load_regs = [&](int kt) {
        const int k0 = kt * 64;
        ra0 = arow0 ? *(const uint4*)(arow0 + k0 + akc) : make_uint4(0, 0, 0, 0);
        ra1 = arow1 ? *(const uint4*)(arow1 + k0 + akc) : make_uint4(0, 0, 0, 0);
#pragma unroll
        for (int r = 0; r < 2; ++r)
#pragma unroll
            for (int j = 0; j < 8; ++j) {
                const size_t o = (size_t)(k0 + r * 32 + j) * ldb;
                rb0[r * 8 + j] = bok ? b0p[o] : 0.f;
                if (NB == 2) rb1[r * 8 + j] = bok ? b1p[o] : 0.f;
            }
    };
    load_regs(0);
    for (int kt = 0; kt < nk; ++kt) {
        __syncthreads();
        *(uint4*)(As + (tid >> 3) * LDS_LD + akc) = ra0;
        *(uint4*)(As + ((tid >> 3) + 64) * LDS_LD + akc) = ra1;
#pragma unroll
        for (int r = 0; r < 2; ++r) {
            uint4 w;
            w.x = pack2(rb0[r * 8 + 0], rb0[r * 8 + 1]); w.y = pack2(rb0[r * 8 + 2], rb0[r * 8 + 3]);
            w.z = pack2(rb0[r * 8 + 4], rb0[r * 8 + 5]); w.w = pack2(rb0[r * 8 + 6], rb0[r * 8 + 7]);
            *(uint4*)(Bs0 + bn * LDS_LD + bkg * 8 + r * 32) = w;
            if (NB == 2) {
                w.x = pack2(rb1[r * 8 + 0], rb1[r * 8 + 1]); w.y = pack2(rb1[r * 8 + 2], rb1[r * 8 + 3]);
                w.z = pack2(rb1[r * 8 + 4], rb1[r * 8 + 5]); w.w = pack2(rb1[r * 8 + 6], rb1[r * 8 + 7]);
                *(uint4*)(Bs1 + bn * LDS_LD + bkg * 8 + r * 32) = w;
            }
        }
        __syncthreads();
        if (kt + 1 < nk) load_regs(kt + 1);
#pragma unroll
        for (int kk = 0; kk < 2; ++kk) {
            bf16x8 af[2];
#pragma unroll
            for (int mi = 0; mi < 2; ++mi)
                af[mi] = *(const bf16x8*)(As + (wm * 32 + mi * 16 + l15) * LDS_LD + kk * 32 + lq * 8);
#pragma unroll
            for (int ni = 0; ni < 4; ++ni) {
                const bf16x8 bf0 = *(const bf16x8*)(Bs0 + (wn * 64 + ni * 16 + l15) * LDS_LD + kk * 32 + lq * 8);
#pragma unroll
                for (int mi = 0; mi < 2; ++mi) acc0[mi][ni] = __builtin_amdgcn_mfma_f32_16x16x32_bf16(af[mi], bf0, acc0[mi][ni], 0, 0, 0);
                if (NB == 2) {
                    const bf16x8 bf1 = *(const bf16x8*)(Bs1 + (wn * 64 + ni * 16 + l15) * LDS_LD + kk * 32 + lq * 8);
#pragma unroll
                    for (int mi = 0; mi < 2; ++mi) acc1[mi][ni] = __builtin_amdgcn_mfma_f32_16x16x32_bf16(af[mi], bf1, acc1[mi][ni], 0, 0, 0);
                }
            }
        }
    }
#pragma unroll
    for (int mi = 0; mi < 2; ++mi)
#pragma unroll
        for (int ni = 0; ni < 4; ++ni) {
            const int n = n0 + wn * 64 + ni * 16 + l15;
            if (n < N) {
#pragma unroll
                for (int j = 0; j < 4; ++j) epi(wm * 32 + mi * 16 + lq * 4 + j, n, acc0[mi][ni][j], acc1[mi][ni][j]);
            }
        }
}

namespace g8 {
constexpr int BM = 256, BK = 64, HALF = 128, HTB = HALF * BK * 2, STAGE_BYTES = 8 * HTB, NXCD = 8, WGM = 8;
typedef unsigned u32x4 __attribute__((ext_vector_type(4)));
__device__ __forceinline__ int lds_byte(int r, int c) { const int st = (r >> 4) * 2 + (c >> 5), rr = r & 15, cc = c & 31, ob = rr * 64 + cc * 2; return st * 1024 + (ob ^ (((ob >> 9) & 1) << 5)); }
__device__ __forceinline__ void stage_rc(int b, int& R, int& C) { const int st = b / 1024, sb = b % 1024, swz = sb ^ (((sb >> 9) & 1) << 5); R = (st >> 1) * 16 + swz / 64; C = (st & 1) * 32 + (swz % 64) / 2; }
__device__ __forceinline__ int perm32(int rho) { const int n = rho >> 4, i = rho & 15; return 8 * (i >> 2) + 4 * n + (i & 3); }
__device__ __forceinline__ unsigned cvt_pk_bf16(float lo, float hi) { unsigned r; asm volatile("v_cvt_pk_bf16_f32 %0, %1, %2" : "=v"(r) : "v"(lo), "v"(hi)); return r; }

struct Unit {
    const char* A;
    const char* Bt;
    const int* lst;
    int mv;
    int pm, pn;
    int aux;
};

__device__ __forceinline__ void static_order(int wgid, int nM, int nN, int& pm, int& pn) {
    const int nwg = nM * nN;
    { const int q = nwg / NXCD, r = nwg % NXCD, xcd = wgid % NXCD, off = wgid / NXCD; wgid = (xcd < r ? xcd * (q + 1) : r * (q + 1) + (xcd - r) * q) + off; }
    const int nig = WGM * nN, gid = wgid / nig, fm = gid * WGM, gsz = (nM - fm) < WGM ? (nM - fm) : WGM;
    pm = fm + ((wgid % nig) % gsz); pn = (wgid % nig) / gsz;
}

template <bool GATHER, int GSHIFT, class Epi, class Sched>
__device__ __forceinline__ void gemm_phase(LAS unsigned char* lds, const int K, const Sched& S, const Epi& E) {
    const int tid = hide_tid(), wid = __builtin_amdgcn_readfirstlane(tid >> 6), lane = tid & 63, wr = wid >> 2, wc = wid & 3, fr = lane & 15, fq = lane >> 4;
    const int nt = K / BK;
    unsigned voffA[2], voffB[2];
#pragma unroll
    for (int i = 0; i < 2; ++i) { int R, C; stage_rc(tid * 16 + i * 8192, R, C); const int Rb = Epi::PERM ? ((R & ~31) + perm32(R & 31)) : R;
        voffA[i] = (unsigned)(R * K + C) * 2u; voffB[i] = (unsigned)(Rb * K + C) * 2u; }
    const size_t kstep = (size_t)(BK * 2);
    const size_t hstep = (size_t)HALF * K * 2;
    const unsigned ldsw = (unsigned)wid * 1024u;
    const int aoff = lds_byte(wr * 64 + fr, fq * 8), boff = lds_byte(wc * 32 + fr, fq * 8);
    unsigned gcur[2][2];
    auto gather_offs = [&](const Unit& u, unsigned (&g)[2][2]) {
#pragma unroll
        for (int h = 0; h < 2; ++h)
#pragma unroll
            for (int i = 0; i < 2; ++i) { int R, C; stage_rc(tid * 16 + i * 8192, R, C); int idx = h * 128 + R; idx = idx < u.mv ? idx : u.mv - 1;
                g[h][i] = (unsigned)(u.lst[idx] >> GSHIFT) * (unsigned)(K * 2) + (unsigned)(C * 2); }
    };
#define G8_SA(b, h) (((b) * 2 + (h)) * HTB)
#define G8_SB(b, h) ((4 + (b) * 2 + (h)) * HTB)
#define G8_STAGE(bufoff, gbase, voff) do { _Pragma("unroll") for (int _i = 0; _i < 2; ++_i) \
        __builtin_amdgcn_global_load_lds((const unsigned*)((const char*)(gbase) + (voff)[_i]), (LAS unsigned*)(lds + (bufoff) + ldsw + _i * 8192), 16, 0, 0); } while (0)
#define G8_LDA(dst, b, h) do { _Pragma("unroll") for (int m = 0; m < 4; ++m) _Pragma("unroll") for (int k = 0; k < 2; ++k) dst[m][k] = *(const LAS bf16x8*)(lds + G8_SA(b, h) + aoff + m * 2048 + k * 1024); } while (0)
#define G8_LDB(dst, b, h) do { _Pragma("unroll") for (int n = 0; n < 2; ++n) _Pragma("unroll") for (int k = 0; k < 2; ++k) dst[n][k] = *(const LAS bf16x8*)(lds + G8_SB(b, h) + boff + n * 2048 + k * 1024); } while (0)
#define G8_MMA(ai, bj, At, Bt) do { __builtin_amdgcn_s_setprio(1); _Pragma("unroll") for (int m = 0; m < 4; ++m) _Pragma("unroll") for (int n = 0; n < 2; ++n) _Pragma("unroll") for (int k = 0; k < 2; ++k) \
        acc[ai][bj][m][n] = __builtin_amdgcn_mfma_f32_16x16x32_bf16(Bt[n][k], At[m][k], acc[ai][bj][m][n], 0, 0, 0); __builtin_amdgcn_s_setprio(0); } while (0)
#define G8_WAIT_V(n) asm volatile("s_waitcnt vmcnt(" #n ")" ::: "memory")
#define G8_WAIT_L(n) asm volatile("s_waitcnt lgkmcnt(" #n ")" ::: "memory")
#define G8_BAR __builtin_amdgcn_s_barrier()
#define G8_SCHED __builtin_amdgcn_sched_barrier(0)
    Unit cur, nxt; int ui = 0;
    if (!S.next(0, cur)) return;
    f32x4 acc[2][2][4][2];
#pragma unroll
    for (int a = 0; a < 2; ++a)
#pragma unroll
        for (int b = 0; b < 2; ++b)
#pragma unroll
            for (int m = 0; m < 4; ++m)
#pragma unroll
                for (int n = 0; n < 2; ++n) acc[a][b][m][n] = (f32x4){0.f, 0.f, 0.f, 0.f};
    bf16x8 At[4][2], B0[2][2], B1[2][2];
    const char* cA = cur.A; const char* cB = cur.Bt;
    if (GATHER) gather_offs(cur, gcur);
#define G8_STAGE_A(bufoff, kp, h, g) do { if (GATHER) G8_STAGE(bufoff, kp, (g)[h]); else G8_STAGE(bufoff, (kp) + (h) * hstep, voffA); } while (0)
    G8_STAGE(G8_SB(0, 0), cB, voffB); G8_STAGE_A(G8_SA(0, 0), cA, 0, gcur); G8_STAGE(G8_SB(0, 1), cB + hstep, voffB); G8_STAGE_A(G8_SA(0, 1), cA, 1, gcur);
    if (wr == 1) G8_BAR;
    G8_WAIT_V(4); G8_BAR;
    G8_STAGE(G8_SB(1, 0), cB + kstep, voffB); G8_STAGE_A(G8_SA(1, 0), cA + kstep, 0, gcur); G8_STAGE(G8_SB(1, 1), cB + hstep + kstep, voffB);
    G8_WAIT_V(6); G8_BAR;
    for (;;) {
        const bool has_next = S.next(ui + 1, nxt);
        const char* nA = has_next ? nxt.A : cA; const char* nB = has_next ? nxt.Bt : cB;
        for (int t = 0; t < nt; t += 2) {
            const bool last = (t == nt - 2);
            const char* a1 = cA + (size_t)(t + 1) * kstep;
            const char* a2 = last ? nA : cA + (size_t)(t + 2) * kstep; const char* b2 = last ? nB : cB + (size_t)(t + 2) * kstep;
            const char* a3 = a2 + kstep; const char* b3 = b2 + kstep;
            G8_LDB(B0, 0, 0); G8_SCHED; G8_LDA(At, 0, 0); G8_STAGE_A(G8_SA(1, 1), a1, 1, gcur);
            G8_WAIT_L(8); G8_BAR; G8_WAIT_L(0); G8_MMA(0, 0, At, B0); G8_BAR; G8_SCHED;
            if (GATHER) { if (last && has_next) gather_offs(nxt, gcur); }
            G8_LDB(B1, 0, 1); G8_STAGE(G8_SB(0, 0), b2, voffB);
            G8_BAR; G8_WAIT_L(0); G8_MMA(0, 1, At, B1); G8_BAR;
            G8_LDA(At, 0, 1); G8_STAGE_A(G8_SA(0, 0), a2, 0, gcur);
            G8_BAR; G8_WAIT_L(0); G8_MMA(1, 0, At, B0); G8_BAR; G8_SCHED;
            G8_STAGE(G8_SB(0, 1), b2 + hstep, voffB);
            G8_WAIT_V(6); G8_BAR; G8_MMA(1, 1, At, B1); G8_BAR;
            G8_LDB(B0, 1, 0); G8_SCHED; G8_LDA(At, 1, 0); G8_STAGE_A(G8_SA(0, 1), a2, 1, gcur);
            G8_WAIT_L(8); G8_BAR; G8_WAIT_L(0); G8_MMA(0, 0, At, B0); G8_BAR; G8_SCHED;
            G8_LDB(B1, 1, 1); G8_STAGE(G8_SB(1, 0), b3, voffB);
            G8_BAR; G8_WAIT_L(0); G8_MMA(0, 1, At, B1); G8_BAR;
            G8_LDA(At, 1, 1); G8_STAGE_A(G8_SA(1, 0), a3, 0, gcur);
            G8_BAR; G8_WAIT_L(0); G8_MMA(1, 0, At, B0); G8_BAR; G8_SCHED;
            G8_STAGE(G8_SB(1, 1), b3 + hstep, voffB);
            G8_WAIT_V(6); G8_BAR; G8_MMA(1, 1, At, B1); G8_BAR;
        }
        E(acc, cur, wr, wc, fr, fq);
        if (!has_next) break;
#pragma unroll
        for (int a = 0; a < 2; ++a)
#pragma unroll
            for (int b = 0; b < 2; ++b)
#pragma unroll
                for (int m = 0; m < 4; ++m)
#pragma unroll
                    for (int n = 0; n < 2; ++n) acc[a][b][m][n] = (f32x4){0.f, 0.f, 0.f, 0.f};
        cur = nxt; cA = nA; cB = nB; ++ui;
    }
    G8_WAIT_V(0);
    if (wr == 0) G8_BAR;
    G8_BAR;
#undef G8_SA
#undef G8_SB
#undef G8_STAGE
#undef G8_STAGE_A
#undef G8_LDA
#undef G8_LDB
#undef G8_MMA
#undef G8_WAIT_V
#undef G8_WAIT_L
#undef G8_BAR
#undef G8_SCHED
}

struct EpiBf16 {
    static constexpr bool PERM = true;
    bf16_t* O0; int ldc0; bf16_t* O1; int ldc1;
    __device__ __forceinline__ void operator()(const f32x4 (&acc)[2][2][4][2], const Unit& u, int wr, int wc, int fr, int fq) const {
        bf16_t* O = u.aux ? O1 : O0; const int ldc = u.aux ? ldc1 : ldc0;
        const int row0 = u.pm * BM + wr * 64 + fr, col0 = u.pn * BM + wc * 32 + 8 * fq;
#pragma unroll
        for (int ai = 0; ai < 2; ++ai)
#pragma unroll
            for (int m = 0; m < 4; ++m) { bf16_t* rowp = O + (size_t)(row0 + ai * HALF + m * 16) * ldc + col0;
#pragma unroll
                for (int bj = 0; bj < 2; ++bj) { const f32x4 v0 = acc[ai][bj][m][0], v1 = acc[ai][bj][m][1];
                    u32x4 w; w.x = cvt_pk_bf16(v0[0], v0[1]); w.y = cvt_pk_bf16(v0[2], v0[3]); w.z = cvt_pk_bf16(v1[0], v1[1]); w.w = cvt_pk_bf16(v1[2], v1[3]);
                    *(u32x4*)(rowp + bj * HALF) = w; } }
    }
};
struct EpiResid {
    static constexpr bool PERM = false;
    float* X; const float* g1base;
    __device__ __forceinline__ void operator()(const f32x4 (&acc)[2][2][4][2], const Unit& u, int wr, int wc, int fr, int fq) const {
        const int rt = u.pm * BM;
        const int mr = rt < NL ? (rt >> 11) : 8;
        const float* g1 = g1base + (size_t)mr * 6144;
        const int row0 = rt + wr * 64 + fr, col0 = u.pn * BM + wc * 32 + 4 * fq;
        f32x4 gv[2][2];
#pragma unroll
        for (int bj = 0; bj < 2; ++bj)
#pragma unroll
            for (int n = 0; n < 2; ++n) gv[bj][n] = *(const f32x4*)(g1 + col0 + bj * HALF + n * 16);
#pragma unroll
        for (int ai = 0; ai < 2; ++ai)
#pragma unroll
            for (int m = 0; m < 4; ++m) { float* rowp = X + (size_t)(row0 + ai * HALF + m * 16) * 1024 + col0;
#pragma unroll
                for (int bj = 0; bj < 2; ++bj)
#pragma unroll
                    for (int n = 0; n < 2; ++n) { f32x4* q = (f32x4*)(rowp + bj * HALF + n * 16); *q = *q + gv[bj][n] * acc[ai][bj][m][n]; } }
    }
};
struct EpiMoeUp {
    static constexpr bool PERM = true;
    bf16_t* ACT; const float* WSEL;
    __device__ __forceinline__ void operator()(const f32x4 (&acc)[2][2][4][2], const Unit& u, int wr, int wc, int fr, int fq) const {
        const int col0 = u.pn * 128 + wc * 32 + 8 * fq;
#pragma unroll
        for (int ai = 0; ai < 2; ++ai)
#pragma unroll
            for (int m = 0; m < 4; ++m) {
                const int ridx = ai * HALF + wr * 64 + m * 16 + fr;
                if (ridx < u.mv) {
                    const int r = u.lst[ridx];
                    const float w = WSEL[r];
                    float o[8];
#pragma unroll
                    for (int n = 0; n < 2; ++n)
#pragma unroll
                        for (int j = 0; j < 4; ++j) { const float g = acc[ai][0][m][n][j], uu = acc[ai][1][m][n][j]; o[n * 4 + j] = g / (1.f + __expf(-g)) * uu * w; }
                    u32x4 wv; wv.x = cvt_pk_bf16(o[0], o[1]); wv.y = cvt_pk_bf16(o[2], o[3]); wv.z = cvt_pk_bf16(o[4], o[5]); wv.w = cvt_pk_bf16(o[6], o[7]);
                    *(u32x4*)(ACT + (size_t)r * 512 + col0) = wv;
                }
            }
    }
};
struct EpiMoeDown {
    static constexpr bool PERM = true;
    bf16_t* YE;
    __device__ __forceinline__ void operator()(const f32x4 (&acc)[2][2][4][2], const Unit& u, int wr, int wc, int fr, int fq) const {
        const int col0 = u.pn * BM + wc * 32 + 8 * fq;
#pragma unroll
        for (int ai = 0; ai < 2; ++ai)
#pragma unroll
            for (int m = 0; m < 4; ++m) {
                const int ridx = ai * HALF + wr * 64 + m * 16 + fr;
                if (ridx < u.mv) {
                    const int r = u.lst[ridx];
#pragma unroll
                    for (int bj = 0; bj < 2; ++bj) { const f32x4 v0 = acc[ai][bj][m][0], v1 = acc[ai][bj][m][1];
                        u32x4 w; w.x = cvt_pk_bf16(v0[0], v0[1]); w.y = cvt_pk_bf16(v0[2], v0[3]); w.z = cvt_pk_bf16(v1[0], v1[1]); w.w = cvt_pk_bf16(v1[2], v1[3]);
                        *(u32x4*)(YE + (size_t)r * 1024 + col0 + bj * HALF) = w; }
                }
            }
    }
};

struct DenseSched {
    const char* A; const char* Bt; int nM, nN, K, G, c;
    __device__ __forceinline__ bool next(int i, Unit& u) const {
        const int L = i * G + c; if (L >= nM * nN) return false;
        int pm, pn; static_order(L, nM, nN, pm, pn);
        u.A = A + (size_t)pm * BM * K * 2; u.Bt = Bt + (size_t)pn * BM * K * 2; u.lst = nullptr; u.mv = 256; u.pm = pm; u.pn = pn; u.aux = 0;
        return true;
    }
};
struct QkvSched {
    const char* H; const char* Bt; int G, c;
    __device__ __forceinline__ bool next(int i, Unit& u) const {
        const int L = i * G + c;
        if (L < 384) { int pm, pn; static_order(L, 64, 6, pm, pn);
            u.A = H + (size_t)pm * BM * 2048; u.Bt = Bt + (size_t)pn * BM * 2048; u.pm = pm; u.pn = pn; u.aux = 0; }
        else if (L < 400) { const int q = L - 384, pm = q >> 1, pn = q & 1;
            u.A = H + (size_t)(NL + pm * BM) * 2048; u.Bt = Bt + (size_t)(1024 + pn * BM) * 2048; u.pm = pm; u.pn = pn; u.aux = 1; }
        else return false;
        u.lst = nullptr; u.mv = 256;
        return true;
    }
};
template <bool UP>
struct MoeSched {
    char* ws; int L; const LAS int* pre; int G, c;
    static constexpr int K = UP ? 1024 : 512;
    __device__ __forceinline__ bool next(int i, Unit& u) const {
        const int Lx = i * G + c; const int total = pre[32] << 2; if (Lx >= total) return false;
        const int mt = Lx >> 2, pn = Lx & 3;
        int e = 0;
#pragma unroll 1
        for (int j = 1; j < 32; ++j) if (pre[j] <= mt) e = j;
        const int m0 = (mt - pre[e]) * BM;
        int mv = (int)((const unsigned*)(ws + OFF_CNT))[L * 32 + e] - m0; mv = mv > 256 ? 256 : mv;
        u.A = ws + (UP ? OFF_H : OFF_ACT);
        u.Bt = ws + (UP ? OFF_BTGU : OFF_BTD) + ((size_t)e * 1024 + (size_t)pn * BM) * K * 2;
        u.lst = (const int*)(ws + OFF_LIST) + (size_t)e * NT + m0; u.mv = mv; u.pm = mt; u.pn = pn; u.aux = e;
        return true;
    }
};
}

__device__ __forceinline__ void cvt_job(const float* __restrict__ src, int ld, bf16_t* __restrict__ dst, int K, int k0, int tid) {
    const int n = tid & 127, kq = tid >> 7;
    const float* sp = src + (size_t)(k0 + kq * 32) * ld + n;
    float v[32];
#pragma unroll
    for (int r = 0; r < 32; ++r) v[r] = sp[(size_t)r * ld];
    bf16_t* dp = dst + (size_t)n * K + k0 + kq * 32;
#pragma unroll
    for (int q = 0; q < 4; ++q) {
        uint4 w;
        w.x = pack2(v[q * 8 + 0], v[q * 8 + 1]); w.y = pack2(v[q * 8 + 2], v[q * 8 + 3]);
        w.z = pack2(v[q * 8 + 4], v[q * 8 + 5]); w.w = pack2(v[q * 8 + 6], v[q * 8 + 7]);
        *(uint4*)(dp + q * 8) = w;
    }
}
__device__ __forceinline__ void cvt_dense(const Params& p, char* smem) {
    const int tid = hide_tid();
    {
        bf16_t* WRG = (bf16_t*)(p.ws + OFF_WRG);
        for (int i = blockIdx.x * NTHR + tid; i < 8 * 256 * 64; i += gridDim.x * NTHR) {
            const int k = i & 63, n = (i >> 6) & 255, g = i >> 14;
            const int d = n >> 7, ri = (n >> 6) & 1, j = n & 63;
            WRG[i] = f2bf(p.in[ri ? I_RGWI : I_RGWR][((size_t)(d * 8 + g) * 64 + k) * 64 + j]);
        }
    }
    for (int j = blockIdx.x; j < (24 + 8 + 12 + 8) * 8; j += gridDim.x) {
        const int grp = j >> 3, kb = j & 7;
        const float* src; int ld; bf16_t* dst;
        if (grp < 24) { const int c0 = grp * 128; src = p.in[I_ABWIN] + (c0 < 2048 ? c0 : c0 + 16); ld = AB_PROJ; dst = (bf16_t*)(p.ws + OFF_BTIN) + (size_t)c0 * 1024; }
        else if (grp < 32) { const int c0 = (grp - 24) * 128; src = p.in[I_ABWOUT] + c0; ld = 1024; dst = (bf16_t*)(p.ws + OFF_BTOUT0) + (size_t)c0 * 1024; }
        else if (grp < 44) { const int c0 = (grp - 32) * 128; src = p.in[I_ATWQKV] + c0; ld = 1536; dst = (bf16_t*)(p.ws + OFF_BTQKV) + (size_t)c0 * 1024; }
        else { const int c0 = (grp - 44) * 128; src = p.in[I_ATWOUT] + c0; ld = 1024; dst = (bf16_t*)(p.ws + OFF_BTOUT1) + (size_t)c0 * 1024; }
        cvt_job(src, ld, dst, 1024, kb * 128, tid);
    }
}
__device__ __forceinline__ void cvt_moe(const Params& p, int L, char* smem) {
    const int tid = hide_tid();
    for (int j = blockIdx.x; j < 32 * 96; j += gridDim.x) {
        const int e = j / 96, q = j % 96;
        if (q < 64) {
            const int up = q >> 5, grp = (q >> 3) & 3, kb = q & 7;
            const float* src = p.in[up ? I_WUP : I_WGATE] + ((size_t)L * 32 + e) * 1024 * 512 + grp * 128;
            bf16_t* dst = (bf16_t*)(p.ws + OFF_BTGU) + ((size_t)e * 1024 + grp * 256 + up * 128) * 1024;
            cvt_job(src, 512, dst, 1024, kb * 128, tid);
        } else {
            const int q2 = q - 64, grp = q2 >> 2, kb = q2 & 3;
            const float* src = p.in[I_WDOWN] + ((size_t)L * 32 + e) * 512 * 1024 + grp * 128;
            bf16_t* dst = (bf16_t*)(p.ws + OFF_BTD) + ((size_t)e * 1024 + grp * 128) * 512;
            cvt_job(src, 1024, dst, 512, kb * 128, tid);
        }
    }
}

__device__ __forceinline__ void ph_ada(const Params& p, char* smem) {
    const int tid = hide_tid();
    float* scond = (float*)smem;
    float* red = scond + 9 * 1024;
    float* MOD = (float*)(p.ws + OFF_MOD);
    for (int i = tid; i < 9 * 1024; i += NTHR) {
        const int r = i >> 10, k = i & 1023;
        const float v = r < 8 ? p.in[I_C][r * 1024 + k] : p.in[I_CCTX][k];
        scond[i] = siluf_(v);
    }
    __syncthreads();
    for (int item = blockIdx.x; item < 192; item += gridDim.x) {
        const int l = item / 96, cg = item % 96;
        const int kq = tid >> 6, cl = tid & 63, col = cg * 64 + cl;
        const float* W = p.in[I_ADAW] + (size_t)l * 1024 * 6144;
        float acc[9];
#pragma unroll
        for (int r = 0; r < 9; ++r) acc[r] = 0.f;
        for (int k0 = kq * 128; k0 < kq * 128 + 128; k0 += 16) {
            float w[16];
#pragma unroll
            for (int u = 0; u < 16; ++u) w[u] = W[(size_t)(k0 + u) * 6144 + col];
#pragma unroll
            for (int u = 0; u < 16; ++u)
#pragma unroll
                for (int r = 0; r < 9; ++r) acc[r] += scond[r * 1024 + k0 + u] * w[u];
        }
#pragma unroll
        for (int r = 0; r < 9; ++r) red[(kq * 9 + r) * 64 + cl] = acc[r];
        __syncthreads();
        for (int i = tid; i < 9 * 64; i += NTHR) {
            const int r = i >> 6, cc = i & 63;
            float s = 0.f;
#pragma unroll
            for (int q = 0; q < 8; ++q) s += red[(q * 9 + r) * 64 + cc];
            MOD[(size_t)(l * 9 + r) * 6144 + cg * 64 + cc] = s + p.in[I_ADAB][l * 6144 + cg * 64 + cc];
        }
        __syncthreads();
    }
}

#define HS_LD 1028
template <int MODE>
__device__ __forceinline__ void ph_rows(const Params& p, char* smem) {
    const int tid = hide_tid(), lane = tid & 63, wave = tid >> 6;
    constexpr int L = (MODE >= 2) ? 1 : 0;
    constexpr int NROWS = (MODE >= 3) ? NL : NT;
    constexpr bool ROUTER = (MODE == 1 || MODE == 3);
    constexpr bool GATEP = (MODE == 0);
    constexpr bool LOGITS = ROUTER || GATEP;
    constexpr int NTL = GATEP ? 1 : 3;
    float* GATES = (float*)(p.ws + OFF_GATES);
    float* X = (float*)(p.ws + OFF_X);
    bf16_t* H = (bf16_t*)(p.ws + OFF_H);
    const bf16_t* YE = (const bf16_t*)(p.ws + OFF_YE);
    const float* MOD = (const float*)(p.ws + OFF_MOD);
    float* hsb = (float*)smem;
    float* part = hsb + 16 * HS_LD;
    float* lgs = part + 8 * 16 * 48;
    unsigned* cnt = (unsigned*)(p.ws + OFF_CNT) + L * 32;
    int* LIST = (int*)(p.ws + OFF_LIST);
    float* WSEL = (float*)(p.ws + OFF_WSEL);

    for (int base = blockIdx.x * 16; base < NROWS; base += gridDim.x * 16) {
#pragma unroll 1
        for (int rr = 0; rr < 2; ++rr) {
            const int row = base + wave * 2 + rr;
            float* hs = hsb + (wave * 2 + rr) * HS_LD;
            const int mr = row < NL ? (row >> 11) : 8;
            float v[16];
            if (MODE == 0) {
                const float* src = row < NL ? p.in[I_X] + (size_t)row * 1024 : p.in[I_CTX] + (size_t)(row - NL) * 1024;
#pragma unroll
                for (int i = 0; i < 4; ++i) {
                    const float4 t = *(const float4*)(src + i * 256 + lane * 4);
                    v[i * 4 + 0] = t.x; v[i * 4 + 1] = t.y; v[i * 4 + 2] = t.z; v[i * 4 + 3] = t.w;
                }
            } else {
#pragma unroll
                for (int i = 0; i < 4; ++i) {
                    const float4 t = *(const float4*)(X + (size_t)row * 1024 + i * 256 + lane * 4);
                    v[i * 4 + 0] = t.x; v[i * 4 + 1] = t.y; v[i * 4 + 2] = t.z; v[i * 4 + 3] = t.w;
                }
            }
            if (MODE == 2 || MODE == 4) {
                constexpr int LP = (MODE == 2) ? 0 : 1;
                const float* g2 = MOD + (size_t)(LP * 9 + mr) * 6144 + 5 * 1024;
#pragma unroll
                for (int i = 0; i < 4; ++i) {
                    const int c = i * 256 + lane * 4;
                    const uint2 a = *(const uint2*)(YE + (size_t)(2 * row) * 1024 + c);
                    const uint2 b = *(const uint2*)(YE + (size_t)(2 * row + 1) * 1024 + c);
                    const float4 g = *(const float4*)(g2 + c);
                    v[i * 4 + 0] += g.x * (bf2f((bf16_t)(a.x & 0xffff)) + bf2f((bf16_t)(b.x & 0xffff)));
                    v[i * 4 + 1] += g.y * (bf2f((bf16_t)(a.x >> 16)) + bf2f((bf16_t)(b.x >> 16)));
                    v[i * 4 + 2] += g.z * (bf2f((bf16_t)(a.y & 0xffff)) + bf2f((bf16_t)(b.y & 0xffff)));
                    v[i * 4 + 3] += g.w * (bf2f((bf16_t)(a.y >> 16)) + bf2f((bf16_t)(b.y >> 16)));
                }
            }
            if (MODE == 0 || MODE == 2) {
#pragma unroll
                for (int i = 0; i < 4; ++i)
                    *(float4*)(X + (size_t)row * 1024 + i * 256 + lane * 4) = make_float4(v[i * 4], v[i * 4 + 1], v[i * 4 + 2], v[i * 4 + 3]);
            }
            float ss = 0.f;
#pragma unroll
            for (int i = 0; i < 16; ++i) ss += v[i] * v[i];
            ss = wave_sum(ss);
            const float rinv = rsqrtf(ss * (1.f / 1024.f) + EPSF);
            if (MODE == 4) {
#pragma unroll
                for (int i = 0; i < 4; ++i) {
                    const int c = i * 256 + lane * 4;
                    const float4 w = *(const float4*)(p.in[I_FNORM] + c);
                    *(float4*)(p.out + (size_t)row * 1024 + c) =
                        make_float4(v[i * 4] * rinv * w.x, v[i * 4 + 1] * rinv * w.y, v[i * 4 + 2] * rinv * w.z, v[i * 4 + 3] * rinv * w.w);
                }
            } else {
                constexpr int SH = (MODE == 0 || MODE == 2) ? 0 : 3;
                const float* gain = p.in[(MODE == 0 || MODE == 2) ? I_NORM1 : I_NORM2] + L * 1024;
                const float* sh = MOD + (size_t)(L * 9 + mr) * 6144 + SH * 1024;
                const float* sc = sh + 1024;
#pragma unroll
                for (int i = 0; i < 4; ++i) {
                    const int c = i * 256 + lane * 4;
                    const float4 w = *(const float4*)(gain + c);
                    const float4 s1 = *(const float4*)(sc + c);
                    const float4 s0 = *(const float4*)(sh + c);
                    float h0 = v[i * 4 + 0] * rinv * w.x * (1.f + s1.x) + s0.x;
                    float h1 = v[i * 4 + 1] * rinv * w.y * (1.f + s1.y) + s0.y;
                    float h2 = v[i * 4 + 2] * rinv * w.z * (1.f + s1.z) + s0.z;
                    float h3 = v[i * 4 + 3] * rinv * w.w * (1.f + s1.w) + s0.w;
                    uint2 o; o.x = pack2(h0, h1); o.y = pack2(h2, h3);
                    *(uint2*)(H + (size_t)row * 1024 + c) = o;
                    if (LOGITS) *(float4*)(hs + c) = make_float4(h0, h1, h2, h3);
                }
            }
        }
        if (LOGITS) {
            __syncthreads();
            const int l15 = lane & 15, lq = lane >> 4;
            const float* wp[NTL]; int wld[NTL];
#pragma unroll
            for (int nt = 0; nt < NTL; ++nt) {
                const int c = nt * 16 + l15;
                if (GATEP) { wp[nt] = p.in[I_ABWIN] + 2048 + c; wld[nt] = AB_PROJ; }
                else if (c < 4) { wp[nt] = p.in[I_WGRP] + (size_t)L * 1024 * 4 + c; wld[nt] = 4; }
                else if (c < 36) { wp[nt] = p.in[I_WEXP] + (size_t)L * 1024 * 32 + (c - 4); wld[nt] = 32; }
                else { wp[nt] = nullptr; wld[nt] = 0; }
            }
            f32x4 acc[NTL];
#pragma unroll
            for (int nt = 0; nt < NTL; ++nt) acc[nt] = (f32x4){0.f, 0.f, 0.f, 0.f};
            const float* arow = hsb + l15 * HS_LD + wave * 128 + lq;
#pragma unroll 8
            for (int kk = 0; kk < 32; ++kk) {
                const int k = wave * 128 + kk * 4 + lq;
                const float a = arow[kk * 4];
#pragma unroll
                for (int nt = 0; nt < NTL; ++nt) {
                    const float bv = wp[nt] ? wp[nt][(size_t)k * wld[nt]] : 0.f;
                    acc[nt] = __builtin_amdgcn_mfma_f32_16x16x4f32(a, bv, acc[nt], 0, 0, 0);
                }
            }
#pragma unroll
            for (int nt = 0; nt < NTL; ++nt)
#pragma unroll
                for (int j = 0; j < 4; ++j) part[(wave * 16 + lq * 4 + j) * 48 + nt * 16 + l15] = acc[nt][j];
            __syncthreads();
            for (int t = tid; t < 16 * NTL * 16; t += NTHR) {
                const int r = t / (NTL * 16), c = t % (NTL * 16);
                float sacc = 0.f;
#pragma unroll
                for (int w = 0; w < 8; ++w) sacc += part[(w * 16 + r) * 48 + c];
                if (GATEP) GATES[(size_t)(base + r) * 16 + c] = sacc;
                else {
                    float bias = 0.f;
                    if (c < 4) bias = p.in[I_BGRP][L * 4 + c]; else if (c < 36) bias = p.in[I_BEXP][L * 32 + c - 4];
                    lgs[r * 48 + c] = sacc + bias;
                }
            }
            if (ROUTER) {
                __syncthreads();
                if (tid < 16) {
                    const int row = base + tid;
                    const float* lg = lgs + tid * 48;
                    int gi = 0; float gm = lg[0];
#pragma unroll
                    for (int j = 1; j < 4; ++j) if (lg[j] > gm) { gm = lg[j]; gi = j; }
                    float gs = 0.f;
#pragma unroll
                    for (int j = 0; j < 4; ++j) gs += __expf(lg[j] - gm);
                    const float gw = 1.f / gs;
                    const float* el = lg + 4 + gi * 8;
                    int e0 = 0; float v0 = el[0];
#pragma unroll
                    for (int j = 1; j < 8; ++j) if (el[j] > v0) { v0 = el[j]; e0 = j; }
                    int e1 = -1; float v1 = -3.0e38f;
#pragma unroll
                    for (int j = 0; j < 8; ++j) if (j != e0 && el[j] > v1) { v1 = el[j]; e1 = j; }
                    const float t = __expf(v1 - v0);
                    const float w0 = gw / (1.f + t), w1 = gw * t / (1.f + t);
                    const int x0 = gi * 8 + e0, x1 = gi * 8 + e1;
                    const unsigned s0 = __hip_atomic_fetch_add(&cnt[x0], 1u, __ATOMIC_RELAXED, __HIP_MEMORY_SCOPE_AGENT);
                    const unsigned s1 = __hip_atomic_fetch_add(&cnt[x1], 1u, __ATOMIC_RELAXED, __HIP_MEMORY_SCOPE_AGENT);
                    LIST[(size_t)x0 * NT + s0] = 2 * row;
                    LIST[(size_t)x1 * NT + s1] = 2 * row + 1;
                    WSEL[2 * row] = w0;
                    WSEL[2 * row + 1] = w1;
                }
            }
            __syncthreads();
        }
    }
}

__device__ __forceinline__ void ph_gemm_in(const Params& p, LAS unsigned char* lds) {
    g8::DenseSched S{p.ws + OFF_H, p.ws + OFF_BTIN, NT / 256, ZW / 256, 1024, (int)gridDim.x, (int)blockIdx.x};
    g8::EpiBf16 E{(bf16_t*)(p.ws + OFF_Z), ZW, nullptr, 0};
    g8::gemm_phase<false, 0>(lds, 1024, S, E);
}
template <int L>
__device__ __forceinline__ void ph_gemm_out(const Params& p, LAS unsigned char* lds) {
    g8::DenseSched S{p.ws + OFF_H, p.ws + (L == 0 ? OFF_BTOUT0 : OFF_BTOUT1), (L == 0 ? NT : NL) / 256, 4, 1024, (int)gridDim.x, (int)blockIdx.x};
    g8::EpiResid E{(float*)(p.ws + OFF_X), (const float*)(p.ws + OFF_MOD) + (size_t)(L * 9) * 6144 + 2 * 1024};
    g8::gemm_phase<false, 0>(lds, 1024, S, E);
}
__device__ __forceinline__ void ph_gemm_qkv(const Params& p, LAS unsigned char* lds) {
    g8::QkvSched S{p.ws + OFF_H, p.ws + OFF_BTQKV, (int)gridDim.x, (int)blockIdx.x};
    g8::EpiBf16 E{(bf16_t*)(p.ws + OFF_ZQ), 1536, (bf16_t*)(p.ws + OFF_ZC), 512};
    g8::gemm_phase<false, 0>(lds, 1024, S, E);
}

__device__ __forceinline__ void moe_prefix(const Params& p, int L, LAS int* pre) {
    unsigned* cnt = (unsigned*)(p.ws + OFF_CNT) + L * 32;
    __syncthreads();
    if (hide_tid() == 0) {
        int s = 0;
        for (int e = 0; e < 32; ++e) { pre[e] = s; s += ((int)xb_ld(&cnt[e]) + 255) >> 8; }
        pre[32] = s;
    }
    __syncthreads();
}
__device__ __forceinline__ void ph_moe_up(const Params& p, int L, LAS unsigned char* lds) {
    LAS int* pre = (LAS int*)(lds + LDS_PRE);
    moe_prefix(p, L, pre);
    g8::MoeSched<true> S{p.ws, L, pre, (int)gridDim.x, (int)blockIdx.x};
    g8::EpiMoeUp E{(bf16_t*)(p.ws + OFF_ACT), (const float*)(p.ws + OFF_WSEL)};
    g8::gemm_phase<true, 1>(lds, 1024, S, E);
}
__device__ __forceinline__ void ph_moe_down(const Params& p, int L, LAS unsigned char* lds) {
    LAS int* pre = (LAS int*)(lds + LDS_PRE);
    moe_prefix(p, L, pre);
    g8::MoeSched<false> S{p.ws, L, pre, (int)gridDim.x, (int)blockIdx.x};
    g8::EpiMoeDown E{(bf16_t*)(p.ws + OFF_YE)};
    g8::gemm_phase<true, 0>(lds, 512, S, E);
}

__device__ __forceinline__ int unit_row0(int b, int cidx) { return cidx < 4 ? (NL + b * CTXL + cidx * 64) : (b * SEQ + (cidx - 4) * 64); }
__device__ __forceinline__ int tile_row0(int tl) { return tl < 256 ? tl * 64 : NL + (tl - 256) * 64; }

__device__ __forceinline__ void lru_tile(const Params& p, int tl, char* smem) {
    const int tid = hide_tid(), lane = tid & 63, wave = tid >> 6, l15 = lane & 15, lq = lane >> 4;
    const bf16_t* Z = (const bf16_t*)(p.ws + OFF_Z);
    const bf16_t* WRG = (const bf16_t*)(p.ws + OFF_WRG);
    bf16_t* HLOC = (bf16_t*)(p.ws + OFF_HLOC);
    bf16_t* ACUM = (bf16_t*)(p.ws + OFF_ACUM);
    float* LTOT = (float*)(p.ws + OFF_LTOT);
    constexpr int XLD = 520;
    bf16_t* XC = (bf16_t*)smem;
    const int row0 = tile_row0(tl);
    int sbeg, send;
    if (row0 < NL) { sbeg = (row0 >> 11) << 11; send = sbeg + SEQ; }
    else { sbeg = NL + (((row0 - NL) >> 8) << 8); send = sbeg + CTXL; }
    __syncthreads();
    {
        const int c = tid;
        const float w0 = p.in[I_CONVX][c], w1 = p.in[I_CONVX][512 + c], w2 = p.in[I_CONVX][1024 + c], w3 = p.in[I_CONVX][1536 + c];
        unsigned mlo = (row0 > sbeg) ? 0xffffu : 0u, mhi = (row0 + 64 < send) ? 0xffffu : 0u;
        asm volatile("" : "+v"(mlo), "+v"(mhi));
        const bf16_t* zc = Z + 2048 + c;
        const int rlo = row0 > sbeg ? row0 - 2 : row0, rhi = row0 + 64 < send ? row0 + 64 : row0 + 63;
        float zm2 = bf2f((bf16_t)(zc[(size_t)rlo * ZW] & mlo)), zm1 = bf2f((bf16_t)(zc[(size_t)(rlo + 1) * ZW] & mlo)), z0 = bf2f(zc[(size_t)row0 * ZW]);
#pragma unroll
        for (int t0 = 0; t0 < 64; t0 += 32) {
            bf16_t nz[32];
#pragma unroll
            for (int q = 0; q < 32; ++q) {
                const int tk = t0 + q;
                nz[q] = tk == 63 ? (bf16_t)(zc[(size_t)rhi * ZW] & mhi) : zc[(size_t)(row0 + tk + 1) * ZW];
            }
#pragma unroll
            for (int q = 0; q < 32; ++q) {
                const float zp1 = bf2f(nz[q]);
                XC[(t0 + q) * XLD + c] = f2bf(zm2 * w0 + zm1 * w1 + z0 * w2 + zp1 * w3);
                zm2 = zm1; zm1 = z0; z0 = zp1;
            }
        }
    }
    __syncthreads();
    const int g = wave;
    bf16x8 af[4][2];
#pragma unroll
    for (int mi = 0; mi < 4; ++mi)
#pragma unroll
        for (int kk = 0; kk < 2; ++kk) af[mi][kk] = *(const bf16x8*)(XC + (mi * 16 + l15) * XLD + g * 64 + kk * 32 + lq * 8);
#pragma unroll
    for (int d = 0; d < 2; ++d) {
#pragma unroll 1
        for (int ni = 0; ni < 4; ++ni) {
            f32x4 accr[4], acci[4];
#pragma unroll
            for (int mi = 0; mi < 4; ++mi) { accr[mi] = (f32x4){0.f, 0.f, 0.f, 0.f}; acci[mi] = (f32x4){0.f, 0.f, 0.f, 0.f}; }
            {
                const bf16_t* wr_ = WRG + ((size_t)(g * 256 + d * 128 + ni * 16 + l15)) * 64 + lq * 8;
#pragma unroll
                for (int kk = 0; kk < 2; ++kk) {
                    const bf16x8 br_ = *(const bf16x8*)(wr_ + kk * 32);
                    const bf16x8 bi_ = *(const bf16x8*)(wr_ + 64 * 64 + kk * 32);
#pragma unroll
                    for (int mi = 0; mi < 4; ++mi) {
                        accr[mi] = __builtin_amdgcn_mfma_f32_16x16x32_bf16(af[mi][kk], br_, accr[mi], 0, 0, 0);
                        acci[mi] = __builtin_amdgcn_mfma_f32_16x16x32_bf16(af[mi][kk], bi_, acci[mi], 0, 0, 0);
                    }
                }
            }
            const int c = g * 64 + ni * 16 + l15;
            const float br = p.in[I_RGBR][d * 512 + c], bi = p.in[I_RGBI][d * 512 + c];
            const float spl = softplusf_(-p.in[I_RGLAM][d * 512 + c]);
            float A[4][4], Bv[4][4];
#pragma unroll
            for (int mi = 0; mi < 4; ++mi)
#pragma unroll
                for (int j = 0; j < 4; ++j) {
                    const float r = sigmoidf_(accr[mi][j] + br), ig = sigmoidf_(acci[mi][j] + bi);
                    const float la = -8.0f * r * spl;
                    const float a = __expf(la);
                    const float xc = bf2f(XC[(mi * 16 + lq * 4 + j) * XLD + c]);
                    A[mi][j] = a;
                    Bv[mi][j] = __builtin_amdgcn_sqrtf(neg_expm1_small(2.f * la)) * ig * xc;
                }
            float P[4][4], Hh[4][4];
#pragma unroll
            for (int mi = 0; mi < 4; ++mi) {
                if (d == 0) {
                    P[mi][0] = A[mi][0]; Hh[mi][0] = Bv[mi][0];
#pragma unroll
                    for (int j = 1; j < 4; ++j) { P[mi][j] = A[mi][j] * P[mi][j - 1]; Hh[mi][j] = A[mi][j] * Hh[mi][j - 1] + Bv[mi][j]; }
                } else {
                    P[mi][3] = A[mi][3]; Hh[mi][3] = Bv[mi][3];
#pragma unroll
                    for (int j = 2; j >= 0; --j) { P[mi][j] = A[mi][j] * P[mi][j + 1]; Hh[mi][j] = A[mi][j] * Hh[mi][j + 1] + Bv[mi][j]; }
                }
            }
            float cP = 1.f, cH = 0.f;
#pragma unroll
            for (int mm = 0; mm < 4; ++mm) {
                const int mi = d == 0 ? mm : 3 - mm;
                const float sP = d == 0 ? P[mi][3] : P[mi][0], sH = d == 0 ? Hh[mi][3] : Hh[mi][0];
                float iP = sP, iH = sH;
#pragma unroll
                for (int dist = 1; dist <= 2; dist <<= 1) {
                    const int src = d == 0 ? lane - 16 * dist : lane + 16 * dist;
                    const float pP = __shfl(iP, src & 63, 64), pH = __shfl(iH, src & 63, 64);
                    const bool ok = d == 0 ? (lq >= dist) : (lq <= 3 - dist);
                    if (ok) { iH = iP * pH + iH; iP = iP * pP; }
                }
                const int srcx = d == 0 ? lane - 16 : lane + 16;
                float eP = __shfl(iP, srcx & 63, 64), eH = __shfl(iH, srcx & 63, 64);
                const bool first = d == 0 ? (lq == 0) : (lq == 3);
                if (first) { eP = 1.f; eH = 0.f; }
                const float bP = eP * cP, bH = eP * cH + eH;
#pragma unroll
                for (int j = 0; j < 4; ++j) {
                    const float hval = P[mi][j] * bH + Hh[mi][j];
                    const float aval = P[mi][j] * bP;
                    const size_t o = ((size_t)d * NT + row0 + mi * 16 + lq * 4 + j) * 512 + c;
                    HLOC[o] = f2bf(hval); ACUM[o] = f2bf(aval);
                    Hh[mi][j] = hval; P[mi][j] = aval;
                }
                const int lastl = d == 0 ? 48 + l15 : l15;
                const float tP = __shfl(iP, lastl, 64), tH = __shfl(iH, lastl, 64);
                cH = tP * cH + tH; cP = tP * cP;
            }
            if (d == 0 ? (lq == 3) : (lq == 0)) {
                const float aT = d == 0 ? P[3][3] : P[0][0], hT = d == 0 ? Hh[3][3] : Hh[0][0];
                float* o = LTOT + (((size_t)d * 288 + tl) * 512 + c) * 2;
                o[0] = aT; o[1] = hT;
            }
        }
    }
}

__device__ __forceinline__ void delta_unit(const Params& p, int u, char* smem) {
    const int tid = hide_tid(), lane = tid & 63, wave = tid >> 6, l15 = lane & 15, lq = lane >> 4;
    const int cidx = u % 36, bh = u / 36, h = bh & 3, b = bh >> 2;
    const int row0 = unit_row0(b, cidx);
    const int sbeg = cidx < 4 ? NL + b * CTXL : b * SEQ, send = cidx < 4 ? sbeg + CTXL : sbeg + SEQ;
    const bf16_t* Z = (const bf16_t*)(p.ws + OFF_Z);
    const float* GATES = (const float*)(p.ws + OFF_GATES);
    bf16_t* QG = (bf16_t*)(p.ws + OFF_QG) + (size_t)u * 64 * 128;
    bf16_t* KG = (bf16_t*)(p.ws + OFF_KG) + (size_t)u * 64 * 128;
    bf16_t* VG = (bf16_t*)(p.ws + OFF_VG) + (size_t)u * 64 * 128;
    bf16_t* KTG = (bf16_t*)(p.ws + OFF_KTG) + (size_t)u * 128 * 64;
    bf16_t* TT = (bf16_t*)(p.ws + OFF_TT) + (size_t)u * 2 * 4096;
    bf16_t* ATT = (bf16_t*)(p.ws + OFF_ATT) + (size_t)u * 2 * 4096;
    float* VEC = (float*)(p.ws + OFF_VEC) + (size_t)u * 2 * 256;
    float* EGL = (float*)(p.ws + OFF_EGL) + (size_t)u * 2;
    constexpr int QLD = 136, LLD = 68;
    bf16_t* Qs = (bf16_t*)smem;
    bf16_t* Ks = Qs + 64 * QLD;
    float* Lm = (float*)(Ks + 64 * QLD);
    float* gcs = Lm + 2 * 64 * LLD;
    float* bts = gcs + 128;
    __syncthreads();
    if (wave < 6) {
        const int part = wave >> 1, t0 = (wave & 1) * 32;
        const int c = part * 512 + h * 128 + lane * 2;
        const float* cw = p.in[I_CONVQKV] + c;
        const float w00 = cw[0], w01 = cw[1], w10 = cw[1536], w11 = cw[1537], w20 = cw[3072], w21 = cw[3073], w30 = cw[4608], w31 = cw[4609];
        const int rb = row0 + t0;
        unsigned mlo = (rb > sbeg) ? 0xffffffffu : 0u, mhi = (rb + 32 < send) ? 0xffffffffu : 0u;
        asm volatile("" : "+v"(mlo), "+v"(mhi));
        const bf16_t* zc = Z + c;
        const int rlo = rb > sbeg ? rb - 2 : rb, rhi = rb + 32 < send ? rb + 32 : rb + 31;
        unsigned zw[35];
        zw[0] = *(const unsigned*)(zc + (size_t)rlo * ZW) & mlo; zw[1] = *(const unsigned*)(zc + (size_t)(rlo + 1) * ZW) & mlo;
#pragma unroll
        for (int q = 0; q < 32; ++q) zw[2 + q] = *(const unsigned*)(zc + (size_t)(rb + q) * ZW);
        zw[34] = *(const unsigned*)(zc + (size_t)rhi * ZW) & mhi;
#pragma unroll
        for (int tk = 0; tk < 32; ++tk) {
            const unsigned zm2 = zw[tk], zm1 = zw[tk + 1], z0 = zw[tk + 2], zp1 = zw[tk + 3];
            float a0 = bf2f((bf16_t)(zm2 & 0xffff)) * w00 + bf2f((bf16_t)(zm1 & 0xffff)) * w10 + bf2f((bf16_t)(z0 & 0xffff)) * w20 + bf2f((bf16_t)(zp1 & 0xffff)) * w30;
            float a1 = bf2f((bf16_t)(zm2 >> 16)) * w01 + bf2f((bf16_t)(zm1 >> 16)) * w11 + bf2f((bf16_t)(z0 >> 16)) * w21 + bf2f((bf16_t)(zp1 >> 16)) * w31;
            a0 = siluf_(a0); a1 = siluf_(a1);
            const int tok = t0 + tk;
            if (part < 2) {
                const float ss = wave_sum(a0 * a0 + a1 * a1);
                float sc = rsqrtf(ss + EPSF);
                if (part == 0) sc *= 0.08838834764831845f;
                a0 *= sc; a1 *= sc;
                const unsigned pk = pack2(a0, a1);
                *(unsigned*)((part == 0 ? Qs : Ks) + tok * QLD + lane * 2) = pk;
                *(unsigned*)((part == 0 ? QG : KG) + tok * 128 + lane * 2) = pk;
            } else {
                *(unsigned*)(VG + tok * 128 + lane * 2) = pack2(a0, a1);
            }
        }
    } else {
        const int d = wave - 6;
        const int row = row0 + lane;
        const float gv = GATES[(size_t)row * 16 + d * 8 + h], bv = GATES[(size_t)row * 16 + d * 8 + 4 + h];
        const float gdec = -__expf(p.in[I_ALOG][d * 4 + h]) * softplusf_(gv + p.in[I_DTB][d * 4 + h]);
        const float beta = sigmoidf_(bv);
        float gc = gdec;
#pragma unroll
        for (int dist = 1; dist < 64; dist <<= 1) {
            const int src = d == 0 ? lane - dist : lane + dist;
            const float o = __shfl(gc, src & 63, 64);
            if (d == 0 ? (lane >= dist) : (lane + dist < 64)) gc += o;
        }
        const float gl = __shfl(gc, d == 0 ? 63 : 0, 64);
        gcs[d * 64 + lane] = gc; bts[d * 64 + lane] = beta;
        const float egc = __expf(gc);
        VEC[d * 256 + 0 * 64 + lane] = beta * egc;
        VEC[d * 256 + 1 * 64 + lane] = egc;
        VEC[d * 256 + 2 * 64 + lane] = __expf(gl - gc);
        VEC[d * 256 + 3 * 64 + lane] = beta;
        if (lane == 0) EGL[d] = __expf(gl);
    }
    __syncthreads();
    {
        const int mi = wave >> 1, ni0 = (wave & 1) * 2;
        f32x4 kk_acc[2], qk_acc[2];
#pragma unroll
        for (int n = 0; n < 2; ++n) { kk_acc[n] = (f32x4){0.f, 0.f, 0.f, 0.f}; qk_acc[n] = (f32x4){0.f, 0.f, 0.f, 0.f}; }
#pragma unroll
        for (int kk = 0; kk < 4; ++kk) {
            const bf16x8 ak = *(const bf16x8*)(Ks + (mi * 16 + l15) * QLD + kk * 32 + lq * 8);
            const bf16x8 aq = *(const bf16x8*)(Qs + (mi * 16 + l15) * QLD + kk * 32 + lq * 8);
#pragma unroll
            for (int n = 0; n < 2; ++n) {
                const bf16x8 bk = *(const bf16x8*)(Ks + ((ni0 + n) * 16 + l15) * QLD + kk * 32 + lq * 8);
                kk_acc[n] = __builtin_amdgcn_mfma_f32_16x16x32_bf16(ak, bk, kk_acc[n], 0, 0, 0);
                qk_acc[n] = __builtin_amdgcn_mfma_f32_16x16x32_bf16(aq, bk, qk_acc[n], 0, 0, 0);
            }
        }
#pragma unroll
        for (int n = 0; n < 2; ++n)
#pragma unroll
            for (int j = 0; j < 4; ++j) {
                const int i = mi * 16 + lq * 4 + j, jc = (ni0 + n) * 16 + l15;
                {
                    const float e = (i >= jc) ? __expf(gcs[i] - gcs[jc]) : 0.f;
                    if (i > jc) Lm[i * LLD + jc] = bts[i] * kk_acc[n][j] * e;
                    ATT[i * 64 + jc] = f2bf(qk_acc[n][j] * e);
                }
                {
                    const float e = (i <= jc) ? __expf(gcs[64 + i] - gcs[64 + jc]) : 0.f;
                    if (i < jc) Lm[64 * LLD + (63 - i) * LLD + (63 - jc)] = bts[64 + i] * kk_acc[n][j] * e;
                    ATT[4096 + i * 64 + jc] = f2bf(qk_acc[n][j] * e);
                }
            }
    }
    __syncthreads();
    if (wave < 2) {
        const int d = wave;
        const float* Lr = Lm + d * 64 * LLD;
        float T[64];
#pragma unroll
        for (int i = 0; i < 64; ++i) {
            float a0 = (i == lane) ? 1.f : 0.f, a1 = 0.f, a2 = 0.f, a3 = 0.f;
#pragma unroll
            for (int j4 = 0; j4 + 4 <= i; j4 += 4) {
                const float4 l4 = *(const float4*)(Lr + i * LLD + j4);
                a0 -= l4.x * T[j4]; a1 -= l4.y * T[j4 + 1]; a2 -= l4.z * T[j4 + 2]; a3 -= l4.w * T[j4 + 3];
            }
#pragma unroll
            for (int j = (i & ~3); j < i; ++j) a0 -= Lr[i * LLD + j] * T[j];
            T[i] = (a0 + a1) + (a2 + a3);
        }
#pragma unroll
        for (int i = 0; i < 64; ++i) {
            const int ri = d == 0 ? i : 63 - i, rc = d == 0 ? lane : 63 - lane;
            TT[d * 4096 + ri * 64 + rc] = f2bf(T[i]);
        }
    } else {
        for (int q = tid - 128; q < 1024; q += 384) {
            const int dk = q & 127, tg = q >> 7;
            unsigned short e[8];
#pragma unroll
            for (int x = 0; x < 8; ++x) e[x] = Ks[(tg * 8 + x) * QLD + dk];
            uint4 w; w.x = e[0] | ((unsigned)e[1] << 16); w.y = e[2] | ((unsigned)e[3] << 16); w.z = e[4] | ((unsigned)e[5] << 16); w.w = e[6] | ((unsigned)e[7] << 16);
            *(uint4*)(KTG + dk * 64 + tg * 8) = w;
        }
    }
}

__device__ __forceinline__ void ph_prep(const Params& p, char* smem, int rep = 0) {
    const int lo = (rep && REP_SUB == 2) ? 288 : 0, hi = (rep && REP_SUB == 1) ? 288 : 288 + 1152;
    for (int item = lo + blockIdx.x; item < hi; item += gridDim.x) {
        if (item < 288) lru_tile(p, item, smem);
        else delta_unit(p, item - 288, smem);
    }
}

__device__ __forceinline__ void lru_carry(const Params& p, int li) {
    const int idx = li * NTHR + hide_tid();
    const int c = idx & 511, bd = idx >> 9, b = bd >> 1, d = bd & 1;
    const float* LTOT = (const float*)(p.ws + OFF_LTOT);
    float* CIN = (float*)(p.ws + OFF_CIN);
    float s = 0.f;
#pragma unroll 12
    for (int st = 0; st < 36; ++st) {
        int tl;
        if (st < 4) tl = 256 + b * 4 + (d ? 3 - st : st);
        else tl = b * 32 + (d ? 35 - st : st - 4);
        const float2 ah = *(const float2*)(LTOT + (((size_t)d * 288 + tl) * 512 + c) * 2);
        CIN[((size_t)d * 288 + tl) * 512 + c] = s;
        s = ah.x * s + ah.y;
    }
}
struct DFrags { bf16x8 k[4], q[4], t[2], a[2], kt[2]; unsigned v[4]; float4 rs1, rs2, rs3, bt; float egl; };
__device__ __forceinline__ void delta_chain(const Params& p, int item, char* smem) {
    const int tid = hide_tid(), lane = tid & 63, wave = tid >> 6, l15 = lane & 15, lq = lane >> 4;
    const int chain = item >> 2, sl = item & 3;
    const int b = chain >> 3, h = (chain >> 1) & 3, dir = chain & 1;
    const int mi = wave >> 1, ni = wave & 1;
    const bf16_t* QG = (const bf16_t*)(p.ws + OFF_QG);
    const bf16_t* KG = (const bf16_t*)(p.ws + OFF_KG);
    const bf16_t* VG = (const bf16_t*)(p.ws + OFF_VG);
    const bf16_t* KTG = (const bf16_t*)(p.ws + OFF_KTG);
    const bf16_t* TT = (const bf16_t*)(p.ws + OFF_TT);
    const bf16_t* ATT = (const bf16_t*)(p.ws + OFF_ATT);
    const float* VEC = (const float*)(p.ws + OFF_VEC);
    const float* EGL = (const float*)(p.ws + OFF_EGL);
    bf16_t* OA = (bf16_t*)(p.ws + OFF_OA) + (size_t)dir * NT * 512;
    constexpr int SLD = 136, RLD = 72;
    bf16_t* ST = (bf16_t*)smem;
    bf16_t* RT = ST + 32 * SLD;
    bf16_t* VNT = RT + 32 * RLD;
    bf16_t* VST = VNT + 32 * RLD;
    __syncthreads();
    for (int i = tid; i < 32 * SLD / 2; i += NTHR) ((unsigned*)ST)[i] = 0u;
    auto unit_of = [&](int s) -> int { const int cidx = dir ? (s < 4 ? 3 - s : 39 - s) : s; return (b * 4 + h) * 36 + cidx; };
    auto load = [&](int s, DFrags& f) {
        const int u = unit_of(s);
        const bf16_t* kq = KG + (size_t)u * 8192 + (mi * 16 + l15) * 128 + lq * 8;
        const bf16_t* qq = QG + (size_t)u * 8192 + (mi * 16 + l15) * 128 + lq * 8;
#pragma unroll
        for (int kk = 0; kk < 4; ++kk) { f.k[kk] = *(const bf16x8*)(kq + kk * 32); f.q[kk] = *(const bf16x8*)(qq + kk * 32); }
        const bf16_t* tp = TT + ((size_t)u * 2 + dir) * 4096 + (mi * 16 + l15) * 64 + lq * 8;
        const bf16_t* ap = ATT + ((size_t)u * 2 + dir) * 4096 + (mi * 16 + l15) * 64 + lq * 8;
        const bf16_t* ktp = KTG + (size_t)u * 8192 + (wave * 16 + l15) * 64 + lq * 8;
#pragma unroll
        for (int kk = 0; kk < 2; ++kk) { f.t[kk] = *(const bf16x8*)(tp + kk * 32); f.a[kk] = *(const bf16x8*)(ap + kk * 32); f.kt[kk] = *(const bf16x8*)(ktp + kk * 32); }
        const bf16_t* vp = VG + (size_t)u * 8192 + (mi * 16 + lq * 4) * 128 + sl * 32 + ni * 16 + l15;
#pragma unroll
        for (int j = 0; j < 4; ++j) f.v[j] = vp[j * 128];
        const float* vec = VEC + ((size_t)u * 2 + dir) * 256 + mi * 16 + lq * 4;
        f.rs1 = *(const float4*)(vec); f.rs2 = *(const float4*)(vec + 64); f.rs3 = *(const float4*)(vec + 128); f.bt = *(const float4*)(vec + 192);
        f.egl = EGL[(size_t)u * 2 + dir];
    };
    f32x4 Sacc[2];
    Sacc[0] = (f32x4){0.f, 0.f, 0.f, 0.f}; Sacc[1] = (f32x4){0.f, 0.f, 0.f, 0.f};
    DFrags cur, nxt;
    load(0, cur);
    __syncthreads();
#pragma unroll 1
    for (int s = 0; s < 36; ++s) {
        if (s + 1 < 36) load(s + 1, nxt);
        f32x4 kS = (f32x4){0.f, 0.f, 0.f, 0.f}, qS = (f32x4){0.f, 0.f, 0.f, 0.f};
#pragma unroll
        for (int kk = 0; kk < 4; ++kk) {
            const bf16x8 sb = *(const bf16x8*)(ST + (ni * 16 + l15) * SLD + kk * 32 + lq * 8);
            kS = __builtin_amdgcn_mfma_f32_16x16x32_bf16(cur.k[kk], sb, kS, 0, 0, 0);
            qS = __builtin_amdgcn_mfma_f32_16x16x32_bf16(cur.q[kk], sb, qS, 0, 0, 0);
        }
        {
            const float r0 = cur.bt.x * bf2f((bf16_t)cur.v[0]) - cur.rs1.x * kS[0];
            const float r1 = cur.bt.y * bf2f((bf16_t)cur.v[1]) - cur.rs1.y * kS[1];
            const float r2 = cur.bt.z * bf2f((bf16_t)cur.v[2]) - cur.rs1.z * kS[2];
            const float r3 = cur.bt.w * bf2f((bf16_t)cur.v[3]) - cur.rs1.w * kS[3];
            uint2 w; w.x = pack2(r0, r1); w.y = pack2(r2, r3);
            *(uint2*)(RT + (ni * 16 + l15) * RLD + mi * 16 + lq * 4) = w;
        }
        __syncthreads();
        f32x4 vn = (f32x4){0.f, 0.f, 0.f, 0.f};
#pragma unroll
        for (int kk = 0; kk < 2; ++kk) {
            const bf16x8 rb = *(const bf16x8*)(RT + (ni * 16 + l15) * RLD + kk * 32 + lq * 8);
            vn = __builtin_amdgcn_mfma_f32_16x16x32_bf16(cur.t[kk], rb, vn, 0, 0, 0);
        }
        {
            uint2 w; w.x = pack2(vn[0], vn[1]); w.y = pack2(vn[2], vn[3]);
            *(uint2*)(VNT + (ni * 16 + l15) * RLD + mi * 16 + lq * 4) = w;
            uint2 w2; w2.x = pack2(vn[0] * cur.rs3.x, vn[1] * cur.rs3.y); w2.y = pack2(vn[2] * cur.rs3.z, vn[3] * cur.rs3.w);
            *(uint2*)(VST + (ni * 16 + l15) * RLD + mi * 16 + lq * 4) = w2;
        }
        __syncthreads();
        f32x4 o;
        o[0] = cur.rs2.x * qS[0]; o[1] = cur.rs2.y * qS[1]; o[2] = cur.rs2.z * qS[2]; o[3] = cur.rs2.w * qS[3];
#pragma unroll
        for (int kk = 0; kk < 2; ++kk) {
            const bf16x8 vb = *(const bf16x8*)(VNT + (ni * 16 + l15) * RLD + kk * 32 + lq * 8);
            o = __builtin_amdgcn_mfma_f32_16x16x32_bf16(cur.a[kk], vb, o, 0, 0, 0);
        }
        {
            const int u = unit_of(s);
            const int cidx = u % 36;
            const int rowb = unit_row0(b, cidx) + mi * 16 + lq * 4;
            bf16_t* op = OA + (size_t)rowb * 512 + h * 128 + sl * 32 + ni * 16 + l15;
#pragma unroll
            for (int j = 0; j < 4; ++j) op[(size_t)j * 512] = f2bf(o[j]);
        }
#pragma unroll
        for (int n2 = 0; n2 < 2; ++n2) {
            Sacc[n2] = Sacc[n2] * cur.egl;
#pragma unroll
            for (int kk = 0; kk < 2; ++kk) {
                const bf16x8 vb = *(const bf16x8*)(VST + (n2 * 16 + l15) * RLD + kk * 32 + lq * 8);
                Sacc[n2] = __builtin_amdgcn_mfma_f32_16x16x32_bf16(cur.kt[kk], vb, Sacc[n2], 0, 0, 0);
            }
            uint2 w; w.x = pack2(Sacc[n2][0], Sacc[n2][1]); w.y = pack2(Sacc[n2][2], Sacc[n2][3]);
            *(uint2*)(ST + (n2 * 16 + l15) * SLD + wave * 16 + lq * 4) = w;
        }
        __syncthreads();
        cur = nxt;
    }
}
__device__ __forceinline__ void ph_scan(const Params& p, char* smem, int rep = 0) {
    for (int item = blockIdx.x; item < 16 + 256; item += gridDim.x) {
        if (item < 16) { if (!rep) lru_carry(p, item); }
        else delta_chain(p, item - 16, smem);
    }
}

struct MergeRow { unsigned oa0[4], oa1[4], gz[4], h0[4], h1[4], a0[4], a1[4], yz[4]; float2 c0[4], c1[4]; };
__device__ __forceinline__ void merge_load(const Params& p, int row, int lane, MergeRow& m) {
    const bf16_t* Z = (const bf16_t*)(p.ws + OFF_Z) + (size_t)row * ZW;
    const bf16_t* OA0 = (const bf16_t*)(p.ws + OFF_OA) + (size_t)row * 512;
    const bf16_t* OA1 = OA0 + (size_t)NT * 512;
    const bf16_t* HL0 = (const bf16_t*)(p.ws + OFF_HLOC) + (size_t)row * 512;
    const bf16_t* HL1 = HL0 + (size_t)NT * 512;
    const bf16_t* AC0 = (const bf16_t*)(p.ws + OFF_ACUM) + (size_t)row * 512;
    const bf16_t* AC1 = AC0 + (size_t)NT * 512;
    const int tl = row < NL ? (row >> 6) : 256 + ((row - NL) >> 6);
    const float* CIN0 = (const float*)(p.ws + OFF_CIN) + (size_t)tl * 512;
    const float* CIN1 = CIN0 + (size_t)288 * 512;
#pragma unroll
    for (int i = 0; i < 4; ++i) {
        const int c = i * 128 + lane * 2;
        m.oa0[i] = *(const unsigned*)(OA0 + c); m.oa1[i] = *(const unsigned*)(OA1 + c); m.gz[i] = *(const unsigned*)(Z + 1536 + c);
        m.h0[i] = *(const unsigned*)(HL0 + c); m.h1[i] = *(const unsigned*)(HL1 + c);
        m.a0[i] = *(const unsigned*)(AC0 + c); m.a1[i] = *(const unsigned*)(AC1 + c);
        m.yz[i] = *(const unsigned*)(Z + 2560 + c);
        m.c0[i] = *(const float2*)(CIN0 + c); m.c1[i] = *(const float2*)(CIN1 + c);
    }
}
__device__ __forceinline__ void merge_compute(const Params& p, int row, int lane, const MergeRow& m, float on0, float on1) {
    bf16_t* M = (bf16_t*)(p.ws + OFF_H) + (size_t)row * 1024;
#pragma unroll
    for (int h = 0; h < 4; ++h) {
        const int c = h * 128 + lane * 2;
        const float o0 = bf2f((bf16_t)(m.oa0[h] & 0xffff)) + bf2f((bf16_t)(m.oa1[h] & 0xffff));
        const float o1 = bf2f((bf16_t)(m.oa0[h] >> 16)) + bf2f((bf16_t)(m.oa1[h] >> 16));
        const float ss = wave_sum(o0 * o0 + o1 * o1);
        const float rinv = rsqrtf(ss * (1.f / 128.f) + EPSF);
        const float y0 = o0 * rinv * on0 * siluf_(bf2f((bf16_t)(m.gz[h] & 0xffff)));
        const float y1 = o1 * rinv * on1 * siluf_(bf2f((bf16_t)(m.gz[h] >> 16)));
        *(unsigned*)(M + c) = pack2(y0, y1);
    }
#pragma unroll
    for (int i = 0; i < 4; ++i) {
        const int c = i * 128 + lane * 2;
        const float hx = (bf2f((bf16_t)(m.h0[i] & 0xffff)) + bf2f((bf16_t)(m.a0[i] & 0xffff)) * m.c0[i].x) + (bf2f((bf16_t)(m.h1[i] & 0xffff)) + bf2f((bf16_t)(m.a1[i] & 0xffff)) * m.c1[i].x);
        const float hy = (bf2f((bf16_t)(m.h0[i] >> 16)) + bf2f((bf16_t)(m.a0[i] >> 16)) * m.c0[i].y) + (bf2f((bf16_t)(m.h1[i] >> 16)) + bf2f((bf16_t)(m.a1[i] >> 16)) * m.c1[i].y);
        const float y0 = hx * geluf_(bf2f((bf16_t)(m.yz[i] & 0xffff)));
        const float y1 = hy * geluf_(bf2f((bf16_t)(m.yz[i] >> 16)));
        *(unsigned*)(M + 512 + c) = pack2(y0, y1);
    }
}
__device__ __forceinline__ void ph_merge(const Params& p, char* smem) {
    const int tid = hide_tid(), lane = tid & 63, wave = tid >> 6;
    const float on0 = p.in[I_ONORM][lane * 2], on1 = p.in[I_ONORM][lane * 2 + 1];
    for (int base = blockIdx.x * 16; base < NT; base += gridDim.x * 16) {
        const int r0 = base + wave * 2;
        MergeRow m0, m1;
        merge_load(p, r0, lane, m0);
        merge_load(p, r0 + 1, lane, m1);
        merge_compute(p, r0, lane, m0, on0, on1);
        merge_compute(p, r0 + 1, lane, m1, on0, on1);
    }
}

__device__ __forceinline__ void ph_qkprep(const Params& p, char* smem) {
    const int tid = hide_tid(), lane = tid & 63, wave = tid >> 6;
    const bf16_t* ZQ = (const bf16_t*)(p.ws + OFF_ZQ);
    const bf16_t* ZC = (const bf16_t*)(p.ws + OFF_ZC);
    bf16_t* QA = (bf16_t*)(p.ws + OFF_QA);
    bf16_t* KA = (bf16_t*)(p.ws + OFF_KA);
    bf16_t* VT = (bf16_t*)(p.ws + OFF_VT);
    const float* qn = p.in[I_QNORM];
    const float* kn = p.in[I_KNORM];
    for (int row = blockIdx.x * 8 + wave; row < NT; row += gridDim.x * 8) {
        const bool lat = row < NL;
        const int b = lat ? (row >> 11) : ((row - NL) >> 8);
        const int t = lat ? (row & 2047) : ((row - NL) & 255);
        const int key = lat ? t : (SEQ + t);
        float cs = 1.f, sn = 0.f;
        if (lat) {
            const int f = lane & 31;
            const float pos = (lane < 32) ? (float)(t >> 6) : (float)(t & 63);
            const float inv = expf(-(float)f * (1.f / 32.f) * 9.210340371976184f);
            sincosf(pos * inv, &sn, &cs);
        }
        const bf16_t* src = lat ? ZQ + (size_t)row * 1536 : ZC + (size_t)(row - NL) * 512;
        const int koff = lat ? 1024 : 0;
        if (lat) {
#pragma unroll
            for (int h = 0; h < 8; ++h) {
                const unsigned u = *(const unsigned*)(src + h * 128 + lane * 2);
                float x1 = bf2f((bf16_t)(u & 0xffff)), x2 = bf2f((bf16_t)(u >> 16));
                const float ss = wave_sum(x1 * x1 + x2 * x2);
                const float rinv = rsqrtf(ss * (1.f / 128.f) + EPSF);
                x1 *= rinv * qn[lane * 2]; x2 *= rinv * qn[lane * 2 + 1];
                const float y1 = x1 * cs - x2 * sn;
                const float y2 = x1 * sn + x2 * cs;
                *(unsigned*)(QA + (size_t)row * 1024 + h * 128 + lane * 2) = pack2(y1, y2);
            }
        }
#pragma unroll
        for (int kh = 0; kh < 2; ++kh) {
            const unsigned u = *(const unsigned*)(src + koff + kh * 128 + lane * 2);
            float x1 = bf2f((bf16_t)(u & 0xffff)), x2 = bf2f((bf16_t)(u >> 16));
            const float ss = wave_sum(x1 * x1 + x2 * x2);
            const float rinv = rsqrtf(ss * (1.f / 128.f) + EPSF);
            x1 *= rinv * kn[lane * 2]; x2 *= rinv * kn[lane * 2 + 1];
            const float y1 = x1 * cs - x2 * sn;
            const float y2 = x1 * sn + x2 * cs;
            *(unsigned*)(KA + ((size_t)(b * 2 + kh) * TSEQ + key) * 128 + lane * 2) = pack2(y1, y2);
            const unsigned uv = *(const unsigned*)(src + koff + 256 + kh * 128 + lane * 2);
            *(unsigned*)(VT + ((size_t)(b * 2 + kh) * TSEQ + key) * 128 + lane * 2) = uv;
        }
    }
}

namespace att {
constexpr int D = 128, NW = 8, QBLK = 32, KVBLK = 64;
constexpr float SCALE = 0.088388347648318440f;
constexpr float THR = 8.f;
constexpr int LDQ = 1024, LDK = 128, LDO = 1024;
constexpr size_t SHM_V = KVBLK * D * 2, SHM_K = KVBLK * D * 2, SHM_ATTN = 2 * SHM_V + 2 * SHM_K + NW * 64 * 4;
using s16x4  = __attribute__((ext_vector_type(4))) short;
using f32x16 = __attribute__((ext_vector_type(16))) float;
using u32x4  = __attribute__((ext_vector_type(4))) unsigned;
#define KSWZ(row, colB) ((row) * 256 + ((colB) ^ (((row) & 7) << 4)))
#define SBAR() __builtin_amdgcn_sched_barrier(0)
__device__ __forceinline__ int crow(int r, int hi) { return (r & 3) + 8 * (r >> 2) + 4 * hi; }
__device__ __forceinline__ unsigned cvtpk(float lo, float hi) {
  unsigned r; asm volatile("v_cvt_pk_bf16_f32 %0, %1, %2" : "=v"(r) : "v"(lo), "v"(hi)); return r;
}
__device__ __forceinline__ void partialSM(f32x16& p0, f32x16& p1, float& m_reg, float& mn, float& alpha) {
  constexpr float C = SCALE * 1.4426950408889634f;
  float pmax = p0[0];
#pragma unroll
  for (int r = 1; r < 16; ++r) pmax = fmaxf(pmax, p0[r]);
#pragma unroll
  for (int r = 0; r < 16; ++r) pmax = fmaxf(pmax, p1[r]);
  { auto rr = __builtin_amdgcn_permlane32_swap(__float_as_uint(pmax), __float_as_uint(pmax), false, false);
    pmax = fmaxf(__uint_as_float(rr[0]), __uint_as_float(rr[1])); }
  if (__builtin_expect(__all(pmax - m_reg <= THR / SCALE), 1)) { mn = m_reg; alpha = 1.f; }
  else { mn = fmaxf(m_reg, pmax); alpha = __builtin_amdgcn_exp2f((m_reg - mn) * C); m_reg = mn; }
  float mnC = -mn * C;
#pragma unroll
  for (int r = 0; r < 16; ++r) p0[r] = fmaf(p0[r], C, mnC);
#pragma unroll
  for (int r = 0; r < 16; ++r) p1[r] = fmaf(p1[r], C, mnC);
#pragma unroll
  for (int r = 0; r < 16; ++r) p0[r] = __builtin_amdgcn_exp2f(p0[r]);
}
__device__ __forceinline__ void finishSM(f32x16& p0, f32x16& p1, float alpha, float& l_reg, bf16x8& pa0, bf16x8& pa1, bf16x8& pa2, bf16x8& pa3) {
#pragma unroll
  for (int r = 0; r < 16; ++r) p1[r] = __builtin_amdgcn_exp2f(p1[r]);
  float ps = 0;
#pragma unroll
  for (int r = 0; r < 16; ++r) ps += p0[r];
#pragma unroll
  for (int r = 0; r < 16; ++r) ps += p1[r];
  { auto rr = __builtin_amdgcn_permlane32_swap(__float_as_uint(ps), __float_as_uint(ps), false, false);
    ps = __uint_as_float(rr[0]) + __uint_as_float(rr[1]); }
  l_reg = l_reg * alpha + ps;
#define PK4(P, BASE, OUT) do { unsigned a0 = cvtpk(P[BASE + 0], P[BASE + 1]), a1 = cvtpk(P[BASE + 2], P[BASE + 3]);   \
    unsigned b0 = cvtpk(P[BASE + 4], P[BASE + 5]), b1 = cvtpk(P[BASE + 6], P[BASE + 7]);                              \
    auto r0 = __builtin_amdgcn_permlane32_swap(a0, b0, false, false); auto r1 = __builtin_amdgcn_permlane32_swap(a1, b1, false, false); \
    u32x4 w = {r0[0], r1[0], r0[1], r1[1]}; OUT = *reinterpret_cast<bf16x8*>(&w); } while (0)
  PK4(p0, 0, pa0); PK4(p0, 8, pa1); PK4(p1, 0, pa2); PK4(p1, 8, pa3);
#undef PK4
}
__device__ __forceinline__ void qkt(f32x16& p0, f32x16& p1, const bf16_t* Ks, const bf16x8* qr, int r32, int hi) {
  p0 = f32x16{}; p1 = f32x16{};
#pragma unroll
  for (int d0 = 0; d0 < 8; ++d0) { int cb = (d0 * 16 + hi * 8) * 2;
    bf16x8 b0 = *reinterpret_cast<const bf16x8*>((const char*)Ks + KSWZ(r32, cb));
    bf16x8 b1 = *reinterpret_cast<const bf16x8*>((const char*)Ks + KSWZ(32 + r32, cb));
    p0 = __builtin_amdgcn_mfma_f32_32x32x16_bf16(b0, qr[d0], p0, 0, 0, 0);
    p1 = __builtin_amdgcn_mfma_f32_32x32x16_bf16(b1, qr[d0], p1, 0, 0, 0); }
}
__device__ __forceinline__ int v_st(int k, int c) { const int kk = (k & ~0xC) | ((k & 4) << 1) | ((k & 8) >> 1); return ((kk >> 3) * 4 + (c >> 5)) * 512 + ((kk & 7) * 32 + (c & 31)) * 2; }
__device__ __forceinline__ int v_rd_base(int lane) { return ((lane & 3) << 3) | (((lane >> 2) & 3) << 6) | (((lane >> 4) & 1) << 5) | (((lane >> 5) & 1) << 8); }
constexpr int v_rd_off(int d0, int ks, int half) { return d0 * 512 + ks * 4096 + half * 2048; }
template <int OFF> __device__ __forceinline__ s16x4 tr_read(int vb) {
  s16x4 r; asm volatile("ds_read_b64_tr_b16 %0, %1 offset:%2" : "=&v"(r) : "v"(vb), "i"(OFF) : "memory"); return r;
}
template <int D0> __device__ __forceinline__ void pv_one(f32x16& od, int vb, bf16x8 pa0, bf16x8 pa1, bf16x8 pa2, bf16x8 pa3) {
  const s16x4 l0 = tr_read<v_rd_off(D0, 0, 0)>(vb), h0 = tr_read<v_rd_off(D0, 0, 1)>(vb), l1 = tr_read<v_rd_off(D0, 1, 0)>(vb), h1 = tr_read<v_rd_off(D0, 1, 1)>(vb);
  const s16x4 l2 = tr_read<v_rd_off(D0, 2, 0)>(vb), h2 = tr_read<v_rd_off(D0, 2, 1)>(vb), l3 = tr_read<v_rd_off(D0, 3, 0)>(vb), h3 = tr_read<v_rd_off(D0, 3, 1)>(vb);
  asm volatile("s_waitcnt lgkmcnt(0)" ::: "memory"); SBAR();
#define PK(L, H) (bf16x8){L[0], L[1], L[2], L[3], H[0], H[1], H[2], H[3]}
  od = __builtin_amdgcn_mfma_f32_32x32x16_bf16(pa0, PK(l0, h0), od, 0, 0, 0);
  od = __builtin_amdgcn_mfma_f32_32x32x16_bf16(pa1, PK(l1, h1), od, 0, 0, 0);
  od = __builtin_amdgcn_mfma_f32_32x32x16_bf16(pa2, PK(l2, h2), od, 0, 0, 0);
  od = __builtin_amdgcn_mfma_f32_32x32x16_bf16(pa3, PK(l3, h3), od, 0, 0, 0);
#undef PK
}
__device__ __forceinline__ void pv_d0(f32x16* o, int vb, bf16x8 pa0, bf16x8 pa1, bf16x8 pa2, bf16x8 pa3) {
  pv_one<0>(o[0], vb, pa0, pa1, pa2, pa3); pv_one<1>(o[1], vb, pa0, pa1, pa2, pa3); pv_one<2>(o[2], vb, pa0, pa1, pa2, pa3); pv_one<3>(o[3], vb, pa0, pa1, pa2, pa3);
}
__device__ __forceinline__ void attn_dense_body(const bf16_t* __restrict__ Qb, const bf16_t* __restrict__ Kh, const bf16_t* __restrict__ Vh,
                                                bf16_t* __restrict__ Ob, int seq, char* lds) {
  const int tid = hide_tid(), wid = tid >> 6, lane = tid & 63, r32 = lane & 31, hi = lane >> 5;
  bf16_t* V_lds = (bf16_t*)lds; bf16_t* K_lds = (bf16_t*)(lds + 2 * SHM_V);
  float* ws = (float*)(lds + 2 * SHM_V + 2 * SHM_K) + wid * 64; float* li_l = ws; float* al_l = ws + 32;
  float m_reg = -1e30f, l_reg = 0; f32x16 o[4] = {}; bf16x8 qr[8];
  const bf16_t* Qw = Qb + (long)(wid * QBLK + r32) * LDQ + hi * 8;
#pragma unroll
  for (int d0 = 0; d0 < 8; ++d0) qr[d0] = *reinterpret_cast<const bf16x8*>(Qw + d0 * 16);
  const int sr = tid >> 4, sc = (tid & 15) * 8, vst0 = v_st(sr, sc), vst1 = v_st(32 + sr, sc);
  const int vb0 = (int)(uintptr_t)V_lds + v_rd_base(lane);
  struct { bf16x8 vs0, vs1, ks0, ks1; } sr_[2];
#define SLOAD(i, k0) do { sr_[i].vs0 = *reinterpret_cast<const bf16x8*>(&Vh[(long)((k0) + sr) * LDK + sc]); sr_[i].vs1 = *reinterpret_cast<const bf16x8*>(&Vh[(long)((k0) + 32 + sr) * LDK + sc]); \
    sr_[i].ks0 = *reinterpret_cast<const bf16x8*>(&Kh[(long)((k0) + sr) * LDK + sc]); sr_[i].ks1 = *reinterpret_cast<const bf16x8*>(&Kh[(long)((k0) + 32 + sr) * LDK + sc]); } while (0)
#define SWRITE(b, i) do { *(bf16x8*)((char*)V_lds + (b) * SHM_V + vst0) = sr_[i].vs0;          \
    *(bf16x8*)((char*)V_lds + (b) * SHM_V + vst1) = sr_[i].vs1; int kc = sc * 2;               \
    *(bf16x8*)((char*)K_lds + (b) * SHM_K + KSWZ(sr, kc)) = sr_[i].ks0;                       \
    *(bf16x8*)((char*)K_lds + (b) * SHM_K + KSWZ(32 + sr, kc)) = sr_[i].ks1; } while (0)
#define SWAIT() asm volatile("s_waitcnt vmcnt(4)" ::: "memory")
#define RESC(a) do { if (__any((a) < 1.f)) { if (hi == 0) al_l[r32] = (a); asm volatile("s_waitcnt lgkmcnt(0)" ::: "memory"); \
    _Pragma("unroll") for (int d = 0; d < 4; ++d) _Pragma("unroll") for (int r = 0; r < 16; ++r) o[d][r] *= al_l[crow(r, hi)]; } } while (0)
  f32x16 pA0, pA1, pB0, pB1; float mnA, mnB, alA, alB; bf16x8 pa0, pa1, pa2, pa3; const int NKT = seq / KVBLK;
  constexpr int SE = 0, SO = 1;
  SLOAD(SE, 0); asm volatile("s_waitcnt vmcnt(0)" ::: "memory"); SWRITE(0, SE); __syncthreads();
  qkt(pA0, pA1, K_lds, qr, r32, hi); partialSM(pA0, pA1, m_reg, mnA, alA);
  SLOAD(SO, KVBLK); if (2 < NKT) SLOAD(SE, 2 * KVBLK);
  SWAIT(); SWRITE(1, SO); __syncthreads();
  for (int j = 1; j + 1 < NKT; j += 2) {
    SBAR(); qkt(pB0, pB1, (bf16_t*)((char*)K_lds + SHM_K), qr, r32, hi);
    finishSM(pA0, pA1, alA, l_reg, pa0, pa1, pa2, pa3); SBAR();
    SLOAD(SO, (j + 2) * KVBLK); SBAR();
    pv_d0(o, vb0, pa0, pa1, pa2, pa3); partialSM(pB0, pB1, m_reg, mnB, alB);
    __syncthreads(); SWAIT(); SWRITE(0, SE);
    RESC(alB); __syncthreads();
    SBAR(); qkt(pA0, pA1, K_lds, qr, r32, hi);
    finishSM(pB0, pB1, alB, l_reg, pa0, pa1, pa2, pa3); SBAR();
    if (j + 3 < NKT) SLOAD(SE, (j + 3) * KVBLK); SBAR();
    pv_d0(o, vb0 + (int)SHM_V, pa0, pa1, pa2, pa3); partialSM(pA0, pA1, m_reg, mnA, alA);
    __syncthreads(); SWAIT(); SWRITE(1, SO);
    RESC(alA); __syncthreads();
  }
  SBAR(); qkt(pB0, pB1, (bf16_t*)((char*)K_lds + SHM_K), qr, r32, hi);
  finishSM(pA0, pA1, alA, l_reg, pa0, pa1, pa2, pa3); SBAR();
  pv_d0(o, vb0, pa0, pa1, pa2, pa3); partialSM(pB0, pB1, m_reg, mnB, alB);
  __syncthreads(); RESC(alB);
  finishSM(pB0, pB1, alB, l_reg, pa0, pa1, pa2, pa3); SBAR();
  pv_d0(o, vb0 + (int)SHM_V, pa0, pa1, pa2, pa3);
  if (hi == 0) li_l[r32] = l_reg; asm volatile("s_waitcnt lgkmcnt(0)" ::: "memory");
  bf16_t* Ow = Ob + (long)(wid * QBLK) * LDO + r32;
#pragma unroll
  for (int r = 0; r < 16; ++r) { const int orow = crow(r, hi); const float rl = __builtin_amdgcn_rcpf(li_l[orow]);
#pragma unroll
    for (int d0 = 0; d0 < 4; ++d0) Ow[(long)orow * LDO + d0 * 32] = (bf16_t)cvtpk(o[d0][r] * rl, 0.f); }
  __syncthreads();
#undef SLOAD
#undef SWRITE
#undef SWAIT
#undef RESC
}
#undef KSWZ
#undef SBAR
}

__device__ __forceinline__ void ph_attn(const Params& p, char* smem) {
    const bf16_t* QA = (const bf16_t*)(p.ws + OFF_QA);
    const bf16_t* KA = (const bf16_t*)(p.ws + OFF_KA);
    const bf16_t* VA = (const bf16_t*)(p.ws + OFF_VT);
    bf16_t* O = (bf16_t*)(p.ws + OFF_O);
    for (int item = blockIdx.x; item < 8 * 8 * 8; item += gridDim.x) {
        const int qb = item & 7, h = (item >> 3) & 7, b = item >> 6, kvh = h >> 2;
        const size_t qoff = (size_t)(b * SEQ + qb * 256) * 1024 + h * 128;
        const size_t koff = (size_t)(b * 2 + kvh) * TSEQ * 128;
        att::attn_dense_body(QA + qoff, KA + koff, VA + koff, O + qoff, TSEQ, smem);
    }
}

#define N_PHASES 19
template <int PH>
__device__ __forceinline__ void run_phase(const Params& p, LAS unsigned char* lds, int rep = 0) {
    char* smem = (char*)lds;
    if (PH == 0) { if (!(rep && REP_SUB == 2)) ph_ada(p, smem); if (!(rep && REP_SUB == 1)) cvt_dense(p, smem); }
    else if (PH == 1) ph_rows<0>(p, smem);
    else if (PH == 2) ph_gemm_in(p, lds);
    else if (PH == 3) ph_prep(p, smem, rep);
    else if (PH == 4) ph_scan(p, smem, rep);
    else if (PH == 5) ph_merge(p, smem);
    else if (PH == 6) { ph_gemm_out<0>(p, lds); cvt_moe(p, 0, smem); }
    else if (PH == 7) ph_rows<1>(p, smem);
    else if (PH == 8) ph_moe_up(p, 0, lds);
    else if (PH == 9) ph_moe_down(p, 0, lds);
    else if (PH == 10) ph_rows<2>(p, smem);
    else if (PH == 11) ph_gemm_qkv(p, lds);
    else if (PH == 12) { if (!(rep && REP_SUB == 2)) ph_qkprep(p, smem); if (!(rep && REP_SUB == 1)) cvt_moe(p, 1, smem); }
    else if (PH == 13) ph_attn(p, smem);
    else if (PH == 14) ph_gemm_out<1>(p, lds);
    else if (PH == 15) ph_rows<3>(p, smem);
    else if (PH == 16) ph_moe_up(p, 1, lds);
    else if (PH == 17) ph_moe_down(p, 1, lds);
    else if (PH == 18) ph_rows<4>(p, smem);
}

extern __shared__ __attribute__((aligned(16))) unsigned char dyn_lds[];
template <int PH>
__global__ void __launch_bounds__(NTHR, 2) k_phase(Params p) {
    run_phase<PH>(p, (LAS unsigned char*)dyn_lds);
}

#if ONE_LAUNCH
template <int PH>
__device__ __forceinline__ void run_all(const Params& p, LAS unsigned char* lds, const XcdBarrier& bar) {
    if (PH == REP_PH) {
        int nrep = 2; asm volatile("" : "+s"(nrep));
#pragma unroll 1
        for (int r = 0; r < nrep; ++r) { run_phase<PH>(p, lds, r); if (r + 1 < nrep) xcd_barrier(bar); }
    } else run_phase<PH>(p, lds);
    if (PH + 1 < N_PHASES) {
        xcd_barrier(bar);
        run_all<(PH + 1 < N_PHASES) ? PH + 1 : PH>(p, lds, bar);
    }
}
template <>
__device__ __forceinline__ void run_all<N_PHASES - 1>(const Params& p, LAS unsigned char* lds, const XcdBarrier& bar) {
    if (N_PHASES - 1 == REP_PH) {
        int nrep = 2; asm volatile("" : "+s"(nrep));
#pragma unroll 1
        for (int r = 0; r < nrep; ++r) { run_phase<N_PHASES - 1>(p, lds, r); if (r + 1 < nrep) xcd_barrier(bar); }
    } else run_phase<N_PHASES - 1>(p, lds);
}

__global__ void __launch_bounds__(NTHR, 2) k_mega(Params p) {
    LAS unsigned char* lds = (LAS unsigned char*)dyn_lds;
    if (threadIdx.x < 4) ((LAS unsigned*)(lds + LDS_XB))[threadIdx.x] = 0u;
    __syncthreads();
    XcdBarrier bar = xcd_barrier_post((unsigned*)(p.ws + OFF_ZERO), (volatile LAS unsigned*)(lds + LDS_XB));
    run_all<0>(p, lds, bar);
}
#endif

template <int PH>
static void launch_phases(const Params& p, hipStream_t stream) {
    static bool attr_set = false;
    if (!attr_set) { (void)hipFuncSetAttribute((const void*)k_phase<PH>, hipFuncAttributeMaxDynamicSharedMemorySize, DYN_LDS); attr_set = true; }
    hipLaunchKernelGGL(k_phase<PH>, dim3(256), dim3(NTHR), DYN_LDS, stream, p);
    if constexpr (PH + 1 < N_PHASES) launch_phases<PH + 1>(p, stream);
}

extern "C" void kernel_launch(void* const* d_in, const int* in_sizes, int n_in, void* d_out, int out_size, void* d_ws,
                              size_t ws_size, hipStream_t stream) {
    Params p{};
    for (int i = 0; i < 32; ++i) p.in[i] = (const float*)d_in[i];
    p.out = (float*)d_out;
    p.ws = (char*)d_ws;
    (void)hipMemsetAsync(d_ws, 0, ZERO_BYTES, stream);
#if ONE_LAUNCH
    static int grid = 0;
    if (!grid) {
        int dev = 0, cus = 0, per_cu = 0;
        (void)hipGetDevice(&dev);
        (void)hipDeviceGetAttribute(&cus, hipDeviceAttributeMultiprocessorCount, dev);
        (void)hipFuncSetAttribute((const void*)k_mega, hipFuncAttributeMaxDynamicSharedMemorySize, DYN_LDS);
        (void)hipOccupancyMaxActiveBlocksPerMultiprocessor(&per_cu, k_mega, NTHR, DYN_LDS);
        if (cus <= 0) cus = 256;
        grid = cus * (per_cu < 1 ? per_cu : 1);
        if (grid <= 0) grid = cus;
    }
    hipLaunchKernelGGL(k_mega, dim3(grid), dim3(NTHR), DYN_LDS, stream, p);
#else
    launch_phases<0>(p, stream);
#endif
}
```

```cpp
#include <hip/hip_runtime.h>
#include <stdint.h>

#ifndef ONE_LAUNCH
#define ONE_LAUNCH 1
#endif
#ifndef TS_PH
#define TS_PH -2
#endif
#define TSACC(i) do { if (TS_PH >= 100 && blockIdx.x == 0 && threadIdx.x == 0) { LAS unsigned long long* _t = (LAS unsigned long long*)(dyn_lds + LDS_TS); const unsigned long long _n = __builtin_amdgcn_s_memrealtime(); _t[24 + (i)] += _n - _t[23]; _t[23] = _n; } } while (0)
#define TSMARK() do { if (TS_PH >= 100 && blockIdx.x == 0 && threadIdx.x == 0) { ((LAS unsigned long long*)(dyn_lds + LDS_TS))[23] = __builtin_amdgcn_s_memrealtime(); } } while (0)
#ifndef REP_SUB
#define REP_SUB 0
#endif
#ifndef REP_PH
#define REP_PH -1
#endif

typedef unsigned short bf16_t;
typedef __attribute__((ext_vector_type(8))) short bf16x8;
typedef __attribute__((ext_vector_type(4))) float f32x4;
extern __shared__ __attribute__((aligned(16))) unsigned char dyn_lds[];

#define D_MODEL 1024
#define BATCH 8
#define SEQ 2048
#define CTXL 256
#define NL (BATCH * SEQ)
#define NC (BATCH * CTXL)
#define NT (NL + NC)
#define AB_PROJ 3088
#define TSEQ (SEQ + CTXL)
#define EPSF 1e-6f
#define NTHR 512

enum { I_X = 0, I_C, I_CTX, I_CCTX, I_ADAW, I_ADAB, I_NORM1, I_NORM2, I_FNORM, I_ABWIN, I_CONVQKV, I_ALOG, I_DTB,
       I_ONORM, I_CONVX, I_RGWR, I_RGBR, I_RGWI, I_RGBI, I_RGLAM, I_ABWOUT, I_ATWQKV, I_QNORM, I_KNORM, I_ATWOUT,
       I_WGRP, I_BGRP, I_WEXP, I_BEXP, I_WGATE, I_WUP, I_WDOWN };

#define AL256(x) (((size_t)(x) + 255) & ~(size_t)255)
#define ZW 3072
#define OFF_ZERO 0
#define ZERO_BYTES 65536
#define OFF_CNT 16384
#define OFF_MOD (OFF_ZERO + ZERO_BYTES)
#define OFF_X AL256(OFF_MOD + 2 * 9 * 6144 * 4)
#define OFF_H AL256(OFF_X + (size_t)NT * 1024 * 4)
#define OFF_Z AL256(OFF_H + (size_t)NT * 1024 * 2)
#define OFF_BTIN AL256(OFF_Z + (size_t)NT * ZW * 2)
#define OFF_BTOUT0 AL256(OFF_BTIN + (size_t)3072 * 1024 * 2)
#define OFF_BTQKV AL256(OFF_BTOUT0 + (size_t)1024 * 1024 * 2)
#define OFF_BTOUT1 AL256(OFF_BTQKV + (size_t)1536 * 1024 * 2)
#define OFF_WRG AL256(OFF_BTOUT1 + (size_t)1024 * 1024 * 2)
#define OFF_WSEL AL256(OFF_WRG + (size_t)8 * 256 * 64 * 2)
#define OFF_LIST AL256(OFF_WSEL + (size_t)2 * NT * 4)
#define OFF_R1 AL256(OFF_LIST + (size_t)32 * NT * 4)
#define OFF_GATES OFF_R1
#define OFF_QG AL256(OFF_GATES + (size_t)NT * 16 * 4)
#define OFF_KG AL256(OFF_QG + (size_t)1152 * 8192 * 2)
#define OFF_VG AL256(OFF_KG + (size_t)1152 * 8192 * 2)
#define OFF_KTG AL256(OFF_VG + (size_t)1152 * 8192 * 2)
#define OFF_TT AL256(OFF_KTG + (size_t)1152 * 8192 * 2)
#define OFF_ATT AL256(OFF_TT + (size_t)1152 * 2 * 4096 * 2)
#define OFF_VEC AL256(OFF_ATT + (size_t)1152 * 2 * 4096 * 2)
#define OFF_EGL AL256(OFF_VEC + (size_t)1152 * 2 * 256 * 4)
#define OFF_HLOC AL256(OFF_EGL + (size_t)1152 * 2 * 4)
#define OFF_ACUM AL256(OFF_HLOC + (size_t)2 * NT * 512 * 2)
#define OFF_LTOT AL256(OFF_ACUM + (size_t)2 * NT * 512 * 2)
#define OFF_CIN AL256(OFF_LTOT + (size_t)2 * 288 * 512 * 2 * 4)
#define OFF_OA AL256(OFF_CIN + (size_t)2 * 288 * 512 * 4)
#define OFF_END AL256(OFF_OA + (size_t)2 * NT * 512 * 2)
#define OFF_BTGU OFF_R1
#define OFF_BTD AL256(OFF_BTGU + (size_t)32 * 1024 * 1024 * 2)
#define OFF_ACT AL256(OFF_BTD + (size_t)32 * 1024 * 512 * 2)
#define OFF_YE AL256(OFF_ACT + (size_t)2 * NT * 512 * 2)
#define OFF_ZQ OFF_Z
#define OFF_ZC (OFF_Z + (size_t)NL * 1536 * 2)
#define OFF_QA (OFF_ZC + (size_t)NC * 512 * 2)
#define OFF_KA (OFF_QA + (size_t)NL * 1024 * 2)
#define OFF_VT (OFF_KA + (size_t)8 * 2 * TSEQ * 128 * 2)
#define OFF_O OFF_H
static_assert(OFF_YE + (size_t)2 * NT * 1024 * 2 <= OFF_END, "MoE scratch must fit in R1");
static_assert(OFF_VT + (size_t)8 * 2 * TSEQ * 128 * 2 <= OFF_BTIN, "attention buffers must fit in the Z region");
static_assert(OFF_END < (size_t)530 * 1024 * 1024, "workspace budget");

#define DYN_LDS (155 * 1024)
#define LDS_XB 131072
#define LDS_PRE (131072 + 64)
#define LDS_TS (131072 + 512)

struct Params {
    const float* in[32];
    float* out;
    char* ws;
};

__device__ __forceinline__ bf16_t f2bf(float f) {
    unsigned u = __float_as_uint(f);
    u += 0x7fffu + ((u >> 16) & 1u);
    return (bf16_t)(u >> 16);
}
__device__ __forceinline__ float bf2f(bf16_t h) { return __uint_as_float(((unsigned)h) << 16); }
__device__ __forceinline__ unsigned pack2(float a, float b) { return (unsigned)f2bf(a) | ((unsigned)f2bf(b) << 16); }
__device__ __forceinline__ float frcp_(float x) { return __builtin_amdgcn_rcpf(x); }
__device__ __forceinline__ float sigmoidf_(float x) { return frcp_(1.f + __expf(-x)); }
__device__ __forceinline__ float siluf_(float x) { return x * frcp_(1.f + __expf(-x)); }
__device__ __forceinline__ float softplusf_(float x) { return x > 20.f ? x : log1pf(__expf(x)); }
__device__ __forceinline__ float geluf_(float x) {
    const float u = 0.7978845608028654f * (x + 0.044715f * x * x * x);
    return x * frcp_(1.f + __expf(-2.f * u));
}
__device__ __forceinline__ float neg_expm1_small(float x) {
    float q = 1.f / 5040.f;
    q = q * x + 1.f / 720.f; q = q * x + 1.f / 120.f; q = q * x + 1.f / 24.f; q = q * x + 1.f / 6.f; q = q * x + 0.5f; q = q * x + 1.f;
    return x < -0.5f ? 1.f - __expf(x) : -x * q;
}
#define DPP_F(v, ctrl) __int_as_float(__builtin_amdgcn_update_dpp(0, __float_as_int(v), ctrl, 0xF, 0xF, true))
__device__ __forceinline__ float row16_sum(float v) {
    v += DPP_F(v, 0xB1);
    v += DPP_F(v, 0x4E);
    v += DPP_F(v, 0x141);
    v += DPP_F(v, 0x140);
    return v;
}
__device__ __forceinline__ float row16_max(float v) {
    v = fmaxf(v, DPP_F(v, 0xB1)); v = fmaxf(v, DPP_F(v, 0x4E)); v = fmaxf(v, DPP_F(v, 0x141)); v = fmaxf(v, DPP_F(v, 0x140));
    return v;
}
__device__ __forceinline__ float wave_sum(float v) {
    v = row16_sum(v);
    const float a = __int_as_float(__builtin_amdgcn_readlane(__float_as_int(v), 0));
    const float b = __int_as_float(__builtin_amdgcn_readlane(__float_as_int(v), 16));
    const float c = __int_as_float(__builtin_amdgcn_readlane(__float_as_int(v), 32));
    const float d = __int_as_float(__builtin_amdgcn_readlane(__float_as_int(v), 48));
    return (a + b) + (c + d);
}
__device__ __forceinline__ int hide_tid() { int t = threadIdx.x; asm volatile("" : "+v"(t)); return t & 511; }
__device__ __forceinline__ int scan_row(int s, int dir, int b) {
    if (s < CTXL) { const int t = dir ? (CTXL - 1 - s) : s; return NL + b * CTXL + t; }
    const int u = s - CTXL; const int t = dir ? (SEQ - 1 - u) : u; return b * SEQ + t;
}

#define XB_TMO      128
#define XB_XCNT(j)  (256  + 64 * (j))
#define XB_XSUB(j)  (1280 + 64 * (j))
#define XB_XGEN(j)  (2304 + 64 * (j))
#define XB_TOP      3328
#define XB_TOPGEN   3392
#define XCD_BAR_WORDS 3456
#define XB_SPIN_CAP (1u << 22)
#define LAS __attribute__((address_space(3)))

__device__ __forceinline__ unsigned xb_ld(unsigned* p)              { return __hip_atomic_load(p, __ATOMIC_RELAXED, __HIP_MEMORY_SCOPE_AGENT); }
__device__ __forceinline__ unsigned xb_add(unsigned* p, unsigned v) { return __hip_atomic_fetch_add(p, v, __ATOMIC_RELAXED, __HIP_MEMORY_SCOPE_AGENT); }
__device__ __forceinline__ unsigned xb_xcc_id() { return (unsigned)__builtin_amdgcn_s_getreg((3 << 11) | 20) & 0xFu; }
#define XB_SPIN(cond, bar) do { unsigned _sp = 0; while (cond) { __builtin_amdgcn_s_sleep(1); \
    if ((++_sp & 255u) == 0u) { if (xb_ld(&(bar)[XB_TMO])) break; if (_sp > XB_SPIN_CAP) { atomicAdd(&(bar)[XB_TMO], 1u); break; } } } } while (0)

struct XcdBarrier {
    unsigned* bar; unsigned x;
    volatile LAS unsigned* st;
};
__device__ __forceinline__ XcdBarrier xcd_barrier_post(unsigned* bar, volatile LAS unsigned* st) {
    XcdBarrier b; b.bar = bar; b.x = xb_xcc_id(); b.st = st;
    if (threadIdx.x == 0) (void)xb_add(&bar[XB_XCNT(b.x)], 1u);
    return b;
}
__device__ __forceinline__ void xcd_barrier_complete(unsigned* bar, unsigned x, unsigned& nloc, unsigned& nx) {
    const unsigned G = gridDim.x * gridDim.y * gridDim.z;
    unsigned sum, cnt, mine, sp = 0u;
    for (;;) {
        sum = 0u; cnt = 0u; mine = 0u;
#pragma unroll
        for (unsigned j = 0; j < 16; ++j) { const unsigned c = xb_ld(&bar[XB_XCNT(j)]); sum += c; cnt += (c > 0u) ? 1u : 0u; mine = (j == x) ? c : mine; }
        if (sum == G) break;
        __builtin_amdgcn_s_sleep(1);
        if ((++sp & 255u) == 0u) { if (xb_ld(&bar[XB_TMO])) break; if (sp > XB_SPIN_CAP) { atomicAdd(&bar[XB_TMO], 1u); break; } }
    }
    nloc = mine > 0u ? mine : 1u; nx = cnt > 0u ? cnt : 1u;
}
__device__ __forceinline__ void xcd_barrier(const XcdBarrier& b) {
    asm volatile("s_waitcnt vmcnt(0)" ::: "memory");
    __syncthreads();
    if (threadIdx.x == 0) {
        unsigned* bar = b.bar;
        __builtin_amdgcn_s_waitcnt(0);
        unsigned nloc = b.st[0], nx = b.st[1];
        if (nloc == 0u) { xcd_barrier_complete(bar, b.x, nloc, nx); b.st[0] = nloc; b.st[1] = nx; }
        const unsigned old = xb_add(&bar[XB_XSUB(b.x)], 1u);
        const unsigned gen = old / nloc;
        if (old + 1u == (gen + 1u) * nloc) {
            __builtin_amdgcn_fence(__ATOMIC_RELEASE, "agent");
            asm volatile("s_waitcnt vmcnt(0)" ::: "memory");
            const unsigned og = xb_add(&bar[XB_TOP], 1u);
            const unsigned tg = og / nx;
            if (og + 1u == (tg + 1u) * nx) xb_add(&bar[XB_TOPGEN], 1u);
            else XB_SPIN(xb_ld(&bar[XB_TOPGEN]) == tg, bar);
            __builtin_amdgcn_fence(__ATOMIC_ACQUIRE, "agent");
            xb_add(&bar[XB_XGEN(b.x)], 1u);
            asm volatile("s_waitcnt vmcnt(0)" ::: "memory");
        } else {
            XB_SPIN(xb_ld(&bar[XB_XGEN(b.x)]) == gen, bar);
            __builtin_amdgcn_fence(__ATOMIC_ACQUIRE, "agent");
            asm volatile("s_waitcnt vmcnt(0)" ::: "memory");
        }
    }
    __syncthreads();
}

template <int NB, class RowPtr, class Epi>
__device__ __forceinline__ void gemm_tile(RowPtr rowptr, const float* __restrict__ B0, const float* __restrict__ B1,
                                          int ldb, int K, int n0, int N, Epi epi, char* smem) {
    constexpr int LDS_LD = 72;
    bf16_t* As = (bf16_t*)smem;
    bf16_t* Bs0 = As + 128 * LDS_LD;
    bf16_t* Bs1 = Bs0 + 128 * LDS_LD;
    const int tid = hide_tid(), lane = tid & 63, wave = tid >> 6;
    const int wm = wave >> 1, wn = wave & 1;
    const int l15 = lane & 15, lq = lane >> 4;

    const bf16_t* arow0 = rowptr(tid >> 3);
    const bf16_t* arow1 = rowptr((tid >> 3) + 64);
    const int akc = (tid & 7) * 8;
    const int bn = tid & 127, bkg = tid >> 7;
    const bool bok = (n0 + bn) < N;
    const float* b0p = B0 + (size_t)(bkg * 8) * ldb + n0 + bn;
    const float* b1p = (NB == 2) ? (B1 + (size_t)(bkg * 8) * ldb + n0 + bn) : nullptr;

    f32x4 acc0[2][4], acc1[2][4];
#pragma unroll
    for (int i = 0; i < 2; ++i)
#pragma unroll
        for (int j = 0; j < 4; ++j) { acc0[i][j] = (f32x4){0.f, 0.f, 0.f, 0.f}; acc1[i][j] = (f32x4){0.f, 0.f, 0.f, 0.f}; }

    uint4 ra0, ra1;
    float rb0[16], rb1[16];
    const int nk = K >> 6;
    auto load_regs = [&](int kt) {
        const int k0 = kt * 64;
        ra0 = arow0 ? *(const uint4*)(arow0 + k0 + akc) : make_uint4(0, 0, 0, 0);
        ra1 = arow1 ? *(const uint4*)(arow1 + k0 + akc) : make_uint4(0, 0, 0, 0);
#pragma unroll
        for (int r = 0; r < 2; ++r)
#pragma unroll
            for (int j = 0; j < 8; ++j) {
                const size_t o = (size_t)(k0 + r * 32 + j) * ldb;
                rb0[r * 8 + j] = bok ? b0p[o] : 0.f;
                if (NB == 2) rb1[r * 8 + j] = bok ? b1p[o] : 0.f;
            }
    };
    load_regs(0);
    for (int kt = 0; kt < nk; ++kt) {
        __syncthreads();
        *(uint4*)(As + (tid >> 3) * LDS_LD + akc) = ra0;
        *(uint4*)(As + ((tid >> 3) + 64) * LDS_LD + akc) = ra1;
#pragma unroll
        for (int r = 0; r < 2; ++r) {
            uint4 w;
            w.x = pack2(rb0[r * 8 + 0], rb0[r * 8 + 1]); w.y = pack2(rb0[r * 8 + 2], rb0[r * 8 + 3]);
            w.z = pack2(rb0[r * 8 + 4], rb0[r * 8 + 5]); w.w = pack2(rb0[r * 8 + 6], rb0[r * 8 + 7]);
            *(uint4*)(Bs0 + bn * LDS_LD + bkg * 8 + r * 32) = w;
            if (NB == 2) {
                w.x = pack2(rb1[r * 8 + 0], rb1[r * 8 + 1]); w.y = pack2(rb1[r * 8 + 2], rb1[r * 8 + 3]);
                w.z = pack2(rb1[r * 8 + 4], rb1[r * 8 + 5]); w.w = pack2(rb1[r * 8 + 6], rb1[r * 8 + 7]);
                *(uint4*)(Bs1 + bn * LDS_LD + bkg * 8 + r * 32) = w;
            }
        }
        __syncthreads();
        if (kt + 1 < nk) load_regs(kt + 1);
#pragma unroll
        for (int kk = 0; kk < 2; ++kk) {
            bf16x8 af[2];
#pragma unroll
            for (int mi = 0; mi < 2; ++mi)
                af[mi] = *(const bf16x8*)(As + (wm * 32 + mi * 16 + l15) * LDS_LD + kk * 32 + lq * 8);
#pragma unroll
            for (int ni = 0; ni < 4; ++ni) {
                const bf16x8 bf0 = *(const bf16x8*)(Bs0 + (wn * 64 + ni * 16 + l15) * LDS_LD + kk * 32 + lq * 8);
#pragma unroll
                for (int mi = 0; mi < 2; ++mi) acc0[mi][ni] = __builtin_amdgcn_mfma_f32_16x16x32_bf16(af[mi], bf0, acc0[mi][ni], 0, 0, 0);
                if (NB == 2) {
                    const bf16x8 bf1 = *(const bf16x8*)(Bs1 + (wn * 64 + ni * 16 + l15) * LDS_LD + kk * 32 + lq * 8);
#pragma unroll
                    for (int mi = 0; mi < 2; ++mi) acc1[mi][ni] = __builtin_amdgcn_mfma_f32_16x16x32_bf16(af[mi], bf1, acc1[mi][ni], 0, 0, 0);
                }
            }
        }
    }
#pragma unroll
    for (int mi = 0; mi < 2; ++mi)
#pragma unroll
        for (int ni = 0; ni < 4; ++ni) {
            const int n = n0 + wn * 64 + ni * 16 + l15;
            if (n < N) {
#pragma unroll
                for (int j = 0; j < 4; ++j) epi(wm * 32 + mi * 16 + lq * 4 + j, n, acc0[mi][ni][j], acc1[mi][ni][j]);
            }
        }
}

namespace g8 {
constexpr int BM = 256, BK = 64, HALF = 128, HTB = HALF * BK * 2, STAGE_BYTES = 8 * HTB, NXCD = 8, WGM = 8;
typedef unsigned u32x4 __attribute__((ext_vector_type(4)));
__device__ __forceinline__ int lds_byte(int r, int c) { const int st = (r >> 4) * 2 + (c >> 5), rr = r & 15, cc = c & 31, ob = rr * 64 + cc * 2; return st * 1024 + (ob ^ (((ob >> 9) & 1) << 5)); }
__device__ __forceinline__ void stage_rc(int b, int& R, int& C) { const int st = b / 1024, sb = b % 1024, swz = sb ^ (((sb >> 9) & 1) << 5); R = (st >> 1) * 16 + swz / 64; C = (st & 1) * 32 + (swz % 64) / 2; }
__device__ __forceinline__ int perm32(int rho) { const int n = rho >> 4, i = rho & 15; return 8 * (i >> 2) + 4 * n + (i & 3); }
__device__ __forceinline__ unsigned cvt_pk_bf16(float lo, float hi) { unsigned r; asm volatile("v_cvt_pk_bf16_f32 %0, %1, %2" : "=v"(r) : "v"(lo), "v"(hi)); return r; }

struct Unit {
    const char* A;
    const char* Bt;
    const int* lst;
    int mv;
    int pm, pn;
    int aux;
};

__device__ __forceinline__ void static_order(int wgid, int nM, int nN, int& pm, int& pn) {
    const int nwg = nM * nN;
    { const int q = nwg / NXCD, r = nwg % NXCD, xcd = wgid % NXCD, off = wgid / NXCD; wgid = (xcd < r ? xcd * (q + 1) : r * (q + 1) + (xcd - r) * q) + off; }
    const int nig = WGM * nN, gid = wgid / nig, fm = gid * WGM, gsz = (nM - fm) < WGM ? (nM - fm) : WGM;
    pm = fm + ((wgid % nig) % gsz); pn = (wgid % nig) / gsz;
}

template <bool GATHER, int GSHIFT, class Epi, class Sched>
__device__ __forceinline__ void gemm_phase(LAS unsigned char* lds, const int K, const Sched& S, const Epi& E) {
    const int tid = hide_tid(), wid = __builtin_amdgcn_readfirstlane(tid >> 6), lane = tid & 63, wr = wid >> 2, wc = wid & 3, fr = lane & 15, fq = lane >> 4;
    const int nt = K / BK;
    unsigned voffA[2], voffB[2];
#pragma unroll
    for (int i = 0; i < 2; ++i) { int R, C; stage_rc(tid * 16 + i * 8192, R, C); const int Rb = Epi::PERM ? ((R & ~31) + perm32(R & 31)) : R;
        voffA[i] = (unsigned)(R * K + C) * 2u; voffB[i] = (unsigned)(Rb * K + C) * 2u; }
    const size_t kstep = (size_t)(BK * 2);
    const size_t hstep = (size_t)HALF * K * 2;
    const unsigned ldsw = (unsigned)wid * 1024u;
    const int aoff = lds_byte(wr * 64 + fr, fq * 8), boff = lds_byte(wc * 32 + fr, fq * 8);
    unsigned gcur[2][2];
    auto gather_offs = [&](const Unit& u, unsigned (&g)[2][2]) {
#pragma unroll
        for (int h = 0; h < 2; ++h)
#pragma unroll
            for (int i = 0; i < 2; ++i) { int R, C; stage_rc(tid * 16 + i * 8192, R, C); int idx = h * 128 + R; idx = idx < u.mv ? idx : u.mv - 1;
                g[h][i] = (unsigned)(u.lst[idx] >> GSHIFT) * (unsigned)(K * 2) + (unsigned)(C * 2); }
    };
#define G8_SA(b, h) (((b) * 2 + (h)) * HTB)
#define G8_SB(b, h) ((4 + (b) * 2 + (h)) * HTB)
#define G8_STAGE(bufoff, gbase, voff) do { _Pragma("unroll") for (int _i = 0; _i < 2; ++_i) \
        __builtin_amdgcn_global_load_lds((const unsigned*)((const char*)(gbase) + (voff)[_i]), (LAS unsigned*)(lds + (bufoff) + ldsw + _i * 8192), 16, 0, 0); } while (0)
#define G8_LDA(dst, b, h) do { _Pragma("unroll") for (int m = 0; m < 4; ++m) _Pragma("unroll") for (int k = 0; k < 2; ++k) dst[m][k] = *(const LAS bf16x8*)(lds + G8_SA(b, h) + aoff + m * 2048 + k * 1024); } while (0)
#define G8_LDB(dst, b, h) do { _Pragma("unroll") for (int n = 0; n < 2; ++n) _Pragma("unroll") for (int k = 0; k < 2; ++k) dst[n][k] = *(const LAS bf16x8*)(lds + G8_SB(b, h) + boff + n * 2048 + k * 1024); } while (0)
#define G8_MMA(ai, bj, At, Bt) do { __builtin_amdgcn_s_setprio(1); _Pragma("unroll") for (int m = 0; m < 4; ++m) _Pragma("unroll") for (int n = 0; n < 2; ++n) _Pragma("unroll") for (int k = 0; k < 2; ++k) \
        acc[ai][bj][m][n] = __builtin_amdgcn_mfma_f32_16x16x32_bf16(Bt[n][k], At[m][k], acc[ai][bj][m][n], 0, 0, 0); __builtin_amdgcn_s_setprio(0); } while (0)
#define G8_WAIT_V(n) asm volatile("s_waitcnt vmcnt(" #n ")" ::: "memory")
#define G8_WAIT_L(n) asm volatile("s_waitcnt lgkmcnt(" #n ")" ::: "memory")
#define G8_BAR __builtin_amdgcn_s_barrier()
#define G8_SCHED __builtin_amdgcn_sched_barrier(0)
    Unit cur, nxt; int ui = 0;
    if (!S.next(0, cur)) return;
    f32x4 acc[2][2][4][2];
#pragma unroll
    for (int a = 0; a < 2; ++a)
#pragma unroll
        for (int b = 0; b < 2; ++b)
#pragma unroll
            for (int m = 0; m < 4; ++m)
#pragma unroll
                for (int n = 0; n < 2; ++n) acc[a][b][m][n] = (f32x4){0.f, 0.f, 0.f, 0.f};
    bf16x8 At[4][2], B0[2][2], B1[2][2];
    const char* cA = cur.A; const char* cB = cur.Bt;
    if (GATHER) gather_offs(cur, gcur);
#define G8_STAGE_A(bufoff, kp, h, g) do { if (GATHER) G8_STAGE(bufoff, kp, (g)[h]); else G8_STAGE(bufoff, (kp) + (h) * hstep, voffA); } while (0)
    G8_STAGE(G8_SB(0, 0), cB, voffB); G8_STAGE_A(G8_SA(0, 0), cA, 0, gcur); G8_STAGE(G8_SB(0, 1), cB + hstep, voffB); G8_STAGE_A(G8_SA(0, 1), cA, 1, gcur);
    if (wr == 1) G8_BAR;
    G8_WAIT_V(4); G8_BAR;
    G8_STAGE(G8_SB(1, 0), cB + kstep, voffB); G8_STAGE_A(G8_SA(1, 0), cA + kstep, 0, gcur); G8_STAGE(G8_SB(1, 1), cB + hstep + kstep, voffB);
    G8_WAIT_V(6); G8_BAR;
    for (;;) {
        const bool has_next = S.next(ui + 1, nxt);
        const char* nA = has_next ? nxt.A : cA; const char* nB = has_next ? nxt.Bt : cB;
        for (int t = 0; t < nt; t += 2) {
            const bool last = (t == nt - 2);
            const char* a1 = cA + (size_t)(t + 1) * kstep;
            const char* a2 = last ? nA : cA + (size_t)(t + 2) * kstep; const char* b2 = last ? nB : cB + (size_t)(t + 2) * kstep;
            const char* a3 = a2 + kstep; const char* b3 = b2 + kstep;
            G8_LDB(B0, 0, 0); G8_SCHED; G8_LDA(At, 0, 0); G8_STAGE_A(G8_SA(1, 1), a1, 1, gcur);
            G8_WAIT_L(8); G8_BAR; G8_WAIT_L(0); G8_MMA(0, 0, At, B0); G8_BAR; G8_SCHED;
            if (GATHER) { if (last && has_next) gather_offs(nxt, gcur); }
            G8_LDB(B1, 0, 1); G8_STAGE(G8_SB(0, 0), b2, voffB);
            G8_BAR; G8_WAIT_L(0); G8_MMA(0, 1, At, B1); G8_BAR;
            G8_LDA(At, 0, 1); G8_STAGE_A(G8_SA(0, 0), a2, 0, gcur);
            G8_BAR; G8_WAIT_L(0); G8_MMA(1, 0, At, B0); G8_BAR; G8_SCHED;
            G8_STAGE(G8_SB(0, 1), b2 + hstep, voffB);
            G8_WAIT_V(6); G8_BAR; G8_MMA(1, 1, At, B1); G8_BAR;
            G8_LDB(B0, 1, 0); G8_SCHED; G8_LDA(At, 1, 0); G8_STAGE_A(G8_SA(0, 1), a2, 1, gcur);
            G8_WAIT_L(8); G8_BAR; G8_WAIT_L(0); G8_MMA(0, 0, At, B0); G8_BAR; G8_SCHED;
            G8_LDB(B1, 1, 1); G8_STAGE(G8_SB(1, 0), b3, voffB);
            G8_BAR; G8_WAIT_L(0); G8_MMA(0, 1, At, B1); G8_BAR;
            G8_LDA(At, 1, 1); G8_STAGE_A(G8_SA(1, 0), a3, 0, gcur);
            G8_BAR; G8_WAIT_L(0); G8_MMA(1, 0, At, B0); G8_BAR; G8_SCHED;
            G8_STAGE(G8_SB(1, 1), b3 + hstep, voffB);
            G8_WAIT_V(6); G8_BAR; G8_MMA(1, 1, At, B1); G8_BAR;
        }
        E(acc, cur, wr, wc, fr, fq);
        if (!has_next) break;
#pragma unroll
        for (int a = 0; a < 2; ++a)
#pragma unroll
            for (int b = 0; b < 2; ++b)
#pragma unroll
                for (int m = 0; m < 4; ++m)
#pragma unroll
                    for (int n = 0; n < 2; ++n) acc[a][b][m][n] = (f32x4){0.f, 0.f, 0.f, 0.f};
        cur = nxt; cA = nA; cB = nB; ++ui;
    }
    G8_WAIT_V(0);
    if (wr == 0) G8_BAR;
    G8_BAR;
#undef G8_SA
#undef G8_SB
#undef G8_STAGE
#undef G8_STAGE_A
#undef G8_LDA
#undef G8_LDB
#undef G8_MMA
#undef G8_WAIT_V
#undef G8_WAIT_L
#undef G8_BAR
#undef G8_SCHED
}

struct EpiBf16 {
    static constexpr bool PERM = true;
    bf16_t* O0; int ldc0; bf16_t* O1; int ldc1;
    __device__ __forceinline__ void operator()(const f32x4 (&acc)[2][2][4][2], const Unit& u, int wr, int wc, int fr, int fq) const {
        bf16_t* O = u.aux ? O1 : O0; const int ldc = u.aux ? ldc1 : ldc0;
        const int row0 = u.pm * BM + wr * 64 + fr, col0 = u.pn * BM + wc * 32 + 8 * fq;
#pragma unroll
        for (int ai = 0; ai < 2; ++ai)
#pragma unroll
            for (int m = 0; m < 4; ++m) { bf16_t* rowp = O + (size_t)(row0 + ai * HALF + m * 16) * ldc + col0;
#pragma unroll
                for (int bj = 0; bj < 2; ++bj) { const f32x4 v0 = acc[ai][bj][m][0], v1 = acc[ai][bj][m][1];
                    u32x4 w; w.x = cvt_pk_bf16(v0[0], v0[1]); w.y = cvt_pk_bf16(v0[2], v0[3]); w.z = cvt_pk_bf16(v1[0], v1[1]); w.w = cvt_pk_bf16(v1[2], v1[3]);
                    *(u32x4*)(rowp + bj * HALF) = w; } }
    }
};
struct EpiResid {
    static constexpr bool PERM = false;
    float* X; const float* g1base;
    __device__ __forceinline__ void operator()(const f32x4 (&acc)[2][2][4][2], const Unit& u, int wr, int wc, int fr, int fq) const {
        const int rt = u.pm * BM;
        const int mr = rt < NL ? (rt >> 11) : 8;
        const float* g1 = g1base + (size_t)mr * 6144;
        const int row0 = rt + wr * 64 + fr, col0 = u.pn * BM + wc * 32 + 4 * fq;
        f32x4 gv[2][2];
#pragma unroll
        for (int bj = 0; bj < 2; ++bj)
#pragma unroll
            for (int n = 0; n < 2; ++n) gv[bj][n] = *(const f32x4*)(g1 + col0 + bj * HALF + n * 16);
#pragma unroll
        for (int ai = 0; ai < 2; ++ai)
#pragma unroll
            for (int m = 0; m < 4; ++m) { float* rowp = X + (size_t)(row0 + ai * HALF + m * 16) * 1024 + col0;
#pragma unroll
                for (int bj = 0; bj < 2; ++bj)
#pragma unroll
                    for (int n = 0; n < 2; ++n) { f32x4* q = (f32x4*)(rowp + bj * HALF + n * 16); *q = *q + gv[bj][n] * acc[ai][bj][m][n]; } }
    }
};
struct EpiMoeUp {
    static constexpr bool PERM = true;
    bf16_t* ACT; const float* WSEL;
    __device__ __forceinline__ void operator()(const f32x4 (&acc)[2][2][4][2], const Unit& u, int wr, int wc, int fr, int fq) const {
        const int col0 = u.pn * 128 + wc * 32 + 8 * fq;
#pragma unroll
        for (int ai = 0; ai < 2; ++ai)
#pragma unroll
            for (int m = 0; m < 4; ++m) {
                const int ridx = ai * HALF + wr * 64 + m * 16 + fr;
                if (ridx < u.mv) {
                    const int r = u.lst[ridx];
                    const float w = WSEL[r];
                    float o[8];
#pragma unroll
                    for (int n = 0; n < 2; ++n)
#pragma unroll
                        for (int j = 0; j < 4; ++j) { const float g = acc[ai][0][m][n][j], uu = acc[ai][1][m][n][j]; o[n * 4 + j] = g / (1.f + __expf(-g)) * uu * w; }
                    u32x4 wv; wv.x = cvt_pk_bf16(o[0], o[1]); wv.y = cvt_pk_bf16(o[2], o[3]); wv.z = cvt_pk_bf16(o[4], o[5]); wv.w = cvt_pk_bf16(o[6], o[7]);
                    *(u32x4*)(ACT + (size_t)r * 512 + col0) = wv;
                }
            }
    }
};
struct EpiMoeDown {
    static constexpr bool PERM = true;
    bf16_t* YE;
    __device__ __forceinline__ void operator()(const f32x4 (&acc)[2][2][4][2], const Unit& u, int wr, int wc, int fr, int fq) const {
        const int col0 = u.pn * BM + wc * 32 + 8 * fq;
#pragma unroll
        for (int ai = 0; ai < 2; ++ai)
#pragma unroll
            for (int m = 0; m < 4; ++m) {
                const int ridx = ai * HALF + wr * 64 + m * 16 + fr;
                if (ridx < u.mv) {
                    const int r = u.lst[ridx];
#pragma unroll
                    for (int bj = 0; bj < 2; ++bj) { const f32x4 v0 = acc[ai][bj][m][0], v1 = acc[ai][bj][m][1];
                        u32x4 w; w.x = cvt_pk_bf16(v0[0], v0[1]); w.y = cvt_pk_bf16(v0[2], v0[3]); w.z = cvt_pk_bf16(v1[0], v1[1]); w.w = cvt_pk_bf16(v1[2], v1[3]);
                        *(u32x4*)(YE + (size_t)r * 1024 + col0 + bj * HALF) = w; }
                }
            }
    }
};

struct DenseSched {
    const char* A; const char* Bt; int nM, nN, K, G, c;
    __device__ __forceinline__ bool next(int i, Unit& u) const {
        const int L = i * G + c; if (L >= nM * nN) return false;
        int pm, pn; static_order(L, nM, nN, pm, pn);
        u.A = A + (size_t)pm * BM * K * 2; u.Bt = Bt + (size_t)pn * BM * K * 2; u.lst = nullptr; u.mv = 256; u.pm = pm; u.pn = pn; u.aux = 0;
        return true;
    }
};
struct QkvSched {
    const char* H; const char* Bt; int G, c;
    __device__ __forceinline__ bool next(int i, Unit& u) const {
        const int L = i * G + c;
        if (L < 384) { int pm, pn; static_order(L, 64, 6, pm, pn);
            u.A = H + (size_t)pm * BM * 2048; u.Bt = Bt + (size_t)pn * BM * 2048; u.pm = pm; u.pn = pn; u.aux = 0; }
        else if (L < 400) { const int q = L - 384, pm = q >> 1, pn = q & 1;
            u.A = H + (size_t)(NL + pm * BM) * 2048; u.Bt = Bt + (size_t)(1024 + pn * BM) * 2048; u.pm = pm; u.pn = pn; u.aux = 1; }
        else return false;
        u.lst = nullptr; u.mv = 256;
        return true;
    }
};
template <bool UP>
struct MoeSched {
    char* ws; int L; const LAS int* pre; int G, c;
    static constexpr int K = UP ? 1024 : 512;
    __device__ __forceinline__ bool next(int i, Unit& u) const {
        const int Lx = i * G + c; const int total = pre[32] << 2; if (Lx >= total) return false;
        const int mt = Lx >> 2, pn = Lx & 3;
        int e = 0;
#pragma unroll 1
        for (int j = 1; j < 32; ++j) if (pre[j] <= mt) e = j;
        const int m0 = (mt - pre[e]) * BM;
        int mv = (int)((const unsigned*)(ws + OFF_CNT))[L * 32 + e] - m0; mv = mv > 256 ? 256 : mv;
        u.A = ws + (UP ? OFF_H : OFF_ACT);
        u.Bt = ws + (UP ? OFF_BTGU : OFF_BTD) + ((size_t)e * 1024 + (size_t)pn * BM) * K * 2;
        u.lst = (const int*)(ws + OFF_LIST) + (size_t)e * NT + m0; u.mv = mv; u.pm = mt; u.pn = pn; u.aux = e;
        return true;
    }
};
}

__device__ __forceinline__ void cvt_job(const float* __restrict__ src, int ld, bf16_t* __restrict__ dst, int K, int k0, int tid) {
    const int n = tid & 127, kq = tid >> 7;
    const float* sp = src + (size_t)(k0 + kq * 32) * ld + n;
    float v[32];
#pragma unroll
    for (int r = 0; r < 32; ++r) v[r] = sp[(size_t)r * ld];
    bf16_t* dp = dst + (size_t)n * K + k0 + kq * 32;
#pragma unroll
    for (int q = 0; q < 4; ++q) {
        uint4 w;
        w.x = pack2(v[q * 8 + 0], v[q * 8 + 1]); w.y = pack2(v[q * 8 + 2], v[q * 8 + 3]);
        w.z = pack2(v[q * 8 + 4], v[q * 8 + 5]); w.w = pack2(v[q * 8 + 6], v[q * 8 + 7]);
        *(uint4*)(dp + q * 8) = w;
    }
}
__device__ __forceinline__ void cvt_dense(const Params& p, char* smem) {
    const int tid = hide_tid();
    {
        bf16_t* WRG = (bf16_t*)(p.ws + OFF_WRG);
        for (int i = blockIdx.x * NTHR + tid; i < 8 * 256 * 64; i += gridDim.x * NTHR) {
            const int k = i & 63, n = (i >> 6) & 255, g = i >> 14;
            const int d = n >> 7, ri = (n >> 6) & 1, j = n & 63;
            WRG[i] = f2bf(p.in[ri ? I_RGWI : I_RGWR][((size_t)(d * 8 + g) * 64 + k) * 64 + j]);
        }
    }
    for (int j = blockIdx.x; j < (24 + 8 + 12 + 8) * 8; j += gridDim.x) {
        const int grp = j >> 3, kb = j & 7;
        const float* src; int ld; bf16_t* dst;
        if (grp < 24) { const int c0 = grp * 128; src = p.in[I_ABWIN] + (c0 < 2048 ? c0 : c0 + 16); ld = AB_PROJ; dst = (bf16_t*)(p.ws + OFF_BTIN) + (size_t)c0 * 1024; }
        else if (grp < 32) { const int c0 = (grp - 24) * 128; src = p.in[I_ABWOUT] + c0; ld = 1024; dst = (bf16_t*)(p.ws + OFF_BTOUT0) + (size_t)c0 * 1024; }
        else if (grp < 44) { const int c0 = (grp - 32) * 128; src = p.in[I_ATWQKV] + c0; ld = 1536; dst = (bf16_t*)(p.ws + OFF_BTQKV) + (size_t)c0 * 1024; }
        else { const int c0 = (grp - 44) * 128; src = p.in[I_ATWOUT] + c0; ld = 1024; dst = (bf16_t*)(p.ws + OFF_BTOUT1) + (size_t)c0 * 1024; }
        cvt_job(src, ld, dst, 1024, kb * 128, tid);
    }
}
__device__ __forceinline__ void cvt_moe(const Params& p, int L, char* smem) {
    const int tid = hide_tid();
    for (int j = blockIdx.x; j < 32 * 96; j += gridDim.x) {
        const int e = j / 96, q = j % 96;
        if (q < 64) {
            const int up = q >> 5, grp = (q >> 3) & 3, kb = q & 7;
            const float* src = p.in[up ? I_WUP : I_WGATE] + ((size_t)L * 32 + e) * 1024 * 512 + grp * 128;
            bf16_t* dst = (bf16_t*)(p.ws + OFF_BTGU) + ((size_t)e * 1024 + grp * 256 + up * 128) * 1024;
            cvt_job(src, 512, dst, 1024, kb * 128, tid);
        } else {
            const int q2 = q - 64, grp = q2 >> 2, kb = q2 & 3;
            const float* src = p.in[I_WDOWN] + ((size_t)L * 32 + e) * 512 * 1024 + grp * 128;
            bf16_t* dst = (bf16_t*)(p.ws + OFF_BTD) + ((size_t)e * 1024 + grp * 128) * 512;
            cvt_job(src, 1024, dst, 512, kb * 128, tid);
        }
    }
}

__device__ __forceinline__ void ph_ada(const Params& p, char* smem) {
    const int tid = hide_tid();
    float* scond = (float*)smem;
    float* red = scond + 9 * 1024;
    float* MOD = (float*)(p.ws + OFF_MOD);
    for (int i = tid; i < 9 * 1024; i += NTHR) {
        const int r = i >> 10, k = i & 1023;
        const float v = r < 8 ? p.in[I_C][r * 1024 + k] : p.in[I_CCTX][k];
        scond[i] = siluf_(v);
    }
    __syncthreads();
    for (int item = blockIdx.x; item < 192; item += gridDim.x) {
        const int l = item / 96, cg = item % 96;
        const int kq = tid >> 6, cl = tid & 63, col = cg * 64 + cl;
        const float* W = p.in[I_ADAW] + (size_t)l * 1024 * 6144;
        float acc[9];
#pragma unroll
        for (int r = 0; r < 9; ++r) acc[r] = 0.f;
        for (int k0 = kq * 128; k0 < kq * 128 + 128; k0 += 16) {
            float w[16];
#pragma unroll
            for (int u = 0; u < 16; ++u) w[u] = W[(size_t)(k0 + u) * 6144 + col];
#pragma unroll
            for (int u = 0; u < 16; ++u)
#pragma unroll
                for (int r = 0; r < 9; ++r) acc[r] += scond[r * 1024 + k0 + u] * w[u];
        }
#pragma unroll
        for (int r = 0; r < 9; ++r) red[(kq * 9 + r) * 64 + cl] = acc[r];
        __syncthreads();
        for (int i = tid; i < 9 * 64; i += NTHR) {
            const int r = i >> 6, cc = i & 63;
            float s = 0.f;
#pragma unroll
            for (int q = 0; q < 8; ++q) s += red[(q * 9 + r) * 64 + cc];
            MOD[(size_t)(l * 9 + r) * 6144 + cg * 64 + cc] = s + p.in[I_ADAB][l * 6144 + cg * 64 + cc];
        }
        __syncthreads();
    }
}

#define HS_LD 1028
template <int MODE>
__device__ __forceinline__ void ph_rows(const Params& p, char* smem) {
    const int tid = hide_tid(), lane = tid & 63, wave = tid >> 6;
    constexpr int L = (MODE >= 2) ? 1 : 0;
    constexpr int NROWS = (MODE >= 3) ? NL : NT;
    constexpr bool ROUTER = (MODE == 1 || MODE == 3);
    constexpr bool GATEP = (MODE == 0);
    constexpr bool LOGITS = ROUTER || GATEP;
    constexpr int NTL = GATEP ? 1 : 3;
    float* GATES = (float*)(p.ws + OFF_GATES);
    float* X = (float*)(p.ws + OFF_X);
    bf16_t* H = (bf16_t*)(p.ws + OFF_H);
    const bf16_t* YE = (const bf16_t*)(p.ws + OFF_YE);
    const float* MOD = (const float*)(p.ws + OFF_MOD);
    float* hsb = (float*)smem;
    float* part = hsb + 16 * HS_LD;
    float* lgs = part + 8 * 16 * 48;
    unsigned* lcnt = (unsigned*)(lgs + 16 * 48);
    unsigned* gbase = lcnt + 32;
    int* ent = (int*)(gbase + 32);
    constexpr int RT_CAP = 1024;
    int nent = 0;
    if (ROUTER) { if (tid < 32) lcnt[tid] = 0u; __syncthreads(); }
    unsigned* cnt = (unsigned*)(p.ws + OFF_CNT) + L * 32;
    int* LIST = (int*)(p.ws + OFF_LIST);
    float* WSEL = (float*)(p.ws + OFF_WSEL);

    float wreg[LOGITS ? 32 : 1][NTL];
    if (LOGITS) {
        const int l15 = lane & 15, lq = lane >> 4;
#pragma unroll
        for (int nt = 0; nt < NTL; ++nt) {
            const int c = nt * 16 + l15;
            const float* wp; int wld;
            if (GATEP) { wp = p.in[I_ABWIN] + 2048 + c; wld = AB_PROJ; }
            else if (c < 4) { wp = p.in[I_WGRP] + (size_t)L * 1024 * 4 + c; wld = 4; }
            else if (c < 36) { wp = p.in[I_WEXP] + (size_t)L * 1024 * 32 + (c - 4); wld = 32; }
            else { wp = p.in[I_WEXP]; wld = 0; }
#pragma unroll
            for (int kk = 0; kk < 32; ++kk) {
                const float v = wp[(size_t)(wave * 128 + kk * 4 + lq) * wld];
                wreg[kk][nt] = (!GATEP && c >= 36) ? 0.f : v;
            }
        }
    }
    for (int base = blockIdx.x * 16; base < NROWS; base += gridDim.x * 16) {
#pragma unroll 1
        for (int rr = 0; rr < 2; ++rr) {
            const int row = base + wave * 2 + rr;
            float* hs = hsb + (wave * 2 + rr) * HS_LD;
            const int mr = row < NL ? (row >> 11) : 8;
            float v[16];
            if (MODE == 0) {
                const float* src = row < NL ? p.in[I_X] + (size_t)row * 1024 : p.in[I_CTX] + (size_t)(row - NL) * 1024;
#pragma unroll
                for (int i = 0; i < 4; ++i) {
                    const float4 t = *(const float4*)(src + i * 256 + lane * 4);
                    v[i * 4 + 0] = t.x; v[i * 4 + 1] = t.y; v[i * 4 + 2] = t.z; v[i * 4 + 3] = t.w;
                }
            } else {
#pragma unroll
                for (int i = 0; i < 4; ++i) {
                    const float4 t = *(const float4*)(X + (size_t)row * 1024 + i * 256 + lane * 4);
                    v[i * 4 + 0] = t.x; v[i * 4 + 1] = t.y; v[i * 4 + 2] = t.z; v[i * 4 + 3] = t.w;
                }
            }
            if (MODE == 2 || MODE == 4) {
                constexpr int LP = (MODE == 2) ? 0 : 1;
                const float* g2 = MOD + (size_t)(LP * 9 + mr) * 6144 + 5 * 1024;
#pragma unroll
                for (int i = 0; i < 4; ++i) {
                    const int c = i * 256 + lane * 4;
                    const uint2 a = *(const uint2*)(YE + (size_t)(2 * row) * 1024 + c);
                    const uint2 b = *(const uint2*)(YE + (size_t)(2 * row + 1) * 1024 + c);
                    const float4 g = *(const float4*)(g2 + c);
                    v[i * 4 + 0] += g.x * (bf2f((bf16_t)(a.x & 0xffff)) + bf2f((bf16_t)(b.x & 0xffff)));
                    v[i * 4 + 1] += g.y * (bf2f((bf16_t)(a.x >> 16)) + bf2f((bf16_t)(b.x >> 16)));
                    v[i * 4 + 2] += g.z * (bf2f((bf16_t)(a.y & 0xffff)) + bf2f((bf16_t)(b.y & 0xffff)));
                    v[i * 4 + 3] += g.w * (bf2f((bf16_t)(a.y >> 16)) + bf2f((bf16_t)(b.y >> 16)));
                }
            }
            if (MODE == 0 || MODE == 2) {
#pragma unroll
                for (int i = 0; i < 4; ++i)
                    *(float4*)(X + (size_t)row * 1024 + i * 256 + lane * 4) = make_float4(v[i * 4], v[i * 4 + 1], v[i * 4 + 2], v[i * 4 + 3]);
            }
            float ss = 0.f;
#pragma unroll
            for (int i = 0; i < 16; ++i) ss += v[i] * v[i];
            ss = wave_sum(ss);
            const float rinv = rsqrtf(ss * (1.f / 1024.f) + EPSF);
            if (MODE == 4) {
#pragma unroll
                for (int i = 0; i < 4; ++i) {
                    const int c = i * 256 + lane * 4;
                    const float4 w = *(const float4*)(p.in[I_FNORM] + c);
                    *(float4*)(p.out + (size_t)row * 1024 + c) =
                        make_float4(v[i * 4] * rinv * w.x, v[i * 4 + 1] * rinv * w.y, v[i * 4 + 2] * rinv * w.z, v[i * 4 + 3] * rinv * w.w);
                }
            } else {
                constexpr int SH = (MODE == 0 || MODE == 2) ? 0 : 3;
                const float* gain = p.in[(MODE == 0 || MODE == 2) ? I_NORM1 : I_NORM2] + L * 1024;
                const float* sh = MOD + (size_t)(L * 9 + mr) * 6144 + SH * 1024;
                const float* sc = sh + 1024;
#pragma unroll
                for (int i = 0; i < 4; ++i) {
                    const int c = i * 256 + lane * 4;
                    const float4 w = *(const float4*)(gain + c);
                    const float4 s1 = *(const float4*)(sc + c);
                    const float4 s0 = *(const float4*)(sh + c);
                    float h0 = v[i * 4 + 0] * rinv * w.x * (1.f + s1.x) + s0.x;
                    float h1 = v[i * 4 + 1] * rinv * w.y * (1.f + s1.y) + s0.y;
                    float h2 = v[i * 4 + 2] * rinv * w.z * (1.f + s1.z) + s0.z;
                    float h3 = v[i * 4 + 3] * rinv * w.w * (1.f + s1.w) + s0.w;
                    uint2 o; o.x = pack2(h0, h1); o.y = pack2(h2, h3);
                    *(uint2*)(H + (size_t)row * 1024 + c) = o;
                    if (LOGITS) *(float4*)(hs + c) = make_float4(h0, h1, h2, h3);
                }
            }
        }
        if (LOGITS) {
            __syncthreads();
            const int l15 = lane & 15, lq = lane >> 4;
            f32x4 acc[NTL];
#pragma unroll
            for (int nt = 0; nt < NTL; ++nt) acc[nt] = (f32x4){0.f, 0.f, 0.f, 0.f};
            const float* arow = hsb + l15 * HS_LD + wave * 128 + lq;
#pragma unroll
            for (int kk = 0; kk < 32; ++kk) {
                const float a = arow[kk * 4];
#pragma unroll
                for (int nt = 0; nt < NTL; ++nt) acc[nt] = __builtin_amdgcn_mfma_f32_16x16x4f32(a, wreg[kk][nt], acc[nt], 0, 0, 0);
            }
#pragma unroll
            for (int nt = 0; nt < NTL; ++nt)
#pragma unroll
                for (int j = 0; j < 4; ++j) part[(wave * 16 + lq * 4 + j) * 48 + nt * 16 + l15] = acc[nt][j];
            __syncthreads();
            for (int t = tid; t < 16 * NTL * 16; t += NTHR) {
                const int r = t / (NTL * 16), c = t % (NTL * 16);
                float sacc = 0.f;
#pragma unroll
                for (int w = 0; w < 8; ++w) sacc += part[(w * 16 + r) * 48 + c];
                if (GATEP) GATES[(size_t)(base + r) * 16 + c] = sacc;
                else {
                    float bias = 0.f;
                    if (c < 4) bias = p.in[I_BGRP][L * 4 + c]; else if (c < 36) bias = p.in[I_BEXP][L * 32 + c - 4];
                    lgs[r * 48 + c] = sacc + bias;
                }
            }
            if (ROUTER) {
                __syncthreads();
                if (tid < 16) {
                    const int row = base + tid;
                    const float* lg = lgs + tid * 48;
                    int gi = 0; float gm = lg[0];
#pragma unroll
                    for (int j = 1; j < 4; ++j) if (lg[j] > gm) { gm = lg[j]; gi = j; }
                    float gs = 0.f;
#pragma unroll
                    for (int j = 0; j < 4; ++j) gs += __expf(lg[j] - gm);
                    const float gw = 1.f / gs;
                    const float* el = lg + 4 + gi * 8;
                    int e0 = 0; float v0 = el[0];
#pragma unroll
                    for (int j = 1; j < 8; ++j) if (el[j] > v0) { v0 = el[j]; e0 = j; }
                    int e1 = -1; float v1 = -3.0e38f;
#pragma unroll
                    for (int j = 0; j < 8; ++j) if (j != e0 && el[j] > v1) { v1 = el[j]; e1 = j; }
                    const float t = __expf(v1 - v0);
                    const float w0 = gw / (1.f + t), w1 = gw * t / (1.f + t);
                    const int x0 = gi * 8 + e0, x1 = gi * 8 + e1;
                    const unsigned s0 = atomicAdd(&lcnt[x0], 1u);
                    const unsigned s1 = atomicAdd(&lcnt[x1], 1u);
                    int* en = ent + (nent + tid * 2) * 3;
                    en[0] = x0; en[1] = 2 * row; en[2] = (int)s0;
                    en[3] = x1; en[4] = 2 * row + 1; en[5] = (int)s1;
                    WSEL[2 * row] = w0;
                    WSEL[2 * row + 1] = w1;
                }
                nent += 32;
            }
            __syncthreads();
            if (ROUTER && nent + 32 > RT_CAP) {
                if (tid < 32) { gbase[tid] = __hip_atomic_fetch_add(&cnt[tid], lcnt[tid], __ATOMIC_RELAXED, __HIP_MEMORY_SCOPE_AGENT); }
                __syncthreads();
                for (int n = tid; n < nent; n += NTHR) { const int* en = ent + n * 3; LIST[(size_t)en[0] * NT + gbase[en[0]] + en[2]] = en[1]; }
                __syncthreads();
                if (tid < 32) lcnt[tid] = 0u;
                nent = 0;
                __syncthreads();
            }
        }
    }
    if (ROUTER) {
        __syncthreads();
        if (tid < 32) { gbase[tid] = __hip_atomic_fetch_add(&cnt[tid], lcnt[tid], __ATOMIC_RELAXED, __HIP_MEMORY_SCOPE_AGENT); }
        __syncthreads();
        for (int n = tid; n < nent; n += NTHR) { const int* en = ent + n * 3; LIST[(size_t)en[0] * NT + gbase[en[0]] + en[2]] = en[1]; }
    }
}

__device__ __forceinline__ void ph_gemm_in(const Params& p, LAS unsigned char* lds) {
    g8::DenseSched S{p.ws + OFF_H, p.ws + OFF_BTIN, NT / 256, ZW / 256, 1024, (int)gridDim.x, (int)blockIdx.x};
    g8::EpiBf16 E{(bf16_t*)(p.ws + OFF_Z), ZW, nullptr, 0};
    g8::gemm_phase<false, 0>(lds, 1024, S, E);
}
template <int L>
__device__ __forceinline__ void ph_gemm_out(const Params& p, LAS unsigned char* lds) {
    g8::DenseSched S{p.ws + OFF_H, p.ws + (L == 0 ? OFF_BTOUT0 : OFF_BTOUT1), (L == 0 ? NT : NL) / 256, 4, 1024, (int)gridDim.x, (int)blockIdx.x};
    g8::EpiResid E{(float*)(p.ws + OFF_X), (const float*)(p.ws + OFF_MOD) + (size_t)(L * 9) * 6144 + 2 * 1024};
    g8::gemm_phase<false, 0>(lds, 1024, S, E);
}
__device__ __forceinline__ void ph_gemm_qkv(const Params& p, LAS unsigned char* lds) {
    g8::QkvSched S{p.ws + OFF_H, p.ws + OFF_BTQKV, (int)gridDim.x, (int)blockIdx.x};
    g8::EpiBf16 E{(bf16_t*)(p.ws + OFF_ZQ), 1536, (bf16_t*)(p.ws + OFF_ZC), 512};
    g8::gemm_phase<false, 0>(lds, 1024, S, E);
}

__device__ __forceinline__ void moe_prefix(const Params& p, int L, LAS int* pre) {
    unsigned* cnt = (unsigned*)(p.ws + OFF_CNT) + L * 32;
    __syncthreads();
    if (hide_tid() == 0) {
        int s = 0;
        for (int e = 0; e < 32; ++e) { pre[e] = s; s += ((int)xb_ld(&cnt[e]) + 255) >> 8; }
        pre[32] = s;
    }
    __syncthreads();
}
__device__ __forceinline__ void ph_moe_up(const Params& p, int L, LAS unsigned char* lds) {
    LAS int* pre = (LAS int*)(lds + LDS_PRE);
    moe_prefix(p, L, pre);
    g8::MoeSched<true> S{p.ws, L, pre, (int)gridDim.x, (int)blockIdx.x};
    g8::EpiMoeUp E{(bf16_t*)(p.ws + OFF_ACT), (const float*)(p.ws + OFF_WSEL)};
    g8::gemm_phase<true, 1>(lds, 1024, S, E);
}
__device__ __forceinline__ void ph_moe_down(const Params& p, int L, LAS unsigned char* lds) {
    LAS int* pre = (LAS int*)(lds + LDS_PRE);
    moe_prefix(p, L, pre);
    g8::MoeSched<false> S{p.ws, L, pre, (int)gridDim.x, (int)blockIdx.x};
    g8::EpiMoeDown E{(bf16_t*)(p.ws + OFF_YE)};
    g8::gemm_phase<true, 0>(lds, 512, S, E);
}

__device__ __forceinline__ int unit_row0(int b, int cidx) { return cidx < 4 ? (NL + b * CTXL + cidx * 64) : (b * SEQ + (cidx - 4) * 64); }
__device__ __forceinline__ int tile_row0(int tl) { return tl < 256 ? tl * 64 : NL + (tl - 256) * 64; }

__device__ __forceinline__ void lru_tile(const Params& p, int tl, char* smem) {
    const int tid = hide_tid(), lane = tid & 63, wave = tid >> 6, l15 = lane & 15, lq = lane >> 4;
    const bf16_t* Z = (const bf16_t*)(p.ws + OFF_Z);
    const bf16_t* WRG = (const bf16_t*)(p.ws + OFF_WRG);
    bf16_t* HLOC = (bf16_t*)(p.ws + OFF_HLOC);
    bf16_t* ACUM = (bf16_t*)(p.ws + OFF_ACUM);
    float* LTOT = (float*)(p.ws + OFF_LTOT);
    constexpr int XLD = 520;
    bf16_t* XC = (bf16_t*)smem;
    float* SEG = (float*)(smem + 64 * XLD * 2);
    const int row0 = tile_row0(tl);
    int sbeg, send;
    if (row0 < NL) { sbeg = (row0 >> 11) << 11; send = sbeg + SEQ; }
    else { sbeg = NL + (((row0 - NL) >> 8) << 8); send = sbeg + CTXL; }
    __syncthreads();
    {
        const int c = tid;
        const float w0 = p.in[I_CONVX][c], w1 = p.in[I_CONVX][512 + c], w2 = p.in[I_CONVX][1024 + c], w3 = p.in[I_CONVX][1536 + c];
        unsigned mlo = (row0 > sbeg) ? 0xffffu : 0u, mhi = (row0 + 64 < send) ? 0xffffu : 0u;
        asm volatile("" : "+v"(mlo), "+v"(mhi));
        const bf16_t* zc = Z + 2048 + c;
        const int rlo = row0 > sbeg ? row0 - 2 : row0, rhi = row0 + 64 < send ? row0 + 64 : row0 + 63;
        float zm2 = bf2f((bf16_t)(zc[(size_t)rlo * ZW] & mlo)), zm1 = bf2f((bf16_t)(zc[(size_t)(rlo + 1) * ZW] & mlo)), z0 = bf2f(zc[(size_t)row0 * ZW]);
#pragma unroll
        for (int t0 = 0; t0 < 64; t0 += 32) {
            bf16_t nz[32];
#pragma unroll
            for (int q = 0; q < 32; ++q) {
                const int tk = t0 + q;
                nz[q] = tk == 63 ? (bf16_t)(zc[(size_t)rhi * ZW] & mhi) : zc[(size_t)(row0 + tk + 1) * ZW];
            }
#pragma unroll
            for (int q = 0; q < 32; ++q) {
                const float zp1 = bf2f(nz[q]);
                XC[(t0 + q) * XLD + c] = f2bf(zm2 * w0 + zm1 * w1 + z0 * w2 + zp1 * w3);
                zm2 = zm1; zm1 = z0; z0 = zp1;
            }
        }
    }
    __syncthreads();
    TSACC(0);
    const int g = wave;
    bf16x8 af[4][2];
#pragma unroll
    for (int mi = 0; mi < 4; ++mi)
#pragma unroll
        for (int kk = 0; kk < 2; ++kk) af[mi][kk] = *(const bf16x8*)(XC + (mi * 16 + l15) * XLD + g * 64 + kk * 32 + lq * 8);
#pragma unroll
    for (int d = 0; d < 2; ++d) {
        bf16x8 nwr[2], nwi[2]; float nbr, nbi, nlam;
        auto fetch_grp = [&](int ni_) {
            const bf16_t* wr_ = WRG + ((size_t)(g * 256 + d * 128 + ni_ * 16 + l15)) * 64 + lq * 8;
            nwr[0] = *(const bf16x8*)(wr_); nwr[1] = *(const bf16x8*)(wr_ + 32);
            nwi[0] = *(const bf16x8*)(wr_ + 64 * 64); nwi[1] = *(const bf16x8*)(wr_ + 64 * 64 + 32);
            const int c_ = d * 512 + g * 64 + ni_ * 16 + l15;
            nbr = p.in[I_RGBR][c_]; nbi = p.in[I_RGBI][c_]; nlam = p.in[I_RGLAM][c_];
        };
        fetch_grp(0);
#pragma unroll 1
        for (int ni = 0; ni < 4; ++ni) {
            f32x4 accr[4], acci[4];
#pragma unroll
            for (int mi = 0; mi < 4; ++mi) { accr[mi] = (f32x4){0.f, 0.f, 0.f, 0.f}; acci[mi] = (f32x4){0.f, 0.f, 0.f, 0.f}; }
            const bf16x8 cwr0 = nwr[0], cwr1 = nwr[1], cwi0 = nwi[0], cwi1 = nwi[1];
            const float br = nbr, bi = nbi, clam = nlam;
            if (ni + 1 < 4) fetch_grp(ni + 1);
#pragma unroll
            for (int mi = 0; mi < 4; ++mi) {
                accr[mi] = __builtin_amdgcn_mfma_f32_16x16x32_bf16(af[mi][0], cwr0, accr[mi], 0, 0, 0);
                acci[mi] = __builtin_amdgcn_mfma_f32_16x16x32_bf16(af[mi][0], cwi0, acci[mi], 0, 0, 0);
                accr[mi] = __builtin_amdgcn_mfma_f32_16x16x32_bf16(af[mi][1], cwr1, accr[mi], 0, 0, 0);
                acci[mi] = __builtin_amdgcn_mfma_f32_16x16x32_bf16(af[mi][1], cwi1, acci[mi], 0, 0, 0);
            }
            const int c = g * 64 + ni * 16 + l15;
            const float spl = softplusf_(-clam);
            float A[4][4], Bv[4][4];
#pragma unroll
            for (int mi = 0; mi < 4; ++mi)
#pragma unroll
                for (int j = 0; j < 4; ++j) {
                    const float r = sigmoidf_(accr[mi][j] + br), ig = sigmoidf_(acci[mi][j] + bi);
                    const float la = -8.0f * r * spl;
                    const float a = __expf(la);
                    const float xc = bf2f(XC[(mi * 16 + lq * 4 + j) * XLD + c]);
                    A[mi][j] = a;
                    Bv[mi][j] = __builtin_amdgcn_sqrtf(neg_expm1_small(2.f * la)) * ig * xc;
                }
            float P[4][4], Hh[4][4];
#pragma unroll
            for (int mi = 0; mi < 4; ++mi) {
                if (d == 0) {
                    P[mi][0] = A[mi][0]; Hh[mi][0] = Bv[mi][0];
#pragma unroll
                    for (int j = 1; j < 4; ++j) { P[mi][j] = A[mi][j] * P[mi][j - 1]; Hh[mi][j] = A[mi][j] * Hh[mi][j - 1] + Bv[mi][j]; }
                } else {
                    P[mi][3] = A[mi][3]; Hh[mi][3] = Bv[mi][3];
#pragma unroll
                    for (int j = 2; j >= 0; --j) { P[mi][j] = A[mi][j] * P[mi][j + 1]; Hh[mi][j] = A[mi][j] * Hh[mi][j + 1] + Bv[mi][j]; }
                }
            }
            {
                float* seg = SEG + wave * 512 + l15 * 32;
#pragma unroll
                for (int mi = 0; mi < 4; ++mi)
                    *(float2*)(seg + (mi * 4 + lq) * 2) = make_float2(d == 0 ? P[mi][3] : P[mi][0], d == 0 ? Hh[mi][3] : Hh[mi][0]);
                __builtin_amdgcn_wave_barrier();
                float sg[32];
#pragma unroll
                for (int q = 0; q < 8; ++q) { const float4 t = *(const float4*)(seg + q * 4); sg[q * 4] = t.x; sg[q * 4 + 1] = t.y; sg[q * 4 + 2] = t.z; sg[q * 4 + 3] = t.w; }
                __builtin_amdgcn_wave_barrier();
                float cP = 1.f, cH = 0.f, bP[4], bH[4];
#pragma unroll
                for (int mi = 0; mi < 4; ++mi) { bP[mi] = 1.f; bH[mi] = 0.f; }
#pragma unroll
                for (int st = 0; st < 16; ++st) {
                    const int sidx = d == 0 ? st : 15 - st;
                    const int smi = sidx >> 2, sq = sidx & 3;
                    if (sq == lq) { bP[smi] = cP; bH[smi] = cH; }
                    const float sP = sg[sidx * 2], sH = sg[sidx * 2 + 1];
                    cH = sP * cH + sH; cP = sP * cP;
                }
#pragma unroll
                for (int mi = 0; mi < 4; ++mi)
#pragma unroll
                    for (int j = 0; j < 4; ++j) {
                        const float hval = P[mi][j] * bH[mi] + Hh[mi][j];
                        const float aval = P[mi][j] * bP[mi];
                        const size_t o = ((size_t)d * NT + row0 + mi * 16 + lq * 4 + j) * 512 + c;
                        HLOC[o] = f2bf(hval); ACUM[o] = f2bf(aval);
                    }
                if (lq == 0) {
                    float* o = LTOT + (((size_t)d * 288 + tl) * 512 + c) * 2;
                    o[0] = cP; o[1] = cH;
                }
            }
        }
    }
}

__device__ __forceinline__ void delta_unit(const Params& p, int u, char* smem) {
    const int tid = hide_tid(), lane = tid & 63, wave = tid >> 6, l15 = lane & 15, lq = lane >> 4;
    const int cidx = u % 36, bh = u / 36, h = bh & 3, b = bh >> 2;
    const int row0 = unit_row0(b, cidx);
    const int sbeg = cidx < 4 ? NL + b * CTXL : b * SEQ, send = cidx < 4 ? sbeg + CTXL : sbeg + SEQ;
    const bf16_t* Z = (const bf16_t*)(p.ws + OFF_Z);
    const float* GATES = (const float*)(p.ws + OFF_GATES);
    bf16_t* QG = (bf16_t*)(p.ws + OFF_QG) + (size_t)u * 64 * 128;
    bf16_t* KG = (bf16_t*)(p.ws + OFF_KG) + (size_t)u * 64 * 128;
    bf16_t* VG = (bf16_t*)(p.ws + OFF_VG) + (size_t)u * 64 * 128;
    bf16_t* KTG = (bf16_t*)(p.ws + OFF_KTG) + (size_t)u * 128 * 64;
    bf16_t* TT = (bf16_t*)(p.ws + OFF_TT) + (size_t)u * 2 * 4096;
    bf16_t* ATT = (bf16_t*)(p.ws + OFF_ATT) + (size_t)u * 2 * 4096;
    float* VEC = (float*)(p.ws + OFF_VEC) + (size_t)u * 2 * 256;
    float* EGL = (float*)(p.ws + OFF_EGL) + (size_t)u * 2;
    constexpr int QLD = 136, LLD = 68;
    bf16_t* Qs = (bf16_t*)smem;
    bf16_t* Ks = Qs + 64 * QLD;
    float* Lm = (float*)(Ks + 64 * QLD);
    float* gcs = Lm + 2 * 64 * LLD;
    float* bts = gcs + 128;
    __syncthreads();
    if (wave < 6) {
        const int part = wave >> 1, t0 = (wave & 1) * 32;
        const int c = part * 512 + h * 128 + lane * 2;
        const float* cw = p.in[I_CONVQKV] + c;
        const float w00 = cw[0], w01 = cw[1], w10 = cw[1536], w11 = cw[1537], w20 = cw[3072], w21 = cw[3073], w30 = cw[4608], w31 = cw[4609];
        const int rb = row0 + t0;
        unsigned mlo = (rb > sbeg) ? 0xffffffffu : 0u, mhi = (rb + 32 < send) ? 0xffffffffu : 0u;
        asm volatile("" : "+v"(mlo), "+v"(mhi));
        const bf16_t* zc = Z + c;
        const int rlo = rb > sbeg ? rb - 2 : rb, rhi = rb + 32 < send ? rb + 32 : rb + 31;
        unsigned zw[35];
        zw[0] = *(const unsigned*)(zc + (size_t)rlo * ZW) & mlo; zw[1] = *(const unsigned*)(zc + (size_t)(rlo + 1) * ZW) & mlo;
#pragma unroll
        for (int q = 0; q < 32; ++q) zw[2 + q] = *(const unsigned*)(zc + (size_t)(rb + q) * ZW);
        zw[34] = *(const unsigned*)(zc + (size_t)rhi * ZW) & mhi;
#pragma unroll
        for (int tk = 0; tk < 32; ++tk) {
            const unsigned zm2 = zw[tk], zm1 = zw[tk + 1], z0 = zw[tk + 2], zp1 = zw[tk + 3];
            float a0 = bf2f((bf16_t)(zm2 & 0xffff)) * w00 + bf2f((bf16_t)(zm1 & 0xffff)) * w10 + bf2f((bf16_t)(z0 & 0xffff)) * w20 + bf2f((bf16_t)(zp1 & 0xffff)) * w30;
            float a1 = bf2f((bf16_t)(zm2 >> 16)) * w01 + bf2f((bf16_t)(zm1 >> 16)) * w11 + bf2f((bf16_t)(z0 >> 16)) * w21 + bf2f((bf16_t)(zp1 >> 16)) * w31;
            a0 = siluf_(a0); a1 = siluf_(a1);
            const int tok = t0 + tk;
            if (part < 2) {
                const float ss = wave_sum(a0 * a0 + a1 * a1);
                float sc = rsqrtf(ss + EPSF);
                if (part == 0) sc *= 0.08838834764831845f;
                a0 *= sc; a1 *= sc;
                const unsigned pk = pack2(a0, a1);
                *(unsigned*)((part == 0 ? Qs : Ks) + tok * QLD + lane * 2) = pk;
                *(unsigned*)((part == 0 ? QG : KG) + tok * 128 + lane * 2) = pk;
            } else {
                *(unsigned*)(VG + tok * 128 + lane * 2) = pack2(a0, a1);
            }
        }
    } else {
        const int d = wave - 6;
        const int row = row0 + lane;
        const float gv = GATES[(size_t)row * 16 + d * 8 + h], bv = GATES[(size_t)row * 16 + d * 8 + 4 + h];
        const float gdec = -__expf(p.in[I_ALOG][d * 4 + h]) * softplusf_(gv + p.in[I_DTB][d * 4 + h]);
        const float beta = sigmoidf_(bv);
        float gc = gdec;
#pragma unroll
        for (int dist = 1; dist < 64; dist <<= 1) {
            const int src = d == 0 ? lane - dist : lane + dist;
            const float o = __shfl(gc, src & 63, 64);
            if (d == 0 ? (lane >= dist) : (lane + dist < 64)) gc += o;
        }
        const float gl = __shfl(gc, d == 0 ? 63 : 0, 64);
        gcs[d * 64 + lane] = gc; bts[d * 64 + lane] = beta;
        const float egc = __expf(gc);
        VEC[d * 256 + 0 * 64 + lane] = beta * egc;
        VEC[d * 256 + 1 * 64 + lane] = egc;
        VEC[d * 256 + 2 * 64 + lane] = __expf(gl - gc);
        VEC[d * 256 + 3 * 64 + lane] = beta;
        if (lane == 0) EGL[d] = __expf(gl);
    }
    __syncthreads();
    TSACC(2);
    {
        const int mi = wave >> 1, ni0 = (wave & 1) * 2;
        f32x4 kk_acc[2], qk_acc[2];
#pragma unroll
        for (int n = 0; n < 2; ++n) { kk_acc[n] = (f32x4){0.f, 0.f, 0.f, 0.f}; qk_acc[n] = (f32x4){0.f, 0.f, 0.f, 0.f}; }
#pragma unroll
        for (int kk = 0; kk < 4; ++kk) {
            const bf16x8 ak = *(const bf16x8*)(Ks + (mi * 16 + l15) * QLD + kk * 32 + lq * 8);
            const bf16x8 aq = *(const bf16x8*)(Qs + (mi * 16 + l15) * QLD + kk * 32 + lq * 8);
#pragma unroll
            for (int n = 0; n < 2; ++n) {
                const bf16x8 bk = *(const bf16x8*)(Ks + ((ni0 + n) * 16 + l15) * QLD + kk * 32 + lq * 8);
                kk_acc[n] = __builtin_amdgcn_mfma_f32_16x16x32_bf16(ak, bk, kk_acc[n], 0, 0, 0);
                qk_acc[n] = __builtin_amdgcn_mfma_f32_16x16x32_bf16(aq, bk, qk_acc[n], 0, 0, 0);
            }
        }
#pragma unroll
        for (int n = 0; n < 2; ++n)
#pragma unroll
            for (int j = 0; j < 4; ++j) {
                const int i = mi * 16 + lq * 4 + j, jc = (ni0 + n) * 16 + l15;
                {
                    const float e = (i >= jc) ? __expf(gcs[i] - gcs[jc]) : 0.f;
                    if (i > jc) Lm[i * LLD + jc] = bts[i] * kk_acc[n][j] * e;
                    ATT[i * 64 + jc] = f2bf(qk_acc[n][j] * e);
                }
                {
                    const float e = (i <= jc) ? __expf(gcs[64 + i] - gcs[64 + jc]) : 0.f;
                    if (i < jc) Lm[64 * LLD + (63 - i) * LLD + (63 - jc)] = bts[64 + i] * kk_acc[n][j] * e;
                    ATT[4096 + i * 64 + jc] = f2bf(qk_acc[n][j] * e);
                }
            }
    }
    __syncthreads();
    TSACC(3);
    if (wave < 2) {
        const int d = wave;
        const float* Lr = Lm + d * 64 * LLD;
        float T[64];
        float4 Lb[2][16];
#pragma unroll
        for (int q = 0; q < 1; ++q) Lb[1][q] = *(const float4*)(Lr + 1 * LLD + 4 * q);
        T[0] = (lane == 0) ? 1.f : 0.f;
#pragma unroll
        for (int i = 1; i < 64; ++i) {
            if (i + 1 < 64) {
#pragma unroll
                for (int q = 0; q < (i + 1 + 3) / 4; ++q) Lb[(i + 1) & 1][q] = *(const float4*)(Lr + (i + 1) * LLD + 4 * q);
            }
            float a0 = (i == lane) ? 1.f : 0.f, a1 = 0.f, a2 = 0.f, a3 = 0.f;
#pragma unroll
            for (int q = 0; q < (i + 3) / 4; ++q) {
                const float4 l4 = Lb[i & 1][q];
                if (4 * q + 0 < i) a0 -= l4.x * T[4 * q + 0];
                if (4 * q + 1 < i) a1 -= l4.y * T[4 * q + 1];
                if (4 * q + 2 < i) a2 -= l4.z * T[4 * q + 2];
                if (4 * q + 3 < i) a3 -= l4.w * T[4 * q + 3];
            }
            T[i] = (a0 + a1) + (a2 + a3);
        }
#pragma unroll
        for (int i = 0; i < 64; ++i) {
            const int ri = d == 0 ? i : 63 - i, rc = d == 0 ? lane : 63 - lane;
            TT[d * 4096 + ri * 64 + rc] = f2bf(T[i]);
        }
    } else {
        for (int q = tid - 128; q < 1024; q += 384) {
            const int dk = q & 127, tg = q >> 7;
            unsigned short e[8];
#pragma unroll
            for (int x = 0; x < 8; ++x) e[x] = Ks[(tg * 8 + x) * QLD + dk];
            uint4 w; w.x = e[0] | ((unsigned)e[1] << 16); w.y = e[2] | ((unsigned)e[3] << 16); w.z = e[4] | ((unsigned)e[5] << 16); w.w = e[6] | ((unsigned)e[7] << 16);
            *(uint4*)(KTG + dk * 64 + tg * 8) = w;
        }
    }
    if (TS_PH >= 100) { __syncthreads(); TSACC(4); }
}

__device__ __forceinline__ void ph_prep(const Params& p, char* smem, int rep = 0) {
    const int lo = (rep && REP_SUB == 2) ? 288 : 0, hi = (rep && REP_SUB == 1) ? 288 : 288 + 1152;
    for (int item = lo + blockIdx.x; item < hi; item += gridDim.x) {
        TSMARK();
        if (item < 288) { lru_tile(p, item, smem); __syncthreads(); TSACC(1); }
        else delta_unit(p, item - 288, smem);
    }
}

__device__ __forceinline__ void lru_carry(const Params& p, int li) {
    const int idx = li * NTHR + hide_tid();
    const int c = idx & 511, bd = idx >> 9, b = bd >> 1, d = bd & 1;
    const float* LTOT = (const float*)(p.ws + OFF_LTOT);
    float* CIN = (float*)(p.ws + OFF_CIN);
    float2 ah[36];
#pragma unroll
    for (int st = 0; st < 36; ++st) {
        const int tl = st < 4 ? 256 + b * 4 + (d ? 3 - st : st) : b * 32 + (d ? 35 - st : st - 4);
        ah[st] = *(const float2*)(LTOT + (((size_t)d * 288 + tl) * 512 + c) * 2);
    }
    float s = 0.f;
#pragma unroll
    for (int st = 0; st < 36; ++st) {
        const int tl = st < 4 ? 256 + b * 4 + (d ? 3 - st : st) : b * 32 + (d ? 35 - st : st - 4);
        CIN[((size_t)d * 288 + tl) * 512 + c] = s;
        s = ah[st].x * s + ah[st].y;
    }
}
typedef unsigned nu32x4 __attribute__((ext_vector_type(4)));
struct DStage { nu32x4 k[2], q[2], kt[2], t, a, v; f32x4 rs1, rs2, rs3, bt; float egl; };
__device__ __forceinline__ void delta_chain(const Params& p, int item, char* smem) {
    const int tid = hide_tid(), lane = tid & 63, wave = tid >> 6, l15 = lane & 15, lq = lane >> 4;
    const int chain = item >> 2, sl = item & 3;
    const int b = chain >> 3, h = (chain >> 1) & 3, dir = chain & 1;
    const int mi = wave >> 1, ni = wave & 1;
    const bf16_t* QG = (const bf16_t*)(p.ws + OFF_QG);
    const bf16_t* KG = (const bf16_t*)(p.ws + OFF_KG);
    const bf16_t* VG = (const bf16_t*)(p.ws + OFF_VG);
    const bf16_t* KTG = (const bf16_t*)(p.ws + OFF_KTG);
    const bf16_t* TT = (const bf16_t*)(p.ws + OFF_TT);
    const bf16_t* ATT = (const bf16_t*)(p.ws + OFF_ATT);
    const float* VEC = (const float*)(p.ws + OFF_VEC);
    const float* EGL = (const float*)(p.ws + OFF_EGL);
    bf16_t* OA = (bf16_t*)(p.ws + OFF_OA) + (size_t)dir * NT * 512;
    constexpr int SLD = 136, RLD = 72, VLD = 40;
    bf16_t* ST = (bf16_t*)smem;
    bf16_t* RT = ST + 32 * SLD;
    bf16_t* VNT = RT + 32 * RLD;
    bf16_t* VST = VNT + 32 * RLD;
    bf16_t* Kt = VST + 32 * RLD;
    bf16_t* Qt = Kt + 64 * SLD;
    bf16_t* KTt = Qt + 64 * SLD;
    bf16_t* Tt = KTt + 128 * RLD;
    bf16_t* At = Tt + 64 * RLD;
    bf16_t* Vt = At + 64 * RLD;
    __syncthreads();
    for (int i = tid; i < 32 * SLD / 2; i += NTHR) ((unsigned*)ST)[i] = 0u;
    auto unit_of = [&](int s) -> int { const int cidx = dir ? (s < 4 ? 3 - s : 39 - s) : s; return (b * 4 + h) * 36 + cidx; };
    auto load = [&](int s, DStage& f) {
        const int u = unit_of(s);
        const size_t ub = (size_t)u * 8192;
#pragma unroll
        for (int i = 0; i < 2; ++i) {
            const int c = tid + i * NTHR;
            f.k[i] = *(const nu32x4*)(KG + ub + c * 8);
            f.q[i] = *(const nu32x4*)(QG + ub + c * 8);
            f.kt[i] = *(const nu32x4*)(KTG + ub + c * 8);
        }
        f.t = *(const nu32x4*)(TT + ((size_t)u * 2 + dir) * 4096 + tid * 8);
        f.a = *(const nu32x4*)(ATT + ((size_t)u * 2 + dir) * 4096 + tid * 8);
        f.v = *(const nu32x4*)(VG + ub + ((tid >> 2) & 63) * 128 + sl * 32 + (tid & 3) * 8);
        const float* vec = VEC + ((size_t)u * 2 + dir) * 256 + mi * 16 + lq * 4;
        f.rs1 = *(const f32x4*)(vec); f.rs2 = *(const f32x4*)(vec + 64); f.rs3 = *(const f32x4*)(vec + 128); f.bt = *(const f32x4*)(vec + 192);
        f.egl = EGL[(size_t)u * 2 + dir];
    };
    auto put = [&](const DStage& f) {
#pragma unroll
        for (int i = 0; i < 2; ++i) {
            const int c = tid + i * NTHR;
            *(nu32x4*)(Kt + (c >> 4) * SLD + (c & 15) * 8) = f.k[i];
            *(nu32x4*)(Qt + (c >> 4) * SLD + (c & 15) * 8) = f.q[i];
            *(nu32x4*)(KTt + (c >> 3) * RLD + (c & 7) * 8) = f.kt[i];
        }
        *(nu32x4*)(Tt + (tid >> 3) * RLD + (tid & 7) * 8) = f.t;
        *(nu32x4*)(At + (tid >> 3) * RLD + (tid & 7) * 8) = f.a;
        if (tid < 256) *(nu32x4*)(Vt + (tid >> 2) * VLD + (tid & 3) * 8) = f.v;
    };
    f32x4 Sacc[2];
    Sacc[0] = (f32x4){0.f, 0.f, 0.f, 0.f}; Sacc[1] = (f32x4){0.f, 0.f, 0.f, 0.f};
    DStage fa, fb;
    load(0, fa);
    put(fa);
    __syncthreads();
    auto step = [&](int s, DStage& cur, DStage& nxt) {
        TSMARK();
        if (s + 1 < 36) load(s + 1, nxt);
        f32x4 kS = (f32x4){0.f, 0.f, 0.f, 0.f}, qS = (f32x4){0.f, 0.f, 0.f, 0.f};
#pragma unroll
        for (int kk = 0; kk < 4; ++kk) {
            const bf16x8 sb = *(const bf16x8*)(ST + (ni * 16 + l15) * SLD + kk * 32 + lq * 8);
            const bf16x8 kf = *(const bf16x8*)(Kt + (mi * 16 + l15) * SLD + kk * 32 + lq * 8);
            const bf16x8 qf = *(const bf16x8*)(Qt + (mi * 16 + l15) * SLD + kk * 32 + lq * 8);
            kS = __builtin_amdgcn_mfma_f32_16x16x32_bf16(kf, sb, kS, 0, 0, 0);
            qS = __builtin_amdgcn_mfma_f32_16x16x32_bf16(qf, sb, qS, 0, 0, 0);
        }
        {
            const bf16_t* vp = Vt + (mi * 16 + lq * 4) * VLD + ni * 16 + l15;
            const float r0 = cur.bt[0] * bf2f(vp[0]) - cur.rs1[0] * kS[0];
            const float r1 = cur.bt[1] * bf2f(vp[VLD]) - cur.rs1[1] * kS[1];
            const float r2 = cur.bt[2] * bf2f(vp[2 * VLD]) - cur.rs1[2] * kS[2];
            const float r3 = cur.bt[3] * bf2f(vp[3 * VLD]) - cur.rs1[3] * kS[3];
            uint2 w; w.x = pack2(r0, r1); w.y = pack2(r2, r3);
            *(uint2*)(RT + (ni * 16 + l15) * RLD + mi * 16 + lq * 4) = w;
        }
        __syncthreads();
        TSACC(5);
        f32x4 vn = (f32x4){0.f, 0.f, 0.f, 0.f};
#pragma unroll
        for (int kk = 0; kk < 2; ++kk) {
            const bf16x8 rb = *(const bf16x8*)(RT + (ni * 16 + l15) * RLD + kk * 32 + lq * 8);
            const bf16x8 tf = *(const bf16x8*)(Tt + (mi * 16 + l15) * RLD + kk * 32 + lq * 8);
            vn = __builtin_amdgcn_mfma_f32_16x16x32_bf16(tf, rb, vn, 0, 0, 0);
        }
        {
            uint2 w; w.x = pack2(vn[0], vn[1]); w.y = pack2(vn[2], vn[3]);
            *(uint2*)(VNT + (ni * 16 + l15) * RLD + mi * 16 + lq * 4) = w;
            uint2 w2; w2.x = pack2(vn[0] * cur.rs3[0], vn[1] * cur.rs3[1]); w2.y = pack2(vn[2] * cur.rs3[2], vn[3] * cur.rs3[3]);
            *(uint2*)(VST + (ni * 16 + l15) * RLD + mi * 16 + lq * 4) = w2;
        }
        __syncthreads();
        TSACC(6);
        f32x4 o;
        o[0] = cur.rs2[0] * qS[0]; o[1] = cur.rs2[1] * qS[1]; o[2] = cur.rs2[2] * qS[2]; o[3] = cur.rs2[3] * qS[3];
#pragma unroll
        for (int kk = 0; kk < 2; ++kk) {
            const bf16x8 vb = *(const bf16x8*)(VNT + (ni * 16 + l15) * RLD + kk * 32 + lq * 8);
            const bf16x8 afr = *(const bf16x8*)(At + (mi * 16 + l15) * RLD + kk * 32 + lq * 8);
            o = __builtin_amdgcn_mfma_f32_16x16x32_bf16(afr, vb, o, 0, 0, 0);
        }
        {
            const int u = unit_of(s);
            const int cidx = u % 36;
            const int rowb = unit_row0(b, cidx) + mi * 16 + lq * 4;
            bf16_t* op = OA + (size_t)rowb * 512 + h * 128 + sl * 32 + ni * 16 + l15;
#pragma unroll
            for (int j = 0; j < 4; ++j) op[(size_t)j * 512] = f2bf(o[j]);
        }
#pragma unroll
        for (int n2 = 0; n2 < 2; ++n2) {
            Sacc[n2] = Sacc[n2] * cur.egl;
#pragma unroll
            for (int kk = 0; kk < 2; ++kk) {
                const bf16x8 vb = *(const bf16x8*)(VST + (n2 * 16 + l15) * RLD + kk * 32 + lq * 8);
                const bf16x8 ktf = *(const bf16x8*)(KTt + (wave * 16 + l15) * RLD + kk * 32 + lq * 8);
                Sacc[n2] = __builtin_amdgcn_mfma_f32_16x16x32_bf16(ktf, vb, Sacc[n2], 0, 0, 0);
            }
        }
        __syncthreads();
#pragma unroll
        for (int n2 = 0; n2 < 2; ++n2) {
            uint2 w; w.x = pack2(Sacc[n2][0], Sacc[n2][1]); w.y = pack2(Sacc[n2][2], Sacc[n2][3]);
            *(uint2*)(ST + (n2 * 16 + l15) * SLD + wave * 16 + lq * 4) = w;
        }
        if (s + 1 < 36) put(nxt);
        __syncthreads();
        TSACC(7);
    };
#pragma unroll 1
    for (int s = 0; s < 36; s += 2) { step(s, fa, fb); step(s + 1, fb, fa); }
}
#define OFF_SCANQ (OFF_CNT + 1024)
__device__ __forceinline__ void ph_scan(const Params& p, char* smem, int rep = 0) {
    unsigned* q = (unsigned*)(p.ws + OFF_SCANQ) + (rep ? 16 : 0);
    int* slot = (int*)(smem + 150 * 1024);
    for (int round = blockIdx.x; round < 256; round += gridDim.x) {
        __syncthreads();
        if (hide_tid() == 0) {
            const unsigned x0 = xb_xcc_id() & 7u;
            int item = -1;
            for (unsigned t = 0; t < 8 && item < 0; ++t) {
                const unsigned x = (x0 + t) & 7u;
                if (xb_ld(&q[x]) < 32u) { const unsigned i = xb_add(&q[x], 1u); if (i < 32u) item = (int)(x * 32u + i); }
            }
            *slot = item;
        }
        __syncthreads();
        const int item = *slot;
        if (item >= 0) {
            const int xcd = item >> 5, j = item & 31;
            const int bh = xcd * 4 + (j >> 3), dir = (j >> 2) & 1, sl = j & 3;
            delta_chain(p, ((bh * 2 + dir) << 2) | sl, smem);
        }
    }
    if (!rep) for (int item = blockIdx.x; item < 16; item += gridDim.x) lru_carry(p, item);
}

struct MergeRow { unsigned oa0[4], oa1[4], gz[4], h0[4], h1[4], a0[4], a1[4], yz[4]; float2 c0[4], c1[4]; };
__device__ __forceinline__ void merge_load(const Params& p, int row, int lane, MergeRow& m) {
    const bf16_t* Z = (const bf16_t*)(p.ws + OFF_Z) + (size_t)row * ZW;
    const bf16_t* OA0 = (const bf16_t*)(p.ws + OFF_OA) + (size_t)row * 512;
    const bf16_t* OA1 = OA0 + (size_t)NT * 512;
    const bf16_t* HL0 = (const bf16_t*)(p.ws + OFF_HLOC) + (size_t)row * 512;
    const bf16_t* HL1 = HL0 + (size_t)NT * 512;
    const bf16_t* AC0 = (const bf16_t*)(p.ws + OFF_ACUM) + (size_t)row * 512;
    const bf16_t* AC1 = AC0 + (size_t)NT * 512;
    const int tl = row < NL ? (row >> 6) : 256 + ((row - NL) >> 6);
    const float* CIN0 = (const float*)(p.ws + OFF_CIN) + (size_t)tl * 512;
    const float* CIN1 = CIN0 + (size_t)288 * 512;
#pragma unroll
    for (int i = 0; i < 4; ++i) {
        const int c = i * 128 + lane * 2;
        m.oa0[i] = *(const unsigned*)(OA0 + c); m.oa1[i] = *(const unsigned*)(OA1 + c); m.gz[i] = *(const unsigned*)(Z + 1536 + c);
        m.h0[i] = *(const unsigned*)(HL0 + c); m.h1[i] = *(const unsigned*)(HL1 + c);
        m.a0[i] = *(const unsigned*)(AC0 + c); m.a1[i] = *(const unsigned*)(AC1 + c);
        m.yz[i] = *(const unsigned*)(Z + 2560 + c);
        m.c0[i] = *(const float2*)(CIN0 + c); m.c1[i] = *(const float2*)(CIN1 + c);
    }
}
__device__ __forceinline__ void merge_compute(const Params& p, int row, int lane, const MergeRow& m, float on0, float on1) {
    bf16_t* M = (bf16_t*)(p.ws + OFF_H) + (size_t)row * 1024;
#pragma unroll
    for (int h = 0; h < 4; ++h) {
        const int c = h * 128 + lane * 2;
        const float o0 = bf2f((bf16_t)(m.oa0[h] & 0xffff)) + bf2f((bf16_t)(m.oa1[h] & 0xffff));
        const float o1 = bf2f((bf16_t)(m.oa0[h] >> 16)) + bf2f((bf16_t)(m.oa1[h] >> 16));
        const float ss = wave_sum(o0 * o0 + o1 * o1);
        const float rinv = rsqrtf(ss * (1.f / 128.f) + EPSF);
        const float y0 = o0 * rinv * on0 * siluf_(bf2f((bf16_t)(m.gz[h] & 0xffff)));
        const float y1 = o1 * rinv * on1 * siluf_(bf2f((bf16_t)(m.gz[h] >> 16)));
        *(unsigned*)(M + c) = pack2(y0, y1);
    }
#pragma unroll
    for (int i = 0; i < 4; ++i) {
        const int c = i * 128 + lane * 2;
        const float hx = (bf2f((bf16_t)(m.h0[i] & 0xffff)) + bf2f((bf16_t)(m.a0[i] & 0xffff)) * m.c0[i].x) + (bf2f((bf16_t)(m.h1[i] & 0xffff)) + bf2f((bf16_t)(m.a1[i] & 0xffff)) * m.c1[i].x);
        const float hy = (bf2f((bf16_t)(m.h0[i] >> 16)) + bf2f((bf16_t)(m.a0[i] >> 16)) * m.c0[i].y) + (bf2f((bf16_t)(m.h1[i] >> 16)) + bf2f((bf16_t)(m.a1[i] >> 16)) * m.c1[i].y);
        const float y0 = hx * geluf_(bf2f((bf16_t)(m.yz[i] & 0xffff)));
        const float y1 = hy * geluf_(bf2f((bf16_t)(m.yz[i] >> 16)));
        *(unsigned*)(M + 512 + c) = pack2(y0, y1);
    }
}
__device__ __forceinline__ void ph_merge(const Params& p, char* smem) {
    const int tid = hide_tid(), lane = tid & 63, wave = tid >> 6;
    const float on0 = p.in[I_ONORM][lane * 2], on1 = p.in[I_ONORM][lane * 2 + 1];
    for (int base = blockIdx.x * 16; base < NT; base += gridDim.x * 16) {
        const int r0 = base + wave * 2;
        MergeRow m0, m1;
        merge_load(p, r0, lane, m0);
        merge_load(p, r0 + 1, lane, m1);
        merge_compute(p, r0, lane, m0, on0, on1);
        merge_compute(p, r0 + 1, lane, m1, on0, on1);
    }
}

__device__ __forceinline__ void ph_qkprep(const Params& p, char* smem) {
    const int tid = hide_tid(), lane = tid & 63, wave = tid >> 6;
    const bf16_t* ZQ = (const bf16_t*)(p.ws + OFF_ZQ);
    const bf16_t* ZC = (const bf16_t*)(p.ws + OFF_ZC);
    bf16_t* QA = (bf16_t*)(p.ws + OFF_QA);
    bf16_t* KA = (bf16_t*)(p.ws + OFF_KA);
    bf16_t* VT = (bf16_t*)(p.ws + OFF_VT);
    const float* qn = p.in[I_QNORM];
    const float* kn = p.in[I_KNORM];
    for (int row = blockIdx.x * 8 + wave; row < NT; row += gridDim.x * 8) {
        const bool lat = row < NL;
        const int b = lat ? (row >> 11) : ((row - NL) >> 8);
        const int t = lat ? (row & 2047) : ((row - NL) & 255);
        const int key = lat ? t : (SEQ + t);
        float cs = 1.f, sn = 0.f;
        if (lat) {
            const int f = lane & 31;
            const float pos = (lane < 32) ? (float)(t >> 6) : (float)(t & 63);
            const float inv = expf(-(float)f * (1.f / 32.f) * 9.210340371976184f);
            sincosf(pos * inv, &sn, &cs);
        }
        const bf16_t* src = lat ? ZQ + (size_t)row * 1536 : ZC + (size_t)(row - NL) * 512;
        const int koff = lat ? 1024 : 0;
        if (lat) {
#pragma unroll
            for (int h = 0; h < 8; ++h) {
                const unsigned u = *(const unsigned*)(src + h * 128 + lane * 2);
                float x1 = bf2f((bf16_t)(u & 0xffff)), x2 = bf2f((bf16_t)(u >> 16));
                const float ss = wave_sum(x1 * x1 + x2 * x2);
                const float rinv = rsqrtf(ss * (1.f / 128.f) + EPSF);
                x1 *= rinv * qn[lane * 2]; x2 *= rinv * qn[lane * 2 + 1];
                const float y1 = x1 * cs - x2 * sn;
                const float y2 = x1 * sn + x2 * cs;
                *(unsigned*)(QA + (size_t)row * 1024 + h * 128 + lane * 2) = pack2(y1, y2);
            }
        }
#pragma unroll
        for (int kh = 0; kh < 2; ++kh) {
            const unsigned u = *(const unsigned*)(src + koff + kh * 128 + lane * 2);
            float x1 = bf2f((bf16_t)(u & 0xffff)), x2 = bf2f((bf16_t)(u >> 16));
            const float ss = wave_sum(x1 * x1 + x2 * x2);
            const float rinv = rsqrtf(ss * (1.f / 128.f) + EPSF);
            x1 *= rinv * kn[lane * 2]; x2 *= rinv * kn[lane * 2 + 1];
            const float y1 = x1 * cs - x2 * sn;
            const float y2 = x1 * sn + x2 * cs;
            *(unsigned*)(KA + ((size_t)(b * 2 + kh) * TSEQ + key) * 128 + lane * 2) = pack2(y1, y2);
            const unsigned uv = *(const unsigned*)(src + koff + 256 + kh * 128 + lane * 2);
            *(unsigned*)(VT + ((size_t)(b * 2 + kh) * TSEQ + key) * 128 + lane * 2) = uv;
        }
    }
}

namespace att {
constexpr int D = 128, NW = 8, QBLK = 32, KVBLK = 64;
constexpr float SCALE = 0.088388347648318440f;
constexpr float THR = 8.f;
constexpr int LDQ = 1024, LDK = 128, LDO = 1024;
constexpr size_t SHM_V = KVBLK * D * 2, SHM_K = KVBLK * D * 2, SHM_ATTN = 2 * SHM_V + 2 * SHM_K + NW * 64 * 4;
using s16x4  = __attribute__((ext_vector_type(4))) short;
using f32x16 = __attribute__((ext_vector_type(16))) float;
using u32x4  = __attribute__((ext_vector_type(4))) unsigned;
#define KSWZ(row, colB) ((row) * 256 + ((colB) ^ (((row) & 7) << 4)))
#define SBAR() __builtin_amdgcn_sched_barrier(0)
__device__ __forceinline__ int crow(int r, int hi) { return (r & 3) + 8 * (r >> 2) + 4 * hi; }
__device__ __forceinline__ unsigned cvtpk(float lo, float hi) {
  unsigned r; asm volatile("v_cvt_pk_bf16_f32 %0, %1, %2" : "=v"(r) : "v"(lo), "v"(hi)); return r;
}
__device__ __forceinline__ void partialSM(f32x16& p0, f32x16& p1, float& m_reg, float& mn, float& alpha) {
  constexpr float C = SCALE * 1.4426950408889634f;
  float pmax = p0[0];
#pragma unroll
  for (int r = 1; r < 16; ++r) pmax = fmaxf(pmax, p0[r]);
#pragma unroll
  for (int r = 0; r < 16; ++r) pmax = fmaxf(pmax, p1[r]);
  { auto rr = __builtin_amdgcn_permlane32_swap(__float_as_uint(pmax), __float_as_uint(pmax), false, false);
    pmax = fmaxf(__uint_as_float(rr[0]), __uint_as_float(rr[1])); }
  if (__builtin_expect(__all(pmax - m_reg <= THR / SCALE), 1)) { mn = m_reg; alpha = 1.f; }
  else { mn = fmaxf(m_reg, pmax); alpha = __builtin_amdgcn_exp2f((m_reg - mn) * C); m_reg = mn; }
  float mnC = -mn * C;
#pragma unroll
  for (int r = 0; r < 16; ++r) p0[r] = fmaf(p0[r], C, mnC);
#pragma unroll
  for (int r = 0; r < 16; ++r) p1[r] = fmaf(p1[r], C, mnC);
#pragma unroll
  for (int r = 0; r < 16; ++r) p0[r] = __builtin_amdgcn_exp2f(p0[r]);
}
__device__ __forceinline__ void finishSM(f32x16& p0, f32x16& p1, float alpha, float& l_reg, bf16x8& pa0, bf16x8& pa1, bf16x8& pa2, bf16x8& pa3) {
#pragma unroll
  for (int r = 0; r < 16; ++r) p1[r] = __builtin_amdgcn_exp2f(p1[r]);
  float ps = 0;
#pragma unroll
  for (int r = 0; r < 16; ++r) ps += p0[r];
#pragma unroll
  for (int r = 0; r < 16; ++r) ps += p1[r];
  { auto rr = __builtin_amdgcn_permlane32_swap(__float_as_uint(ps), __float_as_uint(ps), false, false);
    ps = __uint_as_float(rr[0]) + __uint_as_float(rr[1]); }
  l_reg = l_reg * alpha + ps;
#define PK4(P, BASE, OUT) do { unsigned a0 = cvtpk(P[BASE + 0], P[BASE + 1]), a1 = cvtpk(P[BASE + 2], P[BASE + 3]);   \
    unsigned b0 = cvtpk(P[BASE + 4], P[BASE + 5]), b1 = cvtpk(P[BASE + 6], P[BASE + 7]);                              \
    auto r0 = __builtin_amdgcn_permlane32_swap(a0, b0, false, false); auto r1 = __builtin_amdgcn_permlane32_swap(a1, b1, false, false); \
    u32x4 w = {r0[0], r1[0], r0[1], r1[1]}; OUT = *reinterpret_cast<bf16x8*>(&w); } while (0)
  PK4(p0, 0, pa0); PK4(p0, 8, pa1); PK4(p1, 0, pa2); PK4(p1, 8, pa3);
#undef PK4
}
__device__ __forceinline__ void qkt(f32x16& p0, f32x16& p1, const bf16_t* Ks, const bf16x8* qr, int r32, int hi) {
  p0 = f32x16{}; p1 = f32x16{};
#pragma unroll
  for (int d0 = 0; d0 < 8; ++d0) { int cb = (d0 * 16 + hi * 8) * 2;
    bf16x8 b0 = *reinterpret_cast<const bf16x8*>((const char*)Ks + KSWZ(r32, cb));
    bf16x8 b1 = *reinterpret_cast<const bf16x8*>((const char*)Ks + KSWZ(32 + r32, cb));
    p0 = __builtin_amdgcn_mfma_f32_32x32x16_bf16(b0, qr[d0], p0, 0, 0, 0);
    p1 = __builtin_amdgcn_mfma_f32_32x32x16_bf16(b1, qr[d0], p1, 0, 0, 0); }
}
__device__ __forceinline__ int v_st(int k, int c) { const int kk = (k & ~0xC) | ((k & 4) << 1) | ((k & 8) >> 1); return ((kk >> 3) * 4 + (c >> 5)) * 512 + ((kk & 7) * 32 + (c & 31)) * 2; }
__device__ __forceinline__ int v_rd_base(int lane) { return ((lane & 3) << 3) | (((lane >> 2) & 3) << 6) | (((lane >> 4) & 1) << 5) | (((lane >> 5) & 1) << 8); }
constexpr int v_rd_off(int d0, int ks, int half) { return d0 * 512 + ks * 4096 + half * 2048; }
template <int OFF> __device__ __forceinline__ s16x4 tr_read(int vb) {
  s16x4 r; asm volatile("ds_read_b64_tr_b16 %0, %1 offset:%2" : "=&v"(r) : "v"(vb), "i"(OFF) : "memory"); return r;
}
template <int D0> __device__ __forceinline__ void pv_one(f32x16& od, int vb, bf16x8 pa0, bf16x8 pa1, bf16x8 pa2, bf16x8 pa3) {
  const s16x4 l0 = tr_read<v_rd_off(D0, 0, 0)>(vb), h0 = tr_read<v_rd_off(D0, 0, 1)>(vb), l1 = tr_read<v_rd_off(D0, 1, 0)>(vb), h1 = tr_read<v_rd_off(D0, 1, 1)>(vb);
  const s16x4 l2 = tr_read<v_rd_off(D0, 2, 0)>(vb), h2 = tr_read<v_rd_off(D0, 2, 1)>(vb), l3 = tr_read<v_rd_off(D0, 3, 0)>(vb), h3 = tr_read<v_rd_off(D0, 3, 1)>(vb);
  asm volatile("s_waitcnt lgkmcnt(0)" ::: "memory"); SBAR();
#define PK(L, H) (bf16x8){L[0], L[1], L[2], L[3], H[0], H[1], H[2], H[3]}
  od = __builtin_amdgcn_mfma_f32_32x32x16_bf16(pa0, PK(l0, h0), od, 0, 0, 0);
  od = __builtin_amdgcn_mfma_f32_32x32x16_bf16(pa1, PK(l1, h1), od, 0, 0, 0);
  od = __builtin_amdgcn_mfma_f32_32x32x16_bf16(pa2, PK(l2, h2), od, 0, 0, 0);
  od = __builtin_amdgcn_mfma_f32_32x32x16_bf16(pa3, PK(l3, h3), od, 0, 0, 0);
#undef PK
}
__device__ __forceinline__ void pv_d0(f32x16* o, int vb, bf16x8 pa0, bf16x8 pa1, bf16x8 pa2, bf16x8 pa3) {
  pv_one<0>(o[0], vb, pa0, pa1, pa2, pa3); pv_one<1>(o[1], vb, pa0, pa1, pa2, pa3); pv_one<2>(o[2], vb, pa0, pa1, pa2, pa3); pv_one<3>(o[3], vb, pa0, pa1, pa2, pa3);
}
__device__ __forceinline__ void attn_dense_body(const bf16_t* __restrict__ Qb, const bf16_t* __restrict__ Kh, const bf16_t* __restrict__ Vh,
                                                bf16_t* __restrict__ Ob, int seq, char* lds) {
  const int tid = hide_tid(), wid = tid >> 6, lane = tid & 63, r32 = lane & 31, hi = lane >> 5;
  bf16_t* V_lds = (bf16_t*)lds; bf16_t* K_lds = (bf16_t*)(lds + 2 * SHM_V);
  float* ws = (float*)(lds + 2 * SHM_V + 2 * SHM_K) + wid * 64; float* li_l = ws; float* al_l = ws + 32;
  float m_reg = -1e30f, l_reg = 0; f32x16 o[4] = {}; bf16x8 qr[8];
  const bf16_t* Qw = Qb + (long)(wid * QBLK + r32) * LDQ + hi * 8;
#pragma unroll
  for (int d0 = 0; d0 < 8; ++d0) qr[d0] = *reinterpret_cast<const bf16x8*>(Qw + d0 * 16);
  const int sr = tid >> 4, sc = (tid & 15) * 8, vst0 = v_st(sr, sc), vst1 = v_st(32 + sr, sc);
  const int vb0 = (int)(uintptr_t)V_lds + v_rd_base(lane);
  struct { bf16x8 vs0, vs1, ks0, ks1; } sr_[2];
#define SLOAD(i, k0) do { sr_[i].vs0 = *reinterpret_cast<const bf16x8*>(&Vh[(long)((k0) + sr) * LDK + sc]); sr_[i].vs1 = *reinterpret_cast<const bf16x8*>(&Vh[(long)((k0) + 32 + sr) * LDK + sc]); \
    sr_[i].ks0 = *reinterpret_cast<const bf16x8*>(&Kh[(long)((k0) + sr) * LDK + sc]); sr_[i].ks1 = *reinterpret_cast<const bf16x8*>(&Kh[(long)((k0) + 32 + sr) * LDK + sc]); } while (0)
#define SWRITE(b, i) do { *(bf16x8*)((char*)V_lds + (b) * SHM_V + vst0) = sr_[i].vs0;          \
    *(bf16x8*)((char*)V_lds + (b) * SHM_V + vst1) = sr_[i].vs1; int kc = sc * 2;               \
    *(bf16x8*)((char*)K_lds + (b) * SHM_K + KSWZ(sr, kc)) = sr_[i].ks0;                       \
    *(bf16x8*)((char*)K_lds + (b) * SHM_K + KSWZ(32 + sr, kc)) = sr_[i].ks1; } while (0)
#define SWAIT() asm volatile("s_waitcnt vmcnt(4)" ::: "memory")
#define RESC(a) do { if (__any((a) < 1.f)) { if (hi == 0) al_l[r32] = (a); asm volatile("s_waitcnt lgkmcnt(0)" ::: "memory"); \
    _Pragma("unroll") for (int d = 0; d < 4; ++d) _Pragma("unroll") for (int r = 0; r < 16; ++r) o[d][r] *= al_l[crow(r, hi)]; } } while (0)
  f32x16 pA0, pA1, pB0, pB1; float mnA, mnB, alA, alB; bf16x8 pa0, pa1, pa2, pa3; const int NKT = seq / KVBLK;
  constexpr int SE = 0, SO = 1;
  SLOAD(SE, 0); asm volatile("s_waitcnt vmcnt(0)" ::: "memory"); SWRITE(0, SE); __syncthreads();
  qkt(pA0, pA1, K_lds, qr, r32, hi); partialSM(pA0, pA1, m_reg, mnA, alA);
  SLOAD(SO, KVBLK); if (2 < NKT) SLOAD(SE, 2 * KVBLK);
  SWAIT(); SWRITE(1, SO); __syncthreads();
  for (int j = 1; j + 1 < NKT; j += 2) {
    SBAR(); qkt(pB0, pB1, (bf16_t*)((char*)K_lds + SHM_K), qr, r32, hi);
    finishSM(pA0, pA1, alA, l_reg, pa0, pa1, pa2, pa3); SBAR();
    SLOAD(SO, (j + 2) * KVBLK); SBAR();
    pv_d0(o, vb0, pa0, pa1, pa2, pa3); partialSM(pB0, pB1, m_reg, mnB, alB);
    __syncthreads(); SWAIT(); SWRITE(0, SE);
    RESC(alB); __syncthreads();
    SBAR(); qkt(pA0, pA1, K_lds, qr, r32, hi);
    finishSM(pB0, pB1, alB, l_reg, pa0, pa1, pa2, pa3); SBAR();
    if (j + 3 < NKT) SLOAD(SE, (j + 3) * KVBLK); SBAR();
    pv_d0(o, vb0 + (int)SHM_V, pa0, pa1, pa2, pa3); partialSM(pA0, pA1, m_reg, mnA, alA);
    __syncthreads(); SWAIT(); SWRITE(1, SO);
    RESC(alA); __syncthreads();
  }
  SBAR(); qkt(pB0, pB1, (bf16_t*)((char*)K_lds + SHM_K), qr, r32, hi);
  finishSM(pA0, pA1, alA, l_reg, pa0, pa1, pa2, pa3); SBAR();
  pv_d0(o, vb0, pa0, pa1, pa2, pa3); partialSM(pB0, pB1, m_reg, mnB, alB);
  __syncthreads(); RESC(alB);
  finishSM(pB0, pB1, alB, l_reg, pa0, pa1, pa2, pa3); SBAR();
  pv_d0(o, vb0 + (int)SHM_V, pa0, pa1, pa2, pa3);
  if (hi == 0) li_l[r32] = l_reg; asm volatile("s_waitcnt lgkmcnt(0)" ::: "memory");
  bf16_t* Ow = Ob + (long)(wid * QBLK) * LDO + r32;
#pragma unroll
  for (int r = 0; r < 16; ++r) { const int orow = crow(r, hi); const float rl = __builtin_amdgcn_rcpf(li_l[orow]);
#pragma unroll
    for (int d0 = 0; d0 < 4; ++d0) Ow[(long)orow * LDO + d0 * 32] = (bf16_t)cvtpk(o[d0][r] * rl, 0.f); }
  __syncthreads();
#undef SLOAD
#undef SWRITE
#undef SWAIT
#undef RESC
}
#undef KSWZ
#undef SBAR
}

__device__ __forceinline__ void ph_attn(const Params& p, char* smem) {
    const bf16_t* QA = (const bf16_t*)(p.ws + OFF_QA);
    const bf16_t* KA = (const bf16_t*)(p.ws + OFF_KA);
    const bf16_t* VA = (const bf16_t*)(p.ws + OFF_VT);
    bf16_t* O = (bf16_t*)(p.ws + OFF_O);
    for (int item = blockIdx.x; item < 8 * 8 * 8; item += gridDim.x) {
        const int qb = item & 7, h = (item >> 3) & 7, b = item >> 6, kvh = h >> 2;
        const size_t qoff = (size_t)(b * SEQ + qb * 256) * 1024 + h * 128;
        const size_t koff = (size_t)(b * 2 + kvh) * TSEQ * 128;
        att::attn_dense_body(QA + qoff, KA + koff, VA + koff, O + qoff, TSEQ, smem);
    }
}

#define N_PHASES 19
template <int PH>
__device__ __forceinline__ void run_phase(const Params& p, LAS unsigned char* lds, int rep = 0) {
    char* smem = (char*)lds;
    if (PH == 0) { if (!(rep && REP_SUB == 2)) ph_ada(p, smem); if (!(rep && REP_SUB == 1)) cvt_dense(p, smem); }
    else if (PH == 1) ph_rows<0>(p, smem);
    else if (PH == 2) ph_gemm_in(p, lds);
    else if (PH == 3) ph_prep(p, smem, rep);
    else if (PH == 4) ph_scan(p, smem, rep);
    else if (PH == 5) ph_merge(p, smem);
    else if (PH == 6) { ph_gemm_out<0>(p, lds); cvt_moe(p, 0, smem); }
    else if (PH == 7) ph_rows<1>(p, smem);
    else if (PH == 8) ph_moe_up(p, 0, lds);
    else if (PH == 9) ph_moe_down(p, 0, lds);
    else if (PH == 10) ph_rows<2>(p, smem);
    else if (PH == 11) ph_gemm_qkv(p, lds);
    else if (PH == 12) { if (!(rep && REP_SUB == 2)) ph_qkprep(p, smem); if (!(rep && REP_SUB == 1)) cvt_moe(p, 1, smem); }
    else if (PH == 13) ph_attn(p, smem);
    else if (PH == 14) ph_gemm_out<1>(p, lds);
    else if (PH == 15) ph_rows<3>(p, smem);
    else if (PH == 16) ph_moe_up(p, 1, lds);
    else if (PH == 17) ph_moe_down(p, 1, lds);
    else if (PH == 18) ph_rows<4>(p, smem);
}

template <int PH>
__global__ void __launch_bounds__(NTHR, 2) k_phase(Params p) {
    run_phase<PH>(p, (LAS unsigned char*)dyn_lds);
}

#if ONE_LAUNCH
template <int PH>
__device__ __forceinline__ void run_all(const Params& p, LAS unsigned char* lds, const XcdBarrier& bar) {
    if (PH == REP_PH) {
        int nrep = 2; asm volatile("" : "+s"(nrep));
#pragma unroll 1
        for (int r = 0; r < nrep; ++r) { run_phase<PH>(p, lds, r); if (r + 1 < nrep) xcd_barrier(bar); }
    } else run_phase<PH>(p, lds);
    if (PH + 1 < N_PHASES) {
        xcd_barrier(bar);
        if (TS_PH > -2 && blockIdx.x == 0 && threadIdx.x == 0) ((LAS unsigned long long*)(lds + LDS_TS))[PH + 1] = __builtin_amdgcn_s_memrealtime();
        run_all<(PH + 1 < N_PHASES) ? PH + 1 : PH>(p, lds, bar);
    }
}
template <>
__device__ __forceinline__ void run_all<N_PHASES - 1>(const Params& p, LAS unsigned char* lds, const XcdBarrier& bar) {
    if (N_PHASES - 1 == REP_PH) {
        int nrep = 2; asm volatile("" : "+s"(nrep));
#pragma unroll 1
        for (int r = 0; r < nrep; ++r) { run_phase<N_PHASES - 1>(p, lds, r); if (r + 1 < nrep) xcd_barrier(bar); }
    } else run_phase<N_PHASES - 1>(p, lds);
}

__global__ void __launch_bounds__(NTHR, 2) k_mega(Params p) {
    LAS unsigned char* lds = (LAS unsigned char*)dyn_lds;
    if (threadIdx.x < 4) ((LAS unsigned*)(lds + LDS_XB))[threadIdx.x] = 0u;
    __syncthreads();
    XcdBarrier bar = xcd_barrier_post((unsigned*)(p.ws + OFF_ZERO), (volatile LAS unsigned*)(lds + LDS_XB));
    if (TS_PH > -2 && blockIdx.x == 0 && threadIdx.x == 0) { LAS unsigned long long* ts = (LAS unsigned long long*)(lds + LDS_TS); for (int i = 0; i < 40; ++i) ts[i] = 0ull; ts[0] = __builtin_amdgcn_s_memrealtime(); }
    run_all<0>(p, lds, bar);
    if (TS_PH >= 100) {
        __syncthreads();
        if (blockIdx.x == 0 && threadIdx.x == 0) {
            LAS unsigned long long* ts = (LAS unsigned long long*)(lds + LDS_TS);
            const unsigned long long now = __builtin_amdgcn_s_memrealtime();
            const unsigned long long d = ts[24 + (TS_PH - 100)];
            while (__builtin_amdgcn_s_memrealtime() - now < 10ull * d) __builtin_amdgcn_s_sleep(8);
        }
    } else if (TS_PH >= 0) {
        __syncthreads();
        if (blockIdx.x == 0 && threadIdx.x == 0) {
            LAS unsigned long long* ts = (LAS unsigned long long*)(lds + LDS_TS);
            const unsigned long long now = __builtin_amdgcn_s_memrealtime();
            if (TS_PH == N_PHASES - 1) ts[N_PHASES] = now;
            const unsigned long long d = ts[TS_PH + 1] - ts[TS_PH];
            while (__builtin_amdgcn_s_memrealtime() - now < 10ull * d) __builtin_amdgcn_s_sleep(8);
        }
    }
}
#endif

template <int PH>
static void launch_phases(const Params& p, hipStream_t stream) {
    static bool attr_set = false;
    if (!attr_set) { (void)hipFuncSetAttribute((const void*)k_phase<PH>, hipFuncAttributeMaxDynamicSharedMemorySize, DYN_LDS); attr_set = true; }
    hipLaunchKernelGGL(k_phase<PH>, dim3(256), dim3(NTHR), DYN_LDS, stream, p);
    if constexpr (PH + 1 < N_PHASES) launch_phases<PH + 1>(p, stream);
}

extern "C" void kernel_launch(void* const* d_in, const int* in_sizes, int n_in, void* d_out, int out_size, void* d_ws,
                              size_t ws_size, hipStream_t stream) {
    Params p{};
    for (int i = 0; i < 32; ++i) p.in[i] = (const float*)d_in[i];
    p.out = (float*)d_out;
    p.ws = (char*)d_ws;
    (void)hipMemsetAsync(d_ws, 0, ZERO_BYTES, stream);
#if ONE_LAUNCH
    static int grid = 0;
    if (!grid) {
        int dev = 0, cus = 0, per_cu = 0;
        (void)hipGetDevice(&dev);
        (void)hipDeviceGetAttribute(&cus, hipDeviceAttributeMultiprocessorCount, dev);
        (void)hipFuncSetAttribute((const void*)k_mega, hipFuncAttributeMaxDynamicSharedMemorySize, DYN_LDS);
        (void)hipOccupancyMaxActiveBlocksPerMultiprocessor(&per_cu, k_mega, NTHR, DYN_LDS);
        if (cus <= 0) cus = 256;
        grid = cus * (per_cu < 1 ? per_cu : 1);
        if (grid <= 0) grid = cus;
    }
    hipLaunchKernelGGL(k_mega, dim3(grid), dim3(NTHR), DYN_LDS, stream, p);
#else
    launch_phases<0>(p, stream);
#endif
}
```

```cpp
#include <hip/hip_runtime.h>
#include <stdint.h>

#ifndef ONE_LAUNCH
#define ONE_LAUNCH 1
#endif
#ifndef TS_PH
#define TS_PH -2
#endif
#define TSACC(i) do { if (TS_PH >= 100 && blockIdx.x == 0 && threadIdx.x == 0) { LAS unsigned long long* _t = (LAS unsigned long long*)(dyn_lds + LDS_TS); const unsigned long long _n = __builtin_amdgcn_s_memrealtime(); _t[24 + (i)] += _n - _t[23]; _t[23] = _n; } } while (0)
#define TSMARK() do { if (TS_PH >= 100 && blockIdx.x == 0 && threadIdx.x == 0) { ((LAS unsigned long long*)(dyn_lds + LDS_TS))[23] = __builtin_amdgcn_s_memrealtime(); } } while (0)
#ifndef REP_SUB
#define REP_SUB 0
#endif
#ifndef REP_PH
#define REP_PH -1
#endif

typedef unsigned short bf16_t;
typedef __attribute__((ext_vector_type(8))) short bf16x8;
typedef __attribute__((ext_vector_type(4))) float f32x4;
extern __shared__ __attribute__((aligned(16))) unsigned char dyn_lds[];

#define D_MODEL 1024
#define BATCH 8
#define SEQ 2048
#define CTXL 256
#define NL (BATCH * SEQ)
#define NC (BATCH * CTXL)
#define NT (NL + NC)
#define AB_PROJ 3088
#define TSEQ (SEQ + CTXL)
#define EPSF 1e-6f
#define NTHR 512

enum { I_X = 0, I_C, I_CTX, I_CCTX, I_ADAW, I_ADAB, I_NORM1, I_NORM2, I_FNORM, I_ABWIN, I_CONVQKV, I_ALOG, I_DTB,
       I_ONORM, I_CONVX, I_RGWR, I_RGBR, I_RGWI, I_RGBI, I_RGLAM, I_ABWOUT, I_ATWQKV, I_QNORM, I_KNORM, I_ATWOUT,
       I_WGRP, I_BGRP, I_WEXP, I_BEXP, I_WGATE, I_WUP, I_WDOWN };

#define AL256(x) (((size_t)(x) + 255) & ~(size_t)255)
#define ZW 3072
#define OFF_ZERO 0
#define ZERO_BYTES 65536
#define OFF_CNT 16384
#define OFF_DYNQ (OFF_CNT + 2048)
#define OFF_MOD (OFF_ZERO + ZERO_BYTES)
#define OFF_X AL256(OFF_MOD + 2 * 9 * 6144 * 4)
#define OFF_H AL256(OFF_X + (size_t)NT * 1024 * 4)
#define OFF_Z AL256(OFF_H + (size_t)NT * 1024 * 2)
#define OFF_BTIN AL256(OFF_Z + (size_t)NT * ZW * 2)
#define OFF_BTOUT0 AL256(OFF_BTIN + (size_t)3072 * 1024 * 2)
#define OFF_BTQKV AL256(OFF_BTOUT0 + (size_t)1024 * 1024 * 2)
#define OFF_BTOUT1 AL256(OFF_BTQKV + (size_t)1536 * 1024 * 2)
#define OFF_WRG AL256(OFF_BTOUT1 + (size_t)1024 * 1024 * 2)
#define OFF_WSEL AL256(OFF_WRG + (size_t)8 * 256 * 64 * 2)
#define OFF_LIST AL256(OFF_WSEL + (size_t)2 * NT * 4)
#define OFF_POS AL256(OFF_LIST + (size_t)32 * NT * 4)
#define OFF_R1 AL256(OFF_POS + (size_t)2 * NT * 4)
#define OFF_GATES OFF_R1
#define OFF_QG AL256(OFF_GATES + (size_t)NT * 16 * 4)
#define OFF_KG AL256(OFF_QG + (size_t)1152 * 8192 * 2)
#define OFF_VG AL256(OFF_KG + (size_t)1152 * 8192 * 2)
#define OFF_KTG AL256(OFF_VG + (size_t)1152 * 8192 * 2)
#define OFF_TT AL256(OFF_KTG + (size_t)1152 * 8192 * 2)
#define OFF_ATT AL256(OFF_TT + (size_t)1152 * 2 * 4096 * 2)
#define OFF_VEC AL256(OFF_ATT + (size_t)1152 * 2 * 4096 * 2)
#define OFF_EGL AL256(OFF_VEC + (size_t)1152 * 2 * 320 * 4)
#define OFF_HLOC AL256(OFF_EGL + (size_t)1152 * 2 * 4)
#define OFF_ACUM AL256(OFF_HLOC + (size_t)2 * NT * 512 * 2)
#define OFF_LTOT AL256(OFF_ACUM + (size_t)2 * NT * 512 * 2)
#define OFF_CIN AL256(OFF_LTOT + (size_t)2 * 288 * 512 * 2 * 4)
#define OFF_OA AL256(OFF_CIN + (size_t)2 * 288 * 512 * 4)
#define OFF_END AL256(OFF_OA + (size_t)2 * NT * 512 * 2)
#define OFF_BTGU OFF_R1
#define OFF_BTD AL256(OFF_BTGU + (size_t)32 * 1024 * 1024 * 2)
#define ACT_ROWS (2 * NT + 32 * 256)
#define OFF_ACT AL256(OFF_BTD + (size_t)32 * 1024 * 512 * 2)
#define OFF_YE AL256(OFF_ACT + (size_t)ACT_ROWS * 512 * 2)
#define OFF_ZQ OFF_Z
#define OFF_ZC (OFF_Z + (size_t)NL * 1536 * 2)
#define OFF_QA (OFF_ZC + (size_t)NC * 512 * 2)
#define OFF_KA (OFF_QA + (size_t)NL * 1024 * 2)
#define OFF_VT (OFF_KA + (size_t)8 * 2 * TSEQ * 128 * 2)
#define OFF_O OFF_H
#define OFF_END_MOE AL256(OFF_YE + (size_t)ACT_ROWS * 1024 * 2)
static_assert(OFF_END_MOE < (size_t)530 * 1024 * 1024, "workspace budget (MoE scratch)");
static_assert(OFF_VT + (size_t)8 * 2 * TSEQ * 128 * 2 <= OFF_BTIN, "attention buffers must fit in the Z region");
static_assert(OFF_END < (size_t)530 * 1024 * 1024, "workspace budget");

#define DYN_LDS (155 * 1024)
#define LDS_XB (154 * 1024)
#define LDS_PRE (154 * 1024 + 64)
#define LDS_TS (154 * 1024 + 512)
#define MOE_MAXU 12
#define LDS_ROWTAB (130 * 1024)

struct Params {
    const float* in[32];
    float* out;
    char* ws;
};

typedef float pk_f32x2 __attribute__((ext_vector_type(2)));
typedef __bf16 pk_bf16x2 __attribute__((ext_vector_type(2)));
__device__ __forceinline__ unsigned pack2(float a, float b) { const pk_f32x2 v = {a, b}; return __builtin_bit_cast(unsigned, __builtin_convertvector(v, pk_bf16x2)); }
__device__ __forceinline__ bf16_t f2bf(float f) { return (bf16_t)(pack2(f, f) & 0xffffu); }
__device__ __forceinline__ float bf2f(bf16_t h) { return __uint_as_float(((unsigned)h) << 16); }
__device__ __forceinline__ float frcp_(float x) { return __builtin_amdgcn_rcpf(x); }
__device__ __forceinline__ float frsq_(float x) { return __builtin_amdgcn_rsqf(x); }
__device__ __forceinline__ float sigmoidf_(float x) { return frcp_(1.f + __expf(-x)); }
__device__ __forceinline__ float siluf_(float x) { return x * frcp_(1.f + __expf(-x)); }
__device__ __forceinline__ float softplusf_(float x) {
    const float e = __expf(fminf(x, 20.f));
    const float s = e * (1.f - e * (0.5f - e * (1.f / 3.f - 0.25f * e)));
    return x > 20.f ? x : (e < 0.03f ? s : __logf(1.f + e));
}
__device__ __forceinline__ float geluf_(float x) {
    const float u = 0.7978845608028654f * (x + 0.044715f * x * x * x);
    return x * frcp_(1.f + __expf(-2.f * u));
}
__device__ __forceinline__ float neg_expm1_small(float x) {
    float q = 1.f / 5040.f;
    q = q * x + 1.f / 720.f; q = q * x + 1.f / 120.f; q = q * x + 1.f / 24.f; q = q * x + 1.f / 6.f; q = q * x + 0.5f; q = q * x + 1.f;
    return x < -0.5f ? 1.f - __expf(x) : -x * q;
}
#define DPP_F(v, ctrl) __int_as_float(__builtin_amdgcn_update_dpp(0, __float_as_int(v), ctrl, 0xF, 0xF, true))
__device__ __forceinline__ float row16_sum(float v) {
    v += DPP_F(v, 0xB1);
    v += DPP_F(v, 0x4E);
    v += DPP_F(v, 0x141);
    v += DPP_F(v, 0x140);
    return v;
}
__device__ __forceinline__ float row16_max(float v) {
    v = fmaxf(v, DPP_F(v, 0xB1)); v = fmaxf(v, DPP_F(v, 0x4E)); v = fmaxf(v, DPP_F(v, 0x141)); v = fmaxf(v, DPP_F(v, 0x140));
    return v;
}
__device__ __forceinline__ float wave_sum(float v) {
    v = row16_sum(v);
    const float a = __int_as_float(__builtin_amdgcn_readlane(__float_as_int(v), 0));
    const float b = __int_as_float(__builtin_amdgcn_readlane(__float_as_int(v), 16));
    const float c = __int_as_float(__builtin_amdgcn_readlane(__float_as_int(v), 32));
    const float d = __int_as_float(__builtin_amdgcn_readlane(__float_as_int(v), 48));
    return (a + b) + (c + d);
}
__device__ __forceinline__ int hide_tid() { int t = threadIdx.x; asm volatile("" : "+v"(t)); return t & 511; }
__device__ __forceinline__ int scan_row(int s, int dir, int b) {
    if (s < CTXL) { const int t = dir ? (CTXL - 1 - s) : s; return NL + b * CTXL + t; }
    const int u = s - CTXL; const int t = dir ? (SEQ - 1 - u) : u; return b * SEQ + t;
}

#define XB_TMO      128
#define XB_XCNT(j)  (256  + 64 * (j))
#define XB_XSUB(j)  (1280 + 64 * (j))
#define XB_XGEN(j)  (2304 + 64 * (j))
#define XB_TOP      3328
#define XB_TOPGEN   3392
#define XCD_BAR_WORDS 3456
#define XB_SPIN_CAP (1u << 22)
#define LAS __attribute__((address_space(3)))

__device__ __forceinline__ unsigned xb_ld(unsigned* p)              { return __hip_atomic_load(p, __ATOMIC_RELAXED, __HIP_MEMORY_SCOPE_AGENT); }
__device__ __forceinline__ unsigned xb_add(unsigned* p, unsigned v) { return __hip_atomic_fetch_add(p, v, __ATOMIC_RELAXED, __HIP_MEMORY_SCOPE_AGENT); }
__device__ __forceinline__ unsigned xb_xcc_id() { return (unsigned)__builtin_amdgcn_s_getreg((3 << 11) | 20) & 0xFu; }
#define XB_SPIN(cond, bar) do { unsigned _sp = 0; while (cond) { __builtin_amdgcn_s_sleep(1); \
    if ((++_sp & 255u) == 0u) { if (xb_ld(&(bar)[XB_TMO])) break; if (_sp > XB_SPIN_CAP) { atomicAdd(&(bar)[XB_TMO], 1u); break; } } } } while (0)

struct XcdBarrier {
    unsigned* bar; unsigned x;
    volatile LAS unsigned* st;
};
__device__ __forceinline__ XcdBarrier xcd_barrier_post(unsigned* bar, volatile LAS unsigned* st) {
    XcdBarrier b; b.bar = bar; b.x = xb_xcc_id(); b.st = st;
    if (threadIdx.x == 0) (void)xb_add(&bar[XB_XCNT(b.x)], 1u);
    return b;
}
__device__ __forceinline__ void xcd_barrier_complete(unsigned* bar, unsigned x, unsigned& nloc, unsigned& nx) {
    const unsigned G = gridDim.x * gridDim.y * gridDim.z;
    unsigned sum, cnt, mine, sp = 0u;
    for (;;) {
        sum = 0u; cnt = 0u; mine = 0u;
#pragma unroll
        for (unsigned j = 0; j < 16; ++j) { const unsigned c = xb_ld(&bar[XB_XCNT(j)]); sum += c; cnt += (c > 0u) ? 1u : 0u; mine = (j == x) ? c : mine; }
        if (sum == G) break;
        __builtin_amdgcn_s_sleep(1);
        if ((++sp & 255u) == 0u) { if (xb_ld(&bar[XB_TMO])) break; if (sp > XB_SPIN_CAP) { atomicAdd(&bar[XB_TMO], 1u); break; } }
    }
    nloc = mine > 0u ? mine : 1u; nx = cnt > 0u ? cnt : 1u;
}
__device__ __forceinline__ void xcd_barrier(const XcdBarrier& b) {
    asm volatile("s_waitcnt vmcnt(0)" ::: "memory");
    __syncthreads();
    if (threadIdx.x == 0) {
        unsigned* bar = b.bar;
        __builtin_amdgcn_s_waitcnt(0);
        unsigned nloc = b.st[0], nx = b.st[1];
        if (nloc == 0u) { xcd_barrier_complete(bar, b.x, nloc, nx); b.st[0] = nloc; b.st[1] = nx; }
        const unsigned old = xb_add(&bar[XB_XSUB(b.x)], 1u);
        const unsigned gen = old / nloc;
        if (old + 1u == (gen + 1u) * nloc) {
            __builtin_amdgcn_fence(__ATOMIC_RELEASE, "agent");
            asm volatile("s_waitcnt vmcnt(0)" ::: "memory");
            const unsigned og = xb_add(&bar[XB_TOP], 1u);
            const unsigned tg = og / nx;
            if (og + 1u == (tg + 1u) * nx) xb_add(&bar[XB_TOPGEN], 1u);
            else XB_SPIN(xb_ld(&bar[XB_TOPGEN]) == tg, bar);
            __builtin_amdgcn_fence(__ATOMIC_ACQUIRE, "agent");
            xb_add(&bar[XB_XGEN(b.x)], 1u);
            asm volatile("s_waitcnt vmcnt(0)" ::: "memory");
        } else {
            XB_SPIN(xb_ld(&bar[XB_XGEN(b.x)]) == gen, bar);
            __builtin_amdgcn_fence(__ATOMIC_ACQUIRE, "agent");
            asm volatile("s_waitcnt vmcnt(0)" ::: "memory");
        }
    }
    __syncthreads();
}

__device__ __forceinline__ unsigned pull_issue(unsigned* head, int count) { return hide_tid() == 0 ? xb_add(head, (unsigned)count) : 0u; }
__device__ __forceinline__ int pull_take(unsigned ticket, char* smem_slot) {
    int* slot = (int*)smem_slot;
    __syncthreads();
    if (hide_tid() == 0) *slot = (int)ticket;
    __syncthreads();
    return *slot;
}
__device__ __forceinline__ int pull_item(unsigned* head, int count, char* smem_slot) {
    int* slot = (int*)smem_slot;
    __syncthreads();
    if (hide_tid() == 0) *slot = (int)xb_add(head, (unsigned)count);
    __syncthreads();
    return *slot;
}
namespace g8 {
constexpr int BM = 256, BK = 64, HALF = 128, HTB = HALF * BK * 2, STAGE_BYTES = 8 * HTB, NXCD = 8, WGM = 8;
typedef unsigned u32x4 __attribute__((ext_vector_type(4)));
__device__ __forceinline__ int lds_byte(int r, int c) { const int st = (r >> 4) * 2 + (c >> 5), rr = r & 15, cc = c & 31, ob = rr * 64 + cc * 2; return st * 1024 + (ob ^ (((ob >> 9) & 1) << 5)); }
__device__ __forceinline__ void stage_rc(int b, int& R, int& C) { const int st = b / 1024, sb = b % 1024, swz = sb ^ (((sb >> 9) & 1) << 5); R = (st >> 1) * 16 + swz / 64; C = (st & 1) * 32 + (swz % 64) / 2; }
__device__ __forceinline__ int perm32(int rho) { const int n = rho >> 4, i = rho & 15; return 8 * (i >> 2) + 4 * n + (i & 3); }
__device__ __forceinline__ unsigned cvt_pk_bf16(float lo, float hi) { unsigned r; asm volatile("v_cvt_pk_bf16_f32 %0, %1, %2" : "=v"(r) : "v"(lo), "v"(hi)); return r; }

struct Unit {
    const char* A;
    const char* Bt;
    const int* lst;
    int mv;
    int pm, pn;
    int aux;
    int ui;
};

__device__ __forceinline__ void static_order(int wgid, int nM, int nN, int& pm, int& pn) {
    const int nwg = nM * nN;
    { const int q = nwg / NXCD, r = nwg % NXCD, xcd = wgid % NXCD, off = wgid / NXCD; wgid = (xcd < r ? xcd * (q + 1) : r * (q + 1) + (xcd - r) * q) + off; }
    const int nig = WGM * nN, gid = wgid / nig, fm = gid * WGM, gsz = (nM - fm) < WGM ? (nM - fm) : WGM;
    pm = fm + ((wgid % nig) % gsz); pn = (wgid % nig) / gsz;
}

template <bool GATHER, int GSHIFT, class Epi, class Sched>
__device__ __forceinline__ void gemm_phase(LAS unsigned char* lds, const int K, const Sched& S, const Epi& E) {
    const int tid = hide_tid(), wid = __builtin_amdgcn_readfirstlane(tid >> 6), lane = tid & 63, wr = wid >> 2, wc = wid & 3, fr = lane & 15, fq = lane >> 4;
    const int nt = K / BK;
    unsigned voffA[2], voffB[2];
#pragma unroll
    for (int i = 0; i < 2; ++i) { int R, C; stage_rc(tid * 16 + i * 8192, R, C); const int Rb = Epi::PERM ? ((R & ~31) + perm32(R & 31)) : R;
        voffA[i] = (unsigned)(R * K + C) * 2u; voffB[i] = (unsigned)(Rb * K + C) * 2u; }
    const size_t kstep = (size_t)(BK * 2);
    const size_t hstep = (size_t)HALF * K * 2;
    const unsigned ldsw = (unsigned)wid * 1024u;
    const int aoff = lds_byte(wr * 64 + fr, fq * 8), boff = lds_byte(wc * 32 + fr, fq * 8);
    unsigned gcur[2][2];
    const LAS int* rowtab = (const LAS int*)(lds + LDS_ROWTAB);
    auto gather_offs = [&](int uidx, unsigned (&g)[2][2]) {
#pragma unroll
        for (int h = 0; h < 2; ++h)
#pragma unroll
            for (int i = 0; i < 2; ++i) { int R, C; stage_rc(tid * 16 + i * 8192, R, C);
                g[h][i] = (unsigned)(rowtab[uidx * 256 + h * 128 + R] >> GSHIFT) * (unsigned)(K * 2) + (unsigned)(C * 2); }
    };
#define G8_SA(b, h) (((b) * 2 + (h)) * HTB)
#define G8_SB(b, h) ((4 + (b) * 2 + (h)) * HTB)
#define G8_STAGE(bufoff, gbase, voff) do { _Pragma("unroll") for (int _i = 0; _i < 2; ++_i) \
        __builtin_amdgcn_global_load_lds((const unsigned*)((const char*)(gbase) + (voff)[_i]), (LAS unsigned*)(lds + (bufoff) + ldsw + _i * 8192), 16, 0, 0); } while (0)
#define G8_LDA(dst, b, h) do { _Pragma("unroll") for (int m = 0; m < 4; ++m) _Pragma("unroll") for (int k = 0; k < 2; ++k) dst[m][k] = *(const LAS bf16x8*)(lds + G8_SA(b, h) + aoff + m * 2048 + k * 1024); } while (0)
#define G8_LDB(dst, b, h) do { _Pragma("unroll") for (int n = 0; n < 2; ++n) _Pragma("unroll") for (int k = 0; k < 2; ++k) dst[n][k] = *(const LAS bf16x8*)(lds + G8_SB(b, h) + boff + n * 2048 + k * 1024); } while (0)
#define G8_MMA(ai, bj, At, Bt) do { __builtin_amdgcn_s_setprio(1); _Pragma("unroll") for (int m = 0; m < 4; ++m) _Pragma("unroll") for (int n = 0; n < 2; ++n) _Pragma("unroll") for (int k = 0; k < 2; ++k) \
        acc[ai][bj][m][n] = __builtin_amdgcn_mfma_f32_16x16x32_bf16(Bt[n][k], At[m][k], acc[ai][bj][m][n], 0, 0, 0); __builtin_amdgcn_s_setprio(0); } while (0)
#define G8_WAIT_V(n) asm volatile("s_waitcnt vmcnt(" #n ")" ::: "memory")
#define G8_WAIT_L(n) asm volatile("s_waitcnt lgkmcnt(" #n ")" ::: "memory")
#define G8_BAR __builtin_amdgcn_s_barrier()
#define G8_SCHED __builtin_amdgcn_sched_barrier(0)
    Unit cur, nxt; int ui = 0;
    if (!S.next(0, cur)) return;
    f32x4 acc[2][2][4][2];
#pragma unroll
    for (int a = 0; a < 2; ++a)
#pragma unroll
        for (int b = 0; b < 2; ++b)
#pragma unroll
            for (int m = 0; m < 4; ++m)
#pragma unroll
                for (int n = 0; n < 2; ++n) acc[a][b][m][n] = (f32x4){0.f, 0.f, 0.f, 0.f};
    bf16x8 At[4][2], B0[2][2], B1[2][2];
    const char* cA = cur.A; const char* cB = cur.Bt;
    if (GATHER) gather_offs(0, gcur);
#define G8_STAGE_A(bufoff, kp, h, g) do { if (GATHER) G8_STAGE(bufoff, kp, (g)[h]); else G8_STAGE(bufoff, (kp) + (h) * hstep, voffA); } while (0)
    G8_STAGE(G8_SB(0, 0), cB, voffB); G8_STAGE_A(G8_SA(0, 0), cA, 0, gcur); G8_STAGE(G8_SB(0, 1), cB + hstep, voffB); G8_STAGE_A(G8_SA(0, 1), cA, 1, gcur);
    if (wr == 1) G8_BAR;
    G8_WAIT_V(4); G8_BAR;
    G8_STAGE(G8_SB(1, 0), cB + kstep, voffB); G8_STAGE_A(G8_SA(1, 0), cA + kstep, 0, gcur); G8_STAGE(G8_SB(1, 1), cB + hstep + kstep, voffB);
    G8_WAIT_V(6); G8_BAR;
    for (;;) {
        const bool has_next = S.next(ui + 1, nxt);
        const char* nA = has_next ? nxt.A : cA; const char* nB = has_next ? nxt.Bt : cB;
        for (int t = 0; t < nt; t += 2) {
            const bool last = (t == nt - 2);
            const char* a1 = cA + (size_t)(t + 1) * kstep;
            const char* a2 = last ? nA : cA + (size_t)(t + 2) * kstep; const char* b2 = last ? nB : cB + (size_t)(t + 2) * kstep;
            const char* a3 = a2 + kstep; const char* b3 = b2 + kstep;
            G8_LDB(B0, 0, 0); G8_SCHED; G8_LDA(At, 0, 0); G8_STAGE_A(G8_SA(1, 1), a1, 1, gcur);
            G8_WAIT_L(8); G8_BAR; G8_WAIT_L(0); G8_MMA(0, 0, At, B0); G8_BAR; G8_SCHED;
            if (GATHER) { if (last && has_next) gather_offs(ui + 1, gcur); }
            G8_LDB(B1, 0, 1); G8_STAGE(G8_SB(0, 0), b2, voffB);
            G8_BAR; G8_WAIT_L(0); G8_MMA(0, 1, At, B1); G8_BAR;
            G8_LDA(At, 0, 1); G8_STAGE_A(G8_SA(0, 0), a2, 0, gcur);
            G8_BAR; G8_WAIT_L(0); G8_MMA(1, 0, At, B0); G8_BAR; G8_SCHED;
            G8_STAGE(G8_SB(0, 1), b2 + hstep, voffB);
            G8_WAIT_V(6); G8_BAR; G8_MMA(1, 1, At, B1); G8_BAR;
            G8_LDB(B0, 1, 0); G8_SCHED; G8_LDA(At, 1, 0); G8_STAGE_A(G8_SA(0, 1), a2, 1, gcur);
            G8_WAIT_L(8); G8_BAR; G8_WAIT_L(0); G8_MMA(0, 0, At, B0); G8_BAR; G8_SCHED;
            G8_LDB(B1, 1, 1); G8_STAGE(G8_SB(1, 0), b3, voffB);
            G8_BAR; G8_WAIT_L(0); G8_MMA(0, 1, At, B1); G8_BAR;
            G8_LDA(At, 1, 1); G8_STAGE_A(G8_SA(1, 0), a3, 0, gcur);
            G8_BAR; G8_WAIT_L(0); G8_MMA(1, 0, At, B0); G8_BAR; G8_SCHED;
            G8_STAGE(G8_SB(1, 1), b3 + hstep, voffB);
            G8_WAIT_V(6); G8_BAR; G8_MMA(1, 1, At, B1); G8_BAR;
        }
        E(acc, cur, wr, wc, fr, fq);
        if (!has_next) break;
#pragma unroll
        for (int a = 0; a < 2; ++a)
#pragma unroll
            for (int b = 0; b < 2; ++b)
#pragma unroll
                for (int m = 0; m < 4; ++m)
#pragma unroll
                    for (int n = 0; n < 2; ++n) acc[a][b][m][n] = (f32x4){0.f, 0.f, 0.f, 0.f};
        cur = nxt; cA = nA; cB = nB; ++ui;
    }
    G8_WAIT_V(0);
    if (wr == 0) G8_BAR;
    G8_BAR;
#undef G8_SA
#undef G8_SB
#undef G8_STAGE
#undef G8_STAGE_A
#undef G8_LDA
#undef G8_LDB
#undef G8_MMA
#undef G8_WAIT_V
#undef G8_WAIT_L
#undef G8_BAR
#undef G8_SCHED
}

struct EpiBf16 {
    static constexpr bool PERM = true;
    bf16_t* O0; int ldc0; bf16_t* O1; int ldc1;
    __device__ __forceinline__ void operator()(const f32x4 (&acc)[2][2][4][2], const Unit& u, int wr, int wc, int fr, int fq) const {
        bf16_t* O = u.aux ? O1 : O0; const int ldc = u.aux ? ldc1 : ldc0;
        const int row0 = u.pm * BM + wr * 64 + fr, col0 = u.pn * BM + wc * 32 + 8 * fq;
#pragma unroll
        for (int ai = 0; ai < 2; ++ai)
#pragma unroll
            for (int m = 0; m < 4; ++m) { bf16_t* rowp = O + (size_t)(row0 + ai * HALF + m * 16) * ldc + col0;
#pragma unroll
                for (int bj = 0; bj < 2; ++bj) { const f32x4 v0 = acc[ai][bj][m][0], v1 = acc[ai][bj][m][1];
                    u32x4 w; w.x = cvt_pk_bf16(v0[0], v0[1]); w.y = cvt_pk_bf16(v0[2], v0[3]); w.z = cvt_pk_bf16(v1[0], v1[1]); w.w = cvt_pk_bf16(v1[2], v1[3]);
                    *(u32x4*)(rowp + bj * HALF) = w; } }
    }
};
struct EpiResid {
    static constexpr bool PERM = true;
    float* X; const float* g1base;
    const float* base_lat; const float* base_ctx;
    __device__ __forceinline__ void operator()(const f32x4 (&acc)[2][2][4][2], const Unit& u, int wr, int wc, int fr, int fq) const {
        const int rt = u.pm * BM;
        const int mr = rt < NL ? (rt >> 11) : 8;
        const float* g1 = g1base + (size_t)mr * 6144;
        const float* B0 = rt < NL ? base_lat : base_ctx - (size_t)NL * 1024;
        const int row0 = rt + wr * 64 + fr, col0 = u.pn * BM + wc * 32 + 8 * fq;
        f32x4 gv[2][2];
#pragma unroll
        for (int bj = 0; bj < 2; ++bj)
#pragma unroll
            for (int n = 0; n < 2; ++n) gv[bj][n] = *(const f32x4*)(g1 + col0 + bj * HALF + n * 4);
#pragma unroll
        for (int ai = 0; ai < 2; ++ai)
#pragma unroll
            for (int m = 0; m < 4; ++m) { const size_t ro = (size_t)(row0 + ai * HALF + m * 16) * 1024 + col0;
#pragma unroll
                for (int bj = 0; bj < 2; ++bj)
#pragma unroll
                    for (int n = 0; n < 2; ++n) { const f32x4 xb = *(const f32x4*)(B0 + ro + bj * HALF + n * 4);
                        *(f32x4*)(X + ro + bj * HALF + n * 4) = xb + gv[bj][n] * acc[ai][bj][m][n]; } }
    }
};
struct EpiMoeUp {
    static constexpr bool PERM = true;
    bf16_t* ACT; const float* WSEL; const LAS int* rowtab;
    __device__ __forceinline__ void operator()(const f32x4 (&acc)[2][2][4][2], const Unit& u, int wr, int wc, int fr, int fq) const {
        bf16_t* abase = ACT + ((size_t)u.pm * 256 + wr * 64 + fr) * 512 + u.pn * 128 + wc * 32 + 8 * fq;
        const LAS float* wt = (const LAS float*)(rowtab + MOE_MAXU * 256) + u.ui * 256 + wr * 64 + fr;
#pragma unroll
        for (int ai = 0; ai < 2; ++ai)
#pragma unroll
            for (int m = 0; m < 4; ++m) {
                const int ridx = ai * HALF + wr * 64 + m * 16 + fr;
                if (ridx < u.mv) {
                    const float w = wt[ai * HALF + m * 16];
                    float o[8];
#pragma unroll
                    for (int n = 0; n < 2; ++n)
#pragma unroll
                        for (int j = 0; j < 4; ++j) { const float g = acc[ai][0][m][n][j], uu = acc[ai][1][m][n][j]; o[n * 4 + j] = g * ::frcp_(1.f + __expf(-g)) * uu * w; }
                    u32x4 wv; wv.x = cvt_pk_bf16(o[0], o[1]); wv.y = cvt_pk_bf16(o[2], o[3]); wv.z = cvt_pk_bf16(o[4], o[5]); wv.w = cvt_pk_bf16(o[6], o[7]);
                    *(u32x4*)(abase + (ai * HALF + m * 16) * 512) = wv;
                }
            }
    }
};
struct EpiMoeDown {
    static constexpr bool PERM = true;
    bf16_t* YE;
    __device__ __forceinline__ void operator()(const f32x4 (&acc)[2][2][4][2], const Unit& u, int wr, int wc, int fr, int fq) const {
        const int col0 = u.pn * BM + wc * 32 + 8 * fq;
#pragma unroll
        for (int ai = 0; ai < 2; ++ai)
#pragma unroll
            for (int m = 0; m < 4; ++m) {
                const int ridx = ai * HALF + wr * 64 + m * 16 + fr;
                if (ridx < u.mv) {
#pragma unroll
                    for (int bj = 0; bj < 2; ++bj) { const f32x4 v0 = acc[ai][bj][m][0], v1 = acc[ai][bj][m][1];
                        u32x4 w; w.x = cvt_pk_bf16(v0[0], v0[1]); w.y = cvt_pk_bf16(v0[2], v0[3]); w.z = cvt_pk_bf16(v1[0], v1[1]); w.w = cvt_pk_bf16(v1[2], v1[3]);
                        *(u32x4*)(YE + ((size_t)u.pm * 256 + ridx) * 1024 + col0 + bj * HALF) = w; }
                }
            }
    }
};

struct DenseSched {
    const char* A; const char* Bt; int nM, nN, K, G, c;
    __device__ __forceinline__ bool next(int i, Unit& u) const {
        const int L = i * G + c; if (L >= nM * nN) return false;
        int pm, pn; static_order(L, nM, nN, pm, pn);
        u.A = A + (size_t)pm * BM * K * 2; u.Bt = Bt + (size_t)pn * BM * K * 2; u.lst = nullptr; u.mv = 256; u.pm = pm; u.pn = pn; u.aux = 0;
        return true;
    }
};
struct QkvSched {
    const char* H; const char* Bt; int G, c;
    __device__ __forceinline__ bool next(int i, Unit& u) const {
        const int L = i * G + c;
        if (L < 384) { int pm, pn; static_order(L, 64, 6, pm, pn);
            u.A = H + (size_t)pm * BM * 2048; u.Bt = Bt + (size_t)pn * BM * 2048; u.pm = pm; u.pn = pn; u.aux = 0; }
        else if (L < 400) { const int q = L - 384, pm = q >> 1, pn = q & 1;
            u.A = H + (size_t)(NL + pm * BM) * 2048; u.Bt = Bt + (size_t)(1024 + pn * BM) * 2048; u.pm = pm; u.pn = pn; u.aux = 1; }
        else return false;
        u.lst = nullptr; u.mv = 256;
        return true;
    }
};
template <bool UP>
struct MoeSched {
    char* ws; int L; const LAS int* pre; int G, c; const LAS int* desc;
    static constexpr int K = UP ? 1024 : 512;
    __device__ __forceinline__ bool next(int i, Unit& u) const {
        const int total = pre[32] << 2;
        const int xcd = c & 7, rank = c >> 3, nrank = (G + 7 - xcd) >> 3;
        const int x0 = (int)(((long)total * xcd) >> 3), x1 = (int)(((long)total * (xcd + 1)) >> 3);
        const int Lx = x0 + i * nrank + rank; if (Lx >= x1) return false;
        const int mt = Lx >> 2, pn = Lx & 3;
        int e, m0, mv;
        if (desc && i < MOE_MAXU) {
            e = desc[i * 4 + 0]; m0 = desc[i * 4 + 1]; mv = desc[i * 4 + 2];
        } else {
            e = 0;
#pragma unroll 1
            for (int j = 1; j < 32; ++j) if (pre[j] <= mt) e = j;
            m0 = (mt - pre[e]) * BM;
            mv = (int)((const unsigned*)(ws + OFF_CNT))[L * 32 + e] - m0; mv = mv > 256 ? 256 : mv;
        }
        u.A = UP ? ws + OFF_H : ws + OFF_ACT + (size_t)mt * BM * 512 * 2;
        u.Bt = ws + (UP ? OFF_BTGU : OFF_BTD) + ((size_t)e * 1024 + (size_t)pn * BM) * K * 2;
        u.lst = (const int*)(ws + OFF_LIST) + (size_t)e * NT + m0; u.mv = mv; u.pm = mt; u.pn = pn; u.aux = e; u.ui = i;
        return true;
    }
};
}

template <class RowMap>
__device__ __forceinline__ void cvt_job(const float* __restrict__ src, int ld, bf16_t* __restrict__ dst, int K, int k0, int tid, RowMap rowmap, char* smem) {
    constexpr int TLD = 136;
    bf16_t* T = (bf16_t*)smem;
    const int n = tid & 255, kh = tid >> 8;
    const float* sp = src + (size_t)(k0 + kh * 64) * ld + n;
    float v[64];
#pragma unroll
    for (int r = 0; r < 64; ++r) v[r] = __builtin_nontemporal_load(sp + (size_t)r * ld);
    __syncthreads();
#pragma unroll
    for (int q = 0; q < 8; ++q) {
        uint4 w;
        w.x = pack2(v[q * 8 + 0], v[q * 8 + 1]); w.y = pack2(v[q * 8 + 2], v[q * 8 + 3]);
        w.z = pack2(v[q * 8 + 4], v[q * 8 + 5]); w.w = pack2(v[q * 8 + 6], v[q * 8 + 7]);
        *(uint4*)(T + n * TLD + kh * 64 + q * 8) = w;
    }
    __syncthreads();
#pragma unroll
    for (int r = 0; r < 8; ++r) {
        const int row = (tid >> 4) + r * 32, c16 = tid & 15;
        *(uint4*)(dst + (size_t)rowmap(row) * K + k0 + c16 * 8) = *(const uint4*)(T + row * TLD + c16 * 8);
    }
}
__device__ __forceinline__ void cvt_dense(const Params& p, char* smem) {
    const int tid = hide_tid();
    {
        bf16_t* WRG = (bf16_t*)(p.ws + OFF_WRG);
        for (int i = blockIdx.x * NTHR + tid; i < 8 * 256 * 64; i += gridDim.x * NTHR) {
            const int k = i & 63, n = (i >> 6) & 255, g = i >> 14;
            const int d = n >> 7, ri = (n >> 6) & 1, j = n & 63;
            WRG[i] = f2bf(p.in[ri ? I_RGWI : I_RGWR][((size_t)(d * 8 + g) * 64 + k) * 64 + j]);
        }
    }
    auto ident = [](int n) { return n; };
    for (int j = blockIdx.x; j < (12 + 4 + 6 + 4) * 8; j += gridDim.x) {
        const int grp = j >> 3, kb = j & 7;
        const float* src; int ld; bf16_t* dst;
        if (grp < 12) { const int c0 = grp * 256; src = p.in[I_ABWIN] + (c0 < 2048 ? c0 : c0 + 16); ld = AB_PROJ; dst = (bf16_t*)(p.ws + OFF_BTIN) + (size_t)c0 * 1024; }
        else if (grp < 16) { const int c0 = (grp - 12) * 256; src = p.in[I_ABWOUT] + c0; ld = 1024; dst = (bf16_t*)(p.ws + OFF_BTOUT0) + (size_t)c0 * 1024; }
        else if (grp < 22) { const int c0 = (grp - 16) * 256; src = p.in[I_ATWQKV] + c0; ld = 1536; dst = (bf16_t*)(p.ws + OFF_BTQKV) + (size_t)c0 * 1024; }
        else { const int c0 = (grp - 22) * 256; src = p.in[I_ATWOUT] + c0; ld = 1024; dst = (bf16_t*)(p.ws + OFF_BTOUT1) + (size_t)c0 * 1024; }
        cvt_job(src, ld, dst, 1024, kb * 128, tid, ident, smem);
    }
}
template <bool DYN, int PART, int JPP = 4>
__device__ __forceinline__ void cvt_moe(const Params& p, int L, char* smem, int maxpull = -1) {
    const int tid = hide_tid();
    constexpr int NJ = PART == 0 ? 32 * 32 : 32 * 16;
    unsigned* head = (unsigned*)(p.ws + OFF_DYNQ) + 2 + L * 2 + PART;
    if (DYN && maxpull == 0) return;
    int npull = 1;
    for (int j0 = DYN ? JPP * pull_item(head, 1, smem + 152 * 1024) : (int)blockIdx.x; j0 < NJ;) {
        const bool more = !DYN || maxpull < 0 || npull < maxpull;
        const unsigned ticket = (DYN && more) ? pull_issue(head, 1) : 0u;
        for (int j = j0; j < (DYN ? j0 + JPP : j0 + 1) && j < NJ; ++j) {
            if (PART == 0) {
                const int e = j >> 5, q = j & 31;
                const int up = q >> 4, grp = (q >> 3) & 1, kb = q & 7;
                const float* src = p.in[up ? I_WUP : I_WGATE] + ((size_t)L * 32 + e) * 1024 * 512 + grp * 256;
                bf16_t* dst = (bf16_t*)(p.ws + OFF_BTGU) + (size_t)e * 1024 * 1024;
                cvt_job(src, 512, dst, 1024, kb * 128, tid, [=](int n) { const int f = grp * 256 + n; return (f >> 7) * 256 + up * 128 + (f & 127); }, smem);
            } else {
                const int e = j >> 4, q2 = j & 15, grp = q2 >> 2, kb = q2 & 3;
                const float* src = p.in[I_WDOWN] + ((size_t)L * 32 + e) * 512 * 1024 + grp * 256;
                bf16_t* dst = (bf16_t*)(p.ws + OFF_BTD) + ((size_t)e * 1024 + grp * 256) * 512;
                cvt_job(src, 1024, dst, 512, kb * 128, tid, [](int n) { return n; }, smem);
            }
        }
        if (DYN && !more) break;
        ++npull;
        j0 = DYN ? JPP * pull_take(ticket, smem + 152 * 1024) : j0 + (int)gridDim.x;
    }
}

__device__ __forceinline__ void ph_ada(const Params& p, char* smem) {
    const int tid = hide_tid();
    float* scond = (float*)smem;
    float* red = scond + 9 * 1024;
    float* MOD = (float*)(p.ws + OFF_MOD);
    for (int i = tid; i < 9 * 1024; i += NTHR) {
        const int r = i >> 10, k = i & 1023;
        const float v = r < 8 ? p.in[I_C][r * 1024 + k] : p.in[I_CCTX][k];
        scond[i] = siluf_(v);
    }
    __syncthreads();
    for (int item = blockIdx.x; item < 192; item += gridDim.x) {
        const int l = item / 96, cg = item % 96;
        const int kq = tid >> 6, cl = tid & 63, col = cg * 64 + cl;
        const float* W = p.in[I_ADAW] + (size_t)l * 1024 * 6144;
        float acc[9];
#pragma unroll
        for (int r = 0; r < 9; ++r) acc[r] = 0.f;
        for (int k0 = kq * 128; k0 < kq * 128 + 128; k0 += 16) {
            float w[16];
#pragma unroll
            for (int u = 0; u < 16; ++u) w[u] = __builtin_nontemporal_load(W + (size_t)(k0 + u) * 6144 + col);
#pragma unroll
            for (int u = 0; u < 16; ++u)
#pragma unroll
                for (int r = 0; r < 9; ++r) acc[r] += scond[r * 1024 + k0 + u] * w[u];
        }
#pragma unroll
        for (int r = 0; r < 9; ++r) red[(kq * 9 + r) * 64 + cl] = acc[r];
        __syncthreads();
        for (int i = tid; i < 9 * 64; i += NTHR) {
            const int r = i >> 6, cc = i & 63;
            float s = 0.f;
#pragma unroll
            for (int q = 0; q < 8; ++q) s += red[(q * 9 + r) * 64 + cc];
            MOD[(size_t)(l * 9 + r) * 6144 + cg * 64 + cc] = s + p.in[I_ADAB][l * 6144 + cg * 64 + cc];
        }
        __syncthreads();
    }
}

#define HS_LD 1028
template <int MODE>
__device__ __forceinline__ void ph_rows(const Params& p, char* smem) {
    const int tid = hide_tid(), lane = tid & 63, wave = tid >> 6;
    constexpr int L = (MODE >= 2) ? 1 : 0;
    constexpr int NROWS = (MODE >= 3) ? NL : NT;
    constexpr bool ROUTER = (MODE == 1 || MODE == 3);
    constexpr bool GATEP = (MODE == 0);
    constexpr bool LOGITS = ROUTER || GATEP;
    constexpr int NTL = GATEP ? 1 : 3;
    float* GATES = (float*)(p.ws + OFF_GATES);
    float* X = (float*)(p.ws + OFF_X);
    bf16_t* H = (bf16_t*)(p.ws + OFF_H);
    const bf16_t* YE = (const bf16_t*)(p.ws + OFF_YE);
    const int* POS = (const int*)(p.ws + OFF_POS);
    const float* MOD = (const float*)(p.ws + OFF_MOD);
    float* hsb = (float*)smem;
    float* part = hsb + 16 * HS_LD;
    float* lgs = part + 8 * 16 * 48;
    unsigned* lcnt = (unsigned*)(lgs + 16 * 48);
    unsigned* gbase = lcnt + 32;
    int* ent = (int*)(gbase + 32);
    constexpr int RT_CAP = 1024;
    int nent = 0;
    if (ROUTER) { if (tid < 32) lcnt[tid] = 0u; __syncthreads(); }
    unsigned* cnt = (unsigned*)(p.ws + OFF_CNT) + L * 32;
    int* LIST = (int*)(p.ws + OFF_LIST);
    float* WSEL = (float*)(p.ws + OFF_WSEL);

    bf16x8 whi[LOGITS ? 4 : 1][NTL], wlo[LOGITS ? 4 : 1][NTL];
    if (LOGITS) {
        const int l15 = lane & 15, lq = lane >> 4;
#pragma unroll
        for (int nt = 0; nt < NTL; ++nt) {
            const int c = nt * 16 + l15;
            const float* wp; int wld;
            if (GATEP) { wp = p.in[I_ABWIN] + 2048 + c; wld = AB_PROJ; }
            else if (c < 4) { wp = p.in[I_WGRP] + (size_t)L * 1024 * 4 + c; wld = 4; }
            else if (c < 36) { wp = p.in[I_WEXP] + (size_t)L * 1024 * 32 + (c - 4); wld = 32; }
            else { wp = p.in[I_WEXP]; wld = 0; }
            const bool zero = (!GATEP && c >= 36);
#pragma unroll
            for (int kk = 0; kk < 4; ++kk) {
                float w8[8];
#pragma unroll
                for (int j = 0; j < 8; ++j) { const float v = wp[(size_t)(wave * 128 + kk * 32 + lq * 8 + j) * wld]; w8[j] = zero ? 0.f : v; }
                unsigned hh[4], ll[4];
#pragma unroll
                for (int q = 0; q < 4; ++q) {
                    hh[q] = pack2(w8[2 * q], w8[2 * q + 1]);
                    ll[q] = pack2(w8[2 * q] - __uint_as_float(hh[q] << 16), w8[2 * q + 1] - __uint_as_float(hh[q] & 0xffff0000u));
                }
                const g8::u32x4 hv = {hh[0], hh[1], hh[2], hh[3]}, lv = {ll[0], ll[1], ll[2], ll[3]};
                whi[kk][nt] = __builtin_bit_cast(bf16x8, hv); wlo[kk][nt] = __builtin_bit_cast(bf16x8, lv);
            }
        }
    }
    typedef unsigned u32x2_t __attribute__((ext_vector_type(2)));
    float v[2][16];
    uint2 ya[2][4], yb[2][4];
    auto load_pair = [&](int base) {
        const int row0 = base + wave * 2;
#pragma unroll
        for (int rr = 0; rr < 2; ++rr) {
            const int row = row0 + rr;
            const float* src = (MODE == 0) ? (row < NL ? p.in[I_X] + (size_t)row * 1024 : p.in[I_CTX] + (size_t)(row - NL) * 1024) : X + (size_t)row * 1024;
#pragma unroll
            for (int i = 0; i < 4; ++i) {
                f32x4 t;
                t = __builtin_nontemporal_load((const f32x4*)(src + i * 256 + lane * 4));
                v[rr][i * 4 + 0] = t[0]; v[rr][i * 4 + 1] = t[1]; v[rr][i * 4 + 2] = t[2]; v[rr][i * 4 + 3] = t[3];
            }
            if (MODE == 2 || MODE == 4) {
                const int pa = POS[2 * row], pb = POS[2 * row + 1];
#pragma unroll
                for (int i = 0; i < 4; ++i) {
                    const int c = i * 256 + lane * 4;
                    const u32x2_t ta = __builtin_nontemporal_load((const u32x2_t*)(YE + (size_t)pa * 1024 + c));
                    const u32x2_t tb = __builtin_nontemporal_load((const u32x2_t*)(YE + (size_t)pb * 1024 + c));
                    ya[rr][i] = make_uint2(ta[0], ta[1]); yb[rr][i] = make_uint2(tb[0], tb[1]);
                }
            }
        }
    };
    if ((int)blockIdx.x * 16 < NROWS) load_pair(blockIdx.x * 16);
    for (int base = blockIdx.x * 16; base < NROWS; base += gridDim.x * 16) {
        const int row0 = base + wave * 2;
        const int mr = row0 < NL ? (row0 >> 11) : 8;
#pragma unroll
        for (int rr = 0; rr < 2; ++rr) {
            const int row = row0 + rr;
            float* hs = hsb + (wave * 2 + rr) * HS_LD;
            if (MODE == 2 || MODE == 4) {
                constexpr int LP = (MODE == 2) ? 0 : 1;
                const float* g2 = MOD + (size_t)(LP * 9 + mr) * 6144 + 5 * 1024;
#pragma unroll
                for (int i = 0; i < 4; ++i) {
                    const int c = i * 256 + lane * 4;
                    const uint2 a = ya[rr][i], b = yb[rr][i];
                    const float4 g = *(const float4*)(g2 + c);
                    v[rr][i * 4 + 0] += g.x * (bf2f((bf16_t)(a.x & 0xffff)) + bf2f((bf16_t)(b.x & 0xffff)));
                    v[rr][i * 4 + 1] += g.y * (bf2f((bf16_t)(a.x >> 16)) + bf2f((bf16_t)(b.x >> 16)));
                    v[rr][i * 4 + 2] += g.z * (bf2f((bf16_t)(a.y & 0xffff)) + bf2f((bf16_t)(b.y & 0xffff)));
                    v[rr][i * 4 + 3] += g.w * (bf2f((bf16_t)(a.y >> 16)) + bf2f((bf16_t)(b.y >> 16)));
                }
            }
            if (MODE == 2) {
#pragma unroll
                for (int i = 0; i < 4; ++i)
                    { const f32x4 xv = {v[rr][i * 4], v[rr][i * 4 + 1], v[rr][i * 4 + 2], v[rr][i * 4 + 3]};
                      __builtin_nontemporal_store(xv, (f32x4*)(X + (size_t)row * 1024 + i * 256 + lane * 4)); }
            }
            float ss = 0.f;
#pragma unroll
            for (int i = 0; i < 16; ++i) ss += v[rr][i] * v[rr][i];
            ss = wave_sum(ss);
            const float rinv = frsq_(ss * (1.f / 1024.f) + EPSF);
            if (MODE == 4) {
#pragma unroll
                for (int i = 0; i < 4; ++i) {
                    const int c = i * 256 + lane * 4;
                    const float4 w = *(const float4*)(p.in[I_FNORM] + c);
                    const f32x4 ov = {v[rr][i * 4] * rinv * w.x, v[rr][i * 4 + 1] * rinv * w.y, v[rr][i * 4 + 2] * rinv * w.z, v[rr][i * 4 + 3] * rinv * w.w};
                    __builtin_nontemporal_store(ov, (f32x4*)(p.out + (size_t)row * 1024 + c));
                }
            } else {
                constexpr int SH = (MODE == 0 || MODE == 2) ? 0 : 3;
                const float* gain = p.in[(MODE == 0 || MODE == 2) ? I_NORM1 : I_NORM2] + L * 1024;
                const float* sh = MOD + (size_t)(L * 9 + mr) * 6144 + SH * 1024;
                const float* sc = sh + 1024;
#pragma unroll
                for (int i = 0; i < 4; ++i) {
                    const int c = i * 256 + lane * 4;
                    const float4 w = *(const float4*)(gain + c);
                    const float4 s1 = *(const float4*)(sc + c);
                    const float4 s0 = *(const float4*)(sh + c);
                    float h0 = v[rr][i * 4 + 0] * rinv * w.x * (1.f + s1.x) + s0.x;
                    float h1 = v[rr][i * 4 + 1] * rinv * w.y * (1.f + s1.y) + s0.y;
                    float h2 = v[rr][i * 4 + 2] * rinv * w.z * (1.f + s1.z) + s0.z;
                    float h3 = v[rr][i * 4 + 3] * rinv * w.w * (1.f + s1.w) + s0.w;
                    uint2 o; o.x = pack2(h0, h1); o.y = pack2(h2, h3);
                    *(uint2*)(H + (size_t)row * 1024 + c) = o;
                    if (LOGITS) *(float4*)(hs + c) = make_float4(h0, h1, h2, h3);
                }
            }
        }
        if (base + (int)gridDim.x * 16 < NROWS) load_pair(base + gridDim.x * 16);
        if (LOGITS) {
            __syncthreads();
            const int l15 = lane & 15, lq = lane >> 4;
            f32x4 acc[NTL];
#pragma unroll
            for (int nt = 0; nt < NTL; ++nt) acc[nt] = (f32x4){0.f, 0.f, 0.f, 0.f};
            const float* arow = hsb + l15 * HS_LD + wave * 128 + lq * 8;
#pragma unroll
            for (int kk = 0; kk < 4; ++kk) {
                const float4 a0 = *(const float4*)(arow + kk * 32), a1 = *(const float4*)(arow + kk * 32 + 4);
                const float a8[8] = {a0.x, a0.y, a0.z, a0.w, a1.x, a1.y, a1.z, a1.w};
                unsigned hh[4], ll[4];
#pragma unroll
                for (int q = 0; q < 4; ++q) {
                    hh[q] = pack2(a8[2 * q], a8[2 * q + 1]);
                    ll[q] = pack2(a8[2 * q] - __uint_as_float(hh[q] << 16), a8[2 * q + 1] - __uint_as_float(hh[q] & 0xffff0000u));
                }
                const g8::u32x4 hv = {hh[0], hh[1], hh[2], hh[3]}, lv = {ll[0], ll[1], ll[2], ll[3]};
                const bf16x8 ahi = __builtin_bit_cast(bf16x8, hv), alo = __builtin_bit_cast(bf16x8, lv);
#pragma unroll
                for (int nt = 0; nt < NTL; ++nt) {
                    acc[nt] = __builtin_amdgcn_mfma_f32_16x16x32_bf16(ahi, whi[kk][nt], acc[nt], 0, 0, 0);
                    acc[nt] = __builtin_amdgcn_mfma_f32_16x16x32_bf16(ahi, wlo[kk][nt], acc[nt], 0, 0, 0);
                    acc[nt] = __builtin_amdgcn_mfma_f32_16x16x32_bf16(alo, whi[kk][nt], acc[nt], 0, 0, 0);
                }
            }
#pragma unroll
            for (int nt = 0; nt < NTL; ++nt)
#pragma unroll
                for (int j = 0; j < 4; ++j) part[(wave * 16 + lq * 4 + j) * 48 + nt * 16 + l15] = acc[nt][j];
            __syncthreads();
            for (int t = tid; t < 16 * NTL * 16; t += NTHR) {
                const int r = t / (NTL * 16), c = t % (NTL * 16);
                float sacc = 0.f;
#pragma unroll
                for (int w = 0; w < 8; ++w) sacc += part[(w * 16 + r) * 48 + c];
                if (GATEP) GATES[(size_t)(base + r) * 16 + c] = sacc;
                else {
                    float bias = 0.f;
                    if (c < 4) bias = p.in[I_BGRP][L * 4 + c]; else if (c < 36) bias = p.in[I_BEXP][L * 32 + c - 4];
                    lgs[r * 48 + c] = sacc + bias;
                }
            }
            if (ROUTER) {
                __syncthreads();
                if (tid < 16) {
                    const int row = base + tid;
                    const float* lg = lgs + tid * 48;
                    int gi = 0; float gm = lg[0];
#pragma unroll
                    for (int j = 1; j < 4; ++j) if (lg[j] > gm) { gm = lg[j]; gi = j; }
                    float gs = 0.f;
#pragma unroll
                    for (int j = 0; j < 4; ++j) gs += __expf(lg[j] - gm);
                    const float gw = 1.f / gs;
                    const float* el = lg + 4 + gi * 8;
                    int e0 = 0; float v0 = el[0];
#pragma unroll
                    for (int j = 1; j < 8; ++j) if (el[j] > v0) { v0 = el[j]; e0 = j; }
                    int e1 = -1; float v1 = -3.0e38f;
#pragma unroll
                    for (int j = 0; j < 8; ++j) if (j != e0 && el[j] > v1) { v1 = el[j]; e1 = j; }
                    const float t = __expf(v1 - v0);
                    const float w0 = gw / (1.f + t), w1 = gw * t / (1.f + t);
                    const int x0 = gi * 8 + e0, x1 = gi * 8 + e1;
                    const unsigned s0 = atomicAdd(&lcnt[x0], 1u);
                    const unsigned s1 = atomicAdd(&lcnt[x1], 1u);
                    int* en = ent + (nent + tid * 2) * 3;
                    en[0] = x0; en[1] = 2 * row; en[2] = (int)s0;
                    en[3] = x1; en[4] = 2 * row + 1; en[5] = (int)s1;
                    WSEL[2 * row] = w0;
                    WSEL[2 * row + 1] = w1;
                }
                nent += 32;
            }
            __syncthreads();
            if (ROUTER && nent + 32 > RT_CAP) {
                if (tid < 32) { gbase[tid] = __hip_atomic_fetch_add(&cnt[tid], lcnt[tid], __ATOMIC_RELAXED, __HIP_MEMORY_SCOPE_AGENT); }
                __syncthreads();
                for (int n = tid; n < nent; n += NTHR) { const int* en = ent + n * 3; LIST[(size_t)en[0] * NT + gbase[en[0]] + en[2]] = en[1]; }
                __syncthreads();
                if (tid < 32) lcnt[tid] = 0u;
                nent = 0;
                __syncthreads();
            }
        }
    }
    if (ROUTER) {
        __syncthreads();
        if (tid < 32) { gbase[tid] = __hip_atomic_fetch_add(&cnt[tid], lcnt[tid], __ATOMIC_RELAXED, __HIP_MEMORY_SCOPE_AGENT); }
        __syncthreads();
        for (int n = tid; n < nent; n += NTHR) { const int* en = ent + n * 3; LIST[(size_t)en[0] * NT + gbase[en[0]] + en[2]] = en[1]; }
    }
}

__device__ __forceinline__ void ph_gemm_in(const Params& p, LAS unsigned char* lds) {
    g8::DenseSched S{p.ws + OFF_H, p.ws + OFF_BTIN, NT / 256, ZW / 256, 1024, (int)gridDim.x, (int)blockIdx.x};
    g8::EpiBf16 E{(bf16_t*)(p.ws + OFF_Z), ZW, nullptr, 0};
    g8::gemm_phase<false, 0>(lds, 1024, S, E);
}
template <int L>
__device__ __forceinline__ void ph_gemm_out(const Params& p, LAS unsigned char* lds) {
    g8::DenseSched S{p.ws + OFF_H, p.ws + (L == 0 ? OFF_BTOUT0 : OFF_BTOUT1), (L == 0 ? NT : NL) / 256, 4, 1024, (int)gridDim.x, (int)blockIdx.x};
    g8::EpiResid E{(float*)(p.ws + OFF_X), (const float*)(p.ws + OFF_MOD) + (size_t)(L * 9) * 6144 + 2 * 1024,
                   L == 0 ? p.in[I_X] : (const float*)(p.ws + OFF_X), L == 0 ? p.in[I_CTX] : (const float*)(p.ws + OFF_X) + (size_t)NL * 1024};
    g8::gemm_phase<false, 0>(lds, 1024, S, E);
}
__device__ __forceinline__ void ph_gemm_qkv(const Params& p, LAS unsigned char* lds) {
    g8::QkvSched S{p.ws + OFF_H, p.ws + OFF_BTQKV, (int)gridDim.x, (int)blockIdx.x};
    g8::EpiBf16 E{(bf16_t*)(p.ws + OFF_ZQ), 1536, (bf16_t*)(p.ws + OFF_ZC), 512};
    g8::gemm_phase<false, 0>(lds, 1024, S, E);
}

__device__ __forceinline__ void moe_prefix(const Params& p, int L, LAS int* pre) {
    const unsigned* cnt = (const unsigned*)(p.ws + OFF_CNT) + L * 32;
    const int tid = hide_tid();
    __syncthreads();
    if (tid < 64) {
        const int lane = tid;
        int t = lane < 32 ? (((int)cnt[lane] + 255) >> 8) : 0;
        int incl = t;
#pragma unroll
        for (int d = 1; d < 32; d <<= 1) { const int o = __shfl_up(incl, d, 64); if (lane >= d) incl += o; }
        if (lane < 32) pre[lane] = incl - t;
        if (lane == 31) pre[32] = incl;
    }
    __syncthreads();
}
template <bool FILL_ROWS, class Sched>
__device__ __forceinline__ void moe_rowtab(const Sched& S, LAS unsigned char* lds, const float* WSEL, int* POS) {
    LAS int* rowtab = (LAS int*)(lds + LDS_ROWTAB);
    LAS float* wtab = (LAS float*)(lds + LDS_ROWTAB + MOE_MAXU * 1024);
    const int tid = hide_tid();
    g8::Unit u;
    LAS int* desc = (LAS int*)(lds + LDS_PRE + 256);
    for (int ui = 0; ui < MOE_MAXU && S.next(ui, u); ++ui) {
        if (tid == 0) { desc[ui * 4 + 0] = u.aux; desc[ui * 4 + 1] = (int)(u.lst - ((const int*)(S.ws + OFF_LIST) + (size_t)u.aux * NT)); desc[ui * 4 + 2] = u.mv; }
        if (FILL_ROWS && tid < 256) {
            const int r = u.lst[tid < u.mv ? tid : u.mv - 1];
            rowtab[ui * 256 + tid] = r;
            if (WSEL) wtab[ui * 256 + tid] = WSEL[r];
            if (POS && u.pn == 0 && tid < u.mv) POS[r] = u.pm * 256 + tid;
        }
    }
    __syncthreads();
}
__device__ __forceinline__ void ph_moe_up(const Params& p, int L, LAS unsigned char* lds) {
    LAS int* pre = (LAS int*)(lds + LDS_PRE);
    moe_prefix(p, L, pre);
    g8::MoeSched<true> S0{p.ws, L, pre, (int)gridDim.x, (int)blockIdx.x, nullptr};
    moe_rowtab<true>(S0, lds, (const float*)(p.ws + OFF_WSEL), (int*)(p.ws + OFF_POS));
    g8::MoeSched<true> S{p.ws, L, pre, (int)gridDim.x, (int)blockIdx.x, (const LAS int*)(lds + LDS_PRE + 256)};
    g8::EpiMoeUp E{(bf16_t*)(p.ws + OFF_ACT), (const float*)(p.ws + OFF_WSEL), (const LAS int*)(lds + LDS_ROWTAB)};
    g8::gemm_phase<true, 1>(lds, 1024, S, E);
}
__device__ __forceinline__ int moe_units_short(const LAS int* pre) {
    const int total = pre[32] << 2, G = gridDim.x, c = blockIdx.x;
    const int xcd = c & 7, rank = c >> 3, nrank = (G + 7 - xcd) >> 3;
    const int x0 = (int)(((long)total * xcd) >> 3), x1 = (int)(((long)total * (xcd + 1)) >> 3);
    const int len = x1 - x0, mine = len > rank ? (len - rank + nrank - 1) / nrank : 0;
    const int mx = (((total + 7) >> 3) + (G >> 3) - 1) / (G >> 3);
    return mx - mine > 0 ? mx - mine : 0;
}
__device__ __forceinline__ void ph_moe_down(const Params& p, int L, LAS unsigned char* lds) {
    LAS int* pre = (LAS int*)(lds + LDS_PRE);
    moe_prefix(p, L, pre);
    g8::MoeSched<false> S0{p.ws, L, pre, (int)gridDim.x, (int)blockIdx.x, nullptr};
    moe_rowtab<false>(S0, lds, nullptr, nullptr);
    g8::MoeSched<false> S{p.ws, L, pre, (int)gridDim.x, (int)blockIdx.x, (const LAS int*)(lds + LDS_PRE + 256)};
    g8::EpiMoeDown E{(bf16_t*)(p.ws + OFF_YE)};
    g8::gemm_phase<false, 0>(lds, 512, S, E);
}

__device__ __forceinline__ int unit_row0(int b, int cidx) { return cidx < 4 ? (NL + b * CTXL + cidx * 64) : (b * SEQ + (cidx - 4) * 64); }
__device__ __forceinline__ int tile_row0(int tl) { return tl < 256 ? tl * 64 : NL + (tl - 256) * 64; }

__device__ __forceinline__ void lru_tile(const Params& p, int tl, char* smem) {
    const int tid = hide_tid(), lane = tid & 63, wave = tid >> 6, l15 = lane & 15, lq = lane >> 4;
    const bf16_t* Z = (const bf16_t*)(p.ws + OFF_Z);
    const bf16_t* WRG = (const bf16_t*)(p.ws + OFF_WRG);
    bf16_t* HLOC = (bf16_t*)(p.ws + OFF_HLOC);
    bf16_t* ACUM = (bf16_t*)(p.ws + OFF_ACUM);
    float* LTOT = (float*)(p.ws + OFF_LTOT);
    constexpr int XLD = 520;
    bf16_t* XC = (bf16_t*)smem;
    float* SEG = (float*)(smem + 64 * XLD * 2);
    const int row0 = tile_row0(tl);
    int sbeg, send;
    if (row0 < NL) { sbeg = (row0 >> 11) << 11; send = sbeg + SEQ; }
    else { sbeg = NL + (((row0 - NL) >> 8) << 8); send = sbeg + CTXL; }
    __syncthreads();
    {
        const int c = tid;
        const float w0 = p.in[I_CONVX][c], w1 = p.in[I_CONVX][512 + c], w2 = p.in[I_CONVX][1024 + c], w3 = p.in[I_CONVX][1536 + c];
        unsigned mlo = (row0 > sbeg) ? 0xffffu : 0u, mhi = (row0 + 64 < send) ? 0xffffu : 0u;
        asm volatile("" : "+v"(mlo), "+v"(mhi));
        const bf16_t* zc = Z + 2048 + c;
        const int rlo = row0 > sbeg ? row0 - 2 : row0, rhi = row0 + 64 < send ? row0 + 64 : row0 + 63;
        float zm2 = bf2f((bf16_t)(zc[(size_t)rlo * ZW] & mlo)), zm1 = bf2f((bf16_t)(zc[(size_t)(rlo + 1) * ZW] & mlo)), z0 = bf2f(zc[(size_t)row0 * ZW]);
#pragma unroll
        for (int t0 = 0; t0 < 64; t0 += 32) {
            bf16_t nz[32];
#pragma unroll
            for (int q = 0; q < 32; ++q) {
                const int tk = t0 + q;
                nz[q] = tk == 63 ? (bf16_t)(zc[(size_t)rhi * ZW] & mhi) : zc[(size_t)(row0 + tk + 1) * ZW];
            }
#pragma unroll
            for (int q = 0; q < 32; ++q) {
                const float zp1 = bf2f(nz[q]);
                XC[(t0 + q) * XLD + c] = f2bf(zm2 * w0 + zm1 * w1 + z0 * w2 + zp1 * w3);
                zm2 = zm1; zm1 = z0; z0 = zp1;
            }
        }
    }
    __syncthreads();
    TSACC(0);
    const int g = wave;
    bf16x8 af[4][2];
#pragma unroll
    for (int mi = 0; mi < 4; ++mi)
#pragma unroll
        for (int kk = 0; kk < 2; ++kk) af[mi][kk] = *(const bf16x8*)(XC + (mi * 16 + l15) * XLD + g * 64 + kk * 32 + lq * 8);
#pragma unroll
    for (int d = 0; d < 2; ++d) {
        bf16x8 nwr[2], nwi[2]; float nbr, nbi, nlam;
        auto fetch_grp = [&](int ni_) {
            const bf16_t* wr_ = WRG + ((size_t)(g * 256 + d * 128 + ni_ * 16 + l15)) * 64 + lq * 8;
            nwr[0] = *(const bf16x8*)(wr_); nwr[1] = *(const bf16x8*)(wr_ + 32);
            nwi[0] = *(const bf16x8*)(wr_ + 64 * 64); nwi[1] = *(const bf16x8*)(wr_ + 64 * 64 + 32);
            const int c_ = d * 512 + g * 64 + ni_ * 16 + l15;
            nbr = p.in[I_RGBR][c_]; nbi = p.in[I_RGBI][c_]; nlam = p.in[I_RGLAM][c_];
        };
        fetch_grp(0);
#pragma unroll 1
        for (int ni = 0; ni < 4; ++ni) {
            f32x4 accr[4], acci[4];
#pragma unroll
            for (int mi = 0; mi < 4; ++mi) { accr[mi] = (f32x4){0.f, 0.f, 0.f, 0.f}; acci[mi] = (f32x4){0.f, 0.f, 0.f, 0.f}; }
            const bf16x8 cwr0 = nwr[0], cwr1 = nwr[1], cwi0 = nwi[0], cwi1 = nwi[1];
            const float br = nbr, bi = nbi, clam = nlam;
            if (ni + 1 < 4) fetch_grp(ni + 1);
#pragma unroll
            for (int mi = 0; mi < 4; ++mi) {
                accr[mi] = __builtin_amdgcn_mfma_f32_16x16x32_bf16(af[mi][0], cwr0, accr[mi], 0, 0, 0);
                acci[mi] = __builtin_amdgcn_mfma_f32_16x16x32_bf16(af[mi][0], cwi0, acci[mi], 0, 0, 0);
                accr[mi] = __builtin_amdgcn_mfma_f32_16x16x32_bf16(af[mi][1], cwr1, accr[mi], 0, 0, 0);
                acci[mi] = __builtin_amdgcn_mfma_f32_16x16x32_bf16(af[mi][1], cwi1, acci[mi], 0, 0, 0);
            }
            const int c = g * 64 + ni * 16 + l15;
            const float spl = softplusf_(-clam);
            typedef float f32x2 __attribute__((ext_vector_type(2)));
            float A[4][4], Bv[4][4];
#pragma unroll
            for (int mi = 0; mi < 4; ++mi)
#pragma unroll
                for (int j = 0; j < 4; j += 2) {
                    const f32x2 xr = (f32x2){accr[mi][j], accr[mi][j + 1]}, xi = (f32x2){acci[mi][j], acci[mi][j + 1]};
                    f32x2 tr = (xr + br) * -1.4426950408889634f, ti = (xi + bi) * -1.4426950408889634f;
                    tr = __builtin_elementwise_min(tr, (f32x2){60.f, 60.f}); ti = __builtin_elementwise_min(ti, (f32x2){60.f, 60.f});
                    f32x2 er, ei;
                    er.x = __builtin_amdgcn_exp2f(tr.x); er.y = __builtin_amdgcn_exp2f(tr.y);
                    ei.x = __builtin_amdgcn_exp2f(ti.x); ei.y = __builtin_amdgcn_exp2f(ti.y);
                    const f32x2 dr = er + 1.f, di = ei + 1.f, dd = dr * di;
                    f32x2 inv; inv.x = frcp_(dd.x); inv.y = frcp_(dd.y);
                    const f32x2 r = di * inv, ig = dr * inv;
                    const f32x2 la = r * (-8.0f * spl);
                    const f32x2 la2 = la * 1.4426950408889634f;
                    f32x2 a; a.x = __builtin_amdgcn_exp2f(la2.x); a.y = __builtin_amdgcn_exp2f(la2.y);
                    f32x2 xc;
                    xc.x = bf2f(XC[(mi * 16 + lq * 4 + j) * XLD + c]); xc.y = bf2f(XC[(mi * 16 + lq * 4 + j + 1) * XLD + c]);
                    const f32x2 x2 = la * 2.f;
                    f32x2 q = x2 * (1.f / 120.f) + 1.f / 24.f;
                    q = q * x2 + 1.f / 6.f; q = q * x2 + 0.5f; q = q * x2 + 1.f;
                    const f32x2 om_s = -x2 * q, om_d = 1.f - a * a;
                    f32x2 om; om.x = x2.x < -0.25f ? om_d.x : om_s.x; om.y = x2.y < -0.25f ? om_d.y : om_s.y;
                    f32x2 sq; sq.x = __builtin_amdgcn_sqrtf(om.x); sq.y = __builtin_amdgcn_sqrtf(om.y);
                    const f32x2 bb = sq * ig * xc;
                    A[mi][j] = a.x; A[mi][j + 1] = a.y;
                    Bv[mi][j] = bb.x; Bv[mi][j + 1] = bb.y;
                }
            float P[4][4], Hh[4][4];
#pragma unroll
            for (int mi = 0; mi < 4; ++mi) {
                if (d == 0) {
                    P[mi][0] = A[mi][0]; Hh[mi][0] = Bv[mi][0];
#pragma unroll
                    for (int j = 1; j < 4; ++j) { P[mi][j] = A[mi][j] * P[mi][j - 1]; Hh[mi][j] = A[mi][j] * Hh[mi][j - 1] + Bv[mi][j]; }
                } else {
                    P[mi][3] = A[mi][3]; Hh[mi][3] = Bv[mi][3];
#pragma unroll
                    for (int j = 2; j >= 0; --j) { P[mi][j] = A[mi][j] * P[mi][j + 1]; Hh[mi][j] = A[mi][j] * Hh[mi][j + 1] + Bv[mi][j]; }
                }
            }
            {
                float* seg = SEG + wave * 512 + l15 * 32;
#pragma unroll
                for (int mi = 0; mi < 4; ++mi)
                    *(float2*)(seg + (mi * 4 + lq) * 2) = make_float2(d == 0 ? P[mi][3] : P[mi][0], d == 0 ? Hh[mi][3] : Hh[mi][0]);
                __builtin_amdgcn_wave_barrier();
                float sg[32];
#pragma unroll
                for (int q = 0; q < 8; ++q) { const float4 t = *(const float4*)(seg + q * 4); sg[q * 4] = t.x; sg[q * 4 + 1] = t.y; sg[q * 4 + 2] = t.z; sg[q * 4 + 3] = t.w; }
                __builtin_amdgcn_wave_barrier();
                float cP = 1.f, cH = 0.f, bP[4], bH[4];
#pragma unroll
                for (int mi = 0; mi < 4; ++mi) { bP[mi] = 1.f; bH[mi] = 0.f; }
#pragma unroll
                for (int st = 0; st < 16; ++st) {
                    const int sidx = d == 0 ? st : 15 - st;
                    const int smi = sidx >> 2, sq = sidx & 3;
                    if (sq == lq) { bP[smi] = cP; bH[smi] = cH; }
                    const float sP = sg[sidx * 2], sH = sg[sidx * 2 + 1];
                    cH = sP * cH + sH; cP = sP * cP;
                }
                {
                    bf16_t* hb = HLOC + ((size_t)d * NT + row0 + lq * 4) * 512 + c;
                    bf16_t* ab = ACUM + ((size_t)d * NT + row0 + lq * 4) * 512 + c;
#pragma unroll
                    for (int mi = 0; mi < 4; ++mi) {
                        bf16_t* hm = hb + mi * 16 * 512; bf16_t* am = ab + mi * 16 * 512;
                        asm volatile("" : "+v"(hm), "+v"(am));
#pragma unroll
                        for (int j = 0; j < 4; ++j) {
                            const float hval = P[mi][j] * bH[mi] + Hh[mi][j];
                            const float aval = P[mi][j] * bP[mi];
                            hm[j * 512] = f2bf(hval); am[j * 512] = f2bf(aval);
                        }
                    }
                }
                if (lq == 0) {
                    float* o = LTOT + (((size_t)d * 288 + tl) * 512 + c) * 2;
                    o[0] = cP; o[1] = cH;
                }
            }
        }
    }
}

__device__ __forceinline__ void delta_unit2(const Params& p, int uA, int uB, char* smem) {
    const int tid = hide_tid(), lane = tid & 63, wave = tid >> 6, l15 = lane & 15, lq = lane >> 4;
    const int half = wave >> 2, wv = wave & 3;
    const int u = half ? uB : uA;
    const bool valid = u < 1152;
    const int uu = valid ? u : 0;
    const int cidx = uu % 36, bh = uu / 36, h = bh & 3, b = bh >> 2;
    const int row0 = unit_row0(b, cidx);
    const int sbeg = cidx < 4 ? NL + b * CTXL : b * SEQ, send = cidx < 4 ? sbeg + CTXL : sbeg + SEQ;
    const bf16_t* Z = (const bf16_t*)(p.ws + OFF_Z);
    const float* GATES = (const float*)(p.ws + OFF_GATES);
    bf16_t* QG = (bf16_t*)(p.ws + OFF_QG) + (size_t)uu * 64 * 128;
    bf16_t* KG = (bf16_t*)(p.ws + OFF_KG) + (size_t)uu * 64 * 128;
    bf16_t* VG = (bf16_t*)(p.ws + OFF_VG) + (size_t)uu * 64 * 128;
    bf16_t* KTG = (bf16_t*)(p.ws + OFF_KTG) + (size_t)uu * 128 * 64;
    bf16_t* TT = (bf16_t*)(p.ws + OFF_TT) + (size_t)uu * 2 * 4096;
    bf16_t* ATT = (bf16_t*)(p.ws + OFF_ATT) + (size_t)uu * 2 * 4096;
    float* VEC = (float*)(p.ws + OFF_VEC) + (size_t)uu * 2 * 320;
    constexpr int QLD = 136, LLD = 68, HALFB = 2 * 64 * QLD * 2 + 2 * 64 * LLD * 4 + 1024;
    bf16_t* Qs = (bf16_t*)(smem + half * HALFB);
    bf16_t* Ks = Qs + 64 * QLD;
    float* Lm = (float*)(Ks + 64 * QLD);
    float* gcs = Lm + 2 * 64 * LLD;
    float* bts = gcs + 128;
    __syncthreads();
    if (valid) {
        const int t0 = wv * 16, rb = row0 + t0;
        unsigned mlo = (rb > sbeg) ? 0xffffffffu : 0u, mhi = (rb + 16 < send) ? 0xffffffffu : 0u;
        asm volatile("" : "+v"(mlo), "+v"(mhi));
        const int rlo = rb > sbeg ? rb - 2 : rb, rhi = rb + 16 < send ? rb + 16 : rb + 15;
        unsigned zw[3][19];
#pragma unroll
        for (int part = 0; part < 3; ++part) {
            const bf16_t* zc = Z + part * 512 + h * 128 + lane * 2;
            zw[part][0] = *(const unsigned*)(zc + (size_t)rlo * ZW) & mlo; zw[part][1] = *(const unsigned*)(zc + (size_t)(rlo + 1) * ZW) & mlo;
#pragma unroll
            for (int q = 0; q < 16; ++q) zw[part][2 + q] = *(const unsigned*)(zc + (size_t)(rb + q) * ZW);
            zw[part][18] = *(const unsigned*)(zc + (size_t)rhi * ZW) & mhi;
        }
#pragma unroll
        for (int part = 0; part < 3; ++part) {
            const float* cw = p.in[I_CONVQKV] + part * 512 + h * 128 + lane * 2;
            const float w00 = cw[0], w01 = cw[1], w10 = cw[1536], w11 = cw[1537], w20 = cw[3072], w21 = cw[3073], w30 = cw[4608], w31 = cw[4609];
#pragma unroll
            for (int tk = 0; tk < 16; ++tk) {
                const unsigned zm2 = zw[part][tk], zm1 = zw[part][tk + 1], z0 = zw[part][tk + 2], zp1 = zw[part][tk + 3];
                float a0 = bf2f((bf16_t)(zm2 & 0xffff)) * w00 + bf2f((bf16_t)(zm1 & 0xffff)) * w10 + bf2f((bf16_t)(z0 & 0xffff)) * w20 + bf2f((bf16_t)(zp1 & 0xffff)) * w30;
                float a1 = bf2f((bf16_t)(zm2 >> 16)) * w01 + bf2f((bf16_t)(zm1 >> 16)) * w11 + bf2f((bf16_t)(z0 >> 16)) * w21 + bf2f((bf16_t)(zp1 >> 16)) * w31;
                a0 = siluf_(a0); a1 = siluf_(a1);
                const int tok = t0 + tk;
                if (part < 2) {
                    const float ss = wave_sum(a0 * a0 + a1 * a1);
                    float sc = frsq_(ss + EPSF);
                    if (part == 0) sc *= 0.08838834764831845f;
                    a0 *= sc; a1 *= sc;
                    const unsigned pk = pack2(a0, a1);
                    *(unsigned*)((part == 0 ? Qs : Ks) + tok * QLD + lane * 2) = pk;
                    *(unsigned*)((part == 0 ? QG : KG) + tok * 128 + lane * 2) = pk;
                } else {
                    *(unsigned*)(VG + tok * 128 + lane * 2) = pack2(a0, a1);
                }
            }
        }
        if (wv < 2) {
            const int d = wv;
            const int row = row0 + lane;
            const float gv = GATES[(size_t)row * 16 + d * 8 + h], bv = GATES[(size_t)row * 16 + d * 8 + 4 + h];
            const float gdec = -__expf(p.in[I_ALOG][d * 4 + h]) * softplusf_(gv + p.in[I_DTB][d * 4 + h]);
            const float beta = sigmoidf_(bv);
            float gc = gdec;
#pragma unroll
            for (int dist = 1; dist < 64; dist <<= 1) {
                const int src = d == 0 ? lane - dist : lane + dist;
                const float o = __shfl(gc, src & 63, 64);
                if (d == 0 ? (lane >= dist) : (lane + dist < 64)) gc += o;
            }
            const float gl = __shfl(gc, d == 0 ? 63 : 0, 64);
            gcs[d * 64 + lane] = gc; bts[d * 64 + lane] = beta;
            const float egc = __expf(gc);
            VEC[d * 320 + 0 * 64 + lane] = beta * egc;
            VEC[d * 320 + 1 * 64 + lane] = egc;
            VEC[d * 320 + 2 * 64 + lane] = __expf(gl - gc);
            VEC[d * 320 + 3 * 64 + lane] = beta;
            VEC[d * 320 + 4 * 64 + lane] = __expf(gl);
        }
    }
    __syncthreads();
    if (valid) {
        const int mi = wv;
#pragma unroll 1
        for (int ni0 = 0; ni0 < 4; ni0 += 2) {
            f32x4 kk_acc[2], qk_acc[2];
#pragma unroll
            for (int n = 0; n < 2; ++n) { kk_acc[n] = (f32x4){0.f, 0.f, 0.f, 0.f}; qk_acc[n] = (f32x4){0.f, 0.f, 0.f, 0.f}; }
#pragma unroll
            for (int kk = 0; kk < 4; ++kk) {
                const bf16x8 ak = *(const bf16x8*)(Ks + (mi * 16 + l15) * QLD + kk * 32 + lq * 8);
                const bf16x8 aq = *(const bf16x8*)(Qs + (mi * 16 + l15) * QLD + kk * 32 + lq * 8);
#pragma unroll
                for (int n = 0; n < 2; ++n) {
                    const bf16x8 bk = *(const bf16x8*)(Ks + ((ni0 + n) * 16 + l15) * QLD + kk * 32 + lq * 8);
                    kk_acc[n] = __builtin_amdgcn_mfma_f32_16x16x32_bf16(ak, bk, kk_acc[n], 0, 0, 0);
                    qk_acc[n] = __builtin_amdgcn_mfma_f32_16x16x32_bf16(aq, bk, qk_acc[n], 0, 0, 0);
                }
            }
#pragma unroll
            for (int n = 0; n < 2; ++n)
#pragma unroll
                for (int j = 0; j < 4; ++j) {
                    const int i = mi * 16 + lq * 4 + j, jc = (ni0 + n) * 16 + l15;
                    {
                        const float e = (i >= jc) ? __expf(gcs[i] - gcs[jc]) : 0.f;
                        if (i > jc) Lm[i * LLD + jc] = bts[i] * kk_acc[n][j] * e;
                        ATT[i * 64 + jc] = f2bf(qk_acc[n][j] * e);
                    }
                    {
                        const float e = (i <= jc) ? __expf(gcs[64 + i] - gcs[64 + jc]) : 0.f;
                        if (i < jc) Lm[64 * LLD + (63 - i) * LLD + (63 - jc)] = bts[64 + i] * kk_acc[n][j] * e;
                        ATT[4096 + i * 64 + jc] = f2bf(qk_acc[n][j] * e);
                    }
                }
        }
    }
    __syncthreads();
    if (valid) {
        if (wv < 2) {
            const int d = wv;
            const float* Lr = Lm + d * 64 * LLD;
            float T[64];
            float4 Lb[2][16];
#pragma unroll
            for (int q = 0; q < 1; ++q) Lb[1][q] = *(const float4*)(Lr + 1 * LLD + 4 * q);
            T[0] = (lane == 0) ? 1.f : 0.f;
#pragma unroll
            for (int i = 1; i < 64; ++i) {
                if (i + 1 < 64) {
#pragma unroll
                    for (int q = 0; q < (i + 1 + 3) / 4; ++q) Lb[(i + 1) & 1][q] = *(const float4*)(Lr + (i + 1) * LLD + 4 * q);
                }
                float a0 = (i == lane) ? 1.f : 0.f, a1 = 0.f, a2 = 0.f, a3 = 0.f;
#pragma unroll
                for (int q = 0; q < (i + 3) / 4; ++q) {
                    const float4 l4 = Lb[i & 1][q];
                    if (4 * q + 0 < i) a0 -= l4.x * T[4 * q + 0];
                    if (4 * q + 1 < i) a1 -= l4.y * T[4 * q + 1];
                    if (4 * q + 2 < i) a2 -= l4.z * T[4 * q + 2];
                    if (4 * q + 3 < i) a3 -= l4.w * T[4 * q + 3];
                }
                T[i] = (a0 + a1) + (a2 + a3);
            }
#pragma unroll
            for (int i = 0; i < 64; ++i) {
                const int ri = d == 0 ? i : 63 - i, rc = d == 0 ? lane : 63 - lane;
                TT[d * 4096 + ri * 64 + rc] = f2bf(T[i]);
            }
        } else {
            for (int q = (wv - 2) * 64 + lane; q < 1024; q += 128) {
                const int dk = q & 127, tg = q >> 7;
                unsigned short e[8];
#pragma unroll
                for (int x = 0; x < 8; ++x) e[x] = Ks[(tg * 8 + x) * QLD + dk];
                uint4 w; w.x = e[0] | ((unsigned)e[1] << 16); w.y = e[2] | ((unsigned)e[3] << 16); w.z = e[4] | ((unsigned)e[5] << 16); w.w = e[6] | ((unsigned)e[7] << 16);
                *(uint4*)(KTG + dk * 64 + tg * 8) = w;
            }
        }
    }
}

__device__ __forceinline__ void ph_prep(const Params& p, char* smem, int rep = 0) {
    unsigned* headL = (unsigned*)(p.ws + OFF_DYNQ) + 8 + (rep ? 2 : 0);
    unsigned* headD = headL + 1;
    for (int item = blockIdx.x; item < 288;) {
        const unsigned ticket = pull_issue(headL, 1);
        TSMARK();
        lru_tile(p, item, smem);
        if (TS_PH >= 100) { __syncthreads(); TSACC(1); }
        item = (int)gridDim.x + pull_take(ticket, smem + 152 * 1024);
    }
    for (int pi = blockIdx.x; pi < 576;) {
        const unsigned ticket = pull_issue(headD, 1);
        TSMARK();
        delta_unit2(p, 2 * pi, 2 * pi + 1, smem);
        if (TS_PH >= 100) { __syncthreads(); TSACC(2); }
        pi = (int)gridDim.x + pull_take(ticket, smem + 152 * 1024);
        if (TS_PH >= 100) { TSACC(3); }
    }
}

__device__ __forceinline__ void lru_carry(const Params& p, int li) {
    const int idx = li * NTHR + hide_tid();
    const int c = idx & 511, bd = idx >> 9, b = bd >> 1, d = bd & 1;
    const float* LTOT = (const float*)(p.ws + OFF_LTOT);
    float* CIN = (float*)(p.ws + OFF_CIN);
    float2 ah[36];
#pragma unroll
    for (int st = 0; st < 36; ++st) {
        const int tl = st < 4 ? 256 + b * 4 + (d ? 3 - st : st) : b * 32 + (d ? 35 - st : st - 4);
        ah[st] = *(const float2*)(LTOT + (((size_t)d * 288 + tl) * 512 + c) * 2);
    }
    float s = 0.f;
#pragma unroll
    for (int st = 0; st < 36; ++st) {
        const int tl = st < 4 ? 256 + b * 4 + (d ? 3 - st : st) : b * 32 + (d ? 35 - st : st - 4);
        CIN[((size_t)d * 288 + tl) * 512 + c] = s;
        s = ah[st].x * s + ah[st].y;
    }
}
typedef unsigned nu32x4 __attribute__((ext_vector_type(4)));
struct DStage { nu32x4 k[2], q[2], kt[2], t, a, v, vc; };
__device__ __forceinline__ void delta_chain(const Params& p, int item, char* smem) {
    const int tid = hide_tid(), lane = tid & 63, wave = tid >> 6, l15 = lane & 15, lq = lane >> 4;
    const int chain = item >> 2, sl = item & 3;
    const int b = chain >> 3, h = (chain >> 1) & 3, dir = chain & 1;
    const int mi = wave >> 1, ni = wave & 1;
    const bf16_t* QG = (const bf16_t*)(p.ws + OFF_QG);
    const bf16_t* KG = (const bf16_t*)(p.ws + OFF_KG);
    const bf16_t* VG = (const bf16_t*)(p.ws + OFF_VG);
    const bf16_t* KTG = (const bf16_t*)(p.ws + OFF_KTG);
    const bf16_t* TT = (const bf16_t*)(p.ws + OFF_TT);
    const bf16_t* ATT = (const bf16_t*)(p.ws + OFF_ATT);
    const float* VEC = (const float*)(p.ws + OFF_VEC);
    bf16_t* OA = (bf16_t*)(p.ws + OFF_OA) + (size_t)dir * NT * 512;
    constexpr int SLD = 136, RLD = 72, VLD = 40;
    bf16_t* ST = (bf16_t*)smem;
    bf16_t* RT = ST + 32 * SLD;
    bf16_t* VNT = RT + 32 * RLD;
    bf16_t* VST = VNT + 32 * RLD;
    bf16_t* Kt = VST + 32 * RLD;
    bf16_t* Qt = Kt + 64 * SLD;
    bf16_t* KTt = Qt + 64 * SLD;
    bf16_t* Tt = KTt + 128 * RLD;
    bf16_t* At = Tt + 64 * RLD;
    bf16_t* Vt = At + 64 * RLD;
    float* Vc = (float*)(Vt + 64 * VLD);
    __syncthreads();
    for (int i = tid; i < 32 * SLD / 2; i += NTHR) ((unsigned*)ST)[i] = 0u;
    auto unit_of = [&](int s) -> int { const int cidx = dir ? (s < 4 ? 3 - s : 39 - s) : s; return (b * 4 + h) * 36 + cidx; };
    auto load = [&](int s, DStage& f) {
        const int u = unit_of(s);
        const size_t ub = (size_t)u * 8192;
#pragma unroll
        for (int i = 0; i < 2; ++i) {
            const int c = tid + i * NTHR;
            f.k[i] = *(const nu32x4*)(KG + ub + c * 8);
            f.q[i] = *(const nu32x4*)(QG + ub + c * 8);
            f.kt[i] = *(const nu32x4*)(KTG + ub + c * 8);
        }
        f.t = *(const nu32x4*)(TT + ((size_t)u * 2 + dir) * 4096 + tid * 8);
        f.a = *(const nu32x4*)(ATT + ((size_t)u * 2 + dir) * 4096 + tid * 8);
        f.v = *(const nu32x4*)(VG + ub + ((tid >> 2) & 63) * 128 + sl * 32 + (tid & 3) * 8);
        f.vc = *(const nu32x4*)(VEC + ((size_t)u * 2 + dir) * 320 + (tid % 80) * 4);
    };
    auto put = [&](const DStage& f) {
#pragma unroll
        for (int i = 0; i < 2; ++i) {
            const int c = tid + i * NTHR;
            *(nu32x4*)(Kt + (c >> 4) * SLD + (c & 15) * 8) = f.k[i];
            *(nu32x4*)(Qt + (c >> 4) * SLD + (c & 15) * 8) = f.q[i];
            *(nu32x4*)(KTt + (c >> 3) * RLD + (c & 7) * 8) = f.kt[i];
        }
        *(nu32x4*)(Tt + (tid >> 3) * RLD + (tid & 7) * 8) = f.t;
        *(nu32x4*)(At + (tid >> 3) * RLD + (tid & 7) * 8) = f.a;
        if (tid < 256) *(nu32x4*)(Vt + (tid >> 2) * VLD + (tid & 3) * 8) = f.v;
        if (tid < 80) *(nu32x4*)(Vc + tid * 4) = f.vc;
    };
    f32x4 Sacc[2];
    Sacc[0] = (f32x4){0.f, 0.f, 0.f, 0.f}; Sacc[1] = (f32x4){0.f, 0.f, 0.f, 0.f};
    DStage f0, f1, f2;
    load(0, f0);
    put(f0);
    load(1, f1);
    load(2, f2);
    __syncthreads();
    auto step = [&](int s, DStage& fnew, DStage& fput) {
        TSMARK();
        if (s + 3 < 36) load(s + 3, fnew);
        const f32x4 bt = *(const f32x4*)(Vc + 192 + mi * 16 + lq * 4), rs1 = *(const f32x4*)(Vc + mi * 16 + lq * 4);
        f32x4 kS = (f32x4){0.f, 0.f, 0.f, 0.f}, qS = (f32x4){0.f, 0.f, 0.f, 0.f};
#pragma unroll
        for (int kk = 0; kk < 4; ++kk) {
            const bf16x8 sb = *(const bf16x8*)(ST + (ni * 16 + l15) * SLD + kk * 32 + lq * 8);
            const bf16x8 kf = *(const bf16x8*)(Kt + (mi * 16 + l15) * SLD + kk * 32 + lq * 8);
            const bf16x8 qf = *(const bf16x8*)(Qt + (mi * 16 + l15) * SLD + kk * 32 + lq * 8);
            kS = __builtin_amdgcn_mfma_f32_16x16x32_bf16(kf, sb, kS, 0, 0, 0);
            qS = __builtin_amdgcn_mfma_f32_16x16x32_bf16(qf, sb, qS, 0, 0, 0);
        }
        {
            const bf16_t* vp = Vt + (mi * 16 + lq * 4) * VLD + ni * 16 + l15;
            const float r0 = bt[0] * bf2f(vp[0]) - rs1[0] * kS[0];
            const float r1 = bt[1] * bf2f(vp[VLD]) - rs1[1] * kS[1];
            const float r2 = bt[2] * bf2f(vp[2 * VLD]) - rs1[2] * kS[2];
            const float r3 = bt[3] * bf2f(vp[3 * VLD]) - rs1[3] * kS[3];
            uint2 w; w.x = pack2(r0, r1); w.y = pack2(r2, r3);
            *(uint2*)(RT + (ni * 16 + l15) * RLD + mi * 16 + lq * 4) = w;
        }
        __syncthreads();
        TSACC(5);
        const f32x4 rs3 = *(const f32x4*)(Vc + 128 + mi * 16 + lq * 4), rs2 = *(const f32x4*)(Vc + 64 + mi * 16 + lq * 4);
        const float egl = Vc[256];
        f32x4 vn = (f32x4){0.f, 0.f, 0.f, 0.f};
#pragma unroll
        for (int kk = 0; kk < 2; ++kk) {
            const bf16x8 rb = *(const bf16x8*)(RT + (ni * 16 + l15) * RLD + kk * 32 + lq * 8);
            const bf16x8 tf = *(const bf16x8*)(Tt + (mi * 16 + l15) * RLD + kk * 32 + lq * 8);
            vn = __builtin_amdgcn_mfma_f32_16x16x32_bf16(tf, rb, vn, 0, 0, 0);
        }
        {
            uint2 w; w.x = pack2(vn[0], vn[1]); w.y = pack2(vn[2], vn[3]);
            *(uint2*)(VNT + (ni * 16 + l15) * RLD + mi * 16 + lq * 4) = w;
            uint2 w2; w2.x = pack2(vn[0] * rs3[0], vn[1] * rs3[1]); w2.y = pack2(vn[2] * rs3[2], vn[3] * rs3[3]);
            *(uint2*)(VST + (ni * 16 + l15) * RLD + mi * 16 + lq * 4) = w2;
        }
        __syncthreads();
        TSACC(6);
        f32x4 o;
        o[0] = rs2[0] * qS[0]; o[1] = rs2[1] * qS[1]; o[2] = rs2[2] * qS[2]; o[3] = rs2[3] * qS[3];
#pragma unroll
        for (int kk = 0; kk < 2; ++kk) {
            const bf16x8 vb = *(const bf16x8*)(VNT + (ni * 16 + l15) * RLD + kk * 32 + lq * 8);
            const bf16x8 afr = *(const bf16x8*)(At + (mi * 16 + l15) * RLD + kk * 32 + lq * 8);
            o = __builtin_amdgcn_mfma_f32_16x16x32_bf16(afr, vb, o, 0, 0, 0);
        }
        {
            const int u = unit_of(s);
            const int cidx = u % 36;
            const int rowb = unit_row0(b, cidx) + mi * 16 + lq * 4;
            bf16_t* op = OA + (size_t)rowb * 512 + h * 128 + sl * 32 + ni * 16 + l15;
#pragma unroll
            for (int j = 0; j < 4; ++j) op[(size_t)j * 512] = f2bf(o[j]);
        }
#pragma unroll
        for (int n2 = 0; n2 < 2; ++n2) {
            Sacc[n2] = Sacc[n2] * egl;
#pragma unroll
            for (int kk = 0; kk < 2; ++kk) {
                const bf16x8 vb = *(const bf16x8*)(VST + (n2 * 16 + l15) * RLD + kk * 32 + lq * 8);
                const bf16x8 ktf = *(const bf16x8*)(KTt + (wave * 16 + l15) * RLD + kk * 32 + lq * 8);
                Sacc[n2] = __builtin_amdgcn_mfma_f32_16x16x32_bf16(ktf, vb, Sacc[n2], 0, 0, 0);
            }
        }
        __syncthreads();
#pragma unroll
        for (int n2 = 0; n2 < 2; ++n2) {
            uint2 w; w.x = pack2(Sacc[n2][0], Sacc[n2][1]); w.y = pack2(Sacc[n2][2], Sacc[n2][3]);
            *(uint2*)(ST + (n2 * 16 + l15) * SLD + wave * 16 + lq * 4) = w;
        }
        if (s + 1 < 36) put(fput);
        __syncthreads();
        TSACC(7);
    };
#pragma unroll 1
    for (int s = 0; s < 36; s += 3) { step(s, f0, f1); step(s + 1, f1, f2); step(s + 2, f2, f0); }
}

#define OFF_SCANQ (OFF_CNT + 1024)
__device__ __forceinline__ void ph_scan(const Params& p, char* smem, int rep = 0) {
    unsigned* q = (unsigned*)(p.ws + OFF_SCANQ) + (rep ? 16 : 0);
    int* slot = (int*)(smem + 150 * 1024);
    for (int round = blockIdx.x; round < 256; round += gridDim.x) {
        __syncthreads();
        if (hide_tid() == 0) {
            const unsigned x0 = xb_xcc_id() & 7u;
            int item = -1;
            for (unsigned t = 0; t < 8 && item < 0; ++t) {
                const unsigned x = (x0 + t) & 7u;
                if (xb_ld(&q[x]) < 32u) { const unsigned i = xb_add(&q[x], 1u); if (i < 32u) item = (int)(x * 32u + i); }
            }
            *slot = item;
        }
        __syncthreads();
        const int item = *slot;
        if (item >= 0) {
            const int xcd = item >> 5, j = item & 31;
            const int bh = xcd * 4 + (j >> 3), dir = (j >> 2) & 1, sl = j & 3;
            delta_chain(p, ((bh * 2 + dir) << 2) | sl, smem);
        }
    }
    if (!rep) for (int item = blockIdx.x; item < 16; item += gridDim.x) lru_carry(p, item);
}

struct MergeRow { unsigned oa0[4], oa1[4], gz[4], h0[4], h1[4], a0[4], a1[4], yz[4]; float2 c0[4], c1[4]; };
__device__ __forceinline__ void merge_load(const Params& p, int row, int lane, MergeRow& m) {
    const bf16_t* Z = (const bf16_t*)(p.ws + OFF_Z) + (size_t)row * ZW;
    const bf16_t* OA0 = (const bf16_t*)(p.ws + OFF_OA) + (size_t)row * 512;
    const bf16_t* OA1 = OA0 + (size_t)NT * 512;
    const bf16_t* HL0 = (const bf16_t*)(p.ws + OFF_HLOC) + (size_t)row * 512;
    const bf16_t* HL1 = HL0 + (size_t)NT * 512;
    const bf16_t* AC0 = (const bf16_t*)(p.ws + OFF_ACUM) + (size_t)row * 512;
    const bf16_t* AC1 = AC0 + (size_t)NT * 512;
    const int tl = row < NL ? (row >> 6) : 256 + ((row - NL) >> 6);
    const float* CIN0 = (const float*)(p.ws + OFF_CIN) + (size_t)tl * 512;
    const float* CIN1 = CIN0 + (size_t)288 * 512;
#pragma unroll
    for (int i = 0; i < 4; ++i) {
        const int c = i * 128 + lane * 2;
        m.oa0[i] = __builtin_nontemporal_load((const unsigned*)(OA0 + c)); m.oa1[i] = __builtin_nontemporal_load((const unsigned*)(OA1 + c));
        m.gz[i] = __builtin_nontemporal_load((const unsigned*)(Z + 1536 + c));
        m.h0[i] = __builtin_nontemporal_load((const unsigned*)(HL0 + c)); m.h1[i] = __builtin_nontemporal_load((const unsigned*)(HL1 + c));
        m.a0[i] = __builtin_nontemporal_load((const unsigned*)(AC0 + c)); m.a1[i] = __builtin_nontemporal_load((const unsigned*)(AC1 + c));
        m.yz[i] = __builtin_nontemporal_load((const unsigned*)(Z + 2560 + c));
        m.c0[i] = *(const float2*)(CIN0 + c); m.c1[i] = *(const float2*)(CIN1 + c);
    }
}
__device__ __forceinline__ void merge_compute(const Params& p, int row, int lane, const MergeRow& m, float on0, float on1) {
    bf16_t* M = (bf16_t*)(p.ws + OFF_H) + (size_t)row * 1024;
#pragma unroll
    for (int h = 0; h < 4; ++h) {
        const int c = h * 128 + lane * 2;
        const float o0 = bf2f((bf16_t)(m.oa0[h] & 0xffff)) + bf2f((bf16_t)(m.oa1[h] & 0xffff));
        const float o1 = bf2f((bf16_t)(m.oa0[h] >> 16)) + bf2f((bf16_t)(m.oa1[h] >> 16));
        const float ss = wave_sum(o0 * o0 + o1 * o1);
        const float rinv = frsq_(ss * (1.f / 128.f) + EPSF);
        const float y0 = o0 * rinv * on0 * siluf_(bf2f((bf16_t)(m.gz[h] & 0xffff)));
        const float y1 = o1 * rinv * on1 * siluf_(bf2f((bf16_t)(m.gz[h] >> 16)));
        *(unsigned*)(M + c) = pack2(y0, y1);
    }
#pragma unroll
    for (int i = 0; i < 4; ++i) {
        const int c = i * 128 + lane * 2;
        const float hx = (bf2f((bf16_t)(m.h0[i] & 0xffff)) + bf2f((bf16_t)(m.a0[i] & 0xffff)) * m.c0[i].x) + (bf2f((bf16_t)(m.h1[i] & 0xffff)) + bf2f((bf16_t)(m.a1[i] & 0xffff)) * m.c1[i].x);
        const float hy = (bf2f((bf16_t)(m.h0[i] >> 16)) + bf2f((bf16_t)(m.a0[i] >> 16)) * m.c0[i].y) + (bf2f((bf16_t)(m.h1[i] >> 16)) + bf2f((bf16_t)(m.a1[i] >> 16)) * m.c1[i].y);
        const float y0 = hx * geluf_(bf2f((bf16_t)(m.yz[i] & 0xffff)));
        const float y1 = hy * geluf_(bf2f((bf16_t)(m.yz[i] >> 16)));
        *(unsigned*)(M + 512 + c) = pack2(y0, y1);
    }
}
__device__ __forceinline__ void ph_merge(const Params& p, char* smem) {
    const int tid = hide_tid(), lane = tid & 63, wave = tid >> 6;
    const float on0 = p.in[I_ONORM][lane * 2], on1 = p.in[I_ONORM][lane * 2 + 1];
    for (int base = blockIdx.x * 16; base < NT; base += gridDim.x * 16) {
        const int r0 = base + wave * 2;
        MergeRow m0, m1;
        merge_load(p, r0, lane, m0);
        merge_load(p, r0 + 1, lane, m1);
        merge_compute(p, r0, lane, m0, on0, on1);
        merge_compute(p, r0 + 1, lane, m1, on0, on1);
    }
}

__device__ __forceinline__ void ph_qkprep(const Params& p, char* smem) {
    const int tid = hide_tid(), lane = tid & 63, wave = tid >> 6;
    const bf16_t* ZQ = (const bf16_t*)(p.ws + OFF_ZQ);
    const bf16_t* ZC = (const bf16_t*)(p.ws + OFF_ZC);
    bf16_t* QA = (bf16_t*)(p.ws + OFF_QA);
    bf16_t* KA = (bf16_t*)(p.ws + OFF_KA);
    bf16_t* VT = (bf16_t*)(p.ws + OFF_VT);
    const float* qn = p.in[I_QNORM];
    const float* kn = p.in[I_KNORM];
    for (int row = blockIdx.x * 8 + wave; row < NT; row += gridDim.x * 8) {
        const bool lat = row < NL;
        const int b = lat ? (row >> 11) : ((row - NL) >> 8);
        const int t = lat ? (row & 2047) : ((row - NL) & 255);
        const int key = lat ? t : (SEQ + t);
        float cs = 1.f, sn = 0.f;
        if (lat) {
            const int f = lane & 31;
            const float pos = (lane < 32) ? (float)(t >> 6) : (float)(t & 63);
            const float inv = __expf(-(float)f * (1.f / 32.f) * 9.210340371976184f);
            __sincosf(pos * inv, &sn, &cs);
        }
        const bf16_t* src = lat ? ZQ + (size_t)row * 1536 : ZC + (size_t)(row - NL) * 512;
        const int koff = lat ? 1024 : 0;
        if (lat) {
#pragma unroll
            for (int h = 0; h < 8; ++h) {
                const unsigned u = __builtin_nontemporal_load((const unsigned*)(src + h * 128 + lane * 2));
                float x1 = bf2f((bf16_t)(u & 0xffff)), x2 = bf2f((bf16_t)(u >> 16));
                const float ss = wave_sum(x1 * x1 + x2 * x2);
                const float rinv = frsq_(ss * (1.f / 128.f) + EPSF);
                x1 *= rinv * qn[lane * 2]; x2 *= rinv * qn[lane * 2 + 1];
                const float y1 = x1 * cs - x2 * sn;
                const float y2 = x1 * sn + x2 * cs;
                *(unsigned*)(QA + (size_t)row * 1024 + h * 128 + lane * 2) = pack2(y1, y2);
            }
        }
#pragma unroll
        for (int kh = 0; kh < 2; ++kh) {
            const unsigned u = __builtin_nontemporal_load((const unsigned*)(src + koff + kh * 128 + lane * 2));
            float x1 = bf2f((bf16_t)(u & 0xffff)), x2 = bf2f((bf16_t)(u >> 16));
            const float ss = wave_sum(x1 * x1 + x2 * x2);
            const float rinv = frsq_(ss * (1.f / 128.f) + EPSF);
            x1 *= rinv * kn[lane * 2]; x2 *= rinv * kn[lane * 2 + 1];
            const float y1 = x1 * cs - x2 * sn;
            const float y2 = x1 * sn + x2 * cs;
            *(unsigned*)(KA + ((size_t)(b * 2 + kh) * TSEQ + key) * 128 + lane * 2) = pack2(y1, y2);
            const unsigned uv = __builtin_nontemporal_load((const unsigned*)(src + koff + 256 + kh * 128 + lane * 2));
            *(unsigned*)(VT + ((size_t)(b * 2 + kh) * TSEQ + key) * 128 + lane * 2) = uv;
        }
    }
}

namespace att {
constexpr int D = 128, NW = 8, QBLK = 32, KVBLK = 64;
constexpr float SCALE = 0.088388347648318440f;
constexpr float THR = 8.f;
constexpr int LDQ = 1024, LDK = 128, LDO = 1024;
constexpr size_t SHM_V = KVBLK * D * 2, SHM_K = KVBLK * D * 2, SHM_ATTN = 2 * SHM_V + 2 * SHM_K + NW * 64 * 4;
using s16x4  = __attribute__((ext_vector_type(4))) short;
using f32x16 = __attribute__((ext_vector_type(16))) float;
using u32x4  = __attribute__((ext_vector_type(4))) unsigned;
#define KSWZ(row, colB) ((row) * 256 + ((colB) ^ (((row) & 7) << 4)))
#define SBAR() __builtin_amdgcn_sched_barrier(0)
__device__ __forceinline__ int crow(int r, int hi) { return (r & 3) + 8 * (r >> 2) + 4 * hi; }
__device__ __forceinline__ unsigned cvtpk(float lo, float hi) {
  unsigned r; asm volatile("v_cvt_pk_bf16_f32 %0, %1, %2" : "=v"(r) : "v"(lo), "v"(hi)); return r;
}
__device__ __forceinline__ void partialSM(f32x16& p0, f32x16& p1, float& m_reg, float& mn, float& alpha) {
  constexpr float C = SCALE * 1.4426950408889634f;
  float pmax = p0[0];
#pragma unroll
  for (int r = 1; r < 16; ++r) pmax = fmaxf(pmax, p0[r]);
#pragma unroll
  for (int r = 0; r < 16; ++r) pmax = fmaxf(pmax, p1[r]);
  { auto rr = __builtin_amdgcn_permlane32_swap(__float_as_uint(pmax), __float_as_uint(pmax), false, false);
    pmax = fmaxf(__uint_as_float(rr[0]), __uint_as_float(rr[1])); }
  if (__builtin_expect(__all(pmax - m_reg <= THR / SCALE), 1)) { mn = m_reg; alpha = 1.f; }
  else { mn = fmaxf(m_reg, pmax); alpha = __builtin_amdgcn_exp2f((m_reg - mn) * C); m_reg = mn; }
  float mnC = -mn * C;
#pragma unroll
  for (int r = 0; r < 16; ++r) p0[r] = fmaf(p0[r], C, mnC);
#pragma unroll
  for (int r = 0; r < 16; ++r) p1[r] = fmaf(p1[r], C, mnC);
#pragma unroll
  for (int r = 0; r < 16; ++r) p0[r] = __builtin_amdgcn_exp2f(p0[r]);
}
__device__ __forceinline__ void finishSM(f32x16& p0, f32x16& p1, float alpha, float& l_reg, bf16x8& pa0, bf16x8& pa1, bf16x8& pa2, bf16x8& pa3) {
#pragma unroll
  for (int r = 0; r < 16; ++r) p1[r] = __builtin_amdgcn_exp2f(p1[r]);
  float ps = 0;
#pragma unroll
  for (int r = 0; r < 16; ++r) ps += p0[r];
#pragma unroll
  for (int r = 0; r < 16; ++r) ps += p1[r];
  { auto rr = __builtin_amdgcn_permlane32_swap(__float_as_uint(ps), __float_as_uint(ps), false, false);
    ps = __uint_as_float(rr[0]) + __uint_as_float(rr[1]); }
  l_reg = l_reg * alpha + ps;
#define PK4(P, BASE, OUT) do { unsigned a0 = cvtpk(P[BASE + 0], P[BASE + 1]), a1 = cvtpk(P[BASE + 2], P[BASE + 3]);   \
    unsigned b0 = cvtpk(P[BASE + 4], P[BASE + 5]), b1 = cvtpk(P[BASE + 6], P[BASE + 7]);                              \
    auto r0 = __builtin_amdgcn_permlane32_swap(a0, b0, false, false); auto r1 = __builtin_amdgcn_permlane32_swap(a1, b1, false, false); \
    u32x4 w = {r0[0], r1[0], r0[1], r1[1]}; OUT = *reinterpret_cast<bf16x8*>(&w); } while (0)
  PK4(p0, 0, pa0); PK4(p0, 8, pa1); PK4(p1, 0, pa2); PK4(p1, 8, pa3);
#undef PK4
}
__device__ __forceinline__ void qkt(f32x16& p0, f32x16& p1, const bf16_t* Ks, const bf16x8* qr, int r32, int hi) {
  p0 = f32x16{}; p1 = f32x16{};
#pragma unroll
  for (int d0 = 0; d0 < 8; ++d0) { int cb = (d0 * 16 + hi * 8) * 2;
    bf16x8 b0 = *reinterpret_cast<const bf16x8*>((const char*)Ks + KSWZ(r32, cb));
    bf16x8 b1 = *reinterpret_cast<const bf16x8*>((const char*)Ks + KSWZ(32 + r32, cb));
    p0 = __builtin_amdgcn_mfma_f32_32x32x16_bf16(b0, qr[d0], p0, 0, 0, 0);
    p1 = __builtin_amdgcn_mfma_f32_32x32x16_bf16(b1, qr[d0], p1, 0, 0, 0); }
}
__device__ __forceinline__ int v_st(int k, int c) { const int kk = (k & ~0xC) | ((k & 4) << 1) | ((k & 8) >> 1); return ((kk >> 3) * 4 + (c >> 5)) * 512 + ((kk & 7) * 32 + (c & 31)) * 2; }
__device__ __forceinline__ int v_rd_base(int lane) { return ((lane & 3) << 3) | (((lane >> 2) & 3) << 6) | (((lane >> 4) & 1) << 5) | (((lane >> 5) & 1) << 8); }
constexpr int v_rd_off(int d0, int ks, int half) { return d0 * 512 + ks * 4096 + half * 2048; }
template <int OFF> __device__ __forceinline__ s16x4 tr_read(int vb) {
  s16x4 r; asm volatile("ds_read_b64_tr_b16 %0, %1 offset:%2" : "=&v"(r) : "v"(vb), "i"(OFF) : "memory"); return r;
}
template <int D0> __device__ __forceinline__ void pv_one(f32x16& od, int vb, bf16x8 pa0, bf16x8 pa1, bf16x8 pa2, bf16x8 pa3) {
  const s16x4 l0 = tr_read<v_rd_off(D0, 0, 0)>(vb), h0 = tr_read<v_rd_off(D0, 0, 1)>(vb), l1 = tr_read<v_rd_off(D0, 1, 0)>(vb), h1 = tr_read<v_rd_off(D0, 1, 1)>(vb);
  const s16x4 l2 = tr_read<v_rd_off(D0, 2, 0)>(vb), h2 = tr_read<v_rd_off(D0, 2, 1)>(vb), l3 = tr_read<v_rd_off(D0, 3, 0)>(vb), h3 = tr_read<v_rd_off(D0, 3, 1)>(vb);
  asm volatile("s_waitcnt lgkmcnt(0)" ::: "memory"); SBAR();
#define PK(L, H) (bf16x8){L[0], L[1], L[2], L[3], H[0], H[1], H[2], H[3]}
  od = __builtin_amdgcn_mfma_f32_32x32x16_bf16(pa0, PK(l0, h0), od, 0, 0, 0);
  od = __builtin_amdgcn_mfma_f32_32x32x16_bf16(pa1, PK(l1, h1), od, 0, 0, 0);
  od = __builtin_amdgcn_mfma_f32_32x32x16_bf16(pa2, PK(l2, h2), od, 0, 0, 0);
  od = __builtin_amdgcn_mfma_f32_32x32x16_bf16(pa3, PK(l3, h3), od, 0, 0, 0);
#undef PK
}
__device__ __forceinline__ void pv_d0(f32x16* o, int vb, bf16x8 pa0, bf16x8 pa1, bf16x8 pa2, bf16x8 pa3) {
  pv_one<0>(o[0], vb, pa0, pa1, pa2, pa3); pv_one<1>(o[1], vb, pa0, pa1, pa2, pa3); pv_one<2>(o[2], vb, pa0, pa1, pa2, pa3); pv_one<3>(o[3], vb, pa0, pa1, pa2, pa3);
}
__device__ __forceinline__ void attn_dense_body(const bf16_t* __restrict__ Qb, const bf16_t* __restrict__ Kh, const bf16_t* __restrict__ Vh,
                                                bf16_t* __restrict__ Ob, int seq, char* lds) {
  const int tid = hide_tid(), wid = tid >> 6, lane = tid & 63, r32 = lane & 31, hi = lane >> 5;
  bf16_t* V_lds = (bf16_t*)lds; bf16_t* K_lds = (bf16_t*)(lds + 2 * SHM_V);
  float* ws = (float*)(lds + 2 * SHM_V + 2 * SHM_K) + wid * 64; float* li_l = ws; float* al_l = ws + 32;
  float m_reg = -1e30f, l_reg = 0; f32x16 o[4] = {}; bf16x8 qr[8];
  const bf16_t* Qw = Qb + (long)(wid * QBLK + r32) * LDQ + hi * 8;
#pragma unroll
  for (int d0 = 0; d0 < 8; ++d0) qr[d0] = *reinterpret_cast<const bf16x8*>(Qw + d0 * 16);
  const int sr = tid >> 4, sc = (tid & 15) * 8, vst0 = v_st(sr, sc), vst1 = v_st(32 + sr, sc);
  const int vb0 = (int)(uintptr_t)V_lds + v_rd_base(lane);
  struct { bf16x8 vs0, vs1, ks0, ks1; } sr_[2];
#define SLOAD(i, k0) do { sr_[i].vs0 = *reinterpret_cast<const bf16x8*>(&Vh[(long)((k0) + sr) * LDK + sc]); sr_[i].vs1 = *reinterpret_cast<const bf16x8*>(&Vh[(long)((k0) + 32 + sr) * LDK + sc]); \
    sr_[i].ks0 = *reinterpret_cast<const bf16x8*>(&Kh[(long)((k0) + sr) * LDK + sc]); sr_[i].ks1 = *reinterpret_cast<const bf16x8*>(&Kh[(long)((k0) + 32 + sr) * LDK + sc]); } while (0)
#define SWRITE(b, i) do { *(bf16x8*)((char*)V_lds + (b) * SHM_V + vst0) = sr_[i].vs0;          \
    *(bf16x8*)((char*)V_lds + (b) * SHM_V + vst1) = sr_[i].vs1; int kc = sc * 2;               \
    *(bf16x8*)((char*)K_lds + (b) * SHM_K + KSWZ(sr, kc)) = sr_[i].ks0;                       \
    *(bf16x8*)((char*)K_lds + (b) * SHM_K + KSWZ(32 + sr, kc)) = sr_[i].ks1; } while (0)
#define SWAIT() asm volatile("s_waitcnt vmcnt(4)" ::: "memory")
#define RESC(a) do { if (__any((a) < 1.f)) { if (hi == 0) al_l[r32] = (a); asm volatile("s_waitcnt lgkmcnt(0)" ::: "memory"); \
    _Pragma("unroll") for (int d = 0; d < 4; ++d) _Pragma("unroll") for (int r = 0; r < 16; ++r) o[d][r] *= al_l[crow(r, hi)]; } } while (0)
  f32x16 pA0, pA1, pB0, pB1; float mnA, mnB, alA, alB; bf16x8 pa0, pa1, pa2, pa3; const int NKT = seq / KVBLK;
  constexpr int SE = 0, SO = 1;
  SLOAD(SE, 0); asm volatile("s_waitcnt vmcnt(0)" ::: "memory"); SWRITE(0, SE); __syncthreads();
  qkt(pA0, pA1, K_lds, qr, r32, hi); partialSM(pA0, pA1, m_reg, mnA, alA);
  SLOAD(SO, KVBLK); if (2 < NKT) SLOAD(SE, 2 * KVBLK);
  SWAIT(); SWRITE(1, SO); __syncthreads();
  for (int j = 1; j + 1 < NKT; j += 2) {
    SBAR(); qkt(pB0, pB1, (bf16_t*)((char*)K_lds + SHM_K), qr, r32, hi);
    finishSM(pA0, pA1, alA, l_reg, pa0, pa1, pa2, pa3); SBAR();
    SLOAD(SO, (j + 2) * KVBLK); SBAR();
    pv_d0(o, vb0, pa0, pa1, pa2, pa3); partialSM(pB0, pB1, m_reg, mnB, alB);
    __syncthreads(); SWAIT(); SWRITE(0, SE);
    RESC(alB); __syncthreads();
    SBAR(); qkt(pA0, pA1, K_lds, qr, r32, hi);
    finishSM(pB0, pB1, alB, l_reg, pa0, pa1, pa2, pa3); SBAR();
    if (j + 3 < NKT) SLOAD(SE, (j + 3) * KVBLK); SBAR();
    pv_d0(o, vb0 + (int)SHM_V, pa0, pa1, pa2, pa3); partialSM(pA0, pA1, m_reg, mnA, alA);
    __syncthreads(); SWAIT(); SWRITE(1, SO);
    RESC(alA); __syncthreads();
  }
  SBAR(); qkt(pB0, pB1, (bf16_t*)((char*)K_lds + SHM_K), qr, r32, hi);
  finishSM(pA0, pA1, alA, l_reg, pa0, pa1, pa2, pa3); SBAR();
  pv_d0(o, vb0, pa0, pa1, pa2, pa3); partialSM(pB0, pB1, m_reg, mnB, alB);
  __syncthreads(); RESC(alB);
  finishSM(pB0, pB1, alB, l_reg, pa0, pa1, pa2, pa3); SBAR();
  pv_d0(o, vb0 + (int)SHM_V, pa0, pa1, pa2, pa3);
  if (hi == 0) li_l[r32] = l_reg; asm volatile("s_waitcnt lgkmcnt(0)" ::: "memory");
  bf16_t* Ow = Ob + (long)(wid * QBLK) * LDO + r32;
#pragma unroll
  for (int r = 0; r < 16; ++r) { const int orow = crow(r, hi); const float rl = __builtin_amdgcn_rcpf(li_l[orow]);
#pragma unroll
    for (int d0 = 0; d0 < 4; ++d0) Ow[(long)orow * LDO + d0 * 32] = (bf16_t)cvtpk(o[d0][r] * rl, 0.f); }
  __syncthreads();
#undef SLOAD
#undef SWRITE
#undef SWAIT
#undef RESC
}
#undef KSWZ
#undef SBAR
}

__device__ __forceinline__ void ph_attn(const Params& p, char* smem) {
    const bf16_t* QA = (const bf16_t*)(p.ws + OFF_QA);
    const bf16_t* KA = (const bf16_t*)(p.ws + OFF_KA);
    const bf16_t* VA = (const bf16_t*)(p.ws + OFF_VT);
    bf16_t* O = (bf16_t*)(p.ws + OFF_O);
    for (int it = blockIdx.x; it < 8 * 8 * 8; it += gridDim.x) {
        const int b = it & 7, j = it >> 3;
        const int qb = j & 7, h = (j >> 3) & 7, kvh = h >> 2;
        const size_t qoff = (size_t)(b * SEQ + qb * 256) * 1024 + h * 128;
        const size_t koff = (size_t)(b * 2 + kvh) * TSEQ * 128;
        att::attn_dense_body(QA + qoff, KA + koff, VA + koff, O + qoff, TSEQ, smem);
    }
}

#define N_PHASES 19
template <int PH>
__device__ __forceinline__ void run_phase(const Params& p, LAS unsigned char* lds, int rep = 0) {
    char* smem = (char*)lds;
    if (PH == 0) { if (!(rep && REP_SUB == 2)) ph_ada(p, smem); if (!(rep && REP_SUB == 1)) cvt_dense(p, smem); }
    else if (PH == 1) ph_rows<0>(p, smem);
    else if (PH == 2) ph_gemm_in(p, lds);
    else if (PH == 3) ph_prep(p, smem, rep);
    else if (PH == 4) ph_scan(p, smem, rep);
    else if (PH == 5) ph_merge(p, smem);
    else if (PH == 6) { ph_gemm_out<0>(p, lds); cvt_moe<true, 0, 1>(p, 0, smem); }
    else if (PH == 7) ph_rows<1>(p, smem);
    else if (PH == 8) { ph_moe_up(p, 0, lds); cvt_moe<true, 1, 1>(p, 0, smem); }
    else if (PH == 9) { ph_moe_down(p, 0, lds); cvt_moe<true, 0, 1>(p, 1, smem, moe_units_short((const LAS int*)(lds + LDS_PRE))); }
    else if (PH == 10) ph_rows<2>(p, smem);
    else if (PH == 11) { ph_gemm_qkv(p, lds); cvt_moe<true, 0, 1>(p, 1, smem, ((int)blockIdx.x + (int)gridDim.x < 400) ? 0 : 2); }
    else if (PH == 12) { if (!(rep && REP_SUB == 2)) ph_qkprep(p, smem); if (!(rep && REP_SUB == 1)) cvt_moe<true, 0, 1>(p, 1, smem); }
    else if (PH == 13) ph_attn(p, smem);
    else if (PH == 14) ph_gemm_out<1>(p, lds);
    else if (PH == 15) ph_rows<3>(p, smem);
    else if (PH == 16) { ph_moe_up(p, 1, lds); cvt_moe<true, 1, 1>(p, 1, smem); }
    else if (PH == 17) ph_moe_down(p, 1, lds);
    else if (PH == 18) ph_rows<4>(p, smem);
}

template <int PH>
__global__ void __launch_bounds__(NTHR, 2) k_phase(Params p) {
    run_phase<PH>(p, (LAS unsigned char*)dyn_lds);
}

#if ONE_LAUNCH
template <int PH>
__device__ __forceinline__ void run_all(const Params& p, LAS unsigned char* lds, const XcdBarrier& bar) {
    if (PH == REP_PH) {
        int nrep = 2; asm volatile("" : "+s"(nrep));
#pragma unroll 1
        for (int r = 0; r < nrep; ++r) { run_phase<PH>(p, lds, r); if (r + 1 < nrep) xcd_barrier(bar); }
    } else run_phase<PH>(p, lds);
    if (PH + 1 < N_PHASES) {
        xcd_barrier(bar);
        if (TS_PH > -2 && blockIdx.x == 0 && threadIdx.x == 0) ((LAS unsigned long long*)(lds + LDS_TS))[PH + 1] = __builtin_amdgcn_s_memrealtime();
        run_all<(PH + 1 < N_PHASES) ? PH + 1 : PH>(p, lds, bar);
    }
}
template <>
__device__ __forceinline__ void run_all<N_PHASES - 1>(const Params& p, LAS unsigned char* lds, const XcdBarrier& bar) {
    if (N_PHASES - 1 == REP_PH) {
        int nrep = 2; asm volatile("" : "+s"(nrep));
#pragma unroll 1
        for (int r = 0; r < nrep; ++r) { run_phase<N_PHASES - 1>(p, lds, r); if (r + 1 < nrep) xcd_barrier(bar); }
    } else run_phase<N_PHASES - 1>(p, lds);
}

__global__ void __launch_bounds__(NTHR, 2) k_mega(Params p) {
    LAS unsigned char* lds = (LAS unsigned char*)dyn_lds;
    if (threadIdx.x < 4) ((LAS unsigned*)(lds + LDS_XB))[threadIdx.x] = 0u;
    __syncthreads();
    XcdBarrier bar = xcd_barrier_post((unsigned*)(p.ws + OFF_ZERO), (volatile LAS unsigned*)(lds + LDS_XB));
    if (TS_PH > -2 && blockIdx.x == 0 && threadIdx.x == 0) { LAS unsigned long long* ts = (LAS unsigned long long*)(lds + LDS_TS); for (int i = 0; i < 40; ++i) ts[i] = 0ull; ts[0] = __builtin_amdgcn_s_memrealtime(); }
    run_all<0>(p, lds, bar);
    if (TS_PH >= 100) {
        __syncthreads();
        if (blockIdx.x == 0 && threadIdx.x == 0) {
            LAS unsigned long long* ts = (LAS unsigned long long*)(lds + LDS_TS);
            const unsigned long long now = __builtin_amdgcn_s_memrealtime();
            const unsigned long long d = ts[24 + (TS_PH - 100)];
            while (__builtin_amdgcn_s_memrealtime() - now < 10ull * d) __builtin_amdgcn_s_sleep(8);
        }
    } else if (TS_PH >= 0) {
        __syncthreads();
        if (blockIdx.x == 0 && threadIdx.x == 0) {
            LAS unsigned long long* ts = (LAS unsigned long long*)(lds + LDS_TS);
            const unsigned long long now = __builtin_amdgcn_s_memrealtime();
            if (TS_PH == N_PHASES - 1) ts[N_PHASES] = now;
            const unsigned long long d = ts[TS_PH + 1] - ts[TS_PH];
            while (__builtin_amdgcn_s_memrealtime() - now < 10ull * d) __builtin_amdgcn_s_sleep(8);
        }
    }
}
#endif

template <int PH>
static void launch_phases(const Params& p, hipStream_t stream) {
    static bool attr_set = false;
    if (!attr_set) { (void)hipFuncSetAttribute((const void*)k_phase<PH>, hipFuncAttributeMaxDynamicSharedMemorySize, DYN_LDS); attr_set = true; }
    hipLaunchKernelGGL(k_phase<PH>, dim3(256), dim3(NTHR), DYN_LDS, stream, p);
    if constexpr (PH + 1 < N_PHASES) launch_phases<PH + 1>(p, stream);
}

extern "C" void kernel_launch(void* const* d_in, const int* in_sizes, int n_in, void* d_out, int out_size, void* d_ws,
                              size_t ws_size, hipStream_t stream) {
    Params p{};
    for (int i = 0; i < 32; ++i) p.in[i] = (const float*)d_in[i];
    p.out = (float*)d_out;
    p.ws = (char*)d_ws;
    (void)hipMemsetAsync(d_ws, 0, ZERO_BYTES, stream);
#if ONE_LAUNCH
    static int grid = 0;
    if (!grid) {
        int dev = 0, cus = 0, per_cu = 0;
        (void)hipGetDevice(&dev);
        (void)hipDeviceGetAttribute(&cus, hipDeviceAttributeMultiprocessorCount, dev);
        (void)hipFuncSetAttribute((const void*)k_mega, hipFuncAttributeMaxDynamicSharedMemorySize, DYN_LDS);
        (void)hipOccupancyMaxActiveBlocksPerMultiprocessor(&per_cu, k_mega, NTHR, DYN_LDS);
        if (cus <= 0) cus = 256;
        grid = cus * (per_cu < 1 ? per_cu : 1);
        if (grid <= 0) grid = cus;
    }
    hipLaunchKernelGGL(k_mega, dim3(grid), dim3(NTHR), DYN_LDS, stream, p);
#else
    launch_phases<0>(p, stream);
#endif
}
```
